# Optimizing an MI355X kernel written in HIP

```python
import math
import jax, jax.numpy as jnp
from jax import lax
import numpy as np

D_MODEL = 1024
BATCH = 4
SEQ = 8192
DEPTH = 2

N_A_LAYERS = DEPTH // 2
N_B_LAYERS = DEPTH - N_A_LAYERS
D_FF = 2816
CONV_WIDTH = 3
N_HEADS = 16
N_KV_GROUPS = 4
HEADS_PER_GROUP = N_HEADS // N_KV_GROUPS
HEAD_DIM = D_MODEL // N_HEADS
N_BRANCH = 3
CMP_BLOCK = 32
CMP_STRIDE = 16
CMP_HIDDEN = 2 * HEAD_DIM
SLC_BLOCK = 64
N_SELECT = 16
WINDOW = 512
Q_BLOCK = 128
N_BUCKETS = 32
MAX_EXACT = N_BUCKETS // 2
MAX_DISTANCE = 4096
EPS = 1e-6
NEG = -1e30
BIG = 1e30

kernel_name = "yoco_shortconv_nsa_macaron"


def rmsnorm(x, g):
    xf = x.astype(jnp.float32)
    y = xf * lax.rsqrt(jnp.mean(xf * xf, axis=-1, keepdims=True) + EPS)
    return (y * g.astype(jnp.float32)).astype(x.dtype)


def swiglu_ffn(x, w_in, w_out):
    gate, up = jnp.split(x @ w_in, 2, axis=-1)
    return (jax.nn.silu(gate) * up) @ w_out


def rel_bucket(rel):
    n = jnp.maximum(rel, 0)
    nf = jnp.maximum(n, 1).astype(jnp.float32)
    large = MAX_EXACT + (jnp.log(nf / MAX_EXACT) / math.log(MAX_DISTANCE / MAX_EXACT)
                         * (N_BUCKETS - MAX_EXACT)).astype(jnp.int32)
    large = jnp.minimum(large, N_BUCKETS - 1)
    return jnp.where(n < MAX_EXACT, n, large)


def short_conv_mixer(x, w_in, conv_w, w_out):
    b_gate, c_gate, v = jnp.split(x @ w_in, 3, axis=-1)
    u = c_gate * v
    y = lax.conv_general_dilated(u, conv_w[:, None, :], window_strides=(1,),
                                 padding=[(CONV_WIDTH - 1, 0)],
                                 dimension_numbers=('NWC', 'WIO', 'NWC'),
                                 feature_group_count=D_MODEL)
    return (b_gate * y) @ w_out


def compress(raw, pe, w1, w2):
    bsz, s = raw.shape[0], raw.shape[1]
    nc = (s - CMP_BLOCK) // CMP_STRIDE + 1
    idx = jnp.arange(nc)[:, None] * CMP_STRIDE + jnp.arange(CMP_BLOCK)[None, :]
    blk = raw[:, idx] + pe[None, None, :, None, :]
    blk = blk.transpose(0, 3, 1, 2, 4).reshape(bsz, N_KV_GROUPS, nc, CMP_BLOCK * HEAD_DIM)
    return jax.nn.gelu(blk @ w1) @ w2


def shared_kv(h, kv_norm, w_kv, k_norm, pe_k, pe_v, w1_k, w2_k, w1_v, w2_v):
    bsz, s, _ = h.shape
    kv = (rmsnorm(h, kv_norm) @ w_kv).reshape(bsz, s, N_BRANCH, 2, N_KV_GROUPS, HEAD_DIM)
    k_c = rmsnorm(compress(kv[:, :, 0, 0], pe_k, w1_k, w2_k), k_norm[0])
    v_c = compress(kv[:, :, 0, 1], pe_v, w1_v, w2_v)
    ns = s // SLC_BLOCK
    k_s = rmsnorm(kv[:, :, 1, 0], k_norm[1]).transpose(0, 2, 1, 3).reshape(bsz, N_KV_GROUPS, ns, SLC_BLOCK, HEAD_DIM)
    v_s = kv[:, :, 1, 1].transpose(0, 2, 1, 3).reshape(bsz, N_KV_GROUPS, ns, SLC_BLOCK, HEAD_DIM)
    pad = ((0, 0), (0, 0), (WINDOW, 0), (0, 0))
    k_w = jnp.pad(rmsnorm(kv[:, :, 2, 0], k_norm[2]).transpose(0, 2, 1, 3), pad)
    v_w = jnp.pad(kv[:, :, 2, 1].transpose(0, 2, 1, 3), pad)
    return k_c, v_c, k_s, v_s, k_w, v_w


def masked_softmax(s, mask):
    return jax.nn.softmax(jnp.where(mask, s.astype(jnp.float32), NEG), axis=-1)


def nsa_mixer(x, w_q, q_norm, w_o, rel_bias, kv):
    k_c, v_c, k_s, v_s, k_w, v_w = kv
    bsz, s, _ = x.shape
    G, HG, dh = N_KV_GROUPS, HEADS_PER_GROUP, HEAD_DIM
    proj = x @ w_q
    q = rmsnorm(proj[..., :N_HEADS * dh].reshape(bsz, s, G, HG, dh), q_norm)
    q = q.transpose(0, 2, 3, 1, 4)
    gates = jax.nn.sigmoid(proj[..., N_HEADS * dh:].astype(jnp.float32))
    gates = gates.reshape(bsz, s, G, HG, N_BRANCH).transpose(0, 2, 3, 1, 4).astype(x.dtype)
    nc, ns = k_c.shape[2], k_s.shape[2]
    n_sel = min(N_SELECT, ns)
    scale = HEAD_DIM ** -0.5
    c_start = jnp.arange(nc) * CMP_STRIDE
    c_end = c_start + CMP_BLOCK - 1
    s_start = jnp.arange(ns) * SLC_BLOCK
    overlap = (jnp.clip(jnp.minimum(c_start[:, None] + CMP_BLOCK, s_start[None, :] + SLC_BLOCK)
                        - jnp.maximum(c_start[:, None], s_start[None, :]), 0) / CMP_STRIDE).astype(jnp.float32)
    bias_grp = rel_bias.reshape(N_BUCKETS, G, HG).transpose(1, 0, 2)
    bi = jnp.arange(bsz)[:, None, None, None]
    gi = jnp.arange(G)[None, :, None, None]
    blk_ids = jnp.arange(ns)

    def head_bias(rel):
        return rel_bias[rel_bucket(rel)].reshape(rel.shape + (G, HG)).transpose(2, 3, 0, 1)

    def block(qb):
        q0 = qb * Q_BLOCK
        qblk = lax.dynamic_slice_in_dim(q, q0, Q_BLOCK, axis=3)
        gblk = lax.dynamic_slice_in_dim(gates, q0, Q_BLOCK, axis=3)
        t = q0 + jnp.arange(Q_BLOCK)
        rel_c = t[:, None] - c_end[None, :]
        s_c = jnp.einsum('bghqd,bgnd->bghqn', qblk, k_c) * scale + head_bias(rel_c)
        p_c = masked_softmax(s_c, rel_c >= 0)
        p_c = jnp.where((t >= CMP_BLOCK - 1)[:, None], p_c, 0.0)
        o_c = jnp.einsum('bghqn,bgnd->bghqd', p_c.astype(v_c.dtype), v_c)
        imp = jnp.einsum('bghqn,nj->bgqj', p_c, overlap)
        blk_t = t // SLC_BLOCK
        valid = blk_ids[None, :] <= blk_t[:, None]
        forced = ((blk_ids[None, :] == 0) | (blk_ids[None, :] == blk_t[:, None])
                  | (blk_ids[None, :] == blk_t[:, None] - 1))
        score = jnp.where(valid, jnp.where(forced, BIG, imp), NEG)
        _, idx = lax.top_k(score, n_sel)
        k_sel = k_s[bi, gi, idx].reshape(bsz, G, Q_BLOCK, n_sel * SLC_BLOCK, dh)
        v_sel = v_s[bi, gi, idx].reshape(bsz, G, Q_BLOCK, n_sel * SLC_BLOCK, dh)
        pos = (idx[..., None] * SLC_BLOCK + jnp.arange(SLC_BLOCK)).reshape(bsz, G, Q_BLOCK, n_sel * SLC_BLOCK)
        rel_s = t[None, None, :, None] - pos
        bias_s = bias_grp[gi, rel_bucket(rel_s)].transpose(0, 1, 4, 2, 3)
        s_s = jnp.einsum('bghqd,bgqkd->bghqk', qblk, k_sel) * scale + bias_s
        p_s = masked_softmax(s_s, (rel_s >= 0)[:, :, None])
        o_s = jnp.einsum('bghqk,bgqkd->bghqd', p_s.astype(v_sel.dtype), v_sel)
        k_wb = lax.dynamic_slice_in_dim(k_w, q0, Q_BLOCK + WINDOW, axis=2)
        v_wb = lax.dynamic_slice_in_dim(v_w, q0, Q_BLOCK + WINDOW, axis=2)
        s_pos = q0 - WINDOW + jnp.arange(Q_BLOCK + WINDOW)
        rel_w = t[:, None] - s_pos[None, :]
        mask_w = (rel_w >= 0) & (rel_w < WINDOW) & (s_pos >= 0)[None, :]
        s_w = jnp.einsum('bghqd,bgkd->bghqk', qblk, k_wb) * scale + head_bias(rel_w)
        p_w = masked_softmax(s_w, mask_w)
        o_w = jnp.einsum('bghqk,bgkd->bghqd', p_w.astype(v_wb.dtype), v_wb)
        return gblk[..., 0:1] * o_c + gblk[..., 1:2] * o_s + gblk[..., 2:3] * o_w

    out = lax.map(block, jnp.arange(s // Q_BLOCK))
    out = out.transpose(1, 0, 4, 2, 3, 5).reshape(bsz, s, N_HEADS * dh)
    return out @ w_o


def setup_inputs(seed: int = 0) -> dict:
    key = jax.random.key(seed)
    ks = jax.random.split(key, 32)

    def w(k, shape, fan_in):
        return jax.random.normal(k, shape, jnp.float32) * (fan_in ** -0.5)

    def gain(k, shape):
        return 1.0 + 0.02 * jax.random.normal(k, shape, jnp.float32)

    q_cols = N_HEADS * HEAD_DIM + N_BRANCH * N_HEADS
    kv_cols = N_BRANCH * 2 * N_KV_GROUPS * HEAD_DIM
    return {
        'x': jax.random.normal(ks[0], (BATCH, SEQ, D_MODEL), jnp.float32),
        'ffn1_norm': gain(ks[1], (DEPTH, D_MODEL)),
        'ffn1_w_in': w(ks[2], (DEPTH, D_MODEL, 2 * D_FF), D_MODEL),
        'ffn1_w_out': w(ks[3], (DEPTH, D_FF, D_MODEL), D_FF),
        'mix_norm': gain(ks[4], (DEPTH, D_MODEL)),
        'ffn2_norm': gain(ks[5], (DEPTH, D_MODEL)),
        'ffn2_w_in': w(ks[6], (DEPTH, D_MODEL, 2 * D_FF), D_MODEL),
        'ffn2_w_out': w(ks[7], (DEPTH, D_FF, D_MODEL), D_FF),
        'conv_w_in': w(ks[8], (N_A_LAYERS, D_MODEL, 3 * D_MODEL), D_MODEL),
        'conv_w': w(ks[9], (N_A_LAYERS, CONV_WIDTH, D_MODEL), CONV_WIDTH),
        'conv_w_out': w(ks[10], (N_A_LAYERS, D_MODEL, D_MODEL), D_MODEL),
        'attn_w_q': w(ks[11], (N_B_LAYERS, D_MODEL, q_cols), D_MODEL),
        'attn_q_norm': gain(ks[12], (N_B_LAYERS, HEAD_DIM)),
        'attn_w_o': w(ks[13], (N_B_LAYERS, N_HEADS * HEAD_DIM, D_MODEL), N_HEADS * HEAD_DIM),
        'kv_norm': gain(ks[14], (D_MODEL,)),
        'w_kv': w(ks[15], (D_MODEL, kv_cols), D_MODEL),
        'k_norm': gain(ks[16], (N_BRANCH, HEAD_DIM)),
        'cmp_pe_k': 0.1 * jax.random.normal(ks[17], (CMP_BLOCK, HEAD_DIM), jnp.float32),
        'cmp_pe_v': 0.1 * jax.random.normal(ks[18], (CMP_BLOCK, HEAD_DIM), jnp.float32),
        'cmp_w1_k': w(ks[19], (CMP_BLOCK * HEAD_DIM, CMP_HIDDEN), CMP_BLOCK * HEAD_DIM),
        'cmp_w2_k': w(ks[20], (CMP_HIDDEN, HEAD_DIM), CMP_HIDDEN),
        'cmp_w1_v': w(ks[21], (CMP_BLOCK * HEAD_DIM, CMP_HIDDEN), CMP_BLOCK * HEAD_DIM),
        'cmp_w2_v': w(ks[22], (CMP_HIDDEN, HEAD_DIM), CMP_HIDDEN),
        'rel_bias': 0.5 * jax.random.normal(ks[23], (N_BUCKETS, N_HEADS), jnp.float32),
    }


def reference(x, ffn1_norm, ffn1_w_in, ffn1_w_out, mix_norm, ffn2_norm, ffn2_w_in, ffn2_w_out,
              conv_w_in, conv_w, conv_w_out, attn_w_q, attn_q_norm, attn_w_o,
              kv_norm, w_kv, k_norm, cmp_pe_k, cmp_pe_v, cmp_w1_k, cmp_w2_k, cmp_w1_v, cmp_w2_v,
              rel_bias):
    h = x
    kv = None
    for i in range(DEPTH):
        if i == N_A_LAYERS:
            kv = shared_kv(h, kv_norm, w_kv, k_norm, cmp_pe_k, cmp_pe_v,
                           cmp_w1_k, cmp_w2_k, cmp_w1_v, cmp_w2_v)
        h = h + 0.5 * swiglu_ffn(rmsnorm(h, ffn1_norm[i]), ffn1_w_in[i], ffn1_w_out[i])
        hn = rmsnorm(h, mix_norm[i])
        if i < N_A_LAYERS:
            h = h + short_conv_mixer(hn, conv_w_in[i], conv_w[i], conv_w_out[i])
        else:
            j = i - N_A_LAYERS
            h = h + nsa_mixer(hn, attn_w_q[j], attn_q_norm[j], attn_w_o[j], rel_bias, kv)
        h = h + 0.5 * swiglu_ffn(rmsnorm(h, ffn2_norm[i]), ffn2_w_in[i], ffn2_w_out[i])
    return h
```

```cpp
#include <hip/hip_runtime.h>
#include <hip/hip_cooperative_groups.h>
#include <cstdio>
#include <cstdint>
#include <type_traits>
namespace cg = cooperative_groups;
namespace pg8 {
#define PG8_LAS __attribute__((address_space(3)))
typedef unsigned short bf16_t;
typedef short bf16x8 __attribute__((ext_vector_type(8)));
typedef float f32x4 __attribute__((ext_vector_type(4)));
typedef unsigned u32x4 __attribute__((ext_vector_type(4)));
constexpr int BM = 256, BK = 64, HALF = 128, HTB = HALF * BK * 2  , STAGE_BYTES = 8 * HTB, NXCD = 8, WGM = 8;

__host__ __device__ __forceinline__ int lds_byte(int r, int c) { const int st = (r >> 4) * 2 + (c >> 5), rr = r & 15, cc = c & 31, ob = rr * 64 + cc * 2; return st * 1024 + (ob ^ (((ob >> 9) & 1) << 5)); }
__host__ __device__ __forceinline__ void stage_rc(int b, int& R, int& C) { const int st = b / 1024, sb = b % 1024, swz = sb ^ (((sb >> 9) & 1) << 5); R = (st >> 1) * 16 + swz / 64; C = (st & 1) * 32 + (swz % 64) / 2; }
__host__ __device__ __forceinline__ int perm32(int rho) { const int n = rho >> 4, i = rho & 15; return 8 * (i >> 2) + 4 * n + (i & 3); }

struct Unit { int pm, pn; };
struct Gemm { const bf16_t* A; const bf16_t* Bt; int M, N, K; };

struct StaticOrder {
    int nM, nN, nwg, G, c;
    __host__ __device__ void init(int M, int N, int G_, int c_) { nM = M / BM; nN = N / BM; nwg = nM * nN; G = G_; c = c_; }
    __host__ __device__ bool next(int i, Unit& u) const {
        const long L = (long)i * G + c; if (L >= nwg) return false;
        int wgid = (int)L; { const int q = nwg / NXCD, r = nwg % NXCD, xcd = wgid % NXCD, off = wgid / NXCD; wgid = (xcd < r ? xcd * (q + 1) : r * (q + 1) + (xcd - r) * q) + off; }
        const int nig = WGM * nN, gid = wgid / nig, fm = gid * WGM, gsz = (nM - fm) < WGM ? (nM - fm) : WGM;
        u.pm = fm + ((wgid % nig) % gsz); u.pn = (wgid % nig) / gsz; return true;
    }
    __device__ __forceinline__ void a_ready(const Unit&) const {}
    __device__ __forceinline__ void done(const Unit&) const {}
};

__device__ __forceinline__ unsigned cvt_pk_bf16(float lo, float hi) { unsigned r; asm volatile("v_cvt_pk_bf16_f32 %0, %1, %2" : "=v"(r) : "v"(lo), "v"(hi)); return r; }
__device__ __forceinline__ float fast_sigmoid(float x) { return __builtin_amdgcn_rcpf(1.f + __builtin_amdgcn_exp2f(-1.4426950408889634f * x)); }
__device__ __forceinline__ u32x4 pack8(const f32x4 a, const f32x4 b) { u32x4 w; w.x = cvt_pk_bf16(a[0], a[1]); w.y = cvt_pk_bf16(a[2], a[3]); w.z = cvt_pk_bf16(b[0], b[1]); w.w = cvt_pk_bf16(b[2], b[3]); return w; }

struct EpiSwiglu {
    static constexpr bool PERM = true, AFTER_DRAIN = false;
    bf16_t* O; int ldo; const float* ss;
    __device__ __forceinline__ void operator()(const f32x4 (&acc)[2][2][4][2], const Unit& u, int wr, int wc, int fr, int fq) const {
        const int row0 = u.pm * BM + wr * 64 + fr, col0 = u.pn * HALF + wc * 32 + 8 * fq;
#pragma unroll
        for (int ai = 0; ai < 2; ++ai)
#pragma unroll
            for (int m = 0; m < 4; ++m) {
                f32x4 v[2]; const float rs = __builtin_amdgcn_rsqf(ss[row0 + ai * HALF + m * 16] * (1.f / 1024.f) + 1e-6f);
#pragma unroll
                for (int n = 0; n < 2; ++n) { const f32x4 g = acc[ai][0][m][n] * rs, up = acc[ai][1][m][n] * rs;
#pragma unroll
                    for (int e = 0; e < 4; ++e) v[n][e] = g[e] * fast_sigmoid(g[e]) * up[e]; }
                *(u32x4*)(O + (size_t)(row0 + ai * HALF + m * 16) * ldo + col0) = pack8(v[0], v[1]);
            }
    }
};

template <bool NORM, int ALPHA2  , int HIN, bool FOUT> struct EpiResid {
    static constexpr bool PERM = true, AFTER_DRAIN = false;
    const float* hin; float* hout; bf16_t* HB; float* ssout;
    __device__ __forceinline__ void operator()(const f32x4 (&acc)[2][2][4][2], const Unit& u, int wr, int wc, int fr, int fq) const {
        const int row0 = u.pm * BM + wr * 64 + fr, col0 = u.pn * BM + wc * 32 + 8 * fq; constexpr float alpha = 0.5f * ALPHA2;
#pragma unroll
        for (int ai = 0; ai < 2; ++ai)
#pragma unroll
            for (int m = 0; m < 4; ++m) {
                float sq = 0.f;
#pragma unroll
                for (int bj = 0; bj < 2; ++bj) {
                    const size_t p = (size_t)(row0 + ai * HALF + m * 16) * 1024 + col0 + bj * HALF;
                    f32x4 a0, a1;
                    if (HIN == 0) { a0 = *(const f32x4*)(hin + p); a1 = *(const f32x4*)(hin + p + 4); }
                    else { const u32x4 w = *(const u32x4*)(HB + p);
                        a0 = (f32x4){__builtin_bit_cast(float, w.x << 16), __builtin_bit_cast(float, w.x & 0xffff0000u), __builtin_bit_cast(float, w.y << 16), __builtin_bit_cast(float, w.y & 0xffff0000u)};
                        a1 = (f32x4){__builtin_bit_cast(float, w.z << 16), __builtin_bit_cast(float, w.z & 0xffff0000u), __builtin_bit_cast(float, w.w << 16), __builtin_bit_cast(float, w.w & 0xffff0000u)}; }
                    a0 = a0 + acc[ai][bj][m][0] * alpha; a1 = a1 + acc[ai][bj][m][1] * alpha;
                    if (FOUT) { *(f32x4*)(hout + p) = a0; *(f32x4*)(hout + p + 4) = a1; }
                    if (NORM) { *(u32x4*)(HB + p) = pack8(a0, a1);
                        sq += (a0[0] * a0[0] + a0[1] * a0[1]) + (a0[2] * a0[2] + a0[3] * a0[3]) + (a1[0] * a1[0] + a1[1] * a1[1]) + (a1[2] * a1[2] + a1[3] * a1[3]); }
                }
                if (NORM) { sq += __shfl_xor(sq, 16); sq += __shfl_xor(sq, 32);
                    if (fq == 0) __hip_atomic_fetch_add(ssout + row0 + ai * HALF + m * 16, sq, __ATOMIC_RELAXED, __HIP_MEMORY_SCOPE_AGENT); }
            }
    }
};

struct EpiConvIn {
    static constexpr bool PERM = true, AFTER_DRAIN = false;
    bf16_t* Bg; bf16_t* U; const float* ss;
    __device__ __forceinline__ void operator()(const f32x4 (&acc)[2][2][4][2], const Unit& u, int wr, int wc, int fr, int fq) const {
        const int row0 = u.pm * BM + wr * 64 + fr;
        if (u.pn < 4) {
            const int col0 = u.pn * BM + wc * 32 + 8 * fq;
#pragma unroll
            for (int ai = 0; ai < 2; ++ai)
#pragma unroll
                for (int m = 0; m < 4; ++m)
#pragma unroll
                    for (int bj = 0; bj < 2; ++bj) { const float rs = __builtin_amdgcn_rsqf(ss[row0 + ai * HALF + m * 16] * (1.f / 1024.f) + 1e-6f);
                        *(u32x4*)(Bg + (size_t)(row0 + ai * HALF + m * 16) * 1024 + col0 + bj * HALF) = pack8(acc[ai][bj][m][0] * rs, acc[ai][bj][m][1] * rs); }
        } else {
            const int col0 = (u.pn - 4) * HALF + wc * 32 + 8 * fq;
#pragma unroll
            for (int ai = 0; ai < 2; ++ai)
#pragma unroll
                for (int m = 0; m < 4; ++m) { const float r2 = __builtin_amdgcn_rcpf(ss[row0 + ai * HALF + m * 16] * (1.f / 1024.f) + 1e-6f);
                    *(u32x4*)(U + (size_t)(row0 + ai * HALF + m * 16) * 1024 + col0) = pack8(acc[ai][0][m][0] * acc[ai][1][m][0] * r2, acc[ai][0][m][1] * acc[ai][1][m][1] * r2); }
        }
    }
};

struct EpiKV {
    static constexpr bool PERM = true, AFTER_DRAIN = false;
    bf16_t *Kb, *Vb; size_t brstride; const float* knorm; const float* ss;
    __device__ __forceinline__ void operator()(const f32x4 (&acc)[2][2][4][2], const Unit& u, int wr, int wc, int fr, int fq) const {
        const int br = u.pn >> 1, kv = u.pn & 1;
        const int row0 = u.pm * BM + wr * 64 + fr;
#pragma unroll
        for (int ai = 0; ai < 2; ++ai)
#pragma unroll
            for (int m = 0; m < 4; ++m) {
                const int row = row0 + ai * HALF + m * 16, b = row >> 13, s = row & 8191, bg = b * 4 + wc;
                const float rs = __builtin_amdgcn_rsqf(ss[row] * (1.f / 1024.f) + 1e-6f);
                if (kv == 0) {
                    float rstd = rs;
                    if (br > 0) { float ss = 0.f;
#pragma unroll
                        for (int bj = 0; bj < 2; ++bj)
#pragma unroll
                            for (int n = 0; n < 2; ++n)
#pragma unroll
                                for (int e = 0; e < 4; ++e) ss += acc[ai][bj][m][n][e] * acc[ai][bj][m][n][e];
                        ss += __shfl_xor(ss, 16); ss += __shfl_xor(ss, 32);
                        rstd = rs * __builtin_amdgcn_rsqf(ss * rs * rs * (1.f / 64.f) + 1e-6f); }
                    bf16_t* dst = Kb + (size_t)br * brstride + ((size_t)bg * 8192 + s) * 64 + 8 * fq;
#pragma unroll
                    for (int bj = 0; bj < 2; ++bj) {
                        f32x4 v0 = acc[ai][bj][m][0] * rstd, v1 = acc[ai][bj][m][1] * rstd;
                        if (br > 0) { const float* gp = knorm + br * 64 + bj * 32 + 8 * fq; v0 = v0 * *(const f32x4*)gp; v1 = v1 * *(const f32x4*)(gp + 4); }
                        *(u32x4*)(dst + bj * 32) = pack8(v0, v1);
                    }
                } else if (br == 0) {
                    bf16_t* dst = Vb + ((size_t)bg * 8192 + s) * 64 + 8 * fq;
#pragma unroll
                    for (int bj = 0; bj < 2; ++bj) *(u32x4*)(dst + bj * 32) = pack8(acc[ai][bj][m][0] * rs, acc[ai][bj][m][1] * rs);
                } else {
                    bf16_t* dst = Vb + (size_t)br * brstride + ((size_t)bg * 64 + 8 * fq) * 8192 + s;
#pragma unroll
                    for (int bj = 0; bj < 2; ++bj)
#pragma unroll
                        for (int n = 0; n < 2; ++n) { const f32x4 v = acc[ai][bj][m][n] * rs;
                            const unsigned p0 = cvt_pk_bf16(v[0], v[1]), p1 = cvt_pk_bf16(v[2], v[3]);
                            bf16_t* d = dst + (size_t)(bj * 32 + 4 * n) * 8192;
                            d[0] = (bf16_t)(p0 & 0xffffu); d[8192] = (bf16_t)(p0 >> 16); d[2 * 8192] = (bf16_t)(p1 & 0xffffu); d[3 * 8192] = (bf16_t)(p1 >> 16); }
                }
            }
    }
};

struct EpiQ {
    static constexpr bool PERM = true, AFTER_DRAIN = false;
    bf16_t* Q; float* gates; const float* qnorm; float qscale; const float* ss;
    __device__ __forceinline__ void operator()(const f32x4 (&acc)[2][2][4][2], const Unit& u, int wr, int wc, int fr, int fq) const {
        const int row0 = u.pm * BM + wr * 64 + fr;
        if (u.pn < 4) {
            const int head = u.pn * 4 + wc;
#pragma unroll
            for (int ai = 0; ai < 2; ++ai)
#pragma unroll
                for (int m = 0; m < 4; ++m) {
                    float ss = 0.f;
#pragma unroll
                    for (int bj = 0; bj < 2; ++bj)
#pragma unroll
                        for (int n = 0; n < 2; ++n)
#pragma unroll
                            for (int e = 0; e < 4; ++e) ss += acc[ai][bj][m][n][e] * acc[ai][bj][m][n][e];
                    ss += __shfl_xor(ss, 16); ss += __shfl_xor(ss, 32);
                    const float rs = __builtin_amdgcn_rsqf(this->ss[row0 + ai * HALF + m * 16] * (1.f / 1024.f) + 1e-6f);
                    const float rstd = rs * __builtin_amdgcn_rsqf(ss * rs * rs * (1.f / 64.f) + 1e-6f) * qscale;
                    bf16_t* dst = Q + (size_t)(row0 + ai * HALF + m * 16) * 1024 + head * 64 + 8 * fq;
#pragma unroll
                    for (int bj = 0; bj < 2; ++bj) { const float* gp = qnorm + bj * 32 + 8 * fq;
                        const f32x4 v0 = acc[ai][bj][m][0] * rstd * *(const f32x4*)gp, v1 = acc[ai][bj][m][1] * rstd * *(const f32x4*)(gp + 4);
                        *(u32x4*)(dst + bj * 32) = pack8(v0, v1); }
                }
        } else {
            if (wc < 2) {
#pragma unroll
                for (int ai = 0; ai < 2; ++ai)
#pragma unroll
                    for (int m = 0; m < 4; ++m) {
                        const int c0 = wc * 32 + 8 * fq;
                        if (c0 < 48) { float* dst = gates + (size_t)(row0 + ai * HALF + m * 16) * 48 + c0; const float rs = __builtin_amdgcn_rsqf(this->ss[row0 + ai * HALF + m * 16] * (1.f / 1024.f) + 1e-6f);
                            f32x4 a = acc[ai][0][m][0] * rs, b = acc[ai][0][m][1] * rs;
#pragma unroll
                            for (int e = 0; e < 4; ++e) { a[e] = fast_sigmoid(a[e]); b[e] = fast_sigmoid(b[e]); }
                            *(f32x4*)dst = a; *(f32x4*)(dst + 4) = b; }
                    }
            }
        }
    }
};
template <class Epi, class Sched, bool ALIGN_EPI = false, bool SP2 = false>
__device__ __forceinline__ void gemm_phase(PG8_LAS unsigned char* lds, const Gemm g, const Sched& S, const Epi& E) {
    int tid_ = threadIdx.x; asm volatile("" : "+v"(tid_));
    const int tid = tid_, wid = __builtin_amdgcn_readfirstlane(tid >> 6), lane = tid & 63, wr = wid >> 2, wc = wid & 3, fr = lane & 15, fq = lane >> 4;
    const int K = g.K, nt = K / BK;
    unsigned voffA[2], voffB[2];
#pragma unroll
    for (int i = 0; i < 2; ++i) { int R, C; stage_rc(tid * 16 + i * 8192, R, C); const int Rb = Epi::PERM ? ((R & ~31) + perm32(R & 31)) : R;
        voffA[i] = (unsigned)(R * K + C) * 2u; voffB[i] = (unsigned)(Rb * K + C) * 2u; }
    const size_t kstep = (size_t)(BK * 2);
    const size_t hstep = (size_t)HALF * K * 2;
    const size_t tstep = 2 * hstep;
    const unsigned ldsw = (unsigned)wid * 1024u;
    const int aoff = lds_byte(wr * 64 + fr, fq * 8), boff = lds_byte(wc * 32 + fr, fq * 8);
#define PG8_SA(b, h) (((b) * 2 + (h)) * HTB)
#define PG8_SB(b, h) ((4 + (b) * 2 + (h)) * HTB)
#define PG8_STAGE(bufoff, gbase, voff) do { _Pragma("unroll") for (int _i = 0; _i < 2; ++_i) \
        __builtin_amdgcn_global_load_lds((const unsigned*)((const char*)(gbase) + (voff)[_i]), (PG8_LAS unsigned*)(lds + (bufoff) + ldsw + _i * 8192), 16, 0, 0); } while (0)
#define PG8_LDA(dst, b, h) do { _Pragma("unroll") for (int m = 0; m < 4; ++m) _Pragma("unroll") for (int k = 0; k < 2; ++k) dst[m][k] = *(const PG8_LAS bf16x8*)(lds + PG8_SA(b, h) + aoff + m * 2048 + k * 1024); } while (0)
#define PG8_LDB(dst, b, h) do { _Pragma("unroll") for (int n = 0; n < 2; ++n) _Pragma("unroll") for (int k = 0; k < 2; ++k) dst[n][k] = *(const PG8_LAS bf16x8*)(lds + PG8_SB(b, h) + boff + n * 2048 + k * 1024); } while (0)
#define PG8_MMA(ai, bj, At, Bt) do { __builtin_amdgcn_s_setprio(1); _Pragma("unroll") for (int m = 0; m < 4; ++m) _Pragma("unroll") for (int n = 0; n < 2; ++n) _Pragma("unroll") for (int k = 0; k < 2; ++k) \
        acc[ai][bj][m][n] = __builtin_amdgcn_mfma_f32_16x16x32_bf16(Bt[n][k], At[m][k], acc[ai][bj][m][n], 0, 0, 0); __builtin_amdgcn_s_setprio(0); } while (0)
#define PG8_WAIT_V(n) asm volatile("s_waitcnt vmcnt(" #n ")" ::: "memory")
#define PG8_WAIT_L(n) asm volatile("s_waitcnt lgkmcnt(" #n ")" ::: "memory")
#define PG8_BAR __builtin_amdgcn_s_barrier()
#define PG8_SCHED __builtin_amdgcn_sched_barrier(0)
    Unit cur, nxt; int ui = 0;
    if (!S.next(0, cur)) return;
    f32x4 acc[2][2][4][2];
#pragma unroll
    for (int a = 0; a < 2; ++a)
#pragma unroll
        for (int b = 0; b < 2; ++b)
#pragma unroll
            for (int m = 0; m < 4; ++m)
#pragma unroll
                for (int n = 0; n < 2; ++n) acc[a][b][m][n] = (f32x4){0.f, 0.f, 0.f, 0.f};
    bf16x8 At[4][2], B0[2][2], B1[2][2];
    const char* cA = (const char*)g.A + (size_t)cur.pm * tstep; const char* cB = (const char*)g.Bt + (size_t)cur.pn * tstep;
    S.a_ready(cur);
    if constexpr (SP2) {
        PG8_STAGE(PG8_SB(0, 0), cB, voffB); PG8_STAGE(PG8_SB(0, 1), cB + hstep, voffB); PG8_STAGE(PG8_SA(0, 0), cA, voffA); PG8_STAGE(PG8_SA(0, 1), cA + hstep, voffA);
        if (wr == 1) PG8_BAR;
        PG8_WAIT_V(2); PG8_BAR;
        PG8_STAGE(PG8_SB(1, 0), cB + kstep, voffB); PG8_STAGE(PG8_SA(1, 0), cA + kstep, voffA); PG8_STAGE(PG8_SB(1, 1), cB + hstep + kstep, voffB);
        PG8_WAIT_V(6); PG8_BAR;
    } else {
        PG8_STAGE(PG8_SB(0, 0), cB, voffB); PG8_STAGE(PG8_SA(0, 0), cA, voffA); PG8_STAGE(PG8_SB(0, 1), cB + hstep, voffB); PG8_STAGE(PG8_SA(0, 1), cA + hstep, voffA);
        if (wr == 1) PG8_BAR;
        PG8_WAIT_V(4); PG8_BAR;
        PG8_STAGE(PG8_SB(1, 0), cB + kstep, voffB); PG8_STAGE(PG8_SA(1, 0), cA + kstep, voffA); PG8_STAGE(PG8_SB(1, 1), cB + hstep + kstep, voffB);
        PG8_WAIT_V(6); PG8_BAR;
    }
    for (;;) {
        const bool has_next = S.next(ui + 1, nxt);
        const char* nA = has_next ? (const char*)g.A + (size_t)nxt.pm * tstep : cA; const char* nB = has_next ? (const char*)g.Bt + (size_t)nxt.pn * tstep : cB;
        for (int t = 0; t < nt; t += 2) {
            const bool last = (t == nt - 2);
            const char* a1 = cA + (size_t)(t + 1) * kstep;
            const char* a2 = last ? nA : cA + (size_t)(t + 2) * kstep; const char* b2 = last ? nB : cB + (size_t)(t + 2) * kstep;
            const char* a3 = a2 + kstep; const char* b3 = b2 + kstep;
            if (last && has_next) S.a_ready(nxt);
            if constexpr (SP2) {
            PG8_LDB(B0, 0, 0); PG8_LDB(B1, 0, 1); PG8_SCHED; PG8_LDA(At, 0, 0); PG8_STAGE(PG8_SA(1, 1), a1 + hstep, voffA);
            PG8_WAIT_V(8); PG8_WAIT_L(0); PG8_BAR; PG8_MMA(0, 0, At, B0); PG8_MMA(0, 1, At, B1); PG8_BAR; PG8_SCHED;
            PG8_LDA(At, 0, 1); PG8_STAGE(PG8_SB(0, 0), b2, voffB); PG8_STAGE(PG8_SB(0, 1), b2 + hstep, voffB); PG8_STAGE(PG8_SA(0, 0), a2, voffA);
            PG8_WAIT_V(8); PG8_WAIT_L(0); PG8_BAR; PG8_MMA(1, 0, At, B0); PG8_MMA(1, 1, At, B1); PG8_BAR; PG8_SCHED;
            PG8_LDB(B0, 1, 0); PG8_LDB(B1, 1, 1); PG8_SCHED; PG8_LDA(At, 1, 0); PG8_STAGE(PG8_SA(0, 1), a2 + hstep, voffA);
            PG8_WAIT_V(8); PG8_WAIT_L(0); PG8_BAR; PG8_MMA(0, 0, At, B0); PG8_MMA(0, 1, At, B1); PG8_BAR; PG8_SCHED;
            PG8_LDA(At, 1, 1); PG8_STAGE(PG8_SB(1, 0), b3, voffB); PG8_STAGE(PG8_SB(1, 1), b3 + hstep, voffB); PG8_STAGE(PG8_SA(1, 0), a3, voffA);
            PG8_WAIT_V(8); PG8_WAIT_L(0); PG8_BAR; PG8_MMA(1, 0, At, B0); PG8_MMA(1, 1, At, B1); PG8_BAR; PG8_SCHED;
            } else {
            PG8_LDB(B0, 0, 0); PG8_SCHED; PG8_LDA(At, 0, 0); PG8_STAGE(PG8_SA(1, 1), a1 + hstep, voffA);
            PG8_WAIT_L(8); PG8_BAR; PG8_WAIT_L(0); PG8_MMA(0, 0, At, B0); PG8_BAR; PG8_SCHED;
            PG8_LDB(B1, 0, 1); PG8_STAGE(PG8_SB(0, 0), b2, voffB);
            PG8_BAR; PG8_WAIT_L(0); PG8_MMA(0, 1, At, B1); PG8_BAR;
            PG8_LDA(At, 0, 1); PG8_STAGE(PG8_SA(0, 0), a2, voffA);
            PG8_BAR; PG8_WAIT_L(0); PG8_MMA(1, 0, At, B0); PG8_BAR; PG8_SCHED;
            PG8_STAGE(PG8_SB(0, 1), b2 + hstep, voffB);
            PG8_WAIT_V(6); PG8_BAR; PG8_MMA(1, 1, At, B1); PG8_BAR;
            PG8_LDB(B0, 1, 0); PG8_SCHED; PG8_LDA(At, 1, 0); PG8_STAGE(PG8_SA(0, 1), a2 + hstep, voffA);
            PG8_WAIT_L(8); PG8_BAR; PG8_WAIT_L(0); PG8_MMA(0, 0, At, B0); PG8_BAR; PG8_SCHED;
            PG8_LDB(B1, 1, 1); PG8_STAGE(PG8_SB(1, 0), b3, voffB);
            PG8_BAR; PG8_WAIT_L(0); PG8_MMA(0, 1, At, B1); PG8_BAR;
            PG8_LDA(At, 1, 1); PG8_STAGE(PG8_SA(1, 0), a3, voffA);
            PG8_BAR; PG8_WAIT_L(0); PG8_MMA(1, 0, At, B0); PG8_BAR; PG8_SCHED;
            PG8_STAGE(PG8_SB(1, 1), b3 + hstep, voffB);
            PG8_WAIT_V(6); PG8_BAR; PG8_MMA(1, 1, At, B1); PG8_BAR;
            }
        }
        if constexpr (ALIGN_EPI) { if (wr == 0) PG8_BAR; }
        if constexpr (!Epi::AFTER_DRAIN) { E(acc, cur, wr, wc, fr, fq); S.done(cur); }
        if (!has_next) break;
#pragma unroll
        for (int a = 0; a < 2; ++a)
#pragma unroll
            for (int b = 0; b < 2; ++b)
#pragma unroll
                for (int m = 0; m < 4; ++m)
#pragma unroll
                    for (int n = 0; n < 2; ++n) acc[a][b][m][n] = (f32x4){0.f, 0.f, 0.f, 0.f};
        cur = nxt; cA = nA; cB = nB; ++ui;
        if constexpr (ALIGN_EPI) { if (wr == 1) PG8_BAR; }
    }
    PG8_WAIT_V(0);
    if constexpr (!ALIGN_EPI) { if (wr == 0) PG8_BAR; }
    PG8_BAR;
    if constexpr (Epi::AFTER_DRAIN) { E.fused(acc, cur, wr, wc, fr, fq, lds, wid, lane); S.done(cur); }
#undef PG8_SA
#undef PG8_SB
#undef PG8_STAGE
#undef PG8_LDA
#undef PG8_LDB
#undef PG8_MMA
#undef PG8_WAIT_V
#undef PG8_WAIT_L
#undef PG8_BAR
#undef PG8_SCHED
}
}

#define LAS __attribute__((address_space(3)))
typedef unsigned short bf16;
typedef float f32x4 __attribute__((ext_vector_type(4)));
typedef short bf16x8 __attribute__((ext_vector_type(8)));
typedef unsigned u32x4 __attribute__((ext_vector_type(4)));
typedef unsigned long long u64;

constexpr int NB = 4, SEQ = 8192, DM = 1024, T = NB * SEQ, DFF = 2816, NH = 16, NG = 4, HD = 64;
constexpr int NQP = 1280;
constexpr int NKV = 1536;
constexpr int NCB = 512;
constexpr float RMS_EPS = 1e-6f;
constexpr float LOG2E = 1.4426950408889634f;
constexpr int LDS_BYTES = 151552;

constexpr size_t MiB = 1u << 20;
constexpr size_t SZ_WIN = (size_t)2 * DFF * DM * 2, SZ_WOUT = (size_t)DM * DFF * 2;
constexpr size_t WS_WIN = 1 * MiB;
constexpr size_t WS_WOUT = WS_WIN + 4 * SZ_WIN;
constexpr size_t WS_CWIN = WS_WOUT + 4 * SZ_WOUT;
constexpr size_t WS_CWOUT = WS_CWIN + (size_t)3072 * 1024 * 2;
constexpr size_t WS_WQ = WS_CWOUT + (size_t)1024 * 1024 * 2;
constexpr size_t WS_WO = WS_WQ + (size_t)NQP * 1024 * 2;
constexpr size_t WS_WKV = WS_WO + (size_t)1024 * 1024 * 2;
constexpr size_t WS_W1K = WS_WKV + (size_t)NKV * 1024 * 2;
constexpr size_t WS_W1V = WS_W1K + (size_t)128 * 2048 * 2;
constexpr size_t WS_W2K = WS_W1V + (size_t)128 * 2048 * 2;
constexpr size_t WS_W2V = WS_W2K + (size_t)64 * 128 * 2;
constexpr size_t WS_B1 = WS_W2V + (size_t)64 * 128 * 2;
constexpr size_t WS_WEND = WS_B1 + 1024;
static_assert(WS_WEND <= 90 * MiB, "weights region");
constexpr size_t WS_HN = 96 * MiB;
constexpr size_t WS_HN2 = 160 * MiB;
constexpr size_t WS_ACT = 224 * MiB;
constexpr size_t WS_BG = WS_ACT, WS_U = WS_ACT + 64 * MiB;
constexpr size_t WS_Q = WS_ACT;
constexpr size_t KV_BYTES = (size_t)16 * SEQ * 64 * 2;
constexpr size_t WS_KCR = 400 * MiB, WS_KS = WS_KCR + KV_BYTES, WS_KW = WS_KS + KV_BYTES;
constexpr size_t WS_VCR = WS_KW + KV_BYTES, WS_VST = WS_VCR + KV_BYTES, WS_VWT = WS_VST + KV_BYTES;
constexpr size_t WS_KC = 90 * MiB, WS_VCT = 91 * MiB;
constexpr size_t WS_GATES = WS_VWT + KV_BYTES;
constexpr size_t WS_AO = WS_HN2;
constexpr size_t WS_END = WS_GATES + 6 * MiB;
static_assert(WS_END <= 512 * MiB, "workspace");

struct Args {
    const float* in[24];
    float* out; unsigned char* ws;
};
typedef const __attribute__((address_space(4))) Args* KArgsP;
__device__ __forceinline__ KArgsP KA() { KArgsP p = (KArgsP)__builtin_amdgcn_kernarg_segment_ptr(); asm volatile("" : "+s"(p)); return p; }
#define IN(i) ((const float*)KA()->in[i])
#define WSP ((unsigned char*)KA()->ws)

typedef float f32x2_t __attribute__((ext_vector_type(2)));
typedef __bf16 bf16x2_t __attribute__((ext_vector_type(2)));
__device__ __forceinline__ unsigned cvt_pk(float lo, float hi) { const f32x2_t v = {lo, hi}; const bf16x2_t b = __builtin_convertvector(v, bf16x2_t); return __builtin_bit_cast(unsigned, b); }
__device__ __forceinline__ float bf2f(unsigned short b) { return __builtin_bit_cast(float, (unsigned)b << 16); }
__device__ __forceinline__ float wave_sum(float v) {
#pragma unroll
    for (int o = 1; o < 64; o <<= 1) v += __shfl_xor(v, o);
    return v;
}
__device__ __forceinline__ float wave_max(float v) {
#pragma unroll
    for (int o = 1; o < 64; o <<= 1) v = fmaxf(v, __shfl_xor(v, o));
    return v;
}

enum { MK_IDENT = 0, MK_FFN_IN = 1, MK_CONV_IN = 2, MK_HEADPERM = 3, MK_Q = 4 };
__device__ __forceinline__ int srcmap(int kind, int np) {
    const int pn = np >> 8, r = np & 255, bj = r >> 7, c = r & 127;
    if (kind == MK_FFN_IN) return bj * DFF + 128 * pn + c;
    if (kind == MK_CONV_IN) return pn < 4 ? np : 1024 * (1 + bj) + 128 * (pn - 4) + c;
    if (kind == MK_HEADPERM) return 256 * pn + 64 * (c >> 5) + 32 * bj;
    if (kind == MK_Q) return pn < 4 ? 256 * pn + 64 * (c >> 5) + 32 * bj : (r < 32 ? 1024 : (r < 64 ? 1056 : -1));
    return np;
}
struct MatDesc { const float* W; bf16* WT; int K, N, NP, kind; const float* gain; };

__device__ __forceinline__ void prep_load(const MatDesc& d, int item, int tid, float (&v)[16]) {
    const int nblk = d.NP >> 6, kb = item / nblk, nb = item - kb * nblk;
    const int n = tid & 31, kk = tid >> 5;
#pragma unroll
    for (int s = 0; s < 2; ++s) {
        const int sc = srcmap(d.kind, nb * 64 + s * 32);
        const bool ok = sc >= 0 && (sc + n) < d.N;
        const float* p = d.W + (size_t)(kb * 128 + kk) * d.N + sc + n;
#pragma unroll
        for (int i = 0; i < 8; ++i) v[s * 8 + i] = ok ? p[(size_t)(16 * i) * d.N] * (d.gain ? d.gain[kb * 128 + kk + 16 * i] : 1.f) : 0.f;
    }
}
__device__ __forceinline__ void prep_store_lds(LAS float* scr, int tid, const float (&v)[16]) {
    const int n = tid & 31, kk = tid >> 5;
#pragma unroll
    for (int s = 0; s < 2; ++s)
#pragma unroll
        for (int i = 0; i < 8; ++i) scr[(kk + 16 * i) * 65 + s * 32 + n] = v[s * 8 + i];
}
__device__ __forceinline__ void prep_write(const MatDesc& d, int item, int tid, const LAS float* scr) {
    const int nblk = d.NP >> 6, kb = item / nblk, nb = item - kb * nblk;
#pragma unroll
    for (int s = 0; s < 2; ++s) {
        const int n = (tid >> 4) + 32 * s, c = tid & 15;
        const LAS float* p = scr + (8 * c) * 65 + n;
        u32x4 o; o.x = cvt_pk(p[0], p[65]); o.y = cvt_pk(p[2 * 65], p[3 * 65]); o.z = cvt_pk(p[4 * 65], p[5 * 65]); o.w = cvt_pk(p[6 * 65], p[7 * 65]);
        *(u32x4*)(d.WT + (size_t)(nb * 64 + n) * d.K + kb * 128 + 8 * c) = o;
    }
}

__device__ __forceinline__ MatDesc get_mat(const Args& a, int mi) {
    unsigned char* ws = WSP;
    MatDesc d; d.gain = nullptr;
    if (mi < 4) { const int layer = mi >> 1, f2 = mi & 1;
        d.gain = IN(f2 ? 5 : 1) + layer * DM;
        d.W = IN(f2 ? 6 : 2) + (size_t)layer * DM * 2 * DFF; d.WT = (bf16*)(ws + WS_WIN + (size_t)mi * SZ_WIN); d.K = DM; d.N = 2 * DFF; d.NP = 2 * DFF; d.kind = MK_FFN_IN; return d; }
    if (mi < 8) { const int s = mi - 4, layer = s >> 1, f2 = s & 1;
        d.W = IN(f2 ? 7 : 3) + (size_t)layer * DFF * DM; d.WT = (bf16*)(ws + WS_WOUT + (size_t)s * SZ_WOUT); d.K = DFF; d.N = DM; d.NP = DM; d.kind = MK_IDENT; return d; }
    switch (mi) {
    case 8:  d.W = IN(8);  d.WT = (bf16*)(ws + WS_CWIN);  d.K = DM; d.N = 3072; d.NP = 3072; d.kind = MK_CONV_IN; d.gain = IN(4); break;
    case 9:  d.W = IN(10); d.WT = (bf16*)(ws + WS_CWOUT); d.K = DM; d.N = DM;   d.NP = DM;   d.kind = MK_IDENT; break;
    case 10: d.W = IN(11); d.WT = (bf16*)(ws + WS_WQ);    d.K = DM; d.N = 1072; d.NP = NQP;  d.kind = MK_Q; d.gain = IN(4) + DM; break;
    case 11: d.W = IN(13); d.WT = (bf16*)(ws + WS_WO);    d.K = DM; d.N = DM;   d.NP = DM;   d.kind = MK_IDENT; break;
    case 12: d.W = IN(15); d.WT = (bf16*)(ws + WS_WKV);   d.K = DM; d.N = NKV;  d.NP = NKV;  d.kind = MK_HEADPERM; d.gain = IN(14); break;
    case 13: d.W = IN(19); d.WT = (bf16*)(ws + WS_W1K);   d.K = 2048; d.N = 128; d.NP = 128; d.kind = MK_IDENT; break;
    case 14: d.W = IN(21); d.WT = (bf16*)(ws + WS_W1V);   d.K = 2048; d.N = 128; d.NP = 128; d.kind = MK_IDENT; break;
    case 15: d.W = IN(20); d.WT = (bf16*)(ws + WS_W2K);   d.K = 128; d.N = 64; d.NP = 64; d.kind = MK_IDENT; break;
    default: d.W = IN(22); d.WT = (bf16*)(ws + WS_W2V);   d.K = 128; d.N = 64; d.NP = 64; d.kind = MK_IDENT; break;
    }
    return d;
}
constexpr int N_MATS = 17;
__device__ __forceinline__ int mat_items(int mi) {
    if (mi < 4) return 8 * 88; if (mi < 8) return 22 * 16;
    switch (mi) { case 8: return 8 * 48; case 9: return 8 * 16; case 10: return 8 * 20; case 11: return 8 * 16; case 12: return 8 * 24; case 13: case 14: return 16 * 2; default: return 1; }
}
__device__ __forceinline__ bool prep_locate(int g, int& mi, int& item) {
    for (int m = 0; m < N_MATS; ++m) { const int n = mat_items(m); if (g < n) { mi = m; item = g; return true; } g -= n; }
    return false;
}

__device__ __forceinline__ void phase_prep(const Args& a, LAS unsigned char* lds) {
    LAS float* scr = (LAS float*)lds;
    int tid_ = threadIdx.x; asm volatile("" : "+v"(tid_)); const int tid = tid_, G = gridDim.x;
    float v[16]; int mi, item;
    int g = blockIdx.x;
    bool have = prep_locate(g, mi, item);
    MatDesc d = {};
    if (have) { d = get_mat(a, mi); prep_load(d, item, tid, v); }
    while (have) {
        prep_store_lds(scr, tid, v);
        __syncthreads();
        const MatDesc dc = d; const int itc = item;
        g += G; have = prep_locate(g, mi, item);
        if (have) { d = get_mat(a, mi); prep_load(d, item, tid, v); }
        prep_write(dc, itc, tid, scr);
        __syncthreads();
    }
    if (blockIdx.x < 2) {
        const int kv = blockIdx.x; const float* pe = IN(kv ? 18 : 17); const float* w1 = IN(kv ? 21 : 19);
        const int col = tid & 127, part = tid >> 7; float s = 0.f;
        for (int k = part * 512; k < part * 512 + 512; ++k) s += pe[k] * w1[(size_t)k * 128 + col];
        scr[tid] = s; __syncthreads();
        if (tid < 128) ((float*)(WSP + WS_B1))[kv * 128 + tid] = scr[tid] + scr[tid + 128] + scr[tid + 256] + scr[tid + 384];
        __syncthreads();
    }
}

__device__ __forceinline__ void phase_norm(const float* h, const float* g1, bf16* o1, const float* g2, bf16* o2) {
    int tid_ = threadIdx.x; asm volatile("" : "+v"(tid_));
    const int lane = tid_ & 63, wave = tid_ >> 6;
    const int gw = blockIdx.x * 8 + wave, NGW = gridDim.x * 8;
    f32x4 ga[4], gb[4];
#pragma unroll
    for (int j = 0; j < 4; ++j) { ga[j] = *(const f32x4*)(g1 + 4 * lane + 256 * j); gb[j] = g2 ? *(const f32x4*)(g2 + 4 * lane + 256 * j) : ga[j]; }
    for (int m = gw; m < T; m += NGW) {
        const f32x4* xr = (const f32x4*)(h + (size_t)m * DM) + lane;
        f32x4 v[4]; float s = 0.f;
#pragma unroll
        for (int j = 0; j < 4; ++j) { v[j] = xr[64 * j]; s += (v[j].x * v[j].x + v[j].y * v[j].y) + (v[j].z * v[j].z + v[j].w * v[j].w); }
        const float rstd = __builtin_amdgcn_rsqf(wave_sum(s) * (1.f / DM) + RMS_EPS);
        u64* p1 = (u64*)(o1 + (size_t)m * DM) + lane;
#pragma unroll
        for (int j = 0; j < 4; ++j) { const f32x4 y = v[j] * rstd * ga[j]; p1[64 * j] = (u64)cvt_pk(y.x, y.y) | ((u64)cvt_pk(y.z, y.w) << 32); }
        if (g2) { u64* p2 = (u64*)(o2 + (size_t)m * DM) + lane;
#pragma unroll
            for (int j = 0; j < 4; ++j) { const f32x4 y = v[j] * rstd * gb[j]; p2[64 * j] = (u64)cvt_pk(y.x, y.y) | ((u64)cvt_pk(y.z, y.w) << 32); } }
    }
}

constexpr size_t WS_SS = 131072;
__device__ __forceinline__ void phase_x(const float* x, bf16* hb, float* ss) {
    int tid_ = threadIdx.x; asm volatile("" : "+v"(tid_));
    const int lane = tid_ & 63, wave = tid_ >> 6;
    const int gw = blockIdx.x * 8 + wave, NGW = gridDim.x * 8;
    for (int i = blockIdx.x * 512 + tid_; i < 5 * T; i += gridDim.x * 512) ss[T + i] = 0.f;
    for (int m = gw; m < T; m += NGW) {
        const f32x4* xr = (const f32x4*)(x + (size_t)m * DM) + lane;
        f32x4 v[4]; float s = 0.f;
#pragma unroll
        for (int j = 0; j < 4; ++j) { v[j] = xr[64 * j]; s += (v[j].x * v[j].x + v[j].y * v[j].y) + (v[j].z * v[j].z + v[j].w * v[j].w); }
        s = wave_sum(s);
        u64* p1 = (u64*)(hb + (size_t)m * DM) + lane;
#pragma unroll
        for (int j = 0; j < 4; ++j) p1[64 * j] = (u64)cvt_pk(v[j].x, v[j].y) | ((u64)cvt_pk(v[j].z, v[j].w) << 32);
        if (lane == 0) ss[m] = s;
    }
}

__device__ __forceinline__ void unpack8(const u32x4 w, float (&f)[8]) {
    f[0] = __builtin_bit_cast(float, w.x << 16); f[1] = __builtin_bit_cast(float, w.x & 0xffff0000u); f[2] = __builtin_bit_cast(float, w.y << 16); f[3] = __builtin_bit_cast(float, w.y & 0xffff0000u);
    f[4] = __builtin_bit_cast(float, w.z << 16); f[5] = __builtin_bit_cast(float, w.z & 0xffff0000u); f[6] = __builtin_bit_cast(float, w.w << 16); f[7] = __builtin_bit_cast(float, w.w & 0xffff0000u);
}
__device__ __forceinline__ void phase_conv(const bf16* Bg, const bf16* U, const float* cw, bf16* Z) {
    int tid_ = threadIdx.x; asm volatile("" : "+v"(tid_));
    const int tid = tid_, cc = tid & 127, trow = tid >> 7;
    float w0[8], w1[8], w2[8];
#pragma unroll
    for (int e = 0; e < 8; ++e) { w0[e] = cw[8 * cc + e]; w1[e] = cw[1024 + 8 * cc + e]; w2[e] = cw[2048 + 8 * cc + e]; }
    for (int tb = blockIdx.x; tb < T / 128; tb += gridDim.x) {
        const int tbeg = tb * 128 + trow * 32;
        float u1[8], u2[8];
        if ((tbeg & (SEQ - 1)) == 0) {
#pragma unroll
            for (int e = 0; e < 8; ++e) { u1[e] = 0.f; u2[e] = 0.f; }
        } else {
            unpack8(*(const u32x4*)(U + (size_t)(tbeg - 1) * DM + 8 * cc), u1);
            unpack8(*(const u32x4*)(U + (size_t)(tbeg - 2) * DM + 8 * cc), u2);
        }
#pragma unroll 4
        for (int i = 0; i < 32; ++i) {
            const size_t p = (size_t)(tbeg + i) * DM + 8 * cc;
            float u0[8], bgv[8], z[8];
            unpack8(*(const u32x4*)(U + p), u0); unpack8(*(const u32x4*)(Bg + p), bgv);
#pragma unroll
            for (int e = 0; e < 8; ++e) { z[e] = bgv[e] * (w0[e] * u2[e] + w1[e] * u1[e] + w2[e] * u0[e]); u2[e] = u1[e]; u1[e] = u0[e]; }
            u32x4 o; o.x = cvt_pk(z[0], z[1]); o.y = cvt_pk(z[2], z[3]); o.z = cvt_pk(z[4], z[5]); o.w = cvt_pk(z[6], z[7]);
            *(u32x4*)(Z + p) = o;
        }
    }
}

__device__ __forceinline__ void phase_compress(const Args& a, LAS unsigned char* lds, size_t off_kc = WS_KC, size_t off_vct = WS_VCT) {
    unsigned char* ws = WSP;
    int tid_ = threadIdx.x; asm volatile("" : "+v"(tid_));
    const int tid = tid_, lane = tid & 63, w = tid >> 6, lc = lane & 15, lg = lane >> 4;
    LAS bf16* hid = (LAS bf16*)lds;
    LAS float* outf = (LAS float*)(lds + 32 * 136 * 2);
    for (int u2 = blockIdx.x * 2; u2 < 512; u2 += gridDim.x * 2)
    for (int uu = u2; uu < u2 + 2; ++uu) {
        const int kv = uu >> 8, R0 = (uu & 255) * 32;
        const bf16* raw = (const bf16*)(ws + (kv ? WS_VCR : WS_KCR));
        const bf16* w1t = (const bf16*)(ws + (kv ? WS_W1V : WS_W1K));
        const bf16* w2t = (const bf16*)(ws + (kv ? WS_W2V : WS_W2K));
        const float* b1 = (const float*)(ws + WS_B1) + kv * 128;
        f32x4 acc[2] = {{0.f, 0.f, 0.f, 0.f}, {0.f, 0.f, 0.f, 0.f}};
        const bf16* ap0 = raw + (size_t)(R0 + lc) * 1024 + 8 * lg;
        const bf16* ap1 = ap0 + (size_t)16 * 1024;
        const bf16* bp = w1t + (size_t)(16 * w + lc) * 2048 + 8 * lg;
        bf16x8 A0[4], A1[4], B[4];
#pragma unroll
        for (int s = 0; s < 4; ++s) { A0[s] = *(const bf16x8*)(ap0 + 32 * s); A1[s] = *(const bf16x8*)(ap1 + 32 * s); B[s] = *(const bf16x8*)(bp + 32 * s); }
        for (int k0 = 0; k0 < 2048; k0 += 128) {
            bf16x8 nA0[4], nA1[4], nB[4];
            const int kn = (k0 + 128 < 2048) ? k0 + 128 : k0;
#pragma unroll
            for (int s = 0; s < 4; ++s) { nA0[s] = *(const bf16x8*)(ap0 + kn + 32 * s); nA1[s] = *(const bf16x8*)(ap1 + kn + 32 * s); nB[s] = *(const bf16x8*)(bp + kn + 32 * s); }
#pragma unroll
            for (int s = 0; s < 4; ++s) { acc[0] = __builtin_amdgcn_mfma_f32_16x16x32_bf16(A0[s], B[s], acc[0], 0, 0, 0); acc[1] = __builtin_amdgcn_mfma_f32_16x16x32_bf16(A1[s], B[s], acc[1], 0, 0, 0); }
#pragma unroll
            for (int s = 0; s < 4; ++s) { A0[s] = nA0[s]; A1[s] = nA1[s]; B[s] = nB[s]; }
        }
        { const int col = 16 * w + lc; const float bb = b1[col];
#pragma unroll
          for (int rt = 0; rt < 2; ++rt)
#pragma unroll
            for (int r = 0; r < 4; ++r) { const float x = acc[rt][r] + bb; const float y = 2.f * 0.7978845608028654f * (x + 0.044715f * x * x * x);
                const float gl = x * __builtin_amdgcn_rcpf(1.f + __builtin_amdgcn_exp2f(-LOG2E * y));
                hid[(16 * rt + 4 * lg + r) * 136 + col] = (bf16)(cvt_pk(gl, 0.f) & 0xffffu); } }
        __syncthreads();
        { const int rt = w >> 2, ct = w & 3; f32x4 o = {0.f, 0.f, 0.f, 0.f};
#pragma unroll
          for (int ks = 0; ks < 4; ++ks) { const bf16x8 A = *(const LAS bf16x8*)(hid + (16 * rt + lc) * 136 + 32 * ks + 8 * lg); const bf16x8 B = *(const bf16x8*)(w2t + (size_t)(16 * ct + lc) * 128 + 32 * ks + 8 * lg);
              o = __builtin_amdgcn_mfma_f32_16x16x32_bf16(A, B, o, 0, 0, 0); }
#pragma unroll
          for (int r = 0; r < 4; ++r) outf[(16 * rt + 4 * lg + r) * 65 + 16 * ct + lc] = o[r]; }
        __syncthreads();
        { const int row = tid >> 4, d0 = 4 * (tid & 15); const int R = R0 + row, bg = R >> 9, i = R & 511;
          float v[4]; float ss = 0.f;
#pragma unroll
          for (int e = 0; e < 4; ++e) { v[e] = outf[row * 65 + d0 + e]; ss += v[e] * v[e]; }
          if (kv == 0) {
              ss += __shfl_xor(ss, 1); ss += __shfl_xor(ss, 2); ss += __shfl_xor(ss, 4); ss += __shfl_xor(ss, 8);
              const float rstd = __builtin_amdgcn_rsqf(ss * (1.f / 64.f) + RMS_EPS); const float* kn = IN(16);
#pragma unroll
              for (int e = 0; e < 4; ++e) v[e] = (i == 511) ? 0.f : v[e] * rstd * kn[d0 + e];
              bf16* dst = (bf16*)(ws + off_kc) + ((size_t)bg * NCB + i) * 64 + d0;
              *(u64*)dst = (u64)cvt_pk(v[0], v[1]) | ((u64)cvt_pk(v[2], v[3]) << 32);
          } else {
              bf16* dst = (bf16*)(ws + off_vct) + ((size_t)bg * 64 + d0) * NCB + i;
#pragma unroll
              for (int e = 0; e < 4; ++e) dst[(size_t)e * NCB] = (i == 511) ? (bf16)0 : (bf16)(cvt_pk(v[e], 0.f) & 0xffffu);
          } }
        __syncthreads();
    }
}

constexpr int A_IMP = 0, A_RING = 32768, TILE_PITCH = 192  , TILE_B = 64 * TILE_PITCH, STAGE_B = 2 * TILE_B,
              A_SELQ = A_RING + 2 * STAGE_B, A_BIAS = A_SELQ + 1024, A_MB = A_BIAS + 512, A_OUT = A_MB + 512;
constexpr int RELMAX_BIG = 0x40000000;

template <int MODE, int BM = 0, bool SEL = false>
__device__ __forceinline__ void attn_core(const bf16x8 (&kf)[4][2], const bf16x8 (&vf)[4][2], const bf16x8 (&qf)[2], int tq, int pbase, int pstride, int relmax,
                                          const LAS float* biasrow, float pscale, f32x4 (&oacc)[4], float& lsum, LAS float* improw, int jbase, int lg, int h, float pbias = 0.f, float pbias2 = 0.f, int thr = 0) {
    f32x4 s[4];
#pragma unroll
    for (int kt = 0; kt < 4; ++kt) {
        s[kt] = __builtin_amdgcn_mfma_f32_16x16x32_bf16(kf[kt][0], qf[0], (f32x4){0.f, 0.f, 0.f, 0.f}, 0, 0, 0);
        s[kt] = __builtin_amdgcn_mfma_f32_16x16x32_bf16(kf[kt][1], qf[1], s[kt], 0, 0, 0);
    }
#pragma unroll
    for (int kt = 0; kt < 4; ++kt) {
        const int kap0 = 32 * (kt >> 1) + 8 * lg + 4 * (kt & 1);
        const int rel0 = tq - (pbase + kap0 * pstride);
#pragma unroll
        for (int r = 0; r < 4; ++r) {
            float p;
            if (BM == 1) {
                p = __builtin_amdgcn_exp2f(s[kt][r] + pbias);
            } else if (BM == 2) {
                const int rel = rel0 - r * pstride;
                p = __builtin_amdgcn_exp2f(s[kt][r] + (rel >= thr ? pbias2 : pbias));
            } else {
            const int rel = rel0 - r * pstride;
            const bool valid = (unsigned)rel < (unsigned)relmax;
            const int n = valid ? rel : 0;
            const int nn = (int)__umul24((unsigned)n, (unsigned)n);
            int bk = 39 - __clz(nn); bk = bk > 31 ? 31 : bk; bk = n < 16 ? n : bk;
            const float x = s[kt][r] + biasrow[bk];
            p = valid ? __builtin_amdgcn_exp2f(x) : 0.f;
            }
            if (MODE == 2) p *= pscale;
            s[kt][r] = p; lsum += p;
        }
        __builtin_amdgcn_sched_barrier(0);
        if (MODE == 2) {
            float av = 2.f * (s[kt][0] + s[kt][1] + s[kt][2]) + s[kt][3], bv = s[kt][3];
            av += __shfl_xor(av, 1); av += __shfl_xor(av, 2); bv += __shfl_xor(bv, 1); bv += __shfl_xor(bv, 2);
            if (h == 0) { const int j = jbase + (kap0 >> 2);
                improw[j] = improw[j] + av;
                if (j + 1 < 128) improw[j + 1] = improw[j + 1] + bv; }
        }
    }
    if (MODE >= 1) {
#pragma unroll
        for (int hh = 0; hh < 2; ++hh) {
            u32x4 pw; pw.x = cvt_pk(s[2 * hh][0], s[2 * hh][1]); pw.y = cvt_pk(s[2 * hh][2], s[2 * hh][3]); pw.z = cvt_pk(s[2 * hh + 1][0], s[2 * hh + 1][1]); pw.w = cvt_pk(s[2 * hh + 1][2], s[2 * hh + 1][3]);
            const bf16x8 pf = __builtin_bit_cast(bf16x8, pw);
#pragma unroll
            for (int dt = 0; dt < 4; ++dt) oacc[dt] = __builtin_amdgcn_mfma_f32_16x16x32_bf16(vf[dt][hh], pf, oacc[dt], 0, 0, 0);
        }
    }
}
__device__ __forceinline__ int rel_bucket_i(int n) { int bk = 39 - __clz((int)((unsigned)n * (unsigned)n)); bk = bk > 31 ? 31 : bk; return n < 16 ? n : bk; }
template <int MODE, bool SEL>
__device__ __forceinline__ void tile_stream(LAS unsigned char* ring, const bf16* Kbase, const bf16* Vbase, int ldv, int nt, int pb0, int pbstep, int pstride, int relmax,
                                            const bf16x8 (&qf)[2][2], const int (&tq)[2], const LAS float* biasrow, const float (&psc)[2], f32x4 (&oacc)[2][4], float (&ls)[2],
                                            LAS float* imp0, LAS float* imp1, const LAS u64* selA, const LAS u64* selB, int tid, int lc, int lg, int h) {
    const int row = tid >> 3, ch = tid & 7;
    const bf16* kp = Kbase + row * 64 + ch * 8;
    const bf16* vp = Vbase + (size_t)row * ldv + ch * 8;
    const int woff = row * TILE_PITCH + ch * 16;
    const float bfar = biasrow[31]; const int tqlo = __builtin_amdgcn_readfirstlane(tq[0]) ;
    u32x4 rk = {0u, 0u, 0u, 0u}, rv = {0u, 0u, 0u, 0u};
    if (nt > 0) { rk = *(const u32x4*)kp; if (MODE > 0) rv = *(const u32x4*)vp; }
    for (int t = 0; t < nt; ++t) {
        LAS unsigned char* st = ring + (t & 1) * STAGE_B;
        *(LAS u32x4*)(st + woff) = rk; if (MODE > 0) *(LAS u32x4*)(st + TILE_B + woff) = rv;
        __syncthreads();
        if (t + 1 < nt) { rk = *(const u32x4*)(kp + (size_t)(t + 1) * 4096); if (MODE > 0) rv = *(const u32x4*)(vp + (t + 1) * 64); }
        int tq0 = tq[0], tq1 = tq[1]; bool do0 = true, do1 = true;
        if (SEL) {
            const bool b0 = ((selA[t >> 6] >> (t & 63)) & 1ull) != 0ull, b1 = ((selB[t >> 6] >> (t & 63)) & 1ull) != 0ull;
            tq0 = b0 ? tq0 : -1; tq1 = b1 ? tq1 : -1; do0 = __ballot(b0) != 0ull; do1 = __ballot(b1) != 0ull;
        }
        if (do0 || do1) {
            bf16x8 kf[4][2], vf[4][2];
#pragma unroll
            for (int kt = 0; kt < 4; ++kt) { const LAS unsigned char* p = st + (32 * (kt >> 1) + 8 * (lc >> 2) + 4 * (kt & 1) + (lc & 3)) * TILE_PITCH + 16 * lg;
                kf[kt][0] = *(const LAS bf16x8*)p; kf[kt][1] = *(const LAS bf16x8*)(p + 64); }
            if (MODE > 0) {
#pragma unroll
                for (int dt = 0; dt < 4; ++dt) { const LAS unsigned char* p = st + TILE_B + (16 * dt + lc) * TILE_PITCH + 16 * lg;
                    vf[dt][0] = *(const LAS bf16x8*)p; vf[dt][1] = *(const LAS bf16x8*)(p + 64); }
            }
            const int pbase = pb0 + t * pbstep;
            {
                const int rlo = tqlo - (pbase + 63 * pstride), rhi = tqlo + 7 - pbase;
                const int blo = rel_bucket_i(rlo < 0 ? 0 : rlo), bhi = rel_bucket_i(rhi < 0 ? 0 : rhi);
                if (rlo >= 0 && rhi < relmax && bhi - blo <= 1) {
                    int thr = 0x7fffffff;
                    if (bhi != blo) { int a = rlo, b = rhi;
                        while (b - a > 1) { const int mid = (a + b) >> 1; if (rel_bucket_i(mid) == blo) a = mid; else b = mid; }
                        thr = b; }
                    const float pb1 = biasrow[blo], pb2 = biasrow[bhi];
                    const float pa0 = (!SEL || tq0 >= 0) ? pb1 : -1e30f, pa1 = (!SEL || tq0 >= 0) ? pb2 : -1e30f, pc0 = (!SEL || tq1 >= 0) ? pb1 : -1e30f, pc1 = (!SEL || tq1 >= 0) ? pb2 : -1e30f;
                    if (bhi == blo) {
                        if (do0) attn_core<MODE, 1, SEL>(kf, vf, qf[0], tq0, pbase, pstride, relmax, biasrow, psc[0], oacc[0], ls[0], imp0, 16 * t, lg, h, pa0);
                        if (do1) attn_core<MODE, 1, SEL>(kf, vf, qf[1], tq1, pbase, pstride, relmax, biasrow, psc[1], oacc[1], ls[1], imp1, 16 * t, lg, h, pc0);
                    } else {
                        if (do0) attn_core<MODE, 2, SEL>(kf, vf, qf[0], tq[0], pbase, pstride, relmax, biasrow, psc[0], oacc[0], ls[0], imp0, 16 * t, lg, h, pa0, pa1, thr);
                        if (do1) attn_core<MODE, 2, SEL>(kf, vf, qf[1], tq[1], pbase, pstride, relmax, biasrow, psc[1], oacc[1], ls[1], imp1, 16 * t, lg, h, pc0, pc1, thr);
                    }
                } else {
                    if (do0) attn_core<MODE>(kf, vf, qf[0], tq0, pbase, pstride, relmax, biasrow, psc[0], oacc[0], ls[0], imp0, 16 * t, lg, h);
                    if (do1) attn_core<MODE>(kf, vf, qf[1], tq1, pbase, pstride, relmax, biasrow, psc[1], oacc[1], ls[1], imp1, 16 * t, lg, h);
                }
            }
        }
    }
    __syncthreads();
}

__device__ __forceinline__ void phase_attn(const Args& a, LAS unsigned char* lds) {
    unsigned char* ws = WSP;
    int tid_ = threadIdx.x; asm volatile("" : "+v"(tid_));
    const int w = __builtin_amdgcn_readfirstlane(tid_ >> 6);
    LAS float* imp = (LAS float*)(lds + A_IMP);
    LAS unsigned char* ring = lds + A_RING;
    LAS u64* selq = (LAS u64*)(lds + A_SELQ);
    LAS float* biasL = (LAS float*)(lds + A_BIAS);
    LAS float* mbound = (LAS float*)(lds + A_MB);
    const bf16* Q = (const bf16*)(ws + WS_Q);
    const float* gates = (const float*)(ws + WS_GATES);
    const float* relb = IN(23);
    if (w == 0) {
        const int lane = tid_ & 63;
        float mq = fabsf(IN(12)[lane]);
        float mk = fmaxf(fabsf(IN(16)[lane]), fmaxf(fabsf(IN(16)[64 + lane]), fabsf(IN(16)[128 + lane])));
        mq = wave_max(mq); mk = wave_max(mk);
        float mb = -1e30f;
        if (lane < 16) { for (int bk = 0; bk < 32; ++bk) mb = fmaxf(mb, relb[bk * 16 + lane]); mbound[lane] = mb + 8.f * mq * mk; }
    }
    __syncthreads();
    const int nunits = 2048, G = gridDim.x, bx = blockIdx.x;
    for (int it = 0; ; ++it) {
        int bg, qb;
        if (G == 256) {
            if (it >= 8) break;
            const int slot = bx >> 3, oo = slot >> 1; bg = 2 * (bx & 7) + (slot & 1);
            qb = (it & 1) ? 127 - 16 * (it >> 1) - oo : 16 * (it >> 1) + oo;
        } else {
            const int u = bx + it * G; if (u >= nunits) break;
            const int rr = u >> 4, ui = rr >> 4, oo = rr & 15; bg = u & 15;
            qb = (ui & 1) ? 127 - 16 * (ui >> 1) - oo : 16 * (ui >> 1) + oo;
        }
        const int b = bg >> 2, grp = bg & 3, t0 = 64 * qb, tokbase = b * SEQ + t0;
        int tidu = tid_; asm volatile("" : "+v"(tidu));
        const int tid = tidu, lane = tid & 63, lc = lane & 15, lg = lane >> 4, hq = lc >> 2, h = lc & 3;
        const u64 ltmask = (1ull << lane) - 1ull;
        for (int i = tid; i < 8192; i += 512) imp[i] = 0.f;
        if (tid < 128) { const int hh = tid >> 5, bk = tid & 31; biasL[tid] = (relb[bk * 16 + grp * 4 + hh] - mbound[grp * 4 + hh]) * LOG2E; }
        __syncthreads();
        const LAS float* biasrow = biasL + h * 32;
        bf16x8 qf[2][2]; int tqd[2]; float g0[2], g1[2], g2[2];
#pragma unroll
        for (int ct = 0; ct < 2; ++ct) { const int q = 8 * w + 4 * ct + hq; tqd[ct] = t0 + q;
            const bf16* qp = Q + (size_t)(tokbase + q) * DM + (grp * 4 + h) * 64 + 8 * lg; qf[ct][0] = *(const bf16x8*)qp; qf[ct][1] = *(const bf16x8*)(qp + 32);
            const float* gp = gates + (size_t)(tokbase + q) * 48 + (grp * 4 + h) * 3; g0[ct] = gp[0]; g1[ct] = gp[1]; g2[ct] = gp[2]; }
        LAS float* imp0 = imp + (8 * w + hq) * 128; LAS float* imp1 = imp + (8 * w + 4 + hq) * 128;
        LAS float* outp[2] = {(LAS float*)(lds + A_OUT) + ((8 * w + hq) * 4 + h) * 64 + 4 * lg, (LAS float*)(lds + A_OUT) + ((8 * w + 4 + hq) * 4 + h) * 64 + 4 * lg};
        const float one2[2] = {1.f, 1.f};
        {
            const int ncb = 4 * qb + 3, ntc = (ncb + 63) >> 6;
            const bf16* Kc = (const bf16*)(ws + WS_KC) + (size_t)bg * NCB * 64;
            const bf16* VcT = (const bf16*)(ws + WS_VCT) + (size_t)bg * 64 * NCB;
            float ls[2] = {0.f, 0.f}; f32x4 oc[2][4];
#pragma unroll
            for (int ct = 0; ct < 2; ++ct)
#pragma unroll
                for (int dt = 0; dt < 4; ++dt) oc[ct][dt] = (f32x4){0.f, 0.f, 0.f, 0.f};
            tile_stream<0, false>(ring, Kc, VcT, NCB, ntc, 31, 1024, 16, RELMAX_BIG, qf, tqd, biasrow, one2, oc, ls, imp0, imp1, selq, selq, tid, lc, lg, h);
            float inv[2];
#pragma unroll
            for (int ct = 0; ct < 2; ++ct) { float l = ls[ct]; l += __shfl_xor(l, 16); l += __shfl_xor(l, 32); inv[ct] = l > 0.f ? 1.f / l : 0.f; }
            float dummy[2] = {0.f, 0.f};
            tile_stream<2, false>(ring, Kc, VcT, NCB, ntc, 31, 1024, 16, RELMAX_BIG, qf, tqd, biasrow, inv, oc, dummy, imp0, imp1, selq, selq, tid, lc, lg, h);
#pragma unroll
            for (int ct = 0; ct < 2; ++ct)
#pragma unroll
                for (int dt = 0; dt < 4; ++dt) *(LAS f32x4*)(outp[ct] + 16 * dt) = oc[ct][dt] * g0[ct];
        }
        for (int qi = 0; qi < 8; ++qi) {
            const int q = 8 * w + qi; u64 lo, hi;
            if (qb < 16) { lo = (2ull << qb) - 1ull; hi = 0ull; }
            else {
                const int j0 = lane, j1 = lane + 64;
                const bool c0 = (j0 >= 1 && j0 <= qb - 2), c1 = (j1 <= qb - 2);
                const unsigned key0 = c0 ? __builtin_bit_cast(unsigned, imp[q * 128 + j0]) : 0u, key1 = c1 ? __builtin_bit_cast(unsigned, imp[q * 128 + j1]) : 0u;
                unsigned Tk = 0u;
                for (int bit = 30; bit >= 0; --bit) { const unsigned trial = Tk | (1u << bit);
                    const int cnt = __popcll(__ballot(key0 >= trial)) + __popcll(__ballot(key1 >= trial)); if (cnt >= 13) Tk = trial; }
                const bool gt0 = key0 > Tk, gt1 = key1 > Tk, e0 = (key0 == Tk) && c0, e1 = (key1 == Tk) && c1;
                const int need = 13 - (__popcll(__ballot(gt0)) + __popcll(__ballot(gt1)));
                const u64 m0 = __ballot(e0), m1 = __ballot(e1);
                const int r0 = __popcll(m0 & ltmask), r1 = __popcll(m0) + __popcll(m1 & ltmask);
                const bool s0 = gt0 || (e0 && r0 < need) || j0 == 0 || j0 == qb || j0 == qb - 1;
                const bool s1 = gt1 || (e1 && r1 < need) || j1 == qb || j1 == qb - 1;
                lo = __ballot(s0); hi = __ballot(s1);
            }
            if (lane == 0) { selq[q * 2] = lo; selq[q * 2 + 1] = hi; }
        }
        __builtin_amdgcn_wave_barrier();
        {
            const int tf = qb >= 8 ? 0 : 8 - qb, p0 = t0 - 512 + 64 * tf;
            const bf16* Kw = (const bf16*)(ws + WS_KW) + ((size_t)bg * SEQ + p0) * 64;
            const bf16* VwT = (const bf16*)(ws + WS_VWT) + (size_t)bg * 64 * SEQ + p0;
            float ls[2] = {0.f, 0.f}; f32x4 ow[2][4];
#pragma unroll
            for (int ct = 0; ct < 2; ++ct)
#pragma unroll
                for (int dt = 0; dt < 4; ++dt) ow[ct][dt] = (f32x4){0.f, 0.f, 0.f, 0.f};
            tile_stream<1, false>(ring, Kw, VwT, SEQ, 9 - tf, p0, 64, 1, 512, qf, tqd, biasrow, one2, ow, ls, imp0, imp1, selq, selq, tid, lc, lg, h);
#pragma unroll
            for (int ct = 0; ct < 2; ++ct) { float l = ls[ct]; l += __shfl_xor(l, 16); l += __shfl_xor(l, 32); const float sc = g2[ct] / l;
#pragma unroll
                for (int dt = 0; dt < 4; ++dt) *(LAS f32x4*)(outp[ct] + 16 * dt) = *(LAS f32x4*)(outp[ct] + 16 * dt) + ow[ct][dt] * sc; }
        }
        {
            const bf16* Ks = (const bf16*)(ws + WS_KS) + (size_t)bg * SEQ * 64;
            const bf16* VsT = (const bf16*)(ws + WS_VST) + (size_t)bg * 64 * SEQ;
            float ls[2] = {0.f, 0.f}; f32x4 os[2][4];
#pragma unroll
            for (int ct = 0; ct < 2; ++ct)
#pragma unroll
                for (int dt = 0; dt < 4; ++dt) os[ct][dt] = (f32x4){0.f, 0.f, 0.f, 0.f};
            tile_stream<1, true>(ring, Ks, VsT, SEQ, qb + 1, 0, 64, 1, RELMAX_BIG, qf, tqd, biasrow, one2, os, ls, imp0, imp1, selq + (8 * w + hq) * 2, selq + (8 * w + 4 + hq) * 2, tid, lc, lg, h);
            bf16* AO = (bf16*)(ws + WS_AO);
#pragma unroll
            for (int ct = 0; ct < 2; ++ct) { float l = ls[ct]; l += __shfl_xor(l, 16); l += __shfl_xor(l, 32); const float sc = g1[ct] / l;
                bf16* op = AO + (size_t)(tokbase + 8 * w + 4 * ct + hq) * DM + (grp * 4 + h) * 64 + 4 * lg;
#pragma unroll
                for (int dt = 0; dt < 4; ++dt) { const f32x4 v = *(LAS f32x4*)(outp[ct] + 16 * dt) + os[ct][dt] * sc; *(u64*)(op + 16 * dt) = (u64)cvt_pk(v[0], v[1]) | ((u64)cvt_pk(v[2], v[3]) << 32); } }
        }
    }
}

#define XB_TMO      128
#define XB_XCNT(j)  (256  + 64 * (j))
#define XB_XSUB(j)  (1280 + 64 * (j))
#define XB_XGEN(j)  (2304 + 64 * (j))
#define XB_TOP      3328
#define XB_TOPGEN   3392
#define XCD_BAR_WORDS 3456
#define XB_SPIN_CAP (1u << 18)

__device__ __forceinline__ unsigned xb_ld(unsigned* p)              { return __hip_atomic_load(p, __ATOMIC_RELAXED, __HIP_MEMORY_SCOPE_AGENT); }
__device__ __forceinline__ unsigned xb_add(unsigned* p, unsigned v) { return __hip_atomic_fetch_add(p, v, __ATOMIC_RELAXED, __HIP_MEMORY_SCOPE_AGENT); }
__device__ __forceinline__ unsigned xb_xcc_id() { return (unsigned)__builtin_amdgcn_s_getreg((3 << 11) | 20) & 0xFu; }
#define XB_SPIN(cond, bar) do { unsigned _sp = 0; while (cond) { __builtin_amdgcn_s_sleep(1); \
    if ((++_sp & 255u) == 0u) { if (xb_ld(&(bar)[XB_TMO])) break; if (_sp > XB_SPIN_CAP) { atomicAdd(&(bar)[XB_TMO], 1u); break; } } } } while (0)

struct XcdBarrier {
    unsigned* bar; unsigned x;
    volatile LAS unsigned* st;
};

__device__ __forceinline__ XcdBarrier xcd_barrier_post(unsigned* bar, volatile LAS unsigned* st) {
    XcdBarrier b; b.bar = bar; b.x = xb_xcc_id(); b.st = st;
    if (threadIdx.x == 0) (void)xb_add(&bar[XB_XCNT(b.x)], 1u);
    return b;
}
__device__ __forceinline__ void xcd_barrier_complete(unsigned* bar, unsigned x, unsigned& nloc, unsigned& nx) {
    const unsigned G = gridDim.x * gridDim.y * gridDim.z;
    unsigned sum, cnt, mine, sp = 0u;
    for (;;) {
        sum = 0u; cnt = 0u; mine = 0u;
#pragma unroll
        for (unsigned j = 0; j < 16; ++j) { const unsigned c = xb_ld(&bar[XB_XCNT(j)]); sum += c; cnt += (c > 0u) ? 1u : 0u; mine = (j == x) ? c : mine; }
        if (sum == G) break;
        __builtin_amdgcn_s_sleep(1);
        if ((++sp & 255u) == 0u) { if (xb_ld(&bar[XB_TMO])) break; if (sp > XB_SPIN_CAP) { atomicAdd(&bar[XB_TMO], 1u); break; } }
    }
    nloc = mine > 0u ? mine : 1u; nx = cnt > 0u ? cnt : 1u;
}

__device__ __forceinline__ void xcd_barrier(const XcdBarrier& b) {
    asm volatile("s_waitcnt vmcnt(0)" ::: "memory");
    __syncthreads();
    if (threadIdx.x == 0) {
        unsigned* bar = b.bar;
        __builtin_amdgcn_s_waitcnt(0);
        unsigned nloc = b.st[0], nx = b.st[1];
        if (nloc == 0u) { xcd_barrier_complete(bar, b.x, nloc, nx); b.st[0] = nloc; b.st[1] = nx; }
        const unsigned old = xb_add(&bar[XB_XSUB(b.x)], 1u);
        const unsigned gen = old / nloc;
        if (old + 1u == (gen + 1u) * nloc) {
            __builtin_amdgcn_fence(__ATOMIC_RELEASE, "agent");
            asm volatile("s_waitcnt vmcnt(0)" ::: "memory");
            const unsigned og = xb_add(&bar[XB_TOP], 1u);
            const unsigned tg = og / nx;
            if (og + 1u == (tg + 1u) * nx) xb_add(&bar[XB_TOPGEN], 1u);
            else XB_SPIN(xb_ld(&bar[XB_TOPGEN]) == tg, bar);
            __builtin_amdgcn_fence(__ATOMIC_ACQUIRE, "agent");
            xb_add(&bar[XB_XGEN(b.x)], 1u);
            asm volatile("s_waitcnt vmcnt(0)" ::: "memory");
        } else {
            XB_SPIN(xb_ld(&bar[XB_XGEN(b.x)]) == gen, bar);
            __builtin_amdgcn_fence(__ATOMIC_ACQUIRE, "agent");
            asm volatile("s_waitcnt vmcnt(0)" ::: "memory");
        }
    }
    __syncthreads();
}


__global__ void __launch_bounds__(512, 2) mk_fwd(Args a) {
    extern __shared__ __attribute__((aligned(16))) unsigned char lds_raw[];
    LAS unsigned char* lds = (LAS unsigned char*)lds_raw;
    cg::grid_group grid = cg::this_grid();
    unsigned char* ws = WSP;
    const float* x = IN(0); float* hout = KA()->out;
    bf16* HN = (bf16*)(ws + WS_HN); bf16* HN2 = (bf16*)(ws + WS_HN2); bf16* ACT = (bf16*)(ws + WS_ACT);
    const int G = gridDim.x, bx = blockIdx.x;
#define GRID_SYNC() do { \
        if (sync_no == 0u) { asm volatile("s_waitcnt vmcnt(0) lgkmcnt(0)" ::: "memory"); grid.sync(); \
            if (threadIdx.x == 0) { __builtin_amdgcn_fence(__ATOMIC_ACQUIRE, "agent"); asm volatile("s_waitcnt vmcnt(0)" ::: "memory"); } __syncthreads(); \
            xb = xcd_barrier_post(bar_words, xb_st); } \
        else xcd_barrier(xb); \
        ++sync_no; } while (0)
#define GEMM(EPI, Aptr, Bptr, N_, K_, E) do { pg8::Gemm g_{(const pg8::bf16_t*)(Aptr), (const pg8::bf16_t*)(Bptr), T, (N_), (K_)}; pg8::StaticOrder S_; S_.init(T, (N_), G, bx); \
        pg8::gemm_phase<std::remove_cv_t<std::remove_reference_t<decltype(E)>>, pg8::StaticOrder, true, true>((PG8_LAS unsigned char*)lds, g_, S_, (E)); } while (0)

    unsigned* bar_words = (unsigned*)(ws + 4096); unsigned sync_no = 0u;
    for (int i = bx * 512 + threadIdx.x; i < XCD_BAR_WORDS; i += G * 512) __hip_atomic_store(bar_words + i, 0u, __ATOMIC_RELAXED, __HIP_MEMORY_SCOPE_AGENT);
    volatile LAS unsigned* xb_st = (volatile LAS unsigned*)(lds + LDS_BYTES - 16);
    if (threadIdx.x < 2) xb_st[threadIdx.x] = 0u;
    XcdBarrier xb; xb.bar = bar_words; xb.x = 0u; xb.st = xb_st;
    float* SS = (float*)(ws + WS_SS);
#define SSK(k) (SS + (size_t)(k) * T)
    phase_prep(a, lds);
    phase_x(x, HN, SS);
    GRID_SYNC();
    { pg8::EpiSwiglu E{ACT, DFF, SSK(0)}; GEMM(pg8::EpiSwiglu, HN, ws + WS_WIN, 2 * DFF, DM, E); }
    GRID_SYNC();
    { pg8::EpiResid<true, 1, 0, false> E{x, hout, HN, SSK(1)}; GEMM((pg8::EpiResid<true, 1, 0, false>), ACT, ws + WS_WOUT, DM, DFF, E); }
    GRID_SYNC();
    { pg8::EpiConvIn E{(bf16*)(ws + WS_BG), (bf16*)(ws + WS_U), SSK(1)}; GEMM(pg8::EpiConvIn, HN, ws + WS_CWIN, 3072, DM, E); }
    GRID_SYNC();
    phase_conv((const bf16*)(ws + WS_BG), (const bf16*)(ws + WS_U), IN(9), HN2);
    GRID_SYNC();
    { pg8::EpiResid<true, 2, 1, false> E{hout, hout, HN, SSK(2)}; GEMM((pg8::EpiResid<true, 2, 1, false>), HN2, ws + WS_CWOUT, DM, DM, E); }
    GRID_SYNC();
    { pg8::EpiSwiglu E{ACT, DFF, SSK(2)}; GEMM(pg8::EpiSwiglu, HN, ws + WS_WIN + SZ_WIN, 2 * DFF, DM, E); }
    GRID_SYNC();
    { pg8::EpiResid<true, 1, 1, false> E{hout, hout, HN, SSK(3)}; GEMM((pg8::EpiResid<true, 1, 1, false>), ACT, ws + WS_WOUT + SZ_WOUT, DM, DFF, E); }
    GRID_SYNC();
    { pg8::EpiKV E; E.Kb = (bf16*)(ws + WS_KCR); E.Vb = (bf16*)(ws + WS_VCR); E.brstride = KV_BYTES / 2; E.knorm = IN(16); E.ss = SSK(3);
      GEMM(pg8::EpiKV, HN, ws + WS_WKV, NKV, DM, E); }
    GRID_SYNC();
    phase_compress(a, lds);
    { pg8::EpiSwiglu E{ACT, DFF, SSK(3)}; GEMM(pg8::EpiSwiglu, HN, ws + WS_WIN + 2 * SZ_WIN, 2 * DFF, DM, E); }
    GRID_SYNC();
    { pg8::EpiResid<true, 1, 1, false> E{hout, hout, HN, SSK(4)}; GEMM((pg8::EpiResid<true, 1, 1, false>), ACT, ws + WS_WOUT + 2 * SZ_WOUT, DM, DFF, E); }
    GRID_SYNC();
    { pg8::EpiQ E{(bf16*)(ws + WS_Q), (float*)(ws + WS_GATES), IN(12), 0.125f * LOG2E, SSK(4)}; GEMM(pg8::EpiQ, HN, ws + WS_WQ, NQP, DM, E); }
    GRID_SYNC();
    phase_attn(a, lds);
    GRID_SYNC();
    { pg8::EpiResid<true, 2, 1, false> E{hout, hout, HN, SSK(5)}; GEMM((pg8::EpiResid<true, 2, 1, false>), ws + WS_AO, ws + WS_WO, DM, DM, E); }
    GRID_SYNC();
    { pg8::EpiSwiglu E{ACT, DFF, SSK(5)}; GEMM(pg8::EpiSwiglu, HN, ws + WS_WIN + 3 * SZ_WIN, 2 * DFF, DM, E); }
    GRID_SYNC();
    { pg8::EpiResid<false, 1, 1, true> E{hout, hout, HN, nullptr}; GEMM((pg8::EpiResid<false, 1, 1, true>), ACT, ws + WS_WOUT + 3 * SZ_WOUT, DM, DFF, E); }
#undef SSK
#undef GEMM
}

extern "C" void kernel_launch(void* const* d_in, const int* in_sizes, int n_in, void* d_out, int out_size, void* d_ws, size_t ws_size, hipStream_t stream) {
    static int grid = 0;
    if (grid == 0) {
        if (n_in != 24 || out_size != T * DM || ws_size < WS_END) { fprintf(stderr, "kernel_launch: unexpected problem (n_in %d out %d ws %zu)\n", n_in, out_size, ws_size); grid = -1; return; }
        int dev = 0, cus = 0, per_cu = 0;
        (void)hipGetDevice(&dev);
        (void)hipDeviceGetAttribute(&cus, hipDeviceAttributeMultiprocessorCount, dev);
        (void)hipFuncSetAttribute((const void*)mk_fwd, hipFuncAttributeMaxDynamicSharedMemorySize, LDS_BYTES);
        (void)hipOccupancyMaxActiveBlocksPerMultiprocessor(&per_cu, (const void*)mk_fwd, 512, LDS_BYTES);
        if (per_cu < 1) per_cu = 1;
        grid = cus * per_cu;
    }
    if (grid < 0) return;
    Args a{};
    for (int i = 0; i < 24; ++i) a.in[i] = (const float*)d_in[i];
    a.out = (float*)d_out; a.ws = (unsigned char*)d_ws;
    void* args[] = {&a};
    hipError_t e = hipLaunchCooperativeKernel((const void*)mk_fwd, dim3(grid), dim3(512), args, LDS_BYTES, stream);
    if (e != hipSuccess) fprintf(stderr, "cooperative launch failed: %s (grid %d)\n", hipGetErrorString(e), grid);
}
```

```cpp
#include <hip/hip_runtime.h>
#include <hip/hip_cooperative_groups.h>
#include <cstdio>
#include <cstdint>
#include <type_traits>
namespace cg = cooperative_groups;
namespace pg8 {
#define PG8_LAS __attribute__((address_space(3)))
typedef unsigned short bf16_t;
typedef short bf16x8 __attribute__((ext_vector_type(8)));
typedef float f32x4 __attribute__((ext_vector_type(4)));
typedef unsigned u32x4 __attribute__((ext_vector_type(4)));
constexpr int BM = 256, BK = 64, HALF = 128, HTB = HALF * BK * 2  , STAGE_BYTES = 8 * HTB, NXCD = 8, WGM = 8;

__host__ __device__ __forceinline__ int lds_byte(int r, int c) { const int st = (r >> 4) * 2 + (c >> 5), rr = r & 15, cc = c & 31, ob = rr * 64 + cc * 2; return st * 1024 + (ob ^ (((ob >> 9) & 1) << 5)); }
__host__ __device__ __forceinline__ void stage_rc(int b, int& R, int& C) { const int st = b / 1024, sb = b % 1024, swz = sb ^ (((sb >> 9) & 1) << 5); R = (st >> 1) * 16 + swz / 64; C = (st & 1) * 32 + (swz % 64) / 2; }
__host__ __device__ __forceinline__ int perm32(int rho) { const int n = rho >> 4, i = rho & 15; return 8 * (i >> 2) + 4 * n + (i & 3); }

struct Unit { int pm, pn; };
struct Gemm { const bf16_t* A; const bf16_t* Bt; int M, N, K; };

struct StaticOrder {
    int nM, nN, nwg, G, c;
    __host__ __device__ void init(int M, int N, int G_, int c_) { nM = M / BM; nN = N / BM; nwg = nM * nN; G = G_; c = c_; }
    __host__ __device__ bool next(int i, Unit& u) const {
        const long L = (long)i * G + c; if (L >= nwg) return false;
        int wgid = (int)L; { const int q = nwg / NXCD, r = nwg % NXCD, xcd = wgid % NXCD, off = wgid / NXCD; wgid = (xcd < r ? xcd * (q + 1) : r * (q + 1) + (xcd - r) * q) + off; }
        const int nig = WGM * nN, gid = wgid / nig, fm = gid * WGM, gsz = (nM - fm) < WGM ? (nM - fm) : WGM;
        u.pm = fm + ((wgid % nig) % gsz); u.pn = (wgid % nig) / gsz; return true;
    }
    __device__ __forceinline__ void a_ready(const Unit&) const {}
    __device__ __forceinline__ void done(const Unit&) const {}
};

__device__ __forceinline__ unsigned cvt_pk_bf16(float lo, float hi) { unsigned r; asm volatile("v_cvt_pk_bf16_f32 %0, %1, %2" : "=v"(r) : "v"(lo), "v"(hi)); return r; }
__device__ __forceinline__ float fast_sigmoid(float x) { return __builtin_amdgcn_rcpf(1.f + __builtin_amdgcn_exp2f(-1.4426950408889634f * x)); }
__device__ __forceinline__ u32x4 pack8(const f32x4 a, const f32x4 b) { u32x4 w; w.x = cvt_pk_bf16(a[0], a[1]); w.y = cvt_pk_bf16(a[2], a[3]); w.z = cvt_pk_bf16(b[0], b[1]); w.w = cvt_pk_bf16(b[2], b[3]); return w; }

struct EpiSwiglu {
    static constexpr bool PERM = true, AFTER_DRAIN = false;
    bf16_t* O; int ldo; const float* ss;
    __device__ __forceinline__ void operator()(const f32x4 (&acc)[2][2][4][2], const Unit& u, int wr, int wc, int fr, int fq) const {
        const int row0 = u.pm * BM + wr * 64 + fr, col0 = u.pn * HALF + wc * 32 + 8 * fq;
#pragma unroll
        for (int ai = 0; ai < 2; ++ai)
#pragma unroll
            for (int m = 0; m < 4; ++m) {
                f32x4 v[2]; const float rs = __builtin_amdgcn_rsqf(ss[row0 + ai * HALF + m * 16] * (1.f / 1024.f) + 1e-6f);
#pragma unroll
                for (int n = 0; n < 2; ++n) { const f32x4 g = acc[ai][0][m][n] * rs, up = acc[ai][1][m][n] * rs;
#pragma unroll
                    for (int e = 0; e < 4; ++e) v[n][e] = g[e] * fast_sigmoid(g[e]) * up[e]; }
                *(u32x4*)(O + (size_t)(row0 + ai * HALF + m * 16) * ldo + col0) = pack8(v[0], v[1]);
            }
    }
};

template <bool NORM, int ALPHA2  , int HIN, bool FOUT> struct EpiResid {
    static constexpr bool PERM = true, AFTER_DRAIN = false;
    const float* hin; float* hout; bf16_t* HB; float* ssout;
    __device__ __forceinline__ void operator()(const f32x4 (&acc)[2][2][4][2], const Unit& u, int wr, int wc, int fr, int fq) const {
        const int row0 = u.pm * BM + wr * 64 + fr, col0 = u.pn * BM + wc * 32 + 8 * fq; constexpr float alpha = 0.5f * ALPHA2;
#pragma unroll
        for (int ai = 0; ai < 2; ++ai)
#pragma unroll
            for (int m = 0; m < 4; ++m) {
                float sq = 0.f;
#pragma unroll
                for (int bj = 0; bj < 2; ++bj) {
                    const size_t p = (size_t)(row0 + ai * HALF + m * 16) * 1024 + col0 + bj * HALF;
                    f32x4 a0, a1;
                    if (HIN == 0) { a0 = *(const f32x4*)(hin + p); a1 = *(const f32x4*)(hin + p + 4); }
                    else { const u32x4 w = *(const u32x4*)(HB + p);
                        a0 = (f32x4){__builtin_bit_cast(float, w.x << 16), __builtin_bit_cast(float, w.x & 0xffff0000u), __builtin_bit_cast(float, w.y << 16), __builtin_bit_cast(float, w.y & 0xffff0000u)};
                        a1 = (f32x4){__builtin_bit_cast(float, w.z << 16), __builtin_bit_cast(float, w.z & 0xffff0000u), __builtin_bit_cast(float, w.w << 16), __builtin_bit_cast(float, w.w & 0xffff0000u)}; }
                    a0 = a0 + acc[ai][bj][m][0] * alpha; a1 = a1 + acc[ai][bj][m][1] * alpha;
                    if (FOUT) { *(f32x4*)(hout + p) = a0; *(f32x4*)(hout + p + 4) = a1; }
                    if (NORM) { *(u32x4*)(HB + p) = pack8(a0, a1);
                        sq += (a0[0] * a0[0] + a0[1] * a0[1]) + (a0[2] * a0[2] + a0[3] * a0[3]) + (a1[0] * a1[0] + a1[1] * a1[1]) + (a1[2] * a1[2] + a1[3] * a1[3]); }
                }
                if (NORM) { sq += __shfl_xor(sq, 16); sq += __shfl_xor(sq, 32);
                    if (fq == 0) __hip_atomic_fetch_add(ssout + row0 + ai * HALF + m * 16, sq, __ATOMIC_RELAXED, __HIP_MEMORY_SCOPE_AGENT); }
            }
    }
};

struct EpiConvIn {
    static constexpr bool PERM = true, AFTER_DRAIN = false;
    bf16_t* Bg; bf16_t* U; const float* ss;
    __device__ __forceinline__ void operator()(const f32x4 (&acc)[2][2][4][2], const Unit& u, int wr, int wc, int fr, int fq) const {
        const int row0 = u.pm * BM + wr * 64 + fr;
        if (u.pn < 4) {
            const int col0 = u.pn * BM + wc * 32 + 8 * fq;
#pragma unroll
            for (int ai = 0; ai < 2; ++ai)
#pragma unroll
                for (int m = 0; m < 4; ++m)
#pragma unroll
                    for (int bj = 0; bj < 2; ++bj) { const float rs = __builtin_amdgcn_rsqf(ss[row0 + ai * HALF + m * 16] * (1.f / 1024.f) + 1e-6f);
                        *(u32x4*)(Bg + (size_t)(row0 + ai * HALF + m * 16) * 1024 + col0 + bj * HALF) = pack8(acc[ai][bj][m][0] * rs, acc[ai][bj][m][1] * rs); }
        } else {
            const int col0 = (u.pn - 4) * HALF + wc * 32 + 8 * fq;
#pragma unroll
            for (int ai = 0; ai < 2; ++ai)
#pragma unroll
                for (int m = 0; m < 4; ++m) { const float r2 = __builtin_amdgcn_rcpf(ss[row0 + ai * HALF + m * 16] * (1.f / 1024.f) + 1e-6f);
                    *(u32x4*)(U + (size_t)(row0 + ai * HALF + m * 16) * 1024 + col0) = pack8(acc[ai][0][m][0] * acc[ai][1][m][0] * r2, acc[ai][0][m][1] * acc[ai][1][m][1] * r2); }
        }
    }
};

struct EpiKV {
    static constexpr bool PERM = true, AFTER_DRAIN = false;
    bf16_t *Kb, *Vb; size_t brstride; const float* knorm; const float* ss;
    __device__ __forceinline__ void operator()(const f32x4 (&acc)[2][2][4][2], const Unit& u, int wr, int wc, int fr, int fq) const {
        const int br = u.pn >> 1, kv = u.pn & 1;
        const int row0 = u.pm * BM + wr * 64 + fr;
#pragma unroll
        for (int ai = 0; ai < 2; ++ai)
#pragma unroll
            for (int m = 0; m < 4; ++m) {
                const int row = row0 + ai * HALF + m * 16, b = row >> 13, s = row & 8191, bg = b * 4 + wc;
                const float rs = __builtin_amdgcn_rsqf(ss[row] * (1.f / 1024.f) + 1e-6f);
                if (kv == 0) {
                    float rstd = rs;
                    if (br > 0) { float ss = 0.f;
#pragma unroll
                        for (int bj = 0; bj < 2; ++bj)
#pragma unroll
                            for (int n = 0; n < 2; ++n)
#pragma unroll
                                for (int e = 0; e < 4; ++e) ss += acc[ai][bj][m][n][e] * acc[ai][bj][m][n][e];
                        ss += __shfl_xor(ss, 16); ss += __shfl_xor(ss, 32);
                        rstd = rs * __builtin_amdgcn_rsqf(ss * rs * rs * (1.f / 64.f) + 1e-6f); }
                    bf16_t* dst = Kb + (size_t)br * brstride + ((size_t)bg * 8192 + s) * 64 + 8 * fq;
#pragma unroll
                    for (int bj = 0; bj < 2; ++bj) {
                        f32x4 v0 = acc[ai][bj][m][0] * rstd, v1 = acc[ai][bj][m][1] * rstd;
                        if (br > 0) { const float* gp = knorm + br * 64 + bj * 32 + 8 * fq; v0 = v0 * *(const f32x4*)gp; v1 = v1 * *(const f32x4*)(gp + 4); }
                        *(u32x4*)(dst + bj * 32) = pack8(v0, v1);
                    }
                } else if (br == 0) {
                    bf16_t* dst = Vb + ((size_t)bg * 8192 + s) * 64 + 8 * fq;
#pragma unroll
                    for (int bj = 0; bj < 2; ++bj) *(u32x4*)(dst + bj * 32) = pack8(acc[ai][bj][m][0] * rs, acc[ai][bj][m][1] * rs);
                } else {
                    bf16_t* dst = Vb + (size_t)br * brstride + ((size_t)bg * 64 + 8 * fq) * 8192 + s;
#pragma unroll
                    for (int bj = 0; bj < 2; ++bj)
#pragma unroll
                        for (int n = 0; n < 2; ++n) { const f32x4 v = acc[ai][bj][m][n] * rs;
                            const unsigned p0 = cvt_pk_bf16(v[0], v[1]), p1 = cvt_pk_bf16(v[2], v[3]);
                            bf16_t* d = dst + (size_t)(bj * 32 + 4 * n) * 8192;
                            d[0] = (bf16_t)(p0 & 0xffffu); d[8192] = (bf16_t)(p0 >> 16); d[2 * 8192] = (bf16_t)(p1 & 0xffffu); d[3 * 8192] = (bf16_t)(p1 >> 16); }
                }
            }
    }
};

struct EpiQ {
    static constexpr bool PERM = true, AFTER_DRAIN = false;
    bf16_t* Q; float* gates; const float* qnorm; float qscale; const float* ss;
    __device__ __forceinline__ void operator()(const f32x4 (&acc)[2][2][4][2], const Unit& u, int wr, int wc, int fr, int fq) const {
        const int row0 = u.pm * BM + wr * 64 + fr;
        if (u.pn < 4) {
            const int head = u.pn * 4 + wc;
#pragma unroll
            for (int ai = 0; ai < 2; ++ai)
#pragma unroll
                for (int m = 0; m < 4; ++m) {
                    float ss = 0.f;
#pragma unroll
                    for (int bj = 0; bj < 2; ++bj)
#pragma unroll
                        for (int n = 0; n < 2; ++n)
#pragma unroll
                            for (int e = 0; e < 4; ++e) ss += acc[ai][bj][m][n][e] * acc[ai][bj][m][n][e];
                    ss += __shfl_xor(ss, 16); ss += __shfl_xor(ss, 32);
                    const float rs = __builtin_amdgcn_rsqf(this->ss[row0 + ai * HALF + m * 16] * (1.f / 1024.f) + 1e-6f);
                    const float rstd = rs * __builtin_amdgcn_rsqf(ss * rs * rs * (1.f / 64.f) + 1e-6f) * qscale;
                    bf16_t* dst = Q + (size_t)(row0 + ai * HALF + m * 16) * 1024 + head * 64 + 8 * fq;
#pragma unroll
                    for (int bj = 0; bj < 2; ++bj) { const float* gp = qnorm + bj * 32 + 8 * fq;
                        const f32x4 v0 = acc[ai][bj][m][0] * rstd * *(const f32x4*)gp, v1 = acc[ai][bj][m][1] * rstd * *(const f32x4*)(gp + 4);
                        *(u32x4*)(dst + bj * 32) = pack8(v0, v1); }
                }
        } else {
            if (wc < 2) {
#pragma unroll
                for (int ai = 0; ai < 2; ++ai)
#pragma unroll
                    for (int m = 0; m < 4; ++m) {
                        const int c0 = wc * 32 + 8 * fq;
                        if (c0 < 48) { float* dst = gates + (size_t)(row0 + ai * HALF + m * 16) * 48 + c0; const float rs = __builtin_amdgcn_rsqf(this->ss[row0 + ai * HALF + m * 16] * (1.f / 1024.f) + 1e-6f);
                            f32x4 a = acc[ai][0][m][0] * rs, b = acc[ai][0][m][1] * rs;
#pragma unroll
                            for (int e = 0; e < 4; ++e) { a[e] = fast_sigmoid(a[e]); b[e] = fast_sigmoid(b[e]); }
                            *(f32x4*)dst = a; *(f32x4*)(dst + 4) = b; }
                    }
            }
        }
    }
};
template <class Epi, class Sched, bool ALIGN_EPI = false, bool SP2 = false>
__device__ __forceinline__ void gemm_phase(PG8_LAS unsigned char* lds, const Gemm g, const Sched& S, const Epi& E) {
    int tid_ = threadIdx.x; asm volatile("" : "+v"(tid_));
    const int tid = tid_, wid = __builtin_amdgcn_readfirstlane(tid >> 6), lane = tid & 63, wr = wid >> 2, wc = wid & 3, fr = lane & 15, fq = lane >> 4;
    const int K = g.K, nt = K / BK;
    unsigned voffA[2], voffB[2];
#pragma unroll
    for (int i = 0; i < 2; ++i) { int R, C; stage_rc(tid * 16 + i * 8192, R, C); const int Rb = Epi::PERM ? ((R & ~31) + perm32(R & 31)) : R;
        voffA[i] = (unsigned)(R * K + C) * 2u; voffB[i] = (unsigned)(Rb * K + C) * 2u; }
    const size_t kstep = (size_t)(BK * 2);
    const size_t hstep = (size_t)HALF * K * 2;
    const size_t tstep = 2 * hstep;
    const unsigned ldsw = (unsigned)wid * 1024u;
    const int aoff = lds_byte(wr * 64 + fr, fq * 8), boff = lds_byte(wc * 32 + fr, fq * 8);
#define PG8_SA(b, h) (((b) * 2 + (h)) * HTB)
#define PG8_SB(b, h) ((4 + (b) * 2 + (h)) * HTB)
#define PG8_STAGE(bufoff, gbase, voff) do { _Pragma("unroll") for (int _i = 0; _i < 2; ++_i) \
        __builtin_amdgcn_global_load_lds((const unsigned*)((const char*)(gbase) + (voff)[_i]), (PG8_LAS unsigned*)(lds + (bufoff) + ldsw + _i * 8192), 16, 0, 0); } while (0)
#define PG8_LDA(dst, b, h) do { _Pragma("unroll") for (int m = 0; m < 4; ++m) _Pragma("unroll") for (int k = 0; k < 2; ++k) dst[m][k] = *(const PG8_LAS bf16x8*)(lds + PG8_SA(b, h) + aoff + m * 2048 + k * 1024); } while (0)
#define PG8_LDB(dst, b, h) do { _Pragma("unroll") for (int n = 0; n < 2; ++n) _Pragma("unroll") for (int k = 0; k < 2; ++k) dst[n][k] = *(const PG8_LAS bf16x8*)(lds + PG8_SB(b, h) + boff + n * 2048 + k * 1024); } while (0)
#define PG8_MMA(ai, bj, At, Bt) do { __builtin_amdgcn_s_setprio(1); _Pragma("unroll") for (int m = 0; m < 4; ++m) _Pragma("unroll") for (int n = 0; n < 2; ++n) _Pragma("unroll") for (int k = 0; k < 2; ++k) \
        acc[ai][bj][m][n] = __builtin_amdgcn_mfma_f32_16x16x32_bf16(Bt[n][k], At[m][k], acc[ai][bj][m][n], 0, 0, 0); __builtin_amdgcn_s_setprio(0); } while (0)
#define PG8_WAIT_V(n) asm volatile("s_waitcnt vmcnt(" #n ")" ::: "memory")
#define PG8_WAIT_L(n) asm volatile("s_waitcnt lgkmcnt(" #n ")" ::: "memory")
#define PG8_BAR __builtin_amdgcn_s_barrier()
#define PG8_SCHED __builtin_amdgcn_sched_barrier(0)
    Unit cur, nxt; int ui = 0;
    if (!S.next(0, cur)) return;
    f32x4 acc[2][2][4][2];
#pragma unroll
    for (int a = 0; a < 2; ++a)
#pragma unroll
        for (int b = 0; b < 2; ++b)
#pragma unroll
            for (int m = 0; m < 4; ++m)
#pragma unroll
                for (int n = 0; n < 2; ++n) acc[a][b][m][n] = (f32x4){0.f, 0.f, 0.f, 0.f};
    bf16x8 At[4][2], B0[2][2], B1[2][2];
    const char* cA = (const char*)g.A + (size_t)cur.pm * tstep; const char* cB = (const char*)g.Bt + (size_t)cur.pn * tstep;
    S.a_ready(cur);
    if constexpr (SP2) {
        PG8_STAGE(PG8_SB(0, 0), cB, voffB); PG8_STAGE(PG8_SB(0, 1), cB + hstep, voffB); PG8_STAGE(PG8_SA(0, 0), cA, voffA); PG8_STAGE(PG8_SA(0, 1), cA + hstep, voffA);
        if (wr == 1) PG8_BAR;
        PG8_WAIT_V(2); PG8_BAR;
        PG8_STAGE(PG8_SB(1, 0), cB + kstep, voffB); PG8_STAGE(PG8_SA(1, 0), cA + kstep, voffA); PG8_STAGE(PG8_SB(1, 1), cB + hstep + kstep, voffB);
        PG8_WAIT_V(6); PG8_BAR;
    } else {
        PG8_STAGE(PG8_SB(0, 0), cB, voffB); PG8_STAGE(PG8_SA(0, 0), cA, voffA); PG8_STAGE(PG8_SB(0, 1), cB + hstep, voffB); PG8_STAGE(PG8_SA(0, 1), cA + hstep, voffA);
        if (wr == 1) PG8_BAR;
        PG8_WAIT_V(4); PG8_BAR;
        PG8_STAGE(PG8_SB(1, 0), cB + kstep, voffB); PG8_STAGE(PG8_SA(1, 0), cA + kstep, voffA); PG8_STAGE(PG8_SB(1, 1), cB + hstep + kstep, voffB);
        PG8_WAIT_V(6); PG8_BAR;
    }
    for (;;) {
        const bool has_next = S.next(ui + 1, nxt);
        const char* nA = has_next ? (const char*)g.A + (size_t)nxt.pm * tstep : cA; const char* nB = has_next ? (const char*)g.Bt + (size_t)nxt.pn * tstep : cB;
        for (int t = 0; t < nt; t += 2) {
            const bool last = (t == nt - 2);
            const char* a1 = cA + (size_t)(t + 1) * kstep;
            const char* a2 = last ? nA : cA + (size_t)(t + 2) * kstep; const char* b2 = last ? nB : cB + (size_t)(t + 2) * kstep;
            const char* a3 = a2 + kstep; const char* b3 = b2 + kstep;
            if (last && has_next) S.a_ready(nxt);
            if constexpr (SP2) {
            PG8_LDB(B0, 0, 0); PG8_LDB(B1, 0, 1); PG8_SCHED; PG8_LDA(At, 0, 0); PG8_STAGE(PG8_SA(1, 1), a1 + hstep, voffA);
            PG8_WAIT_V(8); PG8_WAIT_L(0); PG8_BAR; PG8_MMA(0, 0, At, B0); PG8_MMA(0, 1, At, B1); PG8_BAR; PG8_SCHED;
            PG8_LDA(At, 0, 1); PG8_STAGE(PG8_SB(0, 0), b2, voffB); PG8_STAGE(PG8_SB(0, 1), b2 + hstep, voffB); PG8_STAGE(PG8_SA(0, 0), a2, voffA);
            PG8_WAIT_V(8); PG8_WAIT_L(0); PG8_BAR; PG8_MMA(1, 0, At, B0); PG8_MMA(1, 1, At, B1); PG8_BAR; PG8_SCHED;
            PG8_LDB(B0, 1, 0); PG8_LDB(B1, 1, 1); PG8_SCHED; PG8_LDA(At, 1, 0); PG8_STAGE(PG8_SA(0, 1), a2 + hstep, voffA);
            PG8_WAIT_V(8); PG8_WAIT_L(0); PG8_BAR; PG8_MMA(0, 0, At, B0); PG8_MMA(0, 1, At, B1); PG8_BAR; PG8_SCHED;
            PG8_LDA(At, 1, 1); PG8_STAGE(PG8_SB(1, 0), b3, voffB); PG8_STAGE(PG8_SB(1, 1), b3 + hstep, voffB); PG8_STAGE(PG8_SA(1, 0), a3, voffA);
            PG8_WAIT_V(8); PG8_WAIT_L(0); PG8_BAR; PG8_MMA(1, 0, At, B0); PG8_MMA(1, 1, At, B1); PG8_BAR; PG8_SCHED;
            } else {
            PG8_LDB(B0, 0, 0); PG8_SCHED; PG8_LDA(At, 0, 0); PG8_STAGE(PG8_SA(1, 1), a1 + hstep, voffA);
            PG8_WAIT_L(8); PG8_BAR; PG8_WAIT_L(0); PG8_MMA(0, 0, At, B0); PG8_BAR; PG8_SCHED;
            PG8_LDB(B1, 0, 1); PG8_STAGE(PG8_SB(0, 0), b2, voffB);
            PG8_BAR; PG8_WAIT_L(0); PG8_MMA(0, 1, At, B1); PG8_BAR;
            PG8_LDA(At, 0, 1); PG8_STAGE(PG8_SA(0, 0), a2, voffA);
            PG8_BAR; PG8_WAIT_L(0); PG8_MMA(1, 0, At, B0); PG8_BAR; PG8_SCHED;
            PG8_STAGE(PG8_SB(0, 1), b2 + hstep, voffB);
            PG8_WAIT_V(6); PG8_BAR; PG8_MMA(1, 1, At, B1); PG8_BAR;
            PG8_LDB(B0, 1, 0); PG8_SCHED; PG8_LDA(At, 1, 0); PG8_STAGE(PG8_SA(0, 1), a2 + hstep, voffA);
            PG8_WAIT_L(8); PG8_BAR; PG8_WAIT_L(0); PG8_MMA(0, 0, At, B0); PG8_BAR; PG8_SCHED;
            PG8_LDB(B1, 1, 1); PG8_STAGE(PG8_SB(1, 0), b3, voffB);
            PG8_BAR; PG8_WAIT_L(0); PG8_MMA(0, 1, At, B1); PG8_BAR;
            PG8_LDA(At, 1, 1); PG8_STAGE(PG8_SA(1, 0), a3, voffA);
            PG8_BAR; PG8_WAIT_L(0); PG8_MMA(1, 0, At, B0); PG8_BAR; PG8_SCHED;
            PG8_STAGE(PG8_SB(1, 1), b3 + hstep, voffB);
            PG8_WAIT_V(6); PG8_BAR; PG8_MMA(1, 1, At, B1); PG8_BAR;
            }
        }
        if constexpr (ALIGN_EPI) { if (wr == 0) PG8_BAR; }
        if constexpr (!Epi::AFTER_DRAIN) { E(acc, cur, wr, wc, fr, fq); S.done(cur); }
        if (!has_next) break;
#pragma unroll
        for (int a = 0; a < 2; ++a)
#pragma unroll
            for (int b = 0; b < 2; ++b)
#pragma unroll
                for (int m = 0; m < 4; ++m)
#pragma unroll
                    for (int n = 0; n < 2; ++n) acc[a][b][m][n] = (f32x4){0.f, 0.f, 0.f, 0.f};
        cur = nxt; cA = nA; cB = nB; ++ui;
        if constexpr (ALIGN_EPI) { if (wr == 1) PG8_BAR; }
    }
    PG8_WAIT_V(0);
    if constexpr (!ALIGN_EPI) { if (wr == 0) PG8_BAR; }
    PG8_BAR;
    if constexpr (Epi::AFTER_DRAIN) { E.fused(acc, cur, wr, wc, fr, fq, lds, wid, lane); S.done(cur); }
#undef PG8_SA
#undef PG8_SB
#undef PG8_STAGE
#undef PG8_LDA
#undef PG8_LDB
#undef PG8_MMA
#undef PG8_WAIT_V
#undef PG8_WAIT_L
#undef PG8_BAR
#undef PG8_SCHED
}
}

#define LAS __attribute__((address_space(3)))
typedef unsigned short bf16;
typedef float f32x4 __attribute__((ext_vector_type(4)));
typedef short bf16x8 __attribute__((ext_vector_type(8)));
typedef unsigned u32x4 __attribute__((ext_vector_type(4)));
typedef unsigned long long u64;

constexpr int NB = 4, SEQ = 8192, DM = 1024, T = NB * SEQ, DFF = 2816, NH = 16, NG = 4, HD = 64;
constexpr int NQP = 1280;
constexpr int NKV = 1536;
constexpr int NCB = 512;
constexpr float RMS_EPS = 1e-6f;
constexpr float LOG2E = 1.4426950408889634f;
constexpr int LDS_BYTES = 151552;

constexpr size_t MiB = 1u << 20;
constexpr size_t SZ_WIN = (size_t)2 * DFF * DM * 2, SZ_WOUT = (size_t)DM * DFF * 2;
constexpr size_t WS_WIN = 1 * MiB;
constexpr size_t WS_WOUT = WS_WIN + 4 * SZ_WIN;
constexpr size_t WS_CWIN = WS_WOUT + 4 * SZ_WOUT;
constexpr size_t WS_CWOUT = WS_CWIN + (size_t)3072 * 1024 * 2;
constexpr size_t WS_WQ = WS_CWOUT + (size_t)1024 * 1024 * 2;
constexpr size_t WS_WO = WS_WQ + (size_t)NQP * 1024 * 2;
constexpr size_t WS_WKV = WS_WO + (size_t)1024 * 1024 * 2;
constexpr size_t WS_W1K = WS_WKV + (size_t)NKV * 1024 * 2;
constexpr size_t WS_W1V = WS_W1K + (size_t)128 * 2048 * 2;
constexpr size_t WS_W2K = WS_W1V + (size_t)128 * 2048 * 2;
constexpr size_t WS_W2V = WS_W2K + (size_t)64 * 128 * 2;
constexpr size_t WS_B1 = WS_W2V + (size_t)64 * 128 * 2;
constexpr size_t WS_WEND = WS_B1 + 1024;
static_assert(WS_WEND <= 90 * MiB, "weights region");
constexpr size_t WS_HN = 96 * MiB;
constexpr size_t WS_HN2 = 160 * MiB;
constexpr size_t WS_ACT = 224 * MiB;
constexpr size_t WS_BG = WS_ACT, WS_U = WS_ACT + 64 * MiB;
constexpr size_t WS_Q = WS_ACT;
constexpr size_t KV_BYTES = (size_t)16 * SEQ * 64 * 2;
constexpr size_t WS_KCR = 400 * MiB, WS_KS = WS_KCR + KV_BYTES, WS_KW = WS_KS + KV_BYTES;
constexpr size_t WS_VCR = WS_KW + KV_BYTES, WS_VST = WS_VCR + KV_BYTES, WS_VWT = WS_VST + KV_BYTES;
constexpr size_t WS_KC = 90 * MiB, WS_VCT = 91 * MiB;
constexpr size_t WS_GATES = WS_VWT + KV_BYTES;
constexpr size_t WS_AO = WS_HN2;
constexpr size_t WS_END = WS_GATES + 6 * MiB;
static_assert(WS_END <= 512 * MiB, "workspace");

struct Args {
    const float* in[24];
    float* out; unsigned char* ws;
};
typedef const __attribute__((address_space(4))) Args* KArgsP;
__device__ __forceinline__ KArgsP KA() { KArgsP p = (KArgsP)__builtin_amdgcn_kernarg_segment_ptr(); asm volatile("" : "+s"(p)); return p; }
#define IN(i) ((const float*)KA()->in[i])
#define WSP ((unsigned char*)KA()->ws)

typedef float f32x2_t __attribute__((ext_vector_type(2)));
typedef __bf16 bf16x2_t __attribute__((ext_vector_type(2)));
__device__ __forceinline__ unsigned cvt_pk(float lo, float hi) { const f32x2_t v = {lo, hi}; const bf16x2_t b = __builtin_convertvector(v, bf16x2_t); return __builtin_bit_cast(unsigned, b); }
__device__ __forceinline__ float bf2f(unsigned short b) { return __builtin_bit_cast(float, (unsigned)b << 16); }
__device__ __forceinline__ float wave_sum(float v) {
#pragma unroll
    for (int o = 1; o < 64; o <<= 1) v += __shfl_xor(v, o);
    return v;
}
__device__ __forceinline__ float wave_max(float v) {
#pragma unroll
    for (int o = 1; o < 64; o <<= 1) v = fmaxf(v, __shfl_xor(v, o));
    return v;
}

enum { MK_IDENT = 0, MK_FFN_IN = 1, MK_CONV_IN = 2, MK_HEADPERM = 3, MK_Q = 4 };
__device__ __forceinline__ int srcmap(int kind, int np) {
    const int pn = np >> 8, r = np & 255, bj = r >> 7, c = r & 127;
    if (kind == MK_FFN_IN) return bj * DFF + 128 * pn + c;
    if (kind == MK_CONV_IN) return pn < 4 ? np : 1024 * (1 + bj) + 128 * (pn - 4) + c;
    if (kind == MK_HEADPERM) return 256 * pn + 64 * (c >> 5) + 32 * bj;
    if (kind == MK_Q) return pn < 4 ? 256 * pn + 64 * (c >> 5) + 32 * bj : (r < 32 ? 1024 : (r < 64 ? 1056 : -1));
    return np;
}
struct MatDesc { const float* W; bf16* WT; int K, N, NP, kind; const float* gain; };

__device__ __forceinline__ void prep_load(const MatDesc& d, int item, int tid, float (&v)[16]) {
    const int nblk = d.NP >> 6, kb = item / nblk, nb = item - kb * nblk;
    const int n = tid & 31, kk = tid >> 5;
#pragma unroll
    for (int s = 0; s < 2; ++s) {
        const int sc = srcmap(d.kind, nb * 64 + s * 32);
        const bool ok = sc >= 0 && (sc + n) < d.N;
        const float* p = d.W + (size_t)(kb * 128 + kk) * d.N + sc + n;
#pragma unroll
        for (int i = 0; i < 8; ++i) v[s * 8 + i] = ok ? p[(size_t)(16 * i) * d.N] * (d.gain ? d.gain[kb * 128 + kk + 16 * i] : 1.f) : 0.f;
    }
}
__device__ __forceinline__ void prep_store_lds(LAS float* scr, int tid, const float (&v)[16]) {
    const int n = tid & 31, kk = tid >> 5;
#pragma unroll
    for (int s = 0; s < 2; ++s)
#pragma unroll
        for (int i = 0; i < 8; ++i) scr[(kk + 16 * i) * 65 + s * 32 + n] = v[s * 8 + i];
}
__device__ __forceinline__ void prep_write(const MatDesc& d, int item, int tid, const LAS float* scr) {
    const int nblk = d.NP >> 6, kb = item / nblk, nb = item - kb * nblk;
#pragma unroll
    for (int s = 0; s < 2; ++s) {
        const int n = (tid >> 4) + 32 * s, c = tid & 15;
        const LAS float* p = scr + (8 * c) * 65 + n;
        u32x4 o; o.x = cvt_pk(p[0], p[65]); o.y = cvt_pk(p[2 * 65], p[3 * 65]); o.z = cvt_pk(p[4 * 65], p[5 * 65]); o.w = cvt_pk(p[6 * 65], p[7 * 65]);
        *(u32x4*)(d.WT + (size_t)(nb * 64 + n) * d.K + kb * 128 + 8 * c) = o;
    }
}

__device__ __forceinline__ MatDesc get_mat(const Args& a, int mi) {
    unsigned char* ws = WSP;
    MatDesc d; d.gain = nullptr;
    if (mi < 4) { const int layer = mi >> 1, f2 = mi & 1;
        d.gain = IN(f2 ? 5 : 1) + layer * DM;
        d.W = IN(f2 ? 6 : 2) + (size_t)layer * DM * 2 * DFF; d.WT = (bf16*)(ws + WS_WIN + (size_t)mi * SZ_WIN); d.K = DM; d.N = 2 * DFF; d.NP = 2 * DFF; d.kind = MK_FFN_IN; return d; }
    if (mi < 8) { const int s = mi - 4, layer = s >> 1, f2 = s & 1;
        d.W = IN(f2 ? 7 : 3) + (size_t)layer * DFF * DM; d.WT = (bf16*)(ws + WS_WOUT + (size_t)s * SZ_WOUT); d.K = DFF; d.N = DM; d.NP = DM; d.kind = MK_IDENT; return d; }
    switch (mi) {
    case 8:  d.W = IN(8);  d.WT = (bf16*)(ws + WS_CWIN);  d.K = DM; d.N = 3072; d.NP = 3072; d.kind = MK_CONV_IN; d.gain = IN(4); break;
    case 9:  d.W = IN(10); d.WT = (bf16*)(ws + WS_CWOUT); d.K = DM; d.N = DM;   d.NP = DM;   d.kind = MK_IDENT; break;
    case 10: d.W = IN(11); d.WT = (bf16*)(ws + WS_WQ);    d.K = DM; d.N = 1072; d.NP = NQP;  d.kind = MK_Q; d.gain = IN(4) + DM; break;
    case 11: d.W = IN(13); d.WT = (bf16*)(ws + WS_WO);    d.K = DM; d.N = DM;   d.NP = DM;   d.kind = MK_IDENT; break;
    case 12: d.W = IN(15); d.WT = (bf16*)(ws + WS_WKV);   d.K = DM; d.N = NKV;  d.NP = NKV;  d.kind = MK_HEADPERM; d.gain = IN(14); break;
    case 13: d.W = IN(19); d.WT = (bf16*)(ws + WS_W1K);   d.K = 2048; d.N = 128; d.NP = 128; d.kind = MK_IDENT; break;
    case 14: d.W = IN(21); d.WT = (bf16*)(ws + WS_W1V);   d.K = 2048; d.N = 128; d.NP = 128; d.kind = MK_IDENT; break;
    case 15: d.W = IN(20); d.WT = (bf16*)(ws + WS_W2K);   d.K = 128; d.N = 64; d.NP = 64; d.kind = MK_IDENT; break;
    default: d.W = IN(22); d.WT = (bf16*)(ws + WS_W2V);   d.K = 128; d.N = 64; d.NP = 64; d.kind = MK_IDENT; break;
    }
    return d;
}
constexpr int N_MATS = 17;
__device__ __forceinline__ int mat_items(int mi) {
    if (mi < 4) return 8 * 88; if (mi < 8) return 22 * 16;
    switch (mi) { case 8: return 8 * 48; case 9: return 8 * 16; case 10: return 8 * 20; case 11: return 8 * 16; case 12: return 8 * 24; case 13: case 14: return 16 * 2; default: return 1; }
}
__device__ __forceinline__ bool prep_locate(int g, int& mi, int& item) {
    for (int m = 0; m < N_MATS; ++m) { const int n = mat_items(m); if (g < n) { mi = m; item = g; return true; } g -= n; }
    return false;
}

__device__ __forceinline__ void phase_prep(const Args& a, LAS unsigned char* lds) {
    LAS float* scr = (LAS float*)lds;
    int tid_ = threadIdx.x; asm volatile("" : "+v"(tid_)); const int tid = tid_, G = gridDim.x;
    float v[16]; int mi, item;
    int g = blockIdx.x;
    bool have = prep_locate(g, mi, item);
    MatDesc d = {};
    if (have) { d = get_mat(a, mi); prep_load(d, item, tid, v); }
    while (have) {
        prep_store_lds(scr, tid, v);
        __syncthreads();
        const MatDesc dc = d; const int itc = item;
        g += G; have = prep_locate(g, mi, item);
        if (have) { d = get_mat(a, mi); prep_load(d, item, tid, v); }
        prep_write(dc, itc, tid, scr);
        __syncthreads();
    }
    if (blockIdx.x < 2) {
        const int kv = blockIdx.x; const float* pe = IN(kv ? 18 : 17); const float* w1 = IN(kv ? 21 : 19);
        const int col = tid & 127, part = tid >> 7; float s = 0.f;
        for (int k = part * 512; k < part * 512 + 512; ++k) s += pe[k] * w1[(size_t)k * 128 + col];
        scr[tid] = s; __syncthreads();
        if (tid < 128) ((float*)(WSP + WS_B1))[kv * 128 + tid] = scr[tid] + scr[tid + 128] + scr[tid + 256] + scr[tid + 384];
        __syncthreads();
    }
}

__device__ __forceinline__ void phase_norm(const float* h, const float* g1, bf16* o1, const float* g2, bf16* o2) {
    int tid_ = threadIdx.x; asm volatile("" : "+v"(tid_));
    const int lane = tid_ & 63, wave = tid_ >> 6;
    const int gw = blockIdx.x * 8 + wave, NGW = gridDim.x * 8;
    f32x4 ga[4], gb[4];
#pragma unroll
    for (int j = 0; j < 4; ++j) { ga[j] = *(const f32x4*)(g1 + 4 * lane + 256 * j); gb[j] = g2 ? *(const f32x4*)(g2 + 4 * lane + 256 * j) : ga[j]; }
    for (int m = gw; m < T; m += NGW) {
        const f32x4* xr = (const f32x4*)(h + (size_t)m * DM) + lane;
        f32x4 v[4]; float s = 0.f;
#pragma unroll
        for (int j = 0; j < 4; ++j) { v[j] = xr[64 * j]; s += (v[j].x * v[j].x + v[j].y * v[j].y) + (v[j].z * v[j].z + v[j].w * v[j].w); }
        const float rstd = __builtin_amdgcn_rsqf(wave_sum(s) * (1.f / DM) + RMS_EPS);
        u64* p1 = (u64*)(o1 + (size_t)m * DM) + lane;
#pragma unroll
        for (int j = 0; j < 4; ++j) { const f32x4 y = v[j] * rstd * ga[j]; p1[64 * j] = (u64)cvt_pk(y.x, y.y) | ((u64)cvt_pk(y.z, y.w) << 32); }
        if (g2) { u64* p2 = (u64*)(o2 + (size_t)m * DM) + lane;
#pragma unroll
            for (int j = 0; j < 4; ++j) { const f32x4 y = v[j] * rstd * gb[j]; p2[64 * j] = (u64)cvt_pk(y.x, y.y) | ((u64)cvt_pk(y.z, y.w) << 32); } }
    }
}

constexpr size_t WS_SS = 131072;
__device__ __forceinline__ void phase_x(const float* x, bf16* hb, float* ss) {
    int tid_ = threadIdx.x; asm volatile("" : "+v"(tid_));
    const int lane = tid_ & 63, wave = tid_ >> 6;
    const int gw = blockIdx.x * 8 + wave, NGW = gridDim.x * 8;
    for (int i = blockIdx.x * 512 + tid_; i < 5 * T; i += gridDim.x * 512) ss[T + i] = 0.f;
    for (int m = gw; m < T; m += NGW) {
        const f32x4* xr = (const f32x4*)(x + (size_t)m * DM) + lane;
        f32x4 v[4]; float s = 0.f;
#pragma unroll
        for (int j = 0; j < 4; ++j) { v[j] = xr[64 * j]; s += (v[j].x * v[j].x + v[j].y * v[j].y) + (v[j].z * v[j].z + v[j].w * v[j].w); }
        s = wave_sum(s);
        u64* p1 = (u64*)(hb + (size_t)m * DM) + lane;
#pragma unroll
        for (int j = 0; j < 4; ++j) p1[64 * j] = (u64)cvt_pk(v[j].x, v[j].y) | ((u64)cvt_pk(v[j].z, v[j].w) << 32);
        if (lane == 0) ss[m] = s;
    }
}

__device__ __forceinline__ void unpack8(const u32x4 w, float (&f)[8]) {
    f[0] = __builtin_bit_cast(float, w.x << 16); f[1] = __builtin_bit_cast(float, w.x & 0xffff0000u); f[2] = __builtin_bit_cast(float, w.y << 16); f[3] = __builtin_bit_cast(float, w.y & 0xffff0000u);
    f[4] = __builtin_bit_cast(float, w.z << 16); f[5] = __builtin_bit_cast(float, w.z & 0xffff0000u); f[6] = __builtin_bit_cast(float, w.w << 16); f[7] = __builtin_bit_cast(float, w.w & 0xffff0000u);
}
__device__ __forceinline__ void phase_conv(const bf16* Bg, const bf16* U, const float* cw, bf16* Z) {
    int tid_ = threadIdx.x; asm volatile("" : "+v"(tid_));
    const int tid = tid_, cc = tid & 127, trow = tid >> 7;
    float w0[8], w1[8], w2[8];
#pragma unroll
    for (int e = 0; e < 8; ++e) { w0[e] = cw[8 * cc + e]; w1[e] = cw[1024 + 8 * cc + e]; w2[e] = cw[2048 + 8 * cc + e]; }
    for (int tb = blockIdx.x; tb < T / 128; tb += gridDim.x) {
        const int tbeg = tb * 128 + trow * 32;
        float u1[8], u2[8];
        if ((tbeg & (SEQ - 1)) == 0) {
#pragma unroll
            for (int e = 0; e < 8; ++e) { u1[e] = 0.f; u2[e] = 0.f; }
        } else {
            unpack8(*(const u32x4*)(U + (size_t)(tbeg - 1) * DM + 8 * cc), u1);
            unpack8(*(const u32x4*)(U + (size_t)(tbeg - 2) * DM + 8 * cc), u2);
        }
#pragma unroll 4
        for (int i = 0; i < 32; ++i) {
            const size_t p = (size_t)(tbeg + i) * DM + 8 * cc;
            float u0[8], bgv[8], z[8];
            unpack8(*(const u32x4*)(U + p), u0); unpack8(*(const u32x4*)(Bg + p), bgv);
#pragma unroll
            for (int e = 0; e < 8; ++e) { z[e] = bgv[e] * (w0[e] * u2[e] + w1[e] * u1[e] + w2[e] * u0[e]); u2[e] = u1[e]; u1[e] = u0[e]; }
            u32x4 o; o.x = cvt_pk(z[0], z[1]); o.y = cvt_pk(z[2], z[3]); o.z = cvt_pk(z[4], z[5]); o.w = cvt_pk(z[6], z[7]);
            *(u32x4*)(Z + p) = o;
        }
    }
}

__device__ __forceinline__ void phase_compress(const Args& a, LAS unsigned char* lds, size_t off_kc = WS_KC, size_t off_vct = WS_VCT) {
    unsigned char* ws = WSP;
    int tid_ = threadIdx.x; asm volatile("" : "+v"(tid_));
    const int tid = tid_, lane = tid & 63, w = tid >> 6, lc = lane & 15, lg = lane >> 4;
    LAS bf16* hid = (LAS bf16*)lds;
    LAS float* outf = (LAS float*)(lds + 32 * 136 * 2);
    for (int u2 = blockIdx.x * 2; u2 < 512; u2 += gridDim.x * 2)
    for (int uu = u2; uu < u2 + 2; ++uu) {
        const int kv = uu >> 8, R0 = (uu & 255) * 32;
        const bf16* raw = (const bf16*)(ws + (kv ? WS_VCR : WS_KCR));
        const bf16* w1t = (const bf16*)(ws + (kv ? WS_W1V : WS_W1K));
        const bf16* w2t = (const bf16*)(ws + (kv ? WS_W2V : WS_W2K));
        const float* b1 = (const float*)(ws + WS_B1) + kv * 128;
        f32x4 acc[2] = {{0.f, 0.f, 0.f, 0.f}, {0.f, 0.f, 0.f, 0.f}};
        const bf16* ap0 = raw + (size_t)(R0 + lc) * 1024 + 8 * lg;
        const bf16* ap1 = ap0 + (size_t)16 * 1024;
        const bf16* bp = w1t + (size_t)(16 * w + lc) * 2048 + 8 * lg;
        bf16x8 A0[4], A1[4], B[4];
#pragma unroll
        for (int s = 0; s < 4; ++s) { A0[s] = *(const bf16x8*)(ap0 + 32 * s); A1[s] = *(const bf16x8*)(ap1 + 32 * s); B[s] = *(const bf16x8*)(bp + 32 * s); }
        for (int k0 = 0; k0 < 2048; k0 += 128) {
            bf16x8 nA0[4], nA1[4], nB[4];
            const int kn = (k0 + 128 < 2048) ? k0 + 128 : k0;
#pragma unroll
            for (int s = 0; s < 4; ++s) { nA0[s] = *(const bf16x8*)(ap0 + kn + 32 * s); nA1[s] = *(const bf16x8*)(ap1 + kn + 32 * s); nB[s] = *(const bf16x8*)(bp + kn + 32 * s); }
#pragma unroll
            for (int s = 0; s < 4; ++s) { acc[0] = __builtin_amdgcn_mfma_f32_16x16x32_bf16(A0[s], B[s], acc[0], 0, 0, 0); acc[1] = __builtin_amdgcn_mfma_f32_16x16x32_bf16(A1[s], B[s], acc[1], 0, 0, 0); }
#pragma unroll
            for (int s = 0; s < 4; ++s) { A0[s] = nA0[s]; A1[s] = nA1[s]; B[s] = nB[s]; }
        }
        { const int col = 16 * w + lc; const float bb = b1[col];
#pragma unroll
          for (int rt = 0; rt < 2; ++rt)
#pragma unroll
            for (int r = 0; r < 4; ++r) { const float x = acc[rt][r] + bb; const float y = 2.f * 0.7978845608028654f * (x + 0.044715f * x * x * x);
                const float gl = x * __builtin_amdgcn_rcpf(1.f + __builtin_amdgcn_exp2f(-LOG2E * y));
                hid[(16 * rt + 4 * lg + r) * 136 + col] = (bf16)(cvt_pk(gl, 0.f) & 0xffffu); } }
        __syncthreads();
        { const int rt = w >> 2, ct = w & 3; f32x4 o = {0.f, 0.f, 0.f, 0.f};
#pragma unroll
          for (int ks = 0; ks < 4; ++ks) { const bf16x8 A = *(const LAS bf16x8*)(hid + (16 * rt + lc) * 136 + 32 * ks + 8 * lg); const bf16x8 B = *(const bf16x8*)(w2t + (size_t)(16 * ct + lc) * 128 + 32 * ks + 8 * lg);
              o = __builtin_amdgcn_mfma_f32_16x16x32_bf16(A, B, o, 0, 0, 0); }
#pragma unroll
          for (int r = 0; r < 4; ++r) outf[(16 * rt + 4 * lg + r) * 65 + 16 * ct + lc] = o[r]; }
        __syncthreads();
        { const int row = tid >> 4, d0 = 4 * (tid & 15); const int R = R0 + row, bg = R >> 9, i = R & 511;
          float v[4]; float ss = 0.f;
#pragma unroll
          for (int e = 0; e < 4; ++e) { v[e] = outf[row * 65 + d0 + e]; ss += v[e] * v[e]; }
          if (kv == 0) {
              ss += __shfl_xor(ss, 1); ss += __shfl_xor(ss, 2); ss += __shfl_xor(ss, 4); ss += __shfl_xor(ss, 8);
              const float rstd = __builtin_amdgcn_rsqf(ss * (1.f / 64.f) + RMS_EPS); const float* kn = IN(16);
#pragma unroll
              for (int e = 0; e < 4; ++e) v[e] = (i == 511) ? 0.f : v[e] * rstd * kn[d0 + e];
              bf16* dst = (bf16*)(ws + off_kc) + ((size_t)bg * NCB + i) * 64 + d0;
              *(u64*)dst = (u64)cvt_pk(v[0], v[1]) | ((u64)cvt_pk(v[2], v[3]) << 32);
          } else {
              bf16* dst = (bf16*)(ws + off_vct) + ((size_t)bg * 64 + d0) * NCB + i;
#pragma unroll
              for (int e = 0; e < 4; ++e) dst[(size_t)e * NCB] = (i == 511) ? (bf16)0 : (bf16)(cvt_pk(v[e], 0.f) & 0xffffu);
          } }
        __syncthreads();
    }
}

constexpr int A_IMP = 0, A_RING = 32768, TILE_PITCH = 192  , TILE_B = 64 * TILE_PITCH, STAGE_B = 2 * TILE_B,
              A_SELQ = A_RING + 2 * STAGE_B, A_BIAS = A_SELQ + 1024, A_MB = A_BIAS + 512, A_OUT = A_MB + 512;
constexpr int RELMAX_BIG = 0x40000000;

template <int MODE, int BM = 0, bool SEL = false>
__device__ __forceinline__ void attn_core(const bf16x8 (&kf)[4][2], const bf16x8 (&vf)[4][2], const bf16x8 (&qf)[2], int tq, int pbase, int pstride, int relmax,
                                          const LAS float* biasrow, float pscale, f32x4 (&oacc)[4], float& lsum, LAS float* improw, int jbase, int lg, int h, float pbias = 0.f, float pbias2 = 0.f, int thr = 0) {
    f32x4 s[4];
#pragma unroll
    for (int kt = 0; kt < 4; ++kt) {
        s[kt] = __builtin_amdgcn_mfma_f32_16x16x32_bf16(kf[kt][0], qf[0], (f32x4){0.f, 0.f, 0.f, 0.f}, 0, 0, 0);
        s[kt] = __builtin_amdgcn_mfma_f32_16x16x32_bf16(kf[kt][1], qf[1], s[kt], 0, 0, 0);
    }
#pragma unroll
    for (int kt = 0; kt < 4; ++kt) {
        const int kap0 = 32 * (kt >> 1) + 8 * lg + 4 * (kt & 1);
        const int rel0 = tq - (pbase + kap0 * pstride);
#pragma unroll
        for (int r = 0; r < 4; ++r) {
            float p;
            if (BM == 1) {
                p = __builtin_amdgcn_exp2f(s[kt][r] + pbias);
            } else if (BM == 2) {
                const int rel = rel0 - r * pstride;
                p = __builtin_amdgcn_exp2f(s[kt][r] + (rel >= thr ? pbias2 : pbias));
            } else if (BM == 3) {
                const int rel = rel0 - r * pstride;
                int bk = 39 - __clz((int)__umul24((unsigned)rel, (unsigned)rel)); bk = bk > 31 ? 31 : bk;
                p = __builtin_amdgcn_exp2f(s[kt][r] + biasrow[bk]);
                if (SEL) p = tq >= 0 ? p : 0.f;
            } else {
            const int rel = rel0 - r * pstride;
            const bool valid = (unsigned)rel < (unsigned)relmax;
            const int n = valid ? rel : 0;
            const int nn = (int)__umul24((unsigned)n, (unsigned)n);
            int bk = 39 - __clz(nn); bk = bk > 31 ? 31 : bk; bk = n < 16 ? n : bk;
            const float x = s[kt][r] + biasrow[bk];
            p = valid ? __builtin_amdgcn_exp2f(x) : 0.f;
            }
            if (MODE == 2) p *= pscale;
            s[kt][r] = p; lsum += p;
        }
        __builtin_amdgcn_sched_barrier(0);
        if (MODE == 2) {
            float av = 2.f * (s[kt][0] + s[kt][1] + s[kt][2]) + s[kt][3], bv = s[kt][3];
            av += __shfl_xor(av, 1); av += __shfl_xor(av, 2); bv += __shfl_xor(bv, 1); bv += __shfl_xor(bv, 2);
            if (h == 0) { const int j = jbase + (kap0 >> 2);
                improw[j] = improw[j] + av;
                if (j + 1 < 128) improw[j + 1] = improw[j + 1] + bv; }
        }
    }
    if (MODE >= 1) {
#pragma unroll
        for (int hh = 0; hh < 2; ++hh) {
            u32x4 pw; pw.x = cvt_pk(s[2 * hh][0], s[2 * hh][1]); pw.y = cvt_pk(s[2 * hh][2], s[2 * hh][3]); pw.z = cvt_pk(s[2 * hh + 1][0], s[2 * hh + 1][1]); pw.w = cvt_pk(s[2 * hh + 1][2], s[2 * hh + 1][3]);
            const bf16x8 pf = __builtin_bit_cast(bf16x8, pw);
#pragma unroll
            for (int dt = 0; dt < 4; ++dt) oacc[dt] = __builtin_amdgcn_mfma_f32_16x16x32_bf16(vf[dt][hh], pf, oacc[dt], 0, 0, 0);
        }
    }
}
__device__ __forceinline__ int rel_bucket_i(int n) { int bk = 39 - __clz((int)((unsigned)n * (unsigned)n)); bk = bk > 31 ? 31 : bk; return n < 16 ? n : bk; }
template <int MODE, bool SEL>
__device__ __forceinline__ void tile_stream(LAS unsigned char* ring, const bf16* Kbase, const bf16* Vbase, int ldv, int nt, int pb0, int pbstep, int pstride, int relmax,
                                            const bf16x8 (&qf)[2][2], const int (&tq)[2], const LAS float* biasrow, const float (&psc)[2], f32x4 (&oacc)[2][4], float (&ls)[2],
                                            LAS float* imp0, LAS float* imp1, const LAS u64* selA, const LAS u64* selB, int tid, int lc, int lg, int h) {
    const int row = tid >> 3, ch = tid & 7;
    const bf16* kp = Kbase + row * 64 + ch * 8;
    const bf16* vp = Vbase + (size_t)row * ldv + ch * 8;
    const int woff = row * TILE_PITCH + ch * 16;
    const float bfar = biasrow[31]; const int tqlo = __builtin_amdgcn_readfirstlane(tq[0]) ;
    u32x4 rk = {0u, 0u, 0u, 0u}, rv = {0u, 0u, 0u, 0u};
    if (nt > 0) { rk = *(const u32x4*)kp; if (MODE > 0) rv = *(const u32x4*)vp; }
    for (int t = 0; t < nt; ++t) {
        LAS unsigned char* st = ring + (t & 1) * STAGE_B;
        *(LAS u32x4*)(st + woff) = rk; if (MODE > 0) *(LAS u32x4*)(st + TILE_B + woff) = rv;
        __syncthreads();
        if (t + 1 < nt) { rk = *(const u32x4*)(kp + (size_t)(t + 1) * 4096); if (MODE > 0) rv = *(const u32x4*)(vp + (t + 1) * 64); }
        int tq0 = tq[0], tq1 = tq[1]; bool do0 = true, do1 = true;
        if (SEL) {
            const bool b0 = ((selA[t >> 6] >> (t & 63)) & 1ull) != 0ull, b1 = ((selB[t >> 6] >> (t & 63)) & 1ull) != 0ull;
            tq0 = b0 ? tq0 : -1; tq1 = b1 ? tq1 : -1; do0 = __ballot(b0) != 0ull; do1 = __ballot(b1) != 0ull;
        }
        if (do0 || do1) {
            bf16x8 kf[4][2], vf[4][2];
#pragma unroll
            for (int kt = 0; kt < 4; ++kt) { const LAS unsigned char* p = st + (32 * (kt >> 1) + 8 * (lc >> 2) + 4 * (kt & 1) + (lc & 3)) * TILE_PITCH + 16 * lg;
                kf[kt][0] = *(const LAS bf16x8*)p; kf[kt][1] = *(const LAS bf16x8*)(p + 64); }
            if (MODE > 0) {
#pragma unroll
                for (int dt = 0; dt < 4; ++dt) { const LAS unsigned char* p = st + TILE_B + (16 * dt + lc) * TILE_PITCH + 16 * lg;
                    vf[dt][0] = *(const LAS bf16x8*)p; vf[dt][1] = *(const LAS bf16x8*)(p + 64); }
            }
            const int pbase = pb0 + t * pbstep;
            {
                const int rlo = tqlo - (pbase + 63 * pstride), rhi = tqlo + 7 - pbase;
                const int blo = rel_bucket_i(rlo < 0 ? 0 : rlo), bhi = rel_bucket_i(rhi < 0 ? 0 : rhi);
                if (rlo >= 0 && rhi < relmax && bhi - blo <= 1) {
                    int thr = 0x7fffffff;
                    if (bhi != blo) { int a = rlo, b = rhi;
                        while (b - a > 1) { const int mid = (a + b) >> 1; if (rel_bucket_i(mid) == blo) a = mid; else b = mid; }
                        thr = b; }
                    const float pb1 = biasrow[blo], pb2 = biasrow[bhi];
                    const float pa0 = (!SEL || tq0 >= 0) ? pb1 : -1e30f, pa1 = (!SEL || tq0 >= 0) ? pb2 : -1e30f, pc0 = (!SEL || tq1 >= 0) ? pb1 : -1e30f, pc1 = (!SEL || tq1 >= 0) ? pb2 : -1e30f;
                    if (bhi == blo) {
                        if (do0) attn_core<MODE, 1, SEL>(kf, vf, qf[0], tq0, pbase, pstride, relmax, biasrow, psc[0], oacc[0], ls[0], imp0, 16 * t, lg, h, pa0);
                        if (do1) attn_core<MODE, 1, SEL>(kf, vf, qf[1], tq1, pbase, pstride, relmax, biasrow, psc[1], oacc[1], ls[1], imp1, 16 * t, lg, h, pc0);
                    } else {
                        if (do0) attn_core<MODE, 2, SEL>(kf, vf, qf[0], tq[0], pbase, pstride, relmax, biasrow, psc[0], oacc[0], ls[0], imp0, 16 * t, lg, h, pa0, pa1, thr);
                        if (do1) attn_core<MODE, 2, SEL>(kf, vf, qf[1], tq[1], pbase, pstride, relmax, biasrow, psc[1], oacc[1], ls[1], imp1, 16 * t, lg, h, pc0, pc1, thr);
                    }
                } else if (rlo >= 16 && rhi < relmax) {
                    if (do0) attn_core<MODE, 3, SEL>(kf, vf, qf[0], tq0, pbase, pstride, relmax, biasrow, psc[0], oacc[0], ls[0], imp0, 16 * t, lg, h);
                    if (do1) attn_core<MODE, 3, SEL>(kf, vf, qf[1], tq1, pbase, pstride, relmax, biasrow, psc[1], oacc[1], ls[1], imp1, 16 * t, lg, h);
                } else {
                    if (do0) attn_core<MODE>(kf, vf, qf[0], tq0, pbase, pstride, relmax, biasrow, psc[0], oacc[0], ls[0], imp0, 16 * t, lg, h);
                    if (do1) attn_core<MODE>(kf, vf, qf[1], tq1, pbase, pstride, relmax, biasrow, psc[1], oacc[1], ls[1], imp1, 16 * t, lg, h);
                }
            }
        }
    }
    __syncthreads();
}

__device__ __forceinline__ void phase_attn(const Args& a, LAS unsigned char* lds) {
    unsigned char* ws = WSP;
    int tid_ = threadIdx.x; asm volatile("" : "+v"(tid_));
    const int w = __builtin_amdgcn_readfirstlane(tid_ >> 6);
    LAS float* imp = (LAS float*)(lds + A_IMP);
    LAS unsigned char* ring = lds + A_RING;
    LAS u64* selq = (LAS u64*)(lds + A_SELQ);
    LAS float* biasL = (LAS float*)(lds + A_BIAS);
    LAS float* mbound = (LAS float*)(lds + A_MB);
    const bf16* Q = (const bf16*)(ws + WS_Q);
    const float* gates = (const float*)(ws + WS_GATES);
    const float* relb = IN(23);
    if (w == 0) {
        const int lane = tid_ & 63;
        float mq = fabsf(IN(12)[lane]);
        float mk = fmaxf(fabsf(IN(16)[lane]), fmaxf(fabsf(IN(16)[64 + lane]), fabsf(IN(16)[128 + lane])));
        mq = wave_max(mq); mk = wave_max(mk);
        float mb = -1e30f;
        if (lane < 16) { for (int bk = 0; bk < 32; ++bk) mb = fmaxf(mb, relb[bk * 16 + lane]); mbound[lane] = mb + 8.f * mq * mk; }
    }
    __syncthreads();
    const int nunits = 2048, G = gridDim.x, bx = blockIdx.x;
    for (int it = 0; ; ++it) {
        int bg, qb;
        if (G == 256) {
            if (it >= 8) break;
            const int slot = bx >> 3, oo = slot >> 1; bg = 2 * (bx & 7) + (slot & 1);
            qb = (it & 1) ? 127 - 16 * (it >> 1) - oo : 16 * (it >> 1) + oo;
        } else {
            const int u = bx + it * G; if (u >= nunits) break;
            const int rr = u >> 4, ui = rr >> 4, oo = rr & 15; bg = u & 15;
            qb = (ui & 1) ? 127 - 16 * (ui >> 1) - oo : 16 * (ui >> 1) + oo;
        }
        const int b = bg >> 2, grp = bg & 3, t0 = 64 * qb, tokbase = b * SEQ + t0;
        int tidu = tid_; asm volatile("" : "+v"(tidu));
        const int tid = tidu, lane = tid & 63, lc = lane & 15, lg = lane >> 4, hq = lc >> 2, h = lc & 3;
        const u64 ltmask = (1ull << lane) - 1ull;
        for (int i = tid; i < 8192; i += 512) imp[i] = 0.f;
        if (tid < 128) { const int hh = tid >> 5, bk = tid & 31; biasL[tid] = (relb[bk * 16 + grp * 4 + hh] - mbound[grp * 4 + hh]) * LOG2E; }
        __syncthreads();
        const LAS float* biasrow = biasL + h * 32;
        bf16x8 qf[2][2]; int tqd[2]; float g0[2], g1[2], g2[2];
#pragma unroll
        for (int ct = 0; ct < 2; ++ct) { const int q = 8 * w + 4 * ct + hq; tqd[ct] = t0 + q;
            const bf16* qp = Q + (size_t)(tokbase + q) * DM + (grp * 4 + h) * 64 + 8 * lg; qf[ct][0] = *(const bf16x8*)qp; qf[ct][1] = *(const bf16x8*)(qp + 32);
            const float* gp = gates + (size_t)(tokbase + q) * 48 + (grp * 4 + h) * 3; g0[ct] = gp[0]; g1[ct] = gp[1]; g2[ct] = gp[2]; }
        LAS float* imp0 = imp + (8 * w + hq) * 128; LAS float* imp1 = imp + (8 * w + 4 + hq) * 128;
        LAS float* outp[2] = {(LAS float*)(lds + A_OUT) + ((8 * w + hq) * 4 + h) * 64 + 4 * lg, (LAS float*)(lds + A_OUT) + ((8 * w + 4 + hq) * 4 + h) * 64 + 4 * lg};
        const float one2[2] = {1.f, 1.f};
        {
            const int ncb = 4 * qb + 3, ntc = (ncb + 63) >> 6;
            const bf16* Kc = (const bf16*)(ws + WS_KC) + (size_t)bg * NCB * 64;
            const bf16* VcT = (const bf16*)(ws + WS_VCT) + (size_t)bg * 64 * NCB;
            float ls[2] = {0.f, 0.f}; f32x4 oc[2][4];
#pragma unroll
            for (int ct = 0; ct < 2; ++ct)
#pragma unroll
                for (int dt = 0; dt < 4; ++dt) oc[ct][dt] = (f32x4){0.f, 0.f, 0.f, 0.f};
            tile_stream<0, false>(ring, Kc, VcT, NCB, ntc, 31, 1024, 16, RELMAX_BIG, qf, tqd, biasrow, one2, oc, ls, imp0, imp1, selq, selq, tid, lc, lg, h);
            float inv[2];
#pragma unroll
            for (int ct = 0; ct < 2; ++ct) { float l = ls[ct]; l += __shfl_xor(l, 16); l += __shfl_xor(l, 32); inv[ct] = l > 0.f ? 1.f / l : 0.f; }
            float dummy[2] = {0.f, 0.f};
            tile_stream<2, false>(ring, Kc, VcT, NCB, ntc, 31, 1024, 16, RELMAX_BIG, qf, tqd, biasrow, inv, oc, dummy, imp0, imp1, selq, selq, tid, lc, lg, h);
#pragma unroll
            for (int ct = 0; ct < 2; ++ct)
#pragma unroll
                for (int dt = 0; dt < 4; ++dt) *(LAS f32x4*)(outp[ct] + 16 * dt) = oc[ct][dt] * g0[ct];
        }
        for (int qi = 0; qi < 8; ++qi) {
            const int q = 8 * w + qi; u64 lo, hi;
            if (qb < 16) { lo = (2ull << qb) - 1ull; hi = 0ull; }
            else {
                const int j0 = lane, j1 = lane + 64;
                const bool c0 = (j0 >= 1 && j0 <= qb - 2), c1 = (j1 <= qb - 2);
                const unsigned key0 = c0 ? __builtin_bit_cast(unsigned, imp[q * 128 + j0]) : 0u, key1 = c1 ? __builtin_bit_cast(unsigned, imp[q * 128 + j1]) : 0u;
                unsigned Tk = 0u;
                for (int bit = 30; bit >= 0; --bit) { const unsigned trial = Tk | (1u << bit);
                    const int cnt = __popcll(__ballot(key0 >= trial)) + __popcll(__ballot(key1 >= trial)); if (cnt >= 13) Tk = trial; }
                const bool gt0 = key0 > Tk, gt1 = key1 > Tk, e0 = (key0 == Tk) && c0, e1 = (key1 == Tk) && c1;
                const int need = 13 - (__popcll(__ballot(gt0)) + __popcll(__ballot(gt1)));
                const u64 m0 = __ballot(e0), m1 = __ballot(e1);
                const int r0 = __popcll(m0 & ltmask), r1 = __popcll(m0) + __popcll(m1 & ltmask);
                const bool s0 = gt0 || (e0 && r0 < need) || j0 == 0 || j0 == qb || j0 == qb - 1;
                const bool s1 = gt1 || (e1 && r1 < need) || j1 == qb || j1 == qb - 1;
                lo = __ballot(s0); hi = __ballot(s1);
            }
            if (lane == 0) { selq[q * 2] = lo; selq[q * 2 + 1] = hi; }
        }
        __builtin_amdgcn_wave_barrier();
        {
            const int tf = qb >= 8 ? 0 : 8 - qb, p0 = t0 - 512 + 64 * tf;
            const bf16* Kw = (const bf16*)(ws + WS_KW) + ((size_t)bg * SEQ + p0) * 64;
            const bf16* VwT = (const bf16*)(ws + WS_VWT) + (size_t)bg * 64 * SEQ + p0;
            float ls[2] = {0.f, 0.f}; f32x4 ow[2][4];
#pragma unroll
            for (int ct = 0; ct < 2; ++ct)
#pragma unroll
                for (int dt = 0; dt < 4; ++dt) ow[ct][dt] = (f32x4){0.f, 0.f, 0.f, 0.f};
            tile_stream<1, false>(ring, Kw, VwT, SEQ, 9 - tf, p0, 64, 1, 512, qf, tqd, biasrow, one2, ow, ls, imp0, imp1, selq, selq, tid, lc, lg, h);
#pragma unroll
            for (int ct = 0; ct < 2; ++ct) { float l = ls[ct]; l += __shfl_xor(l, 16); l += __shfl_xor(l, 32); const float sc = g2[ct] / l;
#pragma unroll
                for (int dt = 0; dt < 4; ++dt) *(LAS f32x4*)(outp[ct] + 16 * dt) = *(LAS f32x4*)(outp[ct] + 16 * dt) + ow[ct][dt] * sc; }
        }
        {
            const bf16* Ks = (const bf16*)(ws + WS_KS) + (size_t)bg * SEQ * 64;
            const bf16* VsT = (const bf16*)(ws + WS_VST) + (size_t)bg * 64 * SEQ;
            float ls[2] = {0.f, 0.f}; f32x4 os[2][4];
#pragma unroll
            for (int ct = 0; ct < 2; ++ct)
#pragma unroll
                for (int dt = 0; dt < 4; ++dt) os[ct][dt] = (f32x4){0.f, 0.f, 0.f, 0.f};
            tile_stream<1, true>(ring, Ks, VsT, SEQ, qb + 1, 0, 64, 1, RELMAX_BIG, qf, tqd, biasrow, one2, os, ls, imp0, imp1, selq + (8 * w + hq) * 2, selq + (8 * w + 4 + hq) * 2, tid, lc, lg, h);
            bf16* AO = (bf16*)(ws + WS_AO);
#pragma unroll
            for (int ct = 0; ct < 2; ++ct) { float l = ls[ct]; l += __shfl_xor(l, 16); l += __shfl_xor(l, 32); const float sc = g1[ct] / l;
                bf16* op = AO + (size_t)(tokbase + 8 * w + 4 * ct + hq) * DM + (grp * 4 + h) * 64 + 4 * lg;
#pragma unroll
                for (int dt = 0; dt < 4; ++dt) { const f32x4 v = *(LAS f32x4*)(outp[ct] + 16 * dt) + os[ct][dt] * sc; *(u64*)(op + 16 * dt) = (u64)cvt_pk(v[0], v[1]) | ((u64)cvt_pk(v[2], v[3]) << 32); } }
        }
    }
}

#define XB_TMO      128
#define XB_XCNT(j)  (256  + 64 * (j))
#define XB_XSUB(j)  (1280 + 64 * (j))
#define XB_XGEN(j)  (2304 + 64 * (j))
#define XB_TOP      3328
#define XB_TOPGEN   3392
#define XCD_BAR_WORDS 3456
#define XB_SPIN_CAP (1u << 18)

__device__ __forceinline__ unsigned xb_ld(unsigned* p)              { return __hip_atomic_load(p, __ATOMIC_RELAXED, __HIP_MEMORY_SCOPE_AGENT); }
__device__ __forceinline__ unsigned xb_add(unsigned* p, unsigned v) { return __hip_atomic_fetch_add(p, v, __ATOMIC_RELAXED, __HIP_MEMORY_SCOPE_AGENT); }
__device__ __forceinline__ unsigned xb_xcc_id() { return (unsigned)__builtin_amdgcn_s_getreg((3 << 11) | 20) & 0xFu; }
#define XB_SPIN(cond, bar) do { unsigned _sp = 0; while (cond) { __builtin_amdgcn_s_sleep(1); \
    if ((++_sp & 255u) == 0u) { if (xb_ld(&(bar)[XB_TMO])) break; if (_sp > XB_SPIN_CAP) { atomicAdd(&(bar)[XB_TMO], 1u); break; } } } } while (0)

struct XcdBarrier {
    unsigned* bar; unsigned x;
    volatile LAS unsigned* st;
};

__device__ __forceinline__ XcdBarrier xcd_barrier_post(unsigned* bar, volatile LAS unsigned* st) {
    XcdBarrier b; b.bar = bar; b.x = xb_xcc_id(); b.st = st;
    if (threadIdx.x == 0) (void)xb_add(&bar[XB_XCNT(b.x)], 1u);
    return b;
}
__device__ __forceinline__ void xcd_barrier_complete(unsigned* bar, unsigned x, unsigned& nloc, unsigned& nx) {
    const unsigned G = gridDim.x * gridDim.y * gridDim.z;
    unsigned sum, cnt, mine, sp = 0u;
    for (;;) {
        sum = 0u; cnt = 0u; mine = 0u;
#pragma unroll
        for (unsigned j = 0; j < 16; ++j) { const unsigned c = xb_ld(&bar[XB_XCNT(j)]); sum += c; cnt += (c > 0u) ? 1u : 0u; mine = (j == x) ? c : mine; }
        if (sum == G) break;
        __builtin_amdgcn_s_sleep(1);
        if ((++sp & 255u) == 0u) { if (xb_ld(&bar[XB_TMO])) break; if (sp > XB_SPIN_CAP) { atomicAdd(&bar[XB_TMO], 1u); break; } }
    }
    nloc = mine > 0u ? mine : 1u; nx = cnt > 0u ? cnt : 1u;
}

__device__ __forceinline__ void xcd_barrier(const XcdBarrier& b) {
    asm volatile("s_waitcnt vmcnt(0)" ::: "memory");
    __syncthreads();
    if (threadIdx.x == 0) {
        unsigned* bar = b.bar;
        __builtin_amdgcn_s_waitcnt(0);
        unsigned nloc = b.st[0], nx = b.st[1];
        if (nloc == 0u) { xcd_barrier_complete(bar, b.x, nloc, nx); b.st[0] = nloc; b.st[1] = nx; }
        const unsigned old = xb_add(&bar[XB_XSUB(b.x)], 1u);
        const unsigned gen = old / nloc;
        if (old + 1u == (gen + 1u) * nloc) {
            __builtin_amdgcn_fence(__ATOMIC_RELEASE, "agent");
            asm volatile("s_waitcnt vmcnt(0)" ::: "memory");
            const unsigned og = xb_add(&bar[XB_TOP], 1u);
            const unsigned tg = og / nx;
            if (og + 1u == (tg + 1u) * nx) xb_add(&bar[XB_TOPGEN], 1u);
            else XB_SPIN(xb_ld(&bar[XB_TOPGEN]) == tg, bar);
            __builtin_amdgcn_fence(__ATOMIC_ACQUIRE, "agent");
            xb_add(&bar[XB_XGEN(b.x)], 1u);
            asm volatile("s_waitcnt vmcnt(0)" ::: "memory");
        } else {
            XB_SPIN(xb_ld(&bar[XB_XGEN(b.x)]) == gen, bar);
            __builtin_amdgcn_fence(__ATOMIC_ACQUIRE, "agent");
            asm volatile("s_waitcnt vmcnt(0)" ::: "memory");
        }
    }
    __syncthreads();
}


__global__ void __launch_bounds__(512, 2) mk_fwd(Args a) {
    extern __shared__ __attribute__((aligned(16))) unsigned char lds_raw[];
    LAS unsigned char* lds = (LAS unsigned char*)lds_raw;
    cg::grid_group grid = cg::this_grid();
    unsigned char* ws = WSP;
    const float* x = IN(0); float* hout = KA()->out;
    bf16* HN = (bf16*)(ws + WS_HN); bf16* HN2 = (bf16*)(ws + WS_HN2); bf16* ACT = (bf16*)(ws + WS_ACT);
    const int G = gridDim.x, bx = blockIdx.x;
#define GRID_SYNC() do { \
        if (sync_no == 0u) { asm volatile("s_waitcnt vmcnt(0) lgkmcnt(0)" ::: "memory"); grid.sync(); \
            if (threadIdx.x == 0) { __builtin_amdgcn_fence(__ATOMIC_ACQUIRE, "agent"); asm volatile("s_waitcnt vmcnt(0)" ::: "memory"); } __syncthreads(); \
            xb = xcd_barrier_post(bar_words, xb_st); } \
        else xcd_barrier(xb); \
        ++sync_no; } while (0)
#define GEMM(EPI, Aptr, Bptr, N_, K_, E) do { pg8::Gemm g_{(const pg8::bf16_t*)(Aptr), (const pg8::bf16_t*)(Bptr), T, (N_), (K_)}; pg8::StaticOrder S_; S_.init(T, (N_), G, bx); \
        pg8::gemm_phase<std::remove_cv_t<std::remove_reference_t<decltype(E)>>, pg8::StaticOrder, true, true>((PG8_LAS unsigned char*)lds, g_, S_, (E)); } while (0)

    unsigned* bar_words = (unsigned*)(ws + 4096); unsigned sync_no = 0u;
    for (int i = bx * 512 + threadIdx.x; i < XCD_BAR_WORDS; i += G * 512) __hip_atomic_store(bar_words + i, 0u, __ATOMIC_RELAXED, __HIP_MEMORY_SCOPE_AGENT);
    volatile LAS unsigned* xb_st = (volatile LAS unsigned*)(lds + LDS_BYTES - 16);
    if (threadIdx.x < 2) xb_st[threadIdx.x] = 0u;
    XcdBarrier xb; xb.bar = bar_words; xb.x = 0u; xb.st = xb_st;
    float* SS = (float*)(ws + WS_SS);
#define SSK(k) (SS + (size_t)(k) * T)
    phase_prep(a, lds);
    phase_x(x, HN, SS);
    GRID_SYNC();
    { pg8::EpiSwiglu E{ACT, DFF, SSK(0)}; GEMM(pg8::EpiSwiglu, HN, ws + WS_WIN, 2 * DFF, DM, E); }
    GRID_SYNC();
    { pg8::EpiResid<true, 1, 0, false> E{x, hout, HN, SSK(1)}; GEMM((pg8::EpiResid<true, 1, 0, false>), ACT, ws + WS_WOUT, DM, DFF, E); }
    GRID_SYNC();
    { pg8::EpiConvIn E{(bf16*)(ws + WS_BG), (bf16*)(ws + WS_U), SSK(1)}; GEMM(pg8::EpiConvIn, HN, ws + WS_CWIN, 3072, DM, E); }
    GRID_SYNC();
    phase_conv((const bf16*)(ws + WS_BG), (const bf16*)(ws + WS_U), IN(9), HN2);
    GRID_SYNC();
    { pg8::EpiResid<true, 2, 1, false> E{hout, hout, HN, SSK(2)}; GEMM((pg8::EpiResid<true, 2, 1, false>), HN2, ws + WS_CWOUT, DM, DM, E); }
    GRID_SYNC();
    { pg8::EpiSwiglu E{ACT, DFF, SSK(2)}; GEMM(pg8::EpiSwiglu, HN, ws + WS_WIN + SZ_WIN, 2 * DFF, DM, E); }
    GRID_SYNC();
    { pg8::EpiResid<true, 1, 1, false> E{hout, hout, HN, SSK(3)}; GEMM((pg8::EpiResid<true, 1, 1, false>), ACT, ws + WS_WOUT + SZ_WOUT, DM, DFF, E); }
    GRID_SYNC();
    { pg8::EpiKV E; E.Kb = (bf16*)(ws + WS_KCR); E.Vb = (bf16*)(ws + WS_VCR); E.brstride = KV_BYTES / 2; E.knorm = IN(16); E.ss = SSK(3);
      GEMM(pg8::EpiKV, HN, ws + WS_WKV, NKV, DM, E); }
    GRID_SYNC();
    phase_compress(a, lds);
    { pg8::EpiSwiglu E{ACT, DFF, SSK(3)}; GEMM(pg8::EpiSwiglu, HN, ws + WS_WIN + 2 * SZ_WIN, 2 * DFF, DM, E); }
    GRID_SYNC();
    { pg8::EpiResid<true, 1, 1, false> E{hout, hout, HN, SSK(4)}; GEMM((pg8::EpiResid<true, 1, 1, false>), ACT, ws + WS_WOUT + 2 * SZ_WOUT, DM, DFF, E); }
    GRID_SYNC();
    { pg8::EpiQ E{(bf16*)(ws + WS_Q), (float*)(ws + WS_GATES), IN(12), 0.125f * LOG2E, SSK(4)}; GEMM(pg8::EpiQ, HN, ws + WS_WQ, NQP, DM, E); }
    GRID_SYNC();
    phase_attn(a, lds);
    GRID_SYNC();
    { pg8::EpiResid<true, 2, 1, false> E{hout, hout, HN, SSK(5)}; GEMM((pg8::EpiResid<true, 2, 1, false>), ws + WS_AO, ws + WS_WO, DM, DM, E); }
    GRID_SYNC();
    { pg8::EpiSwiglu E{ACT, DFF, SSK(5)}; GEMM(pg8::EpiSwiglu, HN, ws + WS_WIN + 3 * SZ_WIN, 2 * DFF, DM, E); }
    GRID_SYNC();
    { pg8::EpiResid<false, 1, 1, true> E{hout, hout, HN, nullptr}; GEMM((pg8::EpiResid<false, 1, 1, true>), ACT, ws + WS_WOUT + 3 * SZ_WOUT, DM, DFF, E); }
#undef SSK
#undef GEMM
}

extern "C" void kernel_launch(void* const* d_in, const int* in_sizes, int n_in, void* d_out, int out_size, void* d_ws, size_t ws_size, hipStream_t stream) {
    static int grid = 0;
    if (grid == 0) {
        if (n_in != 24 || out_size != T * DM || ws_size < WS_END) { fprintf(stderr, "kernel_launch: unexpected problem (n_in %d out %d ws %zu)\n", n_in, out_size, ws_size); grid = -1; return; }
        int dev = 0, cus = 0, per_cu = 0;
        (void)hipGetDevice(&dev);
        (void)hipDeviceGetAttribute(&cus, hipDeviceAttributeMultiprocessorCount, dev);
        (void)hipFuncSetAttribute((const void*)mk_fwd, hipFuncAttributeMaxDynamicSharedMemorySize, LDS_BYTES);
        (void)hipOccupancyMaxActiveBlocksPerMultiprocessor(&per_cu, (const void*)mk_fwd, 512, LDS_BYTES);
        if (per_cu < 1) per_cu = 1;
        grid = cus * per_cu;
    }
    if (grid < 0) return;
    Args a{};
    for (int i = 0; i < 24; ++i) a.in[i] = (const float*)d_in[i];
    a.out = (float*)d_out; a.ws = (unsigned char*)d_ws;
    void* args[] = {&a};
    hipError_t e = hipLaunchCooperativeKernel((const void*)mk_fwd, dim3(grid), dim3(512), args, LDS_BYTES, stream);
    if (e != hipSuccess) fprintf(stderr, "cooperative launch failed: %s (grid %d)\n", hipGetErrorString(e), grid);
}
```

```cpp
#include <hip/hip_runtime.h>
#include <hip/hip_cooperative_groups.h>
#include <cstdio>
#include <cstdint>
#include <type_traits>
namespace cg = cooperative_groups;
namespace pg8 {
#define PG8_LAS __attribute__((address_space(3)))
typedef unsigned short bf16_t;
typedef short bf16x8 __attribute__((ext_vector_type(8)));
typedef float f32x4 __attribute__((ext_vector_type(4)));
typedef unsigned u32x4 __attribute__((ext_vector_type(4)));
constexpr int BM = 256, BK = 64, HALF = 128, HTB = HALF * BK * 2  , STAGE_BYTES = 8 * HTB, NXCD = 8, WGM = 8;

__host__ __device__ __forceinline__ int lds_byte(int r, int c) { const int st = (r >> 4) * 2 + (c >> 5), rr = r & 15, cc = c & 31, ob = rr * 64 + cc * 2; return st * 1024 + (ob ^ (((ob >> 9) & 1) << 5)); }
__host__ __device__ __forceinline__ void stage_rc(int b, int& R, int& C) { const int st = b / 1024, sb = b % 1024, swz = sb ^ (((sb >> 9) & 1) << 5); R = (st >> 1) * 16 + swz / 64; C = (st & 1) * 32 + (swz % 64) / 2; }
__host__ __device__ __forceinline__ int perm32(int rho) { const int n = rho >> 4, i = rho & 15; return 8 * (i >> 2) + 4 * n + (i & 3); }

struct Unit { int pm, pn; };
struct Gemm { const bf16_t* A; const bf16_t* Bt; int M, N, K; };

struct StaticOrder {
    int nM, nN, nwg, G, c;
    __host__ __device__ void init(int M, int N, int G_, int c_) { nM = M / BM; nN = N / BM; nwg = nM * nN; G = G_; c = c_; }
    __host__ __device__ bool next(int i, Unit& u) const {
        const long L = (long)i * G + c; if (L >= nwg) return false;
        int wgid = (int)L; { const int q = nwg / NXCD, r = nwg % NXCD, xcd = wgid % NXCD, off = wgid / NXCD; wgid = (xcd < r ? xcd * (q + 1) : r * (q + 1) + (xcd - r) * q) + off; }
        const int nig = WGM * nN, gid = wgid / nig, fm = gid * WGM, gsz = (nM - fm) < WGM ? (nM - fm) : WGM;
        u.pm = fm + ((wgid % nig) % gsz); u.pn = (wgid % nig) / gsz; return true;
    }
    __device__ __forceinline__ void a_ready(const Unit&) const {}
    __device__ __forceinline__ void done(const Unit&) const {}
};

__device__ __forceinline__ unsigned cvt_pk_bf16(float lo, float hi) { unsigned r; asm volatile("v_cvt_pk_bf16_f32 %0, %1, %2" : "=v"(r) : "v"(lo), "v"(hi)); return r; }
__device__ __forceinline__ float fast_sigmoid(float x) { return __builtin_amdgcn_rcpf(1.f + __builtin_amdgcn_exp2f(-1.4426950408889634f * x)); }
__device__ __forceinline__ u32x4 pack8(const f32x4 a, const f32x4 b) { u32x4 w; w.x = cvt_pk_bf16(a[0], a[1]); w.y = cvt_pk_bf16(a[2], a[3]); w.z = cvt_pk_bf16(b[0], b[1]); w.w = cvt_pk_bf16(b[2], b[3]); return w; }

struct EpiSwiglu {
    static constexpr bool PERM = true, AFTER_DRAIN = false;
    bf16_t* O; int ldo; const float* ss;
    __device__ __forceinline__ void operator()(const f32x4 (&acc)[2][2][4][2], const Unit& u, int wr, int wc, int fr, int fq) const {
        const int row0 = u.pm * BM + wr * 64 + fr, col0 = u.pn * HALF + wc * 32 + 8 * fq;
#pragma unroll
        for (int ai = 0; ai < 2; ++ai)
#pragma unroll
            for (int m = 0; m < 4; ++m) {
                f32x4 v[2]; const float rs = __builtin_amdgcn_rsqf(ss[row0 + ai * HALF + m * 16] * (1.f / 1024.f) + 1e-6f);
#pragma unroll
                for (int n = 0; n < 2; ++n) { const f32x4 g = acc[ai][0][m][n] * rs, up = acc[ai][1][m][n] * rs;
#pragma unroll
                    for (int e = 0; e < 4; ++e) v[n][e] = g[e] * fast_sigmoid(g[e]) * up[e]; }
                *(u32x4*)(O + (size_t)(row0 + ai * HALF + m * 16) * ldo + col0) = pack8(v[0], v[1]);
            }
    }
};

template <bool NORM, int ALPHA2  , int HIN, bool FOUT> struct EpiResid {
    static constexpr bool PERM = true, AFTER_DRAIN = false;
    const float* hin; float* hout; bf16_t* HB; float* ssout;
    __device__ __forceinline__ void operator()(const f32x4 (&acc)[2][2][4][2], const Unit& u, int wr, int wc, int fr, int fq) const {
        const int row0 = u.pm * BM + wr * 64 + fr, col0 = u.pn * BM + wc * 32 + 8 * fq; constexpr float alpha = 0.5f * ALPHA2;
#pragma unroll
        for (int ai = 0; ai < 2; ++ai)
#pragma unroll
            for (int m = 0; m < 4; ++m) {
                float sq = 0.f;
#pragma unroll
                for (int bj = 0; bj < 2; ++bj) {
                    const size_t p = (size_t)(row0 + ai * HALF + m * 16) * 1024 + col0 + bj * HALF;
                    f32x4 a0, a1;
                    if (HIN == 0) { a0 = *(const f32x4*)(hin + p); a1 = *(const f32x4*)(hin + p + 4); }
                    else { const u32x4 w = *(const u32x4*)(HB + p);
                        a0 = (f32x4){__builtin_bit_cast(float, w.x << 16), __builtin_bit_cast(float, w.x & 0xffff0000u), __builtin_bit_cast(float, w.y << 16), __builtin_bit_cast(float, w.y & 0xffff0000u)};
                        a1 = (f32x4){__builtin_bit_cast(float, w.z << 16), __builtin_bit_cast(float, w.z & 0xffff0000u), __builtin_bit_cast(float, w.w << 16), __builtin_bit_cast(float, w.w & 0xffff0000u)}; }
                    a0 = a0 + acc[ai][bj][m][0] * alpha; a1 = a1 + acc[ai][bj][m][1] * alpha;
                    if (FOUT) { *(f32x4*)(hout + p) = a0; *(f32x4*)(hout + p + 4) = a1; }
                    if (NORM) { *(u32x4*)(HB + p) = pack8(a0, a1);
                        sq += (a0[0] * a0[0] + a0[1] * a0[1]) + (a0[2] * a0[2] + a0[3] * a0[3]) + (a1[0] * a1[0] + a1[1] * a1[1]) + (a1[2] * a1[2] + a1[3] * a1[3]); }
                }
                if (NORM) { sq += __shfl_xor(sq, 16); sq += __shfl_xor(sq, 32);
                    if (fq == 0) __hip_atomic_fetch_add(ssout + row0 + ai * HALF + m * 16, sq, __ATOMIC_RELAXED, __HIP_MEMORY_SCOPE_AGENT); }
            }
    }
};

struct EpiConvIn {
    static constexpr bool PERM = true, AFTER_DRAIN = false;
    bf16_t* Bg; bf16_t* U; const float* ss;
    __device__ __forceinline__ void operator()(const f32x4 (&acc)[2][2][4][2], const Unit& u, int wr, int wc, int fr, int fq) const {
        const int row0 = u.pm * BM + wr * 64 + fr;
        if (u.pn < 4) {
            const int col0 = u.pn * BM + wc * 32 + 8 * fq;
#pragma unroll
            for (int ai = 0; ai < 2; ++ai)
#pragma unroll
                for (int m = 0; m < 4; ++m)
#pragma unroll
                    for (int bj = 0; bj < 2; ++bj) { const float rs = __builtin_amdgcn_rsqf(ss[row0 + ai * HALF + m * 16] * (1.f / 1024.f) + 1e-6f);
                        *(u32x4*)(Bg + (size_t)(row0 + ai * HALF + m * 16) * 1024 + col0 + bj * HALF) = pack8(acc[ai][bj][m][0] * rs, acc[ai][bj][m][1] * rs); }
        } else {
            const int col0 = (u.pn - 4) * HALF + wc * 32 + 8 * fq;
#pragma unroll
            for (int ai = 0; ai < 2; ++ai)
#pragma unroll
                for (int m = 0; m < 4; ++m) { const float r2 = __builtin_amdgcn_rcpf(ss[row0 + ai * HALF + m * 16] * (1.f / 1024.f) + 1e-6f);
                    *(u32x4*)(U + (size_t)(row0 + ai * HALF + m * 16) * 1024 + col0) = pack8(acc[ai][0][m][0] * acc[ai][1][m][0] * r2, acc[ai][0][m][1] * acc[ai][1][m][1] * r2); }
        }
    }
};

struct EpiKV {
    static constexpr bool PERM = true, AFTER_DRAIN = false;
    bf16_t *Kb, *Vb; size_t brstride; const float* knorm; const float* ss;
    __device__ __forceinline__ void operator()(const f32x4 (&acc)[2][2][4][2], const Unit& u, int wr, int wc, int fr, int fq) const {
        const int br = u.pn >> 1, kv = u.pn & 1;
        const int row0 = u.pm * BM + wr * 64 + fr;
#pragma unroll
        for (int ai = 0; ai < 2; ++ai)
#pragma unroll
            for (int m = 0; m < 4; ++m) {
                const int row = row0 + ai * HALF + m * 16, b = row >> 13, s = row & 8191, bg = b * 4 + wc;
                const float rs = __builtin_amdgcn_rsqf(ss[row] * (1.f / 1024.f) + 1e-6f);
                if (kv == 0) {
                    float rstd = rs;
                    if (br > 0) { float ss = 0.f;
#pragma unroll
                        for (int bj = 0; bj < 2; ++bj)
#pragma unroll
                            for (int n = 0; n < 2; ++n)
#pragma unroll
                                for (int e = 0; e < 4; ++e) ss += acc[ai][bj][m][n][e] * acc[ai][bj][m][n][e];
                        ss += __shfl_xor(ss, 16); ss += __shfl_xor(ss, 32);
                        rstd = rs * __builtin_amdgcn_rsqf(ss * rs * rs * (1.f / 64.f) + 1e-6f); }
                    bf16_t* dst = Kb + (size_t)br * brstride + ((size_t)bg * 8192 + s) * 64 + 8 * fq;
#pragma unroll
                    for (int bj = 0; bj < 2; ++bj) {
                        f32x4 v0 = acc[ai][bj][m][0] * rstd, v1 = acc[ai][bj][m][1] * rstd;
                        if (br > 0) { const float* gp = knorm + br * 64 + bj * 32 + 8 * fq; v0 = v0 * *(const f32x4*)gp; v1 = v1 * *(const f32x4*)(gp + 4); }
                        *(u32x4*)(dst + bj * 32) = pack8(v0, v1);
                    }
                } else if (br == 0) {
                    bf16_t* dst = Vb + ((size_t)bg * 8192 + s) * 64 + 8 * fq;
#pragma unroll
                    for (int bj = 0; bj < 2; ++bj) *(u32x4*)(dst + bj * 32) = pack8(acc[ai][bj][m][0] * rs, acc[ai][bj][m][1] * rs);
                } else {
                    bf16_t* dst = Vb + (size_t)br * brstride + ((size_t)bg * 64 + 8 * fq) * 8192 + s;
#pragma unroll
                    for (int bj = 0; bj < 2; ++bj)
#pragma unroll
                        for (int n = 0; n < 2; ++n) { const f32x4 v = acc[ai][bj][m][n] * rs;
                            const unsigned p0 = cvt_pk_bf16(v[0], v[1]), p1 = cvt_pk_bf16(v[2], v[3]);
                            bf16_t* d = dst + (size_t)(bj * 32 + 4 * n) * 8192;
                            d[0] = (bf16_t)(p0 & 0xffffu); d[8192] = (bf16_t)(p0 >> 16); d[2 * 8192] = (bf16_t)(p1 & 0xffffu); d[3 * 8192] = (bf16_t)(p1 >> 16); }
                }
            }
    }
};

struct EpiQ {
    static constexpr bool PERM = true, AFTER_DRAIN = false;
    bf16_t* Q; float* gates; const float* qnorm; float qscale; const float* ss;
    __device__ __forceinline__ void operator()(const f32x4 (&acc)[2][2][4][2], const Unit& u, int wr, int wc, int fr, int fq) const {
        const int row0 = u.pm * BM + wr * 64 + fr;
        if (u.pn < 4) {
            const int head = u.pn * 4 + wc;
#pragma unroll
            for (int ai = 0; ai < 2; ++ai)
#pragma unroll
                for (int m = 0; m < 4; ++m) {
                    float ss = 0.f;
#pragma unroll
                    for (int bj = 0; bj < 2; ++bj)
#pragma unroll
                        for (int n = 0; n < 2; ++n)
#pragma unroll
                            for (int e = 0; e < 4; ++e) ss += acc[ai][bj][m][n][e] * acc[ai][bj][m][n][e];
                    ss += __shfl_xor(ss, 16); ss += __shfl_xor(ss, 32);
                    const float rs = __builtin_amdgcn_rsqf(this->ss[row0 + ai * HALF + m * 16] * (1.f / 1024.f) + 1e-6f);
                    const float rstd = rs * __builtin_amdgcn_rsqf(ss * rs * rs * (1.f / 64.f) + 1e-6f) * qscale;
                    bf16_t* dst = Q + (size_t)(row0 + ai * HALF + m * 16) * 1024 + head * 64 + 8 * fq;
#pragma unroll
                    for (int bj = 0; bj < 2; ++bj) { const float* gp = qnorm + bj * 32 + 8 * fq;
                        const f32x4 v0 = acc[ai][bj][m][0] * rstd * *(const f32x4*)gp, v1 = acc[ai][bj][m][1] * rstd * *(const f32x4*)(gp + 4);
                        *(u32x4*)(dst + bj * 32) = pack8(v0, v1); }
                }
        } else {
            if (wc < 2) {
#pragma unroll
                for (int ai = 0; ai < 2; ++ai)
#pragma unroll
                    for (int m = 0; m < 4; ++m) {
                        const int c0 = wc * 32 + 8 * fq;
                        if (c0 < 48) { float* dst = gates + (size_t)(row0 + ai * HALF + m * 16) * 48 + c0; const float rs = __builtin_amdgcn_rsqf(this->ss[row0 + ai * HALF + m * 16] * (1.f / 1024.f) + 1e-6f);
                            f32x4 a = acc[ai][0][m][0] * rs, b = acc[ai][0][m][1] * rs;
#pragma unroll
                            for (int e = 0; e < 4; ++e) { a[e] = fast_sigmoid(a[e]); b[e] = fast_sigmoid(b[e]); }
                            *(f32x4*)dst = a; *(f32x4*)(dst + 4) = b; }
                    }
            }
        }
    }
};
template <class Epi, class Sched, bool ALIGN_EPI = false, bool SP2 = false>
__device__ __forceinline__ void gemm_phase(PG8_LAS unsigned char* lds, const Gemm g, const Sched& S, const Epi& E) {
    int tid_ = threadIdx.x; asm volatile("" : "+v"(tid_));
    const int tid = tid_, wid = __builtin_amdgcn_readfirstlane(tid >> 6), lane = tid & 63, wr = wid >> 2, wc = wid & 3, fr = lane & 15, fq = lane >> 4;
    const int K = g.K, nt = K / BK;
    unsigned voffA[2], voffB[2];
#pragma unroll
    for (int i = 0; i < 2; ++i) { int R, C; stage_rc(tid * 16 + i * 8192, R, C); const int Rb = Epi::PERM ? ((R & ~31) + perm32(R & 31)) : R;
        voffA[i] = (unsigned)(R * K + C) * 2u; voffB[i] = (unsigned)(Rb * K + C) * 2u; }
    const size_t kstep = (size_t)(BK * 2);
    const size_t hstep = (size_t)HALF * K * 2;
    const size_t tstep = 2 * hstep;
    const unsigned ldsw = (unsigned)wid * 1024u;
    const int aoff = lds_byte(wr * 64 + fr, fq * 8), boff = lds_byte(wc * 32 + fr, fq * 8);
#define PG8_SA(b, h) (((b) * 2 + (h)) * HTB)
#define PG8_SB(b, h) ((4 + (b) * 2 + (h)) * HTB)
#define PG8_STAGE(bufoff, gbase, voff) do { _Pragma("unroll") for (int _i = 0; _i < 2; ++_i) \
        __builtin_amdgcn_global_load_lds((const unsigned*)((const char*)(gbase) + (voff)[_i]), (PG8_LAS unsigned*)(lds + (bufoff) + ldsw + _i * 8192), 16, 0, 0); } while (0)
#define PG8_LDA(dst, b, h) do { _Pragma("unroll") for (int m = 0; m < 4; ++m) _Pragma("unroll") for (int k = 0; k < 2; ++k) dst[m][k] = *(const PG8_LAS bf16x8*)(lds + PG8_SA(b, h) + aoff + m * 2048 + k * 1024); } while (0)
#define PG8_LDB(dst, b, h) do { _Pragma("unroll") for (int n = 0; n < 2; ++n) _Pragma("unroll") for (int k = 0; k < 2; ++k) dst[n][k] = *(const PG8_LAS bf16x8*)(lds + PG8_SB(b, h) + boff + n * 2048 + k * 1024); } while (0)
#define PG8_MMA(ai, bj, At, Bt) do { __builtin_amdgcn_s_setprio(1); _Pragma("unroll") for (int m = 0; m < 4; ++m) _Pragma("unroll") for (int n = 0; n < 2; ++n) _Pragma("unroll") for (int k = 0; k < 2; ++k) \
        acc[ai][bj][m][n] = __builtin_amdgcn_mfma_f32_16x16x32_bf16(Bt[n][k], At[m][k], acc[ai][bj][m][n], 0, 0, 0); __builtin_amdgcn_s_setprio(0); } while (0)
#define PG8_WAIT_V(n) asm volatile("s_waitcnt vmcnt(" #n ")" ::: "memory")
#define PG8_WAIT_L(n) asm volatile("s_waitcnt lgkmcnt(" #n ")" ::: "memory")
#define PG8_BAR __builtin_amdgcn_s_barrier()
#define PG8_SCHED __builtin_amdgcn_sched_barrier(0)
    Unit cur, nxt; int ui = 0;
    if (!S.next(0, cur)) return;
    f32x4 acc[2][2][4][2];
#pragma unroll
    for (int a = 0; a < 2; ++a)
#pragma unroll
        for (int b = 0; b < 2; ++b)
#pragma unroll
            for (int m = 0; m < 4; ++m)
#pragma unroll
                for (int n = 0; n < 2; ++n) acc[a][b][m][n] = (f32x4){0.f, 0.f, 0.f, 0.f};
    bf16x8 At[4][2], B0[2][2], B1[2][2];
    const char* cA = (const char*)g.A + (size_t)cur.pm * tstep; const char* cB = (const char*)g.Bt + (size_t)cur.pn * tstep;
    S.a_ready(cur);
    if constexpr (SP2) {
        PG8_STAGE(PG8_SB(0, 0), cB, voffB); PG8_STAGE(PG8_SB(0, 1), cB + hstep, voffB); PG8_STAGE(PG8_SA(0, 0), cA, voffA); PG8_STAGE(PG8_SA(0, 1), cA + hstep, voffA);
        if (wr == 1) PG8_BAR;
        PG8_WAIT_V(2); PG8_BAR;
        PG8_STAGE(PG8_SB(1, 0), cB + kstep, voffB); PG8_STAGE(PG8_SA(1, 0), cA + kstep, voffA); PG8_STAGE(PG8_SB(1, 1), cB + hstep + kstep, voffB);
        PG8_WAIT_V(6); PG8_BAR;
    } else {
        PG8_STAGE(PG8_SB(0, 0), cB, voffB); PG8_STAGE(PG8_SA(0, 0), cA, voffA); PG8_STAGE(PG8_SB(0, 1), cB + hstep, voffB); PG8_STAGE(PG8_SA(0, 1), cA + hstep, voffA);
        if (wr == 1) PG8_BAR;
        PG8_WAIT_V(4); PG8_BAR;
        PG8_STAGE(PG8_SB(1, 0), cB + kstep, voffB); PG8_STAGE(PG8_SA(1, 0), cA + kstep, voffA); PG8_STAGE(PG8_SB(1, 1), cB + hstep + kstep, voffB);
        PG8_WAIT_V(6); PG8_BAR;
    }
    for (;;) {
        const bool has_next = S.next(ui + 1, nxt);
        const char* nA = has_next ? (const char*)g.A + (size_t)nxt.pm * tstep : cA; const char* nB = has_next ? (const char*)g.Bt + (size_t)nxt.pn * tstep : cB;
        for (int t = 0; t < nt; t += 2) {
            const bool last = (t == nt - 2);
            const char* a1 = cA + (size_t)(t + 1) * kstep;
            const char* a2 = last ? nA : cA + (size_t)(t + 2) * kstep; const char* b2 = last ? nB : cB + (size_t)(t + 2) * kstep;
            const char* a3 = a2 + kstep; const char* b3 = b2 + kstep;
            if (last && has_next) S.a_ready(nxt);
            if constexpr (SP2) {
            PG8_LDB(B0, 0, 0); PG8_LDB(B1, 0, 1); PG8_SCHED; PG8_LDA(At, 0, 0); PG8_STAGE(PG8_SA(1, 1), a1 + hstep, voffA);
            PG8_WAIT_V(8); PG8_WAIT_L(0); PG8_BAR; PG8_MMA(0, 0, At, B0); PG8_MMA(0, 1, At, B1); PG8_BAR; PG8_SCHED;
            PG8_LDA(At, 0, 1); PG8_STAGE(PG8_SB(0, 0), b2, voffB); PG8_STAGE(PG8_SB(0, 1), b2 + hstep, voffB); PG8_STAGE(PG8_SA(0, 0), a2, voffA);
            PG8_WAIT_V(8); PG8_WAIT_L(0); PG8_BAR; PG8_MMA(1, 0, At, B0); PG8_MMA(1, 1, At, B1); PG8_BAR; PG8_SCHED;
            PG8_LDB(B0, 1, 0); PG8_LDB(B1, 1, 1); PG8_SCHED; PG8_LDA(At, 1, 0); PG8_STAGE(PG8_SA(0, 1), a2 + hstep, voffA);
            PG8_WAIT_V(8); PG8_WAIT_L(0); PG8_BAR; PG8_MMA(0, 0, At, B0); PG8_MMA(0, 1, At, B1); PG8_BAR; PG8_SCHED;
            PG8_LDA(At, 1, 1); PG8_STAGE(PG8_SB(1, 0), b3, voffB); PG8_STAGE(PG8_SB(1, 1), b3 + hstep, voffB); PG8_STAGE(PG8_SA(1, 0), a3, voffA);
            PG8_WAIT_V(8); PG8_WAIT_L(0); PG8_BAR; PG8_MMA(1, 0, At, B0); PG8_MMA(1, 1, At, B1); PG8_BAR; PG8_SCHED;
            } else {
            PG8_LDB(B0, 0, 0); PG8_SCHED; PG8_LDA(At, 0, 0); PG8_STAGE(PG8_SA(1, 1), a1 + hstep, voffA);
            PG8_WAIT_L(8); PG8_BAR; PG8_WAIT_L(0); PG8_MMA(0, 0, At, B0); PG8_BAR; PG8_SCHED;
            PG8_LDB(B1, 0, 1); PG8_STAGE(PG8_SB(0, 0), b2, voffB);
            PG8_BAR; PG8_WAIT_L(0); PG8_MMA(0, 1, At, B1); PG8_BAR;
            PG8_LDA(At, 0, 1); PG8_STAGE(PG8_SA(0, 0), a2, voffA);
            PG8_BAR; PG8_WAIT_L(0); PG8_MMA(1, 0, At, B0); PG8_BAR; PG8_SCHED;
            PG8_STAGE(PG8_SB(0, 1), b2 + hstep, voffB);
            PG8_WAIT_V(6); PG8_BAR; PG8_MMA(1, 1, At, B1); PG8_BAR;
            PG8_LDB(B0, 1, 0); PG8_SCHED; PG8_LDA(At, 1, 0); PG8_STAGE(PG8_SA(0, 1), a2 + hstep, voffA);
            PG8_WAIT_L(8); PG8_BAR; PG8_WAIT_L(0); PG8_MMA(0, 0, At, B0); PG8_BAR; PG8_SCHED;
            PG8_LDB(B1, 1, 1); PG8_STAGE(PG8_SB(1, 0), b3, voffB);
            PG8_BAR; PG8_WAIT_L(0); PG8_MMA(0, 1, At, B1); PG8_BAR;
            PG8_LDA(At, 1, 1); PG8_STAGE(PG8_SA(1, 0), a3, voffA);
            PG8_BAR; PG8_WAIT_L(0); PG8_MMA(1, 0, At, B0); PG8_BAR; PG8_SCHED;
            PG8_STAGE(PG8_SB(1, 1), b3 + hstep, voffB);
            PG8_WAIT_V(6); PG8_BAR; PG8_MMA(1, 1, At, B1); PG8_BAR;
            }
        }
        if constexpr (ALIGN_EPI) { if (wr == 0) PG8_BAR; }
        if constexpr (!Epi::AFTER_DRAIN) { E(acc, cur, wr, wc, fr, fq); S.done(cur); }
        if (!has_next) break;
#pragma unroll
        for (int a = 0; a < 2; ++a)
#pragma unroll
            for (int b = 0; b < 2; ++b)
#pragma unroll
                for (int m = 0; m < 4; ++m)
#pragma unroll
                    for (int n = 0; n < 2; ++n) acc[a][b][m][n] = (f32x4){0.f, 0.f, 0.f, 0.f};
        cur = nxt; cA = nA; cB = nB; ++ui;
        if constexpr (ALIGN_EPI) { if (wr == 1) PG8_BAR; }
    }
    PG8_WAIT_V(0);
    if constexpr (!ALIGN_EPI) { if (wr == 0) PG8_BAR; }
    PG8_BAR;
    if constexpr (Epi::AFTER_DRAIN) { E.fused(acc, cur, wr, wc, fr, fq, lds, wid, lane); S.done(cur); }
#undef PG8_SA
#undef PG8_SB
#undef PG8_STAGE
#undef PG8_LDA
#undef PG8_LDB
#undef PG8_MMA
#undef PG8_WAIT_V
#undef PG8_WAIT_L
#undef PG8_BAR
#undef PG8_SCHED
}
}

#define LAS __attribute__((address_space(3)))
typedef unsigned short bf16;
typedef float f32x4 __attribute__((ext_vector_type(4)));
typedef short bf16x8 __attribute__((ext_vector_type(8)));
typedef unsigned u32x4 __attribute__((ext_vector_type(4)));
typedef unsigned long long u64;

constexpr int NB = 4, SEQ = 8192, DM = 1024, T = NB * SEQ, DFF = 2816, NH = 16, NG = 4, HD = 64;
constexpr int NQP = 1280;
constexpr int NKV = 1536;
constexpr int NCB = 512;
constexpr float RMS_EPS = 1e-6f;
constexpr float LOG2E = 1.4426950408889634f;
constexpr int LDS_BYTES = 151552;

constexpr size_t MiB = 1u << 20;
constexpr size_t SZ_WIN = (size_t)2 * DFF * DM * 2, SZ_WOUT = (size_t)DM * DFF * 2;
constexpr size_t WS_WIN = 1 * MiB;
constexpr size_t WS_WOUT = WS_WIN + 4 * SZ_WIN;
constexpr size_t WS_CWIN = WS_WOUT + 4 * SZ_WOUT;
constexpr size_t WS_CWOUT = WS_CWIN + (size_t)3072 * 1024 * 2;
constexpr size_t WS_WQ = WS_CWOUT + (size_t)1024 * 1024 * 2;
constexpr size_t WS_WO = WS_WQ + (size_t)NQP * 1024 * 2;
constexpr size_t WS_WKV = WS_WO + (size_t)1024 * 1024 * 2;
constexpr size_t WS_W1K = WS_WKV + (size_t)NKV * 1024 * 2;
constexpr size_t WS_W1V = WS_W1K + (size_t)128 * 2048 * 2;
constexpr size_t WS_W2K = WS_W1V + (size_t)128 * 2048 * 2;
constexpr size_t WS_W2V = WS_W2K + (size_t)64 * 128 * 2;
constexpr size_t WS_B1 = WS_W2V + (size_t)64 * 128 * 2;
constexpr size_t WS_WEND = WS_B1 + 1024;
static_assert(WS_WEND <= 90 * MiB, "weights region");
constexpr size_t WS_HN = 96 * MiB;
constexpr size_t WS_HN2 = 160 * MiB;
constexpr size_t WS_ACT = 224 * MiB;
constexpr size_t WS_BG = WS_ACT, WS_U = WS_ACT + 64 * MiB;
constexpr size_t WS_Q = WS_ACT;
constexpr size_t KV_BYTES = (size_t)16 * SEQ * 64 * 2;
constexpr size_t WS_KCR = 400 * MiB, WS_KS = WS_KCR + KV_BYTES, WS_KW = WS_KS + KV_BYTES;
constexpr size_t WS_VCR = WS_KW + KV_BYTES, WS_VST = WS_VCR + KV_BYTES, WS_VWT = WS_VST + KV_BYTES;
constexpr size_t WS_KC = 90 * MiB, WS_VCT = 91 * MiB;
constexpr size_t WS_GATES = WS_VWT + KV_BYTES;
constexpr size_t WS_AO = WS_HN2;
constexpr size_t WS_END = WS_GATES + 6 * MiB;
static_assert(WS_END <= 512 * MiB, "workspace");

struct Args {
    const float* in[24];
    float* out; unsigned char* ws;
};
typedef const __attribute__((address_space(4))) Args* KArgsP;
__device__ __forceinline__ KArgsP KA() { KArgsP p = (KArgsP)__builtin_amdgcn_kernarg_segment_ptr(); asm volatile("" : "+s"(p)); return p; }
#define IN(i) ((const float*)KA()->in[i])
#define WSP ((unsigned char*)KA()->ws)

typedef float f32x2_t __attribute__((ext_vector_type(2)));
typedef __bf16 bf16x2_t __attribute__((ext_vector_type(2)));
__device__ __forceinline__ unsigned cvt_pk(float lo, float hi) { const f32x2_t v = {lo, hi}; const bf16x2_t b = __builtin_convertvector(v, bf16x2_t); return __builtin_bit_cast(unsigned, b); }
__device__ __forceinline__ float bf2f(unsigned short b) { return __builtin_bit_cast(float, (unsigned)b << 16); }
__device__ __forceinline__ float wave_sum(float v) {
#pragma unroll
    for (int o = 1; o < 64; o <<= 1) v += __shfl_xor(v, o);
    return v;
}
__device__ __forceinline__ float wave_max(float v) {
#pragma unroll
    for (int o = 1; o < 64; o <<= 1) v = fmaxf(v, __shfl_xor(v, o));
    return v;
}

enum { MK_IDENT = 0, MK_FFN_IN = 1, MK_CONV_IN = 2, MK_HEADPERM = 3, MK_Q = 4 };
__device__ __forceinline__ int srcmap(int kind, int np) {
    const int pn = np >> 8, r = np & 255, bj = r >> 7, c = r & 127;
    if (kind == MK_FFN_IN) return bj * DFF + 128 * pn + c;
    if (kind == MK_CONV_IN) return pn < 4 ? np : 1024 * (1 + bj) + 128 * (pn - 4) + c;
    if (kind == MK_HEADPERM) return 256 * pn + 64 * (c >> 5) + 32 * bj;
    if (kind == MK_Q) return pn < 4 ? 256 * pn + 64 * (c >> 5) + 32 * bj : (r < 32 ? 1024 : (r < 64 ? 1056 : -1));
    return np;
}
struct MatDesc { const float* W; bf16* WT; int K, N, NP, kind; const float* gain; };

__device__ __forceinline__ void prep_load(const MatDesc& d, int item, int tid, float (&v)[16]) {
    const int nblk = d.NP >> 6, kb = item / nblk, nb = item - kb * nblk;
    const int n = tid & 31, kk = tid >> 5;
#pragma unroll
    for (int s = 0; s < 2; ++s) {
        const int sc = srcmap(d.kind, nb * 64 + s * 32);
        const bool ok = sc >= 0 && (sc + n) < d.N;
        const float* p = d.W + (size_t)(kb * 128 + kk) * d.N + sc + n;
#pragma unroll
        for (int i = 0; i < 8; ++i) v[s * 8 + i] = ok ? p[(size_t)(16 * i) * d.N] * (d.gain ? d.gain[kb * 128 + kk + 16 * i] : 1.f) : 0.f;
    }
}
__device__ __forceinline__ void prep_store_lds(LAS float* scr, int tid, const float (&v)[16]) {
    const int n = tid & 31, kk = tid >> 5;
#pragma unroll
    for (int s = 0; s < 2; ++s)
#pragma unroll
        for (int i = 0; i < 8; ++i) scr[(kk + 16 * i) * 65 + s * 32 + n] = v[s * 8 + i];
}
__device__ __forceinline__ void prep_write(const MatDesc& d, int item, int tid, const LAS float* scr) {
    const int nblk = d.NP >> 6, kb = item / nblk, nb = item - kb * nblk;
#pragma unroll
    for (int s = 0; s < 2; ++s) {
        const int n = (tid >> 4) + 32 * s, c = tid & 15;
        const LAS float* p = scr + (8 * c) * 65 + n;
        u32x4 o; o.x = cvt_pk(p[0], p[65]); o.y = cvt_pk(p[2 * 65], p[3 * 65]); o.z = cvt_pk(p[4 * 65], p[5 * 65]); o.w = cvt_pk(p[6 * 65], p[7 * 65]);
        *(u32x4*)(d.WT + (size_t)(nb * 64 + n) * d.K + kb * 128 + 8 * c) = o;
    }
}

__device__ __forceinline__ MatDesc get_mat(const Args& a, int mi) {
    unsigned char* ws = WSP;
    MatDesc d; d.gain = nullptr;
    if (mi < 4) { const int layer = mi >> 1, f2 = mi & 1;
        d.gain = IN(f2 ? 5 : 1) + layer * DM;
        d.W = IN(f2 ? 6 : 2) + (size_t)layer * DM * 2 * DFF; d.WT = (bf16*)(ws + WS_WIN + (size_t)mi * SZ_WIN); d.K = DM; d.N = 2 * DFF; d.NP = 2 * DFF; d.kind = MK_FFN_IN; return d; }
    if (mi < 8) { const int s = mi - 4, layer = s >> 1, f2 = s & 1;
        d.W = IN(f2 ? 7 : 3) + (size_t)layer * DFF * DM; d.WT = (bf16*)(ws + WS_WOUT + (size_t)s * SZ_WOUT); d.K = DFF; d.N = DM; d.NP = DM; d.kind = MK_IDENT; return d; }
    switch (mi) {
    case 8:  d.W = IN(8);  d.WT = (bf16*)(ws + WS_CWIN);  d.K = DM; d.N = 3072; d.NP = 3072; d.kind = MK_CONV_IN; d.gain = IN(4); break;
    case 9:  d.W = IN(10); d.WT = (bf16*)(ws + WS_CWOUT); d.K = DM; d.N = DM;   d.NP = DM;   d.kind = MK_IDENT; break;
    case 10: d.W = IN(11); d.WT = (bf16*)(ws + WS_WQ);    d.K = DM; d.N = 1072; d.NP = NQP;  d.kind = MK_Q; d.gain = IN(4) + DM; break;
    case 11: d.W = IN(13); d.WT = (bf16*)(ws + WS_WO);    d.K = DM; d.N = DM;   d.NP = DM;   d.kind = MK_IDENT; break;
    case 12: d.W = IN(15); d.WT = (bf16*)(ws + WS_WKV);   d.K = DM; d.N = NKV;  d.NP = NKV;  d.kind = MK_HEADPERM; d.gain = IN(14); break;
    case 13: d.W = IN(19); d.WT = (bf16*)(ws + WS_W1K);   d.K = 2048; d.N = 128; d.NP = 128; d.kind = MK_IDENT; break;
    case 14: d.W = IN(21); d.WT = (bf16*)(ws + WS_W1V);   d.K = 2048; d.N = 128; d.NP = 128; d.kind = MK_IDENT; break;
    case 15: d.W = IN(20); d.WT = (bf16*)(ws + WS_W2K);   d.K = 128; d.N = 64; d.NP = 64; d.kind = MK_IDENT; break;
    default: d.W = IN(22); d.WT = (bf16*)(ws + WS_W2V);   d.K = 128; d.N = 64; d.NP = 64; d.kind = MK_IDENT; break;
    }
    return d;
}
constexpr int N_MATS = 17;
__device__ __forceinline__ int mat_items(int mi) {
    if (mi < 4) return 8 * 88; if (mi < 8) return 22 * 16;
    switch (mi) { case 8: return 8 * 48; case 9: return 8 * 16; case 10: return 8 * 20; case 11: return 8 * 16; case 12: return 8 * 24; case 13: case 14: return 16 * 2; default: return 1; }
}
__device__ __forceinline__ bool prep_locate(int g, int& mi, int& item) {
    for (int m = 0; m < N_MATS; ++m) { const int n = mat_items(m); if (g < n) { mi = m; item = g; return true; } g -= n; }
    return false;
}

__device__ __forceinline__ void phase_prep(const Args& a, LAS unsigned char* lds) {
    LAS float* scr = (LAS float*)lds;
    int tid_ = threadIdx.x; asm volatile("" : "+v"(tid_)); const int tid = tid_, G = gridDim.x;
    float v[16]; int mi, item;
    int g = blockIdx.x;
    bool have = prep_locate(g, mi, item);
    MatDesc d = {};
    if (have) { d = get_mat(a, mi); prep_load(d, item, tid, v); }
    while (have) {
        prep_store_lds(scr, tid, v);
        __syncthreads();
        const MatDesc dc = d; const int itc = item;
        g += G; have = prep_locate(g, mi, item);
        if (have) { d = get_mat(a, mi); prep_load(d, item, tid, v); }
        prep_write(dc, itc, tid, scr);
        __syncthreads();
    }
    if (blockIdx.x < 2) {
        const int kv = blockIdx.x; const float* pe = IN(kv ? 18 : 17); const float* w1 = IN(kv ? 21 : 19);
        const int col = tid & 127, part = tid >> 7; float s = 0.f;
        for (int k = part * 512; k < part * 512 + 512; ++k) s += pe[k] * w1[(size_t)k * 128 + col];
        scr[tid] = s; __syncthreads();
        if (tid < 128) ((float*)(WSP + WS_B1))[kv * 128 + tid] = scr[tid] + scr[tid + 128] + scr[tid + 256] + scr[tid + 384];
        __syncthreads();
    }
}

__device__ __forceinline__ void phase_norm(const float* h, const float* g1, bf16* o1, const float* g2, bf16* o2) {
    int tid_ = threadIdx.x; asm volatile("" : "+v"(tid_));
    const int lane = tid_ & 63, wave = tid_ >> 6;
    const int gw = blockIdx.x * 8 + wave, NGW = gridDim.x * 8;
    f32x4 ga[4], gb[4];
#pragma unroll
    for (int j = 0; j < 4; ++j) { ga[j] = *(const f32x4*)(g1 + 4 * lane + 256 * j); gb[j] = g2 ? *(const f32x4*)(g2 + 4 * lane + 256 * j) : ga[j]; }
    for (int m = gw; m < T; m += NGW) {
        const f32x4* xr = (const f32x4*)(h + (size_t)m * DM) + lane;
        f32x4 v[4]; float s = 0.f;
#pragma unroll
        for (int j = 0; j < 4; ++j) { v[j] = xr[64 * j]; s += (v[j].x * v[j].x + v[j].y * v[j].y) + (v[j].z * v[j].z + v[j].w * v[j].w); }
        const float rstd = __builtin_amdgcn_rsqf(wave_sum(s) * (1.f / DM) + RMS_EPS);
        u64* p1 = (u64*)(o1 + (size_t)m * DM) + lane;
#pragma unroll
        for (int j = 0; j < 4; ++j) { const f32x4 y = v[j] * rstd * ga[j]; p1[64 * j] = (u64)cvt_pk(y.x, y.y) | ((u64)cvt_pk(y.z, y.w) << 32); }
        if (g2) { u64* p2 = (u64*)(o2 + (size_t)m * DM) + lane;
#pragma unroll
            for (int j = 0; j < 4; ++j) { const f32x4 y = v[j] * rstd * gb[j]; p2[64 * j] = (u64)cvt_pk(y.x, y.y) | ((u64)cvt_pk(y.z, y.w) << 32); } }
    }
}

constexpr size_t WS_SS = 131072;
__device__ __forceinline__ void phase_x(const float* x, bf16* hb, float* ss) {
    int tid_ = threadIdx.x; asm volatile("" : "+v"(tid_));
    const int lane = tid_ & 63, wave = tid_ >> 6;
    const int gw = blockIdx.x * 8 + wave, NGW = gridDim.x * 8;
    for (int i = blockIdx.x * 512 + tid_; i < 5 * T; i += gridDim.x * 512) ss[T + i] = 0.f;
    for (int m = gw; m < T; m += NGW) {
        const f32x4* xr = (const f32x4*)(x + (size_t)m * DM) + lane;
        f32x4 v[4]; float s = 0.f;
#pragma unroll
        for (int j = 0; j < 4; ++j) { v[j] = xr[64 * j]; s += (v[j].x * v[j].x + v[j].y * v[j].y) + (v[j].z * v[j].z + v[j].w * v[j].w); }
        s = wave_sum(s);
        u64* p1 = (u64*)(hb + (size_t)m * DM) + lane;
#pragma unroll
        for (int j = 0; j < 4; ++j) p1[64 * j] = (u64)cvt_pk(v[j].x, v[j].y) | ((u64)cvt_pk(v[j].z, v[j].w) << 32);
        if (lane == 0) ss[m] = s;
    }
}

__device__ __forceinline__ void unpack8(const u32x4 w, float (&f)[8]) {
    f[0] = __builtin_bit_cast(float, w.x << 16); f[1] = __builtin_bit_cast(float, w.x & 0xffff0000u); f[2] = __builtin_bit_cast(float, w.y << 16); f[3] = __builtin_bit_cast(float, w.y & 0xffff0000u);
    f[4] = __builtin_bit_cast(float, w.z << 16); f[5] = __builtin_bit_cast(float, w.z & 0xffff0000u); f[6] = __builtin_bit_cast(float, w.w << 16); f[7] = __builtin_bit_cast(float, w.w & 0xffff0000u);
}
__device__ __forceinline__ void phase_conv(const bf16* Bg, const bf16* U, const float* cw, bf16* Z) {
    int tid_ = threadIdx.x; asm volatile("" : "+v"(tid_));
    const int tid = tid_, cc = tid & 127, trow = tid >> 7;
    float w0[8], w1[8], w2[8];
#pragma unroll
    for (int e = 0; e < 8; ++e) { w0[e] = cw[8 * cc + e]; w1[e] = cw[1024 + 8 * cc + e]; w2[e] = cw[2048 + 8 * cc + e]; }
    for (int tb = blockIdx.x; tb < T / 128; tb += gridDim.x) {
        const int tbeg = tb * 128 + trow * 32;
        float u1[8], u2[8];
        if ((tbeg & (SEQ - 1)) == 0) {
#pragma unroll
            for (int e = 0; e < 8; ++e) { u1[e] = 0.f; u2[e] = 0.f; }
        } else {
            unpack8(*(const u32x4*)(U + (size_t)(tbeg - 1) * DM + 8 * cc), u1);
            unpack8(*(const u32x4*)(U + (size_t)(tbeg - 2) * DM + 8 * cc), u2);
        }
#pragma unroll 4
        for (int i = 0; i < 32; ++i) {
            const size_t p = (size_t)(tbeg + i) * DM + 8 * cc;
            float u0[8], bgv[8], z[8];
            unpack8(*(const u32x4*)(U + p), u0); unpack8(*(const u32x4*)(Bg + p), bgv);
#pragma unroll
            for (int e = 0; e < 8; ++e) { z[e] = bgv[e] * (w0[e] * u2[e] + w1[e] * u1[e] + w2[e] * u0[e]); u2[e] = u1[e]; u1[e] = u0[e]; }
            u32x4 o; o.x = cvt_pk(z[0], z[1]); o.y = cvt_pk(z[2], z[3]); o.z = cvt_pk(z[4], z[5]); o.w = cvt_pk(z[6], z[7]);
            *(u32x4*)(Z + p) = o;
        }
    }
}

__device__ __forceinline__ void phase_compress(const Args& a, LAS unsigned char* lds, size_t off_kc = WS_KC, size_t off_vct = WS_VCT) {
    unsigned char* ws = WSP;
    int tid_ = threadIdx.x; asm volatile("" : "+v"(tid_));
    const int tid = tid_, lane = tid & 63, w = tid >> 6, lc = lane & 15, lg = lane >> 4;
    LAS bf16* hid = (LAS bf16*)lds;
    LAS float* outf = (LAS float*)(lds + 32 * 136 * 2);
    for (int u2 = blockIdx.x * 2; u2 < 512; u2 += gridDim.x * 2)
    for (int uu = u2; uu < u2 + 2; ++uu) {
        const int kv = uu >> 8, R0 = (uu & 255) * 32;
        const bf16* raw = (const bf16*)(ws + (kv ? WS_VCR : WS_KCR));
        const bf16* w1t = (const bf16*)(ws + (kv ? WS_W1V : WS_W1K));
        const bf16* w2t = (const bf16*)(ws + (kv ? WS_W2V : WS_W2K));
        const float* b1 = (const float*)(ws + WS_B1) + kv * 128;
        f32x4 acc[2] = {{0.f, 0.f, 0.f, 0.f}, {0.f, 0.f, 0.f, 0.f}};
        const bf16* ap0 = raw + (size_t)(R0 + lc) * 1024 + 8 * lg;
        const bf16* ap1 = ap0 + (size_t)16 * 1024;
        const bf16* bp = w1t + (size_t)(16 * w + lc) * 2048 + 8 * lg;
        bf16x8 A0[4], A1[4], B[4];
#pragma unroll
        for (int s = 0; s < 4; ++s) { A0[s] = *(const bf16x8*)(ap0 + 32 * s); A1[s] = *(const bf16x8*)(ap1 + 32 * s); B[s] = *(const bf16x8*)(bp + 32 * s); }
        for (int k0 = 0; k0 < 2048; k0 += 128) {
            bf16x8 nA0[4], nA1[4], nB[4];
            const int kn = (k0 + 128 < 2048) ? k0 + 128 : k0;
#pragma unroll
            for (int s = 0; s < 4; ++s) { nA0[s] = *(const bf16x8*)(ap0 + kn + 32 * s); nA1[s] = *(const bf16x8*)(ap1 + kn + 32 * s); nB[s] = *(const bf16x8*)(bp + kn + 32 * s); }
#pragma unroll
            for (int s = 0; s < 4; ++s) { acc[0] = __builtin_amdgcn_mfma_f32_16x16x32_bf16(A0[s], B[s], acc[0], 0, 0, 0); acc[1] = __builtin_amdgcn_mfma_f32_16x16x32_bf16(A1[s], B[s], acc[1], 0, 0, 0); }
#pragma unroll
            for (int s = 0; s < 4; ++s) { A0[s] = nA0[s]; A1[s] = nA1[s]; B[s] = nB[s]; }
        }
        { const int col = 16 * w + lc; const float bb = b1[col];
#pragma unroll
          for (int rt = 0; rt < 2; ++rt)
#pragma unroll
            for (int r = 0; r < 4; ++r) { const float x = acc[rt][r] + bb; const float y = 2.f * 0.7978845608028654f * (x + 0.044715f * x * x * x);
                const float gl = x * __builtin_amdgcn_rcpf(1.f + __builtin_amdgcn_exp2f(-LOG2E * y));
                hid[(16 * rt + 4 * lg + r) * 136 + col] = (bf16)(cvt_pk(gl, 0.f) & 0xffffu); } }
        __syncthreads();
        { const int rt = w >> 2, ct = w & 3; f32x4 o = {0.f, 0.f, 0.f, 0.f};
#pragma unroll
          for (int ks = 0; ks < 4; ++ks) { const bf16x8 A = *(const LAS bf16x8*)(hid + (16 * rt + lc) * 136 + 32 * ks + 8 * lg); const bf16x8 B = *(const bf16x8*)(w2t + (size_t)(16 * ct + lc) * 128 + 32 * ks + 8 * lg);
              o = __builtin_amdgcn_mfma_f32_16x16x32_bf16(A, B, o, 0, 0, 0); }
#pragma unroll
          for (int r = 0; r < 4; ++r) outf[(16 * rt + 4 * lg + r) * 65 + 16 * ct + lc] = o[r]; }
        __syncthreads();
        { const int row = tid >> 4, d0 = 4 * (tid & 15); const int R = R0 + row, bg = R >> 9, i = R & 511;
          float v[4]; float ss = 0.f;
#pragma unroll
          for (int e = 0; e < 4; ++e) { v[e] = outf[row * 65 + d0 + e]; ss += v[e] * v[e]; }
          if (kv == 0) {
              ss += __shfl_xor(ss, 1); ss += __shfl_xor(ss, 2); ss += __shfl_xor(ss, 4); ss += __shfl_xor(ss, 8);
              const float rstd = __builtin_amdgcn_rsqf(ss * (1.f / 64.f) + RMS_EPS); const float* kn = IN(16);
#pragma unroll
              for (int e = 0; e < 4; ++e) v[e] = (i == 511) ? 0.f : v[e] * rstd * kn[d0 + e];
              bf16* dst = (bf16*)(ws + off_kc) + ((size_t)bg * NCB + i) * 64 + d0;
              *(u64*)dst = (u64)cvt_pk(v[0], v[1]) | ((u64)cvt_pk(v[2], v[3]) << 32);
          } else {
              bf16* dst = (bf16*)(ws + off_vct) + ((size_t)bg * 64 + d0) * NCB + i;
#pragma unroll
              for (int e = 0; e < 4; ++e) dst[(size_t)e * NCB] = (i == 511) ? (bf16)0 : (bf16)(cvt_pk(v[e], 0.f) & 0xffffu);
          } }
        __syncthreads();
    }
}

constexpr int A_IMP = 0, A_RING = 32768, TILE_PITCH = 192  , TILE_B = 64 * TILE_PITCH, STAGE_B = 2 * TILE_B,
              A_SELQ = A_RING + 2 * STAGE_B, A_BIAS = A_SELQ + 1024, A_MB = A_BIAS + 512, A_OUT = A_MB + 512;
constexpr int RELMAX_BIG = 0x40000000;

template <int MODE, int BM = 0, bool SEL = false>
__device__ __forceinline__ void attn_core(const bf16x8 (&kf)[4][2], const bf16x8 (&vf)[4][2], const bf16x8 (&qf)[2], int tq, int pbase, int pstride, int relmax,
                                          const LAS float* biasrow, float pscale, f32x4 (&oacc)[4], float& lsum, LAS float* improw, int jbase, int lg, int h, float pbias = 0.f, float pbias2 = 0.f, int thr = 0) {
    f32x4 s[4];
#pragma unroll
    for (int kt = 0; kt < 4; ++kt) {
        s[kt] = __builtin_amdgcn_mfma_f32_16x16x32_bf16(kf[kt][0], qf[0], (f32x4){0.f, 0.f, 0.f, 0.f}, 0, 0, 0);
        s[kt] = __builtin_amdgcn_mfma_f32_16x16x32_bf16(kf[kt][1], qf[1], s[kt], 0, 0, 0);
    }
#pragma unroll
    for (int kt = 0; kt < 4; ++kt) {
        const int kap0 = 32 * (kt >> 1) + 8 * lg + 4 * (kt & 1);
        const int rel0 = tq - (pbase + kap0 * pstride);
#pragma unroll
        for (int r = 0; r < 4; ++r) {
            float p;
            if (BM == 1) {
                p = __builtin_amdgcn_exp2f(s[kt][r] + pbias);
            } else if (BM == 2) {
                const int rel = rel0 - r * pstride;
                p = __builtin_amdgcn_exp2f(s[kt][r] + (rel >= thr ? pbias2 : pbias));
            } else if (BM == 3) {
                const int rel = rel0 - r * pstride;
                int bk = 39 - __clz((int)__umul24((unsigned)rel, (unsigned)rel)); bk = bk > 31 ? 31 : bk;
                p = __builtin_amdgcn_exp2f(s[kt][r] + biasrow[bk]);
                if (SEL) p = tq >= 0 ? p : 0.f;
            } else {
            const int rel = rel0 - r * pstride;
            const bool valid = (unsigned)rel < (unsigned)relmax;
            const int n = valid ? rel : 0;
            const int nn = (int)__umul24((unsigned)n, (unsigned)n);
            int bk = 39 - __clz(nn); bk = bk > 31 ? 31 : bk; bk = n < 16 ? n : bk;
            const float x = s[kt][r] + biasrow[bk];
            p = valid ? __builtin_amdgcn_exp2f(x) : 0.f;
            }
            if (MODE == 2) p *= pscale;
            s[kt][r] = p; lsum += p;
        }
        __builtin_amdgcn_sched_barrier(0);
        if (MODE == 2) {
            float av = 2.f * (s[kt][0] + s[kt][1] + s[kt][2]) + s[kt][3], bv = s[kt][3];
            av += __shfl_xor(av, 1); av += __shfl_xor(av, 2); bv += __shfl_xor(bv, 1); bv += __shfl_xor(bv, 2);
            if (h == 0) { const int j = jbase + (kap0 >> 2);
                improw[j] = improw[j] + av;
                if (j + 1 < 128) improw[j + 1] = improw[j + 1] + bv; }
        }
    }
    if (MODE >= 1) {
#pragma unroll
        for (int hh = 0; hh < 2; ++hh) {
            u32x4 pw; pw.x = cvt_pk(s[2 * hh][0], s[2 * hh][1]); pw.y = cvt_pk(s[2 * hh][2], s[2 * hh][3]); pw.z = cvt_pk(s[2 * hh + 1][0], s[2 * hh + 1][1]); pw.w = cvt_pk(s[2 * hh + 1][2], s[2 * hh + 1][3]);
            const bf16x8 pf = __builtin_bit_cast(bf16x8, pw);
#pragma unroll
            for (int dt = 0; dt < 4; ++dt) oacc[dt] = __builtin_amdgcn_mfma_f32_16x16x32_bf16(vf[dt][hh], pf, oacc[dt], 0, 0, 0);
        }
    }
}
__device__ __forceinline__ int rel_bucket_i(int n) { int bk = 39 - __clz((int)((unsigned)n * (unsigned)n)); bk = bk > 31 ? 31 : bk; return n < 16 ? n : bk; }
template <int MODE, bool SEL>
__device__ __forceinline__ void tile_stream(LAS unsigned char* ring, const bf16* Kbase, const bf16* Vbase, int ldv, int nt, int pb0, int pbstep, int pstride, int relmax,
                                            const bf16x8 (&qf)[2][2], const int (&tq)[2], const LAS float* biasrow, const float (&psc)[2], f32x4 (&oacc)[2][4], float (&ls)[2],
                                            LAS float* imp0, LAS float* imp1, const LAS u64* selA, const LAS u64* selB, int tid, int lc, int lg, int h) {
    const int row = tid >> 3, ch = tid & 7;
    const bf16* kp = Kbase + row * 64 + ch * 8;
    const bf16* vp = Vbase + (size_t)row * ldv + ch * 8;
    const int woff = row * TILE_PITCH + ch * 16;
    const float bfar = biasrow[31]; const int tqlo = __builtin_amdgcn_readfirstlane(tq[0]) ;
    u32x4 rk = {0u, 0u, 0u, 0u}, rv = {0u, 0u, 0u, 0u};
    if (nt > 0) { rk = *(const u32x4*)kp; if (MODE > 0) rv = *(const u32x4*)vp; }
    for (int t = 0; t < nt; ++t) {
        LAS unsigned char* st = ring + (t & 1) * STAGE_B;
        *(LAS u32x4*)(st + woff) = rk; if (MODE > 0) *(LAS u32x4*)(st + TILE_B + woff) = rv;
        __syncthreads();
        if (t + 1 < nt) { rk = *(const u32x4*)(kp + (size_t)(t + 1) * 4096); if (MODE > 0) rv = *(const u32x4*)(vp + (t + 1) * 64); }
        int tq0 = tq[0], tq1 = tq[1]; bool do0 = true, do1 = true;
        if (SEL) {
            const bool b0 = ((selA[t >> 6] >> (t & 63)) & 1ull) != 0ull, b1 = ((selB[t >> 6] >> (t & 63)) & 1ull) != 0ull;
            tq0 = b0 ? tq0 : -1; tq1 = b1 ? tq1 : -1; do0 = __ballot(b0) != 0ull; do1 = __ballot(b1) != 0ull;
        }
        if (do0 || do1) {
            bf16x8 kf[4][2], vf[4][2];
#pragma unroll
            for (int kt = 0; kt < 4; ++kt) { const LAS unsigned char* p = st + (32 * (kt >> 1) + 8 * (lc >> 2) + 4 * (kt & 1) + (lc & 3)) * TILE_PITCH + 16 * lg;
                kf[kt][0] = *(const LAS bf16x8*)p; kf[kt][1] = *(const LAS bf16x8*)(p + 64); }
            if (MODE > 0) {
#pragma unroll
                for (int dt = 0; dt < 4; ++dt) { const LAS unsigned char* p = st + TILE_B + (16 * dt + lc) * TILE_PITCH + 16 * lg;
                    vf[dt][0] = *(const LAS bf16x8*)p; vf[dt][1] = *(const LAS bf16x8*)(p + 64); }
            }
            const int pbase = pb0 + t * pbstep;
            {
                const int rlo = tqlo - (pbase + 63 * pstride), rhi = tqlo + 7 - pbase;
                const int blo = rel_bucket_i(rlo < 0 ? 0 : rlo), bhi = rel_bucket_i(rhi < 0 ? 0 : rhi);
                if (rlo >= 0 && rhi < relmax && bhi - blo <= 1) {
                    int thr = 0x7fffffff;
                    if (bhi != blo) { int a = rlo, b = rhi;
                        while (b - a > 1) { const int mid = (a + b) >> 1; if (rel_bucket_i(mid) == blo) a = mid; else b = mid; }
                        thr = b; }
                    const float pb1 = biasrow[blo], pb2 = biasrow[bhi];
                    const float pa0 = (!SEL || tq0 >= 0) ? pb1 : -1e30f, pa1 = (!SEL || tq0 >= 0) ? pb2 : -1e30f, pc0 = (!SEL || tq1 >= 0) ? pb1 : -1e30f, pc1 = (!SEL || tq1 >= 0) ? pb2 : -1e30f;
                    if (bhi == blo) {
                        if (do0) attn_core<MODE, 1, SEL>(kf, vf, qf[0], tq0, pbase, pstride, relmax, biasrow, psc[0], oacc[0], ls[0], imp0, 16 * t, lg, h, pa0);
                        if (do1) attn_core<MODE, 1, SEL>(kf, vf, qf[1], tq1, pbase, pstride, relmax, biasrow, psc[1], oacc[1], ls[1], imp1, 16 * t, lg, h, pc0);
                    } else {
                        if (do0) attn_core<MODE, 2, SEL>(kf, vf, qf[0], tq[0], pbase, pstride, relmax, biasrow, psc[0], oacc[0], ls[0], imp0, 16 * t, lg, h, pa0, pa1, thr);
                        if (do1) attn_core<MODE, 2, SEL>(kf, vf, qf[1], tq[1], pbase, pstride, relmax, biasrow, psc[1], oacc[1], ls[1], imp1, 16 * t, lg, h, pc0, pc1, thr);
                    }
                } else if (rlo >= 16 && rhi < relmax) {
                    if (do0) attn_core<MODE, 3, SEL>(kf, vf, qf[0], tq0, pbase, pstride, relmax, biasrow, psc[0], oacc[0], ls[0], imp0, 16 * t, lg, h);
                    if (do1) attn_core<MODE, 3, SEL>(kf, vf, qf[1], tq1, pbase, pstride, relmax, biasrow, psc[1], oacc[1], ls[1], imp1, 16 * t, lg, h);
                } else {
                    if (do0) attn_core<MODE>(kf, vf, qf[0], tq0, pbase, pstride, relmax, biasrow, psc[0], oacc[0], ls[0], imp0, 16 * t, lg, h);
                    if (do1) attn_core<MODE>(kf, vf, qf[1], tq1, pbase, pstride, relmax, biasrow, psc[1], oacc[1], ls[1], imp1, 16 * t, lg, h);
                }
            }
        }
    }
    __syncthreads();
}

__device__ __forceinline__ void phase_attn(const Args& a, LAS unsigned char* lds) {
    unsigned char* ws = WSP;
    int tid_ = threadIdx.x; asm volatile("" : "+v"(tid_));
    const int w = __builtin_amdgcn_readfirstlane(tid_ >> 6);
    LAS float* imp = (LAS float*)(lds + A_IMP);
    LAS unsigned char* ring = lds + A_RING;
    LAS u64* selq = (LAS u64*)(lds + A_SELQ);
    LAS float* biasL = (LAS float*)(lds + A_BIAS);
    LAS float* mbound = (LAS float*)(lds + A_MB);
    const bf16* Q = (const bf16*)(ws + WS_Q);
    const float* gates = (const float*)(ws + WS_GATES);
    const float* relb = IN(23);
    if (w == 0) {
        const int lane = tid_ & 63;
        float mq = fabsf(IN(12)[lane]);
        float mk = fmaxf(fabsf(IN(16)[lane]), fmaxf(fabsf(IN(16)[64 + lane]), fabsf(IN(16)[128 + lane])));
        mq = wave_max(mq); mk = wave_max(mk);
        float mb = -1e30f;
        if (lane < 16) { for (int bk = 0; bk < 32; ++bk) mb = fmaxf(mb, relb[bk * 16 + lane]); mbound[lane] = mb + 8.f * mq * mk; }
    }
    __syncthreads();
    const int nunits = 2048, G = gridDim.x, bx = blockIdx.x;
    for (int it = 0; ; ++it) {
        int bg, qb;
        if (G == 256) {
            if (it >= 8) break;
            const int slot = bx >> 3, oo = slot >> 1; bg = 2 * (bx & 7) + (slot & 1);
            qb = (it & 1) ? 127 - 16 * (it >> 1) - oo : 16 * (it >> 1) + oo;
        } else {
            const int u = bx + it * G; if (u >= nunits) break;
            const int rr = u >> 4, ui = rr >> 4, oo = rr & 15; bg = u & 15;
            qb = (ui & 1) ? 127 - 16 * (ui >> 1) - oo : 16 * (ui >> 1) + oo;
        }
        const int b = bg >> 2, grp = bg & 3, t0 = 64 * qb, tokbase = b * SEQ + t0;
        int tidu = tid_; asm volatile("" : "+v"(tidu));
        const int tid = tidu, lane = tid & 63, lc = lane & 15, lg = lane >> 4, hq = lc >> 2, h = lc & 3;
        const u64 ltmask = (1ull << lane) - 1ull;
        for (int i = tid; i < 8192; i += 512) imp[i] = 0.f;
        if (tid < 128) { const int hh = tid >> 5, bk = tid & 31; biasL[tid] = (relb[bk * 16 + grp * 4 + hh] - mbound[grp * 4 + hh]) * LOG2E; }
        __syncthreads();
        const LAS float* biasrow = biasL + h * 32;
        bf16x8 qf[2][2]; int tqd[2]; float g0[2], g1[2], g2[2];
#pragma unroll
        for (int ct = 0; ct < 2; ++ct) { const int q = 8 * w + 4 * ct + hq; tqd[ct] = t0 + q;
            const bf16* qp = Q + (size_t)(tokbase + q) * DM + (grp * 4 + h) * 64 + 8 * lg; qf[ct][0] = *(const bf16x8*)qp; qf[ct][1] = *(const bf16x8*)(qp + 32);
            const float* gp = gates + (size_t)(tokbase + q) * 48 + (grp * 4 + h) * 3; g0[ct] = gp[0]; g1[ct] = gp[1]; g2[ct] = gp[2]; }
        LAS float* imp0 = imp + (8 * w + hq) * 128; LAS float* imp1 = imp + (8 * w + 4 + hq) * 128;
        LAS float* outp[2] = {(LAS float*)(lds + A_OUT) + ((8 * w + hq) * 4 + h) * 64 + 4 * lg, (LAS float*)(lds + A_OUT) + ((8 * w + 4 + hq) * 4 + h) * 64 + 4 * lg};
        const float one2[2] = {1.f, 1.f};
        {
            const int ncb = 4 * qb + 3, ntc = (ncb + 63) >> 6;
            const bf16* Kc = (const bf16*)(ws + WS_KC) + (size_t)bg * NCB * 64;
            const bf16* VcT = (const bf16*)(ws + WS_VCT) + (size_t)bg * 64 * NCB;
            float ls[2] = {0.f, 0.f}; f32x4 oc[2][4];
#pragma unroll
            for (int ct = 0; ct < 2; ++ct)
#pragma unroll
                for (int dt = 0; dt < 4; ++dt) oc[ct][dt] = (f32x4){0.f, 0.f, 0.f, 0.f};
            tile_stream<0, false>(ring, Kc, VcT, NCB, ntc, 31, 1024, 16, RELMAX_BIG, qf, tqd, biasrow, one2, oc, ls, imp0, imp1, selq, selq, tid, lc, lg, h);
            float inv[2];
#pragma unroll
            for (int ct = 0; ct < 2; ++ct) { float l = ls[ct]; l += __shfl_xor(l, 16); l += __shfl_xor(l, 32); inv[ct] = l > 0.f ? 1.f / l : 0.f; }
            float dummy[2] = {0.f, 0.f};
            tile_stream<2, false>(ring, Kc, VcT, NCB, ntc, 31, 1024, 16, RELMAX_BIG, qf, tqd, biasrow, inv, oc, dummy, imp0, imp1, selq, selq, tid, lc, lg, h);
#pragma unroll
            for (int ct = 0; ct < 2; ++ct)
#pragma unroll
                for (int dt = 0; dt < 4; ++dt) *(LAS f32x4*)(outp[ct] + 16 * dt) = oc[ct][dt] * g0[ct];
        }
        for (int qi = 0; qi < 8; ++qi) {
            const int q = 8 * w + qi; u64 lo, hi;
            if (qb < 16) { lo = (2ull << qb) - 1ull; hi = 0ull; }
            else {
                const int j0 = lane, j1 = lane + 64;
                const bool c0 = (j0 >= 1 && j0 <= qb - 2), c1 = (j1 <= qb - 2);
                const unsigned key0 = c0 ? __builtin_bit_cast(unsigned, imp[q * 128 + j0]) : 0u, key1 = c1 ? __builtin_bit_cast(unsigned, imp[q * 128 + j1]) : 0u;
                unsigned Tk = 0u;
                for (int bit = 30; bit >= 0; --bit) { const unsigned trial = Tk | (1u << bit);
                    const int cnt = __popcll(__ballot(key0 >= trial)) + __popcll(__ballot(key1 >= trial)); if (cnt >= 13) Tk = trial; }
                const bool gt0 = key0 > Tk, gt1 = key1 > Tk, e0 = (key0 == Tk) && c0, e1 = (key1 == Tk) && c1;
                const int need = 13 - (__popcll(__ballot(gt0)) + __popcll(__ballot(gt1)));
                const u64 m0 = __ballot(e0), m1 = __ballot(e1);
                const int r0 = __popcll(m0 & ltmask), r1 = __popcll(m0) + __popcll(m1 & ltmask);
                const bool s0 = gt0 || (e0 && r0 < need) || j0 == 0 || j0 == qb || j0 == qb - 1;
                const bool s1 = gt1 || (e1 && r1 < need) || j1 == qb || j1 == qb - 1;
                lo = __ballot(s0); hi = __ballot(s1);
            }
            if (lane == 0) { selq[q * 2] = lo; selq[q * 2 + 1] = hi; }
        }
        __builtin_amdgcn_wave_barrier();
        {
            const int tf = qb >= 8 ? 0 : 8 - qb, p0 = t0 - 512 + 64 * tf;
            const bf16* Kw = (const bf16*)(ws + WS_KW) + ((size_t)bg * SEQ + p0) * 64;
            const bf16* VwT = (const bf16*)(ws + WS_VWT) + (size_t)bg * 64 * SEQ + p0;
            float ls[2] = {0.f, 0.f}; f32x4 ow[2][4];
#pragma unroll
            for (int ct = 0; ct < 2; ++ct)
#pragma unroll
                for (int dt = 0; dt < 4; ++dt) ow[ct][dt] = (f32x4){0.f, 0.f, 0.f, 0.f};
            tile_stream<1, false>(ring, Kw, VwT, SEQ, 9 - tf, p0, 64, 1, 512, qf, tqd, biasrow, one2, ow, ls, imp0, imp1, selq, selq, tid, lc, lg, h);
#pragma unroll
            for (int ct = 0; ct < 2; ++ct) { float l = ls[ct]; l += __shfl_xor(l, 16); l += __shfl_xor(l, 32); const float sc = g2[ct] / l;
#pragma unroll
                for (int dt = 0; dt < 4; ++dt) *(LAS f32x4*)(outp[ct] + 16 * dt) = *(LAS f32x4*)(outp[ct] + 16 * dt) + ow[ct][dt] * sc; }
        }
        {
            const bf16* Ks = (const bf16*)(ws + WS_KS) + (size_t)bg * SEQ * 64;
            const bf16* VsT = (const bf16*)(ws + WS_VST) + (size_t)bg * 64 * SEQ;
            float ls[2] = {0.f, 0.f}; f32x4 os[2][4];
#pragma unroll
            for (int ct = 0; ct < 2; ++ct)
#pragma unroll
                for (int dt = 0; dt < 4; ++dt) os[ct][dt] = (f32x4){0.f, 0.f, 0.f, 0.f};
            tile_stream<1, true>(ring, Ks, VsT, SEQ, qb + 1, 0, 64, 1, RELMAX_BIG, qf, tqd, biasrow, one2, os, ls, imp0, imp1, selq + (8 * w + hq) * 2, selq + (8 * w + 4 + hq) * 2, tid, lc, lg, h);
            bf16* AO = (bf16*)(ws + WS_AO);
#pragma unroll
            for (int ct = 0; ct < 2; ++ct) { float l = ls[ct]; l += __shfl_xor(l, 16); l += __shfl_xor(l, 32); const float sc = g1[ct] / l;
                bf16* op = AO + (size_t)(tokbase + 8 * w + 4 * ct + hq) * DM + (grp * 4 + h) * 64 + 4 * lg;
#pragma unroll
                for (int dt = 0; dt < 4; ++dt) { const f32x4 v = *(LAS f32x4*)(outp[ct] + 16 * dt) + os[ct][dt] * sc; *(u64*)(op + 16 * dt) = (u64)cvt_pk(v[0], v[1]) | ((u64)cvt_pk(v[2], v[3]) << 32); } }
        }
    }
}

#define XB_TMO      128
#define XB_XCNT(j)  (256  + 64 * (j))
#define XB_XSUB(j)  (1280 + 64 * (j))
#define XB_XGEN(j)  (2304 + 64 * (j))
#define XB_TOP      3328
#define XB_TOPGEN   3392
#define XCD_BAR_WORDS 3456
#define XB_SPIN_CAP (1u << 23)

__device__ __forceinline__ unsigned xb_ld(unsigned* p)              { return __hip_atomic_load(p, __ATOMIC_RELAXED, __HIP_MEMORY_SCOPE_AGENT); }
__device__ __forceinline__ unsigned xb_add(unsigned* p, unsigned v) { return __hip_atomic_fetch_add(p, v, __ATOMIC_RELAXED, __HIP_MEMORY_SCOPE_AGENT); }
__device__ __forceinline__ unsigned xb_xcc_id() { return (unsigned)__builtin_amdgcn_s_getreg((3 << 11) | 20) & 0xFu; }
#define XB_SPIN(cond, bar) do { unsigned _sp = 0; while (cond) { __builtin_amdgcn_s_sleep(1); \
    if ((++_sp & 255u) == 0u) { if (xb_ld(&(bar)[XB_TMO])) break; if (_sp > XB_SPIN_CAP) { atomicAdd(&(bar)[XB_TMO], 1u); break; } } } } while (0)

struct XcdBarrier {
    unsigned* bar; unsigned x;
    volatile LAS unsigned* st;
};

__device__ __forceinline__ XcdBarrier xcd_barrier_post(unsigned* bar, volatile LAS unsigned* st) {
    XcdBarrier b; b.bar = bar; b.x = xb_xcc_id(); b.st = st;
    if (threadIdx.x == 0) (void)xb_add(&bar[XB_XCNT(b.x)], 1u);
    return b;
}
__device__ __forceinline__ void xcd_barrier_complete(unsigned* bar, unsigned x, unsigned& nloc, unsigned& nx) {
    const unsigned G = gridDim.x * gridDim.y * gridDim.z;
    unsigned sum, cnt, mine, sp = 0u;
    for (;;) {
        sum = 0u; cnt = 0u; mine = 0u;
#pragma unroll
        for (unsigned j = 0; j < 16; ++j) { const unsigned c = xb_ld(&bar[XB_XCNT(j)]); sum += c; cnt += (c > 0u) ? 1u : 0u; mine = (j == x) ? c : mine; }
        if (sum == G) break;
        __builtin_amdgcn_s_sleep(1);
        if ((++sp & 255u) == 0u) { if (xb_ld(&bar[XB_TMO])) break; if (sp > XB_SPIN_CAP) { atomicAdd(&bar[XB_TMO], 1u); break; } }
    }
    nloc = mine > 0u ? mine : 1u; nx = cnt > 0u ? cnt : 1u;
}

__device__ __forceinline__ void xcd_barrier(const XcdBarrier& b) {
    asm volatile("s_waitcnt vmcnt(0)" ::: "memory");
    __syncthreads();
    if (threadIdx.x == 0) {
        unsigned* bar = b.bar;
        __builtin_amdgcn_s_waitcnt(0);
        unsigned nloc = b.st[0], nx = b.st[1];
        if (nloc == 0u) { xcd_barrier_complete(bar, b.x, nloc, nx); b.st[0] = nloc; b.st[1] = nx; }
        const unsigned old = xb_add(&bar[XB_XSUB(b.x)], 1u);
        const unsigned gen = old / nloc;
        if (old + 1u == (gen + 1u) * nloc) {
            __builtin_amdgcn_fence(__ATOMIC_RELEASE, "agent");
            asm volatile("s_waitcnt vmcnt(0)" ::: "memory");
            const unsigned og = xb_add(&bar[XB_TOP], 1u);
            const unsigned tg = og / nx;
            if (og + 1u == (tg + 1u) * nx) xb_add(&bar[XB_TOPGEN], 1u);
            else XB_SPIN(xb_ld(&bar[XB_TOPGEN]) == tg, bar);
            __builtin_amdgcn_fence(__ATOMIC_ACQUIRE, "agent");
            xb_add(&bar[XB_XGEN(b.x)], 1u);
            asm volatile("s_waitcnt vmcnt(0)" ::: "memory");
        } else {
            XB_SPIN(xb_ld(&bar[XB_XGEN(b.x)]) == gen, bar);
            __builtin_amdgcn_fence(__ATOMIC_ACQUIRE, "agent");
            asm volatile("s_waitcnt vmcnt(0)" ::: "memory");
        }
    }
    __syncthreads();
}


__global__ void __launch_bounds__(512, 2) mk_fwd(Args a) {
    extern __shared__ __attribute__((aligned(16))) unsigned char lds_raw[];
    LAS unsigned char* lds = (LAS unsigned char*)lds_raw;
    cg::grid_group grid = cg::this_grid();
    unsigned char* ws = WSP;
    const float* x = IN(0); float* hout = KA()->out;
    bf16* HN = (bf16*)(ws + WS_HN); bf16* HN2 = (bf16*)(ws + WS_HN2); bf16* ACT = (bf16*)(ws + WS_ACT);
    const int G = gridDim.x, bx = blockIdx.x;
#define GRID_SYNC() do { \
        if (sync_no == 0u) { asm volatile("s_waitcnt vmcnt(0) lgkmcnt(0)" ::: "memory"); grid.sync(); \
            if (threadIdx.x == 0) { __builtin_amdgcn_fence(__ATOMIC_ACQUIRE, "agent"); asm volatile("s_waitcnt vmcnt(0)" ::: "memory"); } __syncthreads(); \
            xb = xcd_barrier_post(bar_words, xb_st); } \
        else xcd_barrier(xb); \
        ++sync_no; } while (0)
#define GEMM(EPI, Aptr, Bptr, N_, K_, E) do { pg8::Gemm g_{(const pg8::bf16_t*)(Aptr), (const pg8::bf16_t*)(Bptr), T, (N_), (K_)}; pg8::StaticOrder S_; S_.init(T, (N_), G, bx); \
        pg8::gemm_phase<std::remove_cv_t<std::remove_reference_t<decltype(E)>>, pg8::StaticOrder, true, true>((PG8_LAS unsigned char*)lds, g_, S_, (E)); } while (0)

    unsigned* bar_words = (unsigned*)(ws + 4096); unsigned sync_no = 0u;
    for (int i = bx * 512 + threadIdx.x; i < XCD_BAR_WORDS; i += G * 512) __hip_atomic_store(bar_words + i, 0u, __ATOMIC_RELAXED, __HIP_MEMORY_SCOPE_AGENT);
    volatile LAS unsigned* xb_st = (volatile LAS unsigned*)(lds + LDS_BYTES - 16);
    if (threadIdx.x < 2) xb_st[threadIdx.x] = 0u;
    XcdBarrier xb; xb.bar = bar_words; xb.x = 0u; xb.st = xb_st;
    float* SS = (float*)(ws + WS_SS);
#define SSK(k) (SS + (size_t)(k) * T)
    phase_prep(a, lds);
    phase_x(x, HN, SS);
    GRID_SYNC();
    { pg8::EpiSwiglu E{ACT, DFF, SSK(0)}; GEMM(pg8::EpiSwiglu, HN, ws + WS_WIN, 2 * DFF, DM, E); }
    GRID_SYNC();
    { pg8::EpiResid<true, 1, 0, false> E{x, hout, HN, SSK(1)}; GEMM((pg8::EpiResid<true, 1, 0, false>), ACT, ws + WS_WOUT, DM, DFF, E); }
    GRID_SYNC();
    { pg8::EpiConvIn E{(bf16*)(ws + WS_BG), (bf16*)(ws + WS_U), SSK(1)}; GEMM(pg8::EpiConvIn, HN, ws + WS_CWIN, 3072, DM, E); }
    GRID_SYNC();
    phase_conv((const bf16*)(ws + WS_BG), (const bf16*)(ws + WS_U), IN(9), HN2);
    GRID_SYNC();
    { pg8::EpiResid<true, 2, 1, false> E{hout, hout, HN, SSK(2)}; GEMM((pg8::EpiResid<true, 2, 1, false>), HN2, ws + WS_CWOUT, DM, DM, E); }
    GRID_SYNC();
    { pg8::EpiSwiglu E{ACT, DFF, SSK(2)}; GEMM(pg8::EpiSwiglu, HN, ws + WS_WIN + SZ_WIN, 2 * DFF, DM, E); }
    GRID_SYNC();
    { pg8::EpiResid<true, 1, 1, false> E{hout, hout, HN, SSK(3)}; GEMM((pg8::EpiResid<true, 1, 1, false>), ACT, ws + WS_WOUT + SZ_WOUT, DM, DFF, E); }
    GRID_SYNC();
    { pg8::EpiKV E; E.Kb = (bf16*)(ws + WS_KCR); E.Vb = (bf16*)(ws + WS_VCR); E.brstride = KV_BYTES / 2; E.knorm = IN(16); E.ss = SSK(3);
      GEMM(pg8::EpiKV, HN, ws + WS_WKV, NKV, DM, E); }
    GRID_SYNC();
    phase_compress(a, lds);
    { pg8::EpiSwiglu E{ACT, DFF, SSK(3)}; GEMM(pg8::EpiSwiglu, HN, ws + WS_WIN + 2 * SZ_WIN, 2 * DFF, DM, E); }
    GRID_SYNC();
    { pg8::EpiResid<true, 1, 1, false> E{hout, hout, HN, SSK(4)}; GEMM((pg8::EpiResid<true, 1, 1, false>), ACT, ws + WS_WOUT + 2 * SZ_WOUT, DM, DFF, E); }
    GRID_SYNC();
    { pg8::EpiQ E{(bf16*)(ws + WS_Q), (float*)(ws + WS_GATES), IN(12), 0.125f * LOG2E, SSK(4)}; GEMM(pg8::EpiQ, HN, ws + WS_WQ, NQP, DM, E); }
    GRID_SYNC();
    phase_attn(a, lds);
    GRID_SYNC();
    { pg8::EpiResid<true, 2, 1, false> E{hout, hout, HN, SSK(5)}; GEMM((pg8::EpiResid<true, 2, 1, false>), ws + WS_AO, ws + WS_WO, DM, DM, E); }
    GRID_SYNC();
    { pg8::EpiSwiglu E{ACT, DFF, SSK(5)}; GEMM(pg8::EpiSwiglu, HN, ws + WS_WIN + 3 * SZ_WIN, 2 * DFF, DM, E); }
    GRID_SYNC();
    { pg8::EpiResid<false, 1, 1, true> E{hout, hout, HN, nullptr}; GEMM((pg8::EpiResid<false, 1, 1, true>), ACT, ws + WS_WOUT + 3 * SZ_WOUT, DM, DFF, E); }
#undef SSK
#undef GEMM
}

extern "C" void kernel_launch(void* const* d_in, const int* in_sizes, int n_in, void* d_out, int out_size, void* d_ws, size_t ws_size, hipStream_t stream) {
    static int grid = 0;
    if (grid == 0) {
        if (n_in != 24 || out_size != T * DM || ws_size < WS_END) { fprintf(stderr, "kernel_launch: unexpected problem (n_in %d out %d ws %zu)\n", n_in, out_size, ws_size); grid = -1; return; }
        int dev = 0, cus = 0, per_cu = 0;
        (void)hipGetDevice(&dev);
        (void)hipDeviceGetAttribute(&cus, hipDeviceAttributeMultiprocessorCount, dev);
        (void)hipFuncSetAttribute((const void*)mk_fwd, hipFuncAttributeMaxDynamicSharedMemorySize, LDS_BYTES);
        (void)hipOccupancyMaxActiveBlocksPerMultiprocessor(&per_cu, (const void*)mk_fwd, 512, LDS_BYTES);
        if (per_cu < 1) per_cu = 1;
        grid = cus * per_cu;
    }
    if (grid < 0) return;
    Args a{};
    for (int i = 0; i < 24; ++i) a.in[i] = (const float*)d_in[i];
    a.out = (float*)d_out; a.ws = (unsigned char*)d_ws;
    void* args[] = {&a};
    hipError_t e = hipLaunchCooperativeKernel((const void*)mk_fwd, dim3(grid), dim3(512), args, LDS_BYTES, stream);
    if (e != hipSuccess) fprintf(stderr, "cooperative launch failed: %s (grid %d)\n", hipGetErrorString(e), grid);
}
```

```cpp
#include <hip/hip_runtime.h>
#include <hip/hip_cooperative_groups.h>
#include <cstdio>
#include <cstdint>
#include <type_traits>
namespace cg = cooperative_groups;
namespace pg8 {
#define PG8_LAS __attribute__((address_space(3)))
typedef unsigned short bf16_t;
typedef short bf16x8 __attribute__((ext_vector_type(8)));
typedef float f32x4 __attribute__((ext_vector_type(4)));
typedef unsigned u32x4 __attribute__((ext_vector_type(4)));
constexpr int BM = 256, BK = 64, HALF = 128, HTB = HALF * BK * 2  , STAGE_BYTES = 8 * HTB, NXCD = 8, WGM = 8;

__host__ __device__ __forceinline__ int lds_byte(int r, int c) { const int st = (r >> 4) * 2 + (c >> 5), rr = r & 15, cc = c & 31, ob = rr * 64 + cc * 2; return st * 1024 + (ob ^ (((ob >> 9) & 1) << 5)); }
__host__ __device__ __forceinline__ void stage_rc(int b, int& R, int& C) { const int st = b / 1024, sb = b % 1024, swz = sb ^ (((sb >> 9) & 1) << 5); R = (st >> 1) * 16 + swz / 64; C = (st & 1) * 32 + (swz % 64) / 2; }
__host__ __device__ __forceinline__ int perm32(int rho) { const int n = rho >> 4, i = rho & 15; return 8 * (i >> 2) + 4 * n + (i & 3); }

struct Unit { int pm, pn; };
struct Gemm { const bf16_t* A; const bf16_t* Bt; int M, N, K; };

struct StaticOrder {
    int nM, nN, nwg, G, c;
    __host__ __device__ void init(int M, int N, int G_, int c_) { nM = M / BM; nN = N / BM; nwg = nM * nN; G = G_; c = c_; }
    __host__ __device__ bool next(int i, Unit& u) const {
        const long L = (long)i * G + c; if (L >= nwg) return false;
        int wgid = (int)L; { const int q = nwg / NXCD, r = nwg % NXCD, xcd = wgid % NXCD, off = wgid / NXCD; wgid = (xcd < r ? xcd * (q + 1) : r * (q + 1) + (xcd - r) * q) + off; }
        const int nig = WGM * nN, gid = wgid / nig, fm = gid * WGM, gsz = (nM - fm) < WGM ? (nM - fm) : WGM;
        u.pm = fm + ((wgid % nig) % gsz); u.pn = (wgid % nig) / gsz; return true;
    }
    __device__ __forceinline__ void a_ready(const Unit&) const {}
    __device__ __forceinline__ void done(const Unit&) const {}
};

__device__ __forceinline__ unsigned cvt_pk_bf16(float lo, float hi) { unsigned r; asm volatile("v_cvt_pk_bf16_f32 %0, %1, %2" : "=v"(r) : "v"(lo), "v"(hi)); return r; }
__device__ __forceinline__ float fast_sigmoid(float x) { return __builtin_amdgcn_rcpf(1.f + __builtin_amdgcn_exp2f(-1.4426950408889634f * x)); }
__device__ __forceinline__ u32x4 pack8(const f32x4 a, const f32x4 b) { u32x4 w; w.x = cvt_pk_bf16(a[0], a[1]); w.y = cvt_pk_bf16(a[2], a[3]); w.z = cvt_pk_bf16(b[0], b[1]); w.w = cvt_pk_bf16(b[2], b[3]); return w; }

struct EpiSwiglu {
    static constexpr bool PERM = true, AFTER_DRAIN = false;
    bf16_t* O; int ldo; const float* ss;
    __device__ __forceinline__ void operator()(const f32x4 (&acc)[2][2][4][2], const Unit& u, int wr, int wc, int fr, int fq) const {
        const int row0 = u.pm * BM + wr * 64 + fr, col0 = u.pn * HALF + wc * 32 + 8 * fq;
#pragma unroll
        for (int ai = 0; ai < 2; ++ai)
#pragma unroll
            for (int m = 0; m < 4; ++m) {
                f32x4 v[2]; const float rs = __builtin_amdgcn_rsqf(ss[row0 + ai * HALF + m * 16] * (1.f / 1024.f) + 1e-6f);
#pragma unroll
                for (int n = 0; n < 2; ++n) { const f32x4 g = acc[ai][0][m][n] * rs, up = acc[ai][1][m][n] * rs;
#pragma unroll
                    for (int e = 0; e < 4; ++e) v[n][e] = g[e] * fast_sigmoid(g[e]) * up[e]; }
                *(u32x4*)(O + (size_t)(row0 + ai * HALF + m * 16) * ldo + col0) = pack8(v[0], v[1]);
            }
    }
};

template <bool NORM, int ALPHA2  , int HIN, bool FOUT> struct EpiResid {
    static constexpr bool PERM = true, AFTER_DRAIN = false;
    const float* hin; float* hout; bf16_t* HB; float* ssout;
    __device__ __forceinline__ void operator()(const f32x4 (&acc)[2][2][4][2], const Unit& u, int wr, int wc, int fr, int fq) const {
        const int row0 = u.pm * BM + wr * 64 + fr, col0 = u.pn * BM + wc * 32 + 8 * fq; constexpr float alpha = 0.5f * ALPHA2;
#pragma unroll
        for (int ai = 0; ai < 2; ++ai)
#pragma unroll
            for (int m = 0; m < 4; ++m) {
                float sq = 0.f;
#pragma unroll
                for (int bj = 0; bj < 2; ++bj) {
                    const size_t p = (size_t)(row0 + ai * HALF + m * 16) * 1024 + col0 + bj * HALF;
                    f32x4 a0, a1;
                    if (HIN == 0) { a0 = *(const f32x4*)(hin + p); a1 = *(const f32x4*)(hin + p + 4); }
                    else { const u32x4 w = *(const u32x4*)(HB + p);
                        a0 = (f32x4){__builtin_bit_cast(float, w.x << 16), __builtin_bit_cast(float, w.x & 0xffff0000u), __builtin_bit_cast(float, w.y << 16), __builtin_bit_cast(float, w.y & 0xffff0000u)};
                        a1 = (f32x4){__builtin_bit_cast(float, w.z << 16), __builtin_bit_cast(float, w.z & 0xffff0000u), __builtin_bit_cast(float, w.w << 16), __builtin_bit_cast(float, w.w & 0xffff0000u)}; }
                    a0 = a0 + acc[ai][bj][m][0] * alpha; a1 = a1 + acc[ai][bj][m][1] * alpha;
                    if (FOUT) { *(f32x4*)(hout + p) = a0; *(f32x4*)(hout + p + 4) = a1; }
                    if (NORM) { *(u32x4*)(HB + p) = pack8(a0, a1);
                        sq += (a0[0] * a0[0] + a0[1] * a0[1]) + (a0[2] * a0[2] + a0[3] * a0[3]) + (a1[0] * a1[0] + a1[1] * a1[1]) + (a1[2] * a1[2] + a1[3] * a1[3]); }
                }
                if (NORM) { sq += __shfl_xor(sq, 16); sq += __shfl_xor(sq, 32);
                    if (fq == 0) __hip_atomic_fetch_add(ssout + row0 + ai * HALF + m * 16, sq, __ATOMIC_RELAXED, __HIP_MEMORY_SCOPE_AGENT); }
            }
    }
};

struct EpiConvIn {
    static constexpr bool PERM = true, AFTER_DRAIN = false;
    bf16_t* Bg; bf16_t* U; const float* ss;
    __device__ __forceinline__ void operator()(const f32x4 (&acc)[2][2][4][2], const Unit& u, int wr, int wc, int fr, int fq) const {
        const int row0 = u.pm * BM + wr * 64 + fr;
        if (u.pn < 4) {
            const int col0 = u.pn * BM + wc * 32 + 8 * fq;
#pragma unroll
            for (int ai = 0; ai < 2; ++ai)
#pragma unroll
                for (int m = 0; m < 4; ++m)
#pragma unroll
                    for (int bj = 0; bj < 2; ++bj) { const float rs = __builtin_amdgcn_rsqf(ss[row0 + ai * HALF + m * 16] * (1.f / 1024.f) + 1e-6f);
                        *(u32x4*)(Bg + (size_t)(row0 + ai * HALF + m * 16) * 1024 + col0 + bj * HALF) = pack8(acc[ai][bj][m][0] * rs, acc[ai][bj][m][1] * rs); }
        } else {
            const int col0 = (u.pn - 4) * HALF + wc * 32 + 8 * fq;
#pragma unroll
            for (int ai = 0; ai < 2; ++ai)
#pragma unroll
                for (int m = 0; m < 4; ++m) { const float r2 = __builtin_amdgcn_rcpf(ss[row0 + ai * HALF + m * 16] * (1.f / 1024.f) + 1e-6f);
                    *(u32x4*)(U + (size_t)(row0 + ai * HALF + m * 16) * 1024 + col0) = pack8(acc[ai][0][m][0] * acc[ai][1][m][0] * r2, acc[ai][0][m][1] * acc[ai][1][m][1] * r2); }
        }
    }
};

struct EpiKV {
    static constexpr bool PERM = true, AFTER_DRAIN = false;
    bf16_t *Kb, *Vb; size_t brstride; const float* knorm; const float* ss;
    __device__ __forceinline__ void operator()(const f32x4 (&acc)[2][2][4][2], const Unit& u, int wr, int wc, int fr, int fq) const {
        const int br = u.pn >> 1, kv = u.pn & 1;
        const int row0 = u.pm * BM + wr * 64 + fr;
#pragma unroll
        for (int ai = 0; ai < 2; ++ai)
#pragma unroll
            for (int m = 0; m < 4; ++m) {
                const int row = row0 + ai * HALF + m * 16, b = row >> 13, s = row & 8191, bg = b * 4 + wc;
                const float rs = __builtin_amdgcn_rsqf(ss[row] * (1.f / 1024.f) + 1e-6f);
                if (kv == 0) {
                    float rstd = rs;
                    if (br > 0) { float ss = 0.f;
#pragma unroll
                        for (int bj = 0; bj < 2; ++bj)
#pragma unroll
                            for (int n = 0; n < 2; ++n)
#pragma unroll
                                for (int e = 0; e < 4; ++e) ss += acc[ai][bj][m][n][e] * acc[ai][bj][m][n][e];
                        ss += __shfl_xor(ss, 16); ss += __shfl_xor(ss, 32);
                        rstd = rs * __builtin_amdgcn_rsqf(ss * rs * rs * (1.f / 64.f) + 1e-6f); }
                    bf16_t* dst = Kb + (size_t)br * brstride + ((size_t)bg * 8192 + s) * 64 + 8 * fq;
#pragma unroll
                    for (int bj = 0; bj < 2; ++bj) {
                        f32x4 v0 = acc[ai][bj][m][0] * rstd, v1 = acc[ai][bj][m][1] * rstd;
                        if (br > 0) { const float* gp = knorm + br * 64 + bj * 32 + 8 * fq; v0 = v0 * *(const f32x4*)gp; v1 = v1 * *(const f32x4*)(gp + 4); }
                        *(u32x4*)(dst + bj * 32) = pack8(v0, v1);
                    }
                } else if (br == 0) {
                    bf16_t* dst = Vb + ((size_t)bg * 8192 + s) * 64 + 8 * fq;
#pragma unroll
                    for (int bj = 0; bj < 2; ++bj) *(u32x4*)(dst + bj * 32) = pack8(acc[ai][bj][m][0] * rs, acc[ai][bj][m][1] * rs);
                } else {
                    bf16_t* dst = Vb + (size_t)br * brstride + ((size_t)bg * 64 + 8 * fq) * 8192 + s;
#pragma unroll
                    for (int bj = 0; bj < 2; ++bj)
#pragma unroll
                        for (int n = 0; n < 2; ++n) { const f32x4 v = acc[ai][bj][m][n] * rs;
                            const unsigned p0 = cvt_pk_bf16(v[0], v[1]), p1 = cvt_pk_bf16(v[2], v[3]);
                            bf16_t* d = dst + (size_t)(bj * 32 + 4 * n) * 8192;
                            d[0] = (bf16_t)(p0 & 0xffffu); d[8192] = (bf16_t)(p0 >> 16); d[2 * 8192] = (bf16_t)(p1 & 0xffffu); d[3 * 8192] = (bf16_t)(p1 >> 16); }
                }
            }
    }
};

struct EpiQ {
    static constexpr bool PERM = true, AFTER_DRAIN = false;
    bf16_t* Q; float* gates; const float* qnorm; float qscale; const float* ss;
    __device__ __forceinline__ void operator()(const f32x4 (&acc)[2][2][4][2], const Unit& u, int wr, int wc, int fr, int fq) const {
        const int row0 = u.pm * BM + wr * 64 + fr;
        if (u.pn < 4) {
            const int head = u.pn * 4 + wc;
#pragma unroll
            for (int ai = 0; ai < 2; ++ai)
#pragma unroll
                for (int m = 0; m < 4; ++m) {
                    float ss = 0.f;
#pragma unroll
                    for (int bj = 0; bj < 2; ++bj)
#pragma unroll
                        for (int n = 0; n < 2; ++n)
#pragma unroll
                            for (int e = 0; e < 4; ++e) ss += acc[ai][bj][m][n][e] * acc[ai][bj][m][n][e];
                    ss += __shfl_xor(ss, 16); ss += __shfl_xor(ss, 32);
                    const float rs = __builtin_amdgcn_rsqf(this->ss[row0 + ai * HALF + m * 16] * (1.f / 1024.f) + 1e-6f);
                    const float rstd = rs * __builtin_amdgcn_rsqf(ss * rs * rs * (1.f / 64.f) + 1e-6f) * qscale;
                    bf16_t* dst = Q + (size_t)(row0 + ai * HALF + m * 16) * 1024 + head * 64 + 8 * fq;
#pragma unroll
                    for (int bj = 0; bj < 2; ++bj) { const float* gp = qnorm + bj * 32 + 8 * fq;
                        const f32x4 v0 = acc[ai][bj][m][0] * rstd * *(const f32x4*)gp, v1 = acc[ai][bj][m][1] * rstd * *(const f32x4*)(gp + 4);
                        *(u32x4*)(dst + bj * 32) = pack8(v0, v1); }
                }
        } else {
            if (wc < 2) {
#pragma unroll
                for (int ai = 0; ai < 2; ++ai)
#pragma unroll
                    for (int m = 0; m < 4; ++m) {
                        const int c0 = wc * 32 + 8 * fq;
                        if (c0 < 48) { float* dst = gates + (size_t)(row0 + ai * HALF + m * 16) * 48 + c0; const float rs = __builtin_amdgcn_rsqf(this->ss[row0 + ai * HALF + m * 16] * (1.f / 1024.f) + 1e-6f);
                            f32x4 a = acc[ai][0][m][0] * rs, b = acc[ai][0][m][1] * rs;
#pragma unroll
                            for (int e = 0; e < 4; ++e) { a[e] = fast_sigmoid(a[e]); b[e] = fast_sigmoid(b[e]); }
                            *(f32x4*)dst = a; *(f32x4*)(dst + 4) = b; }
                    }
            }
        }
    }
};
template <class Epi, class Sched, bool ALIGN_EPI = false, bool SP2 = false>
__device__ __forceinline__ void gemm_phase(PG8_LAS unsigned char* lds, const Gemm g, const Sched& S, const Epi& E) {
    int tid_ = threadIdx.x; asm volatile("" : "+v"(tid_));
    const int tid = tid_, wid = __builtin_amdgcn_readfirstlane(tid >> 6), lane = tid & 63, wr = wid >> 2, wc = wid & 3, fr = lane & 15, fq = lane >> 4;
    const int K = g.K, nt = K / BK;
    unsigned voffA[2], voffB[2];
#pragma unroll
    for (int i = 0; i < 2; ++i) { int R, C; stage_rc(tid * 16 + i * 8192, R, C); const int Rb = Epi::PERM ? ((R & ~31) + perm32(R & 31)) : R;
        voffA[i] = (unsigned)(R * K + C) * 2u; voffB[i] = (unsigned)(Rb * K + C) * 2u; }
    const size_t kstep = (size_t)(BK * 2);
    const size_t hstep = (size_t)HALF * K * 2;
    const size_t tstep = 2 * hstep;
    const unsigned ldsw = (unsigned)wid * 1024u;
    const int aoff = lds_byte(wr * 64 + fr, fq * 8), boff = lds_byte(wc * 32 + fr, fq * 8);
#define PG8_SA(b, h) (((b) * 2 + (h)) * HTB)
#define PG8_SB(b, h) ((4 + (b) * 2 + (h)) * HTB)
#define PG8_STAGE(bufoff, gbase, voff) do { _Pragma("unroll") for (int _i = 0; _i < 2; ++_i) \
        __builtin_amdgcn_global_load_lds((const unsigned*)((const char*)(gbase) + (voff)[_i]), (PG8_LAS unsigned*)(lds + (bufoff) + ldsw + _i * 8192), 16, 0, 0); } while (0)
#define PG8_LDA(dst, b, h) do { _Pragma("unroll") for (int m = 0; m < 4; ++m) _Pragma("unroll") for (int k = 0; k < 2; ++k) dst[m][k] = *(const PG8_LAS bf16x8*)(lds + PG8_SA(b, h) + aoff + m * 2048 + k * 1024); } while (0)
#define PG8_LDB(dst, b, h) do { _Pragma("unroll") for (int n = 0; n < 2; ++n) _Pragma("unroll") for (int k = 0; k < 2; ++k) dst[n][k] = *(const PG8_LAS bf16x8*)(lds + PG8_SB(b, h) + boff + n * 2048 + k * 1024); } while (0)
#define PG8_MMA(ai, bj, At, Bt) do { __builtin_amdgcn_s_setprio(1); _Pragma("unroll") for (int m = 0; m < 4; ++m) _Pragma("unroll") for (int n = 0; n < 2; ++n) _Pragma("unroll") for (int k = 0; k < 2; ++k) \
        acc[ai][bj][m][n] = __builtin_amdgcn_mfma_f32_16x16x32_bf16(Bt[n][k], At[m][k], acc[ai][bj][m][n], 0, 0, 0); __builtin_amdgcn_s_setprio(0); } while (0)
#define PG8_WAIT_V(n) asm volatile("s_waitcnt vmcnt(" #n ")" ::: "memory")
#define PG8_WAIT_L(n) asm volatile("s_waitcnt lgkmcnt(" #n ")" ::: "memory")
#define PG8_BAR __builtin_amdgcn_s_barrier()
#define PG8_SCHED __builtin_amdgcn_sched_barrier(0)
    Unit cur, nxt; int ui = 0;
    if (!S.next(0, cur)) return;
    f32x4 acc[2][2][4][2];
#pragma unroll
    for (int a = 0; a < 2; ++a)
#pragma unroll
        for (int b = 0; b < 2; ++b)
#pragma unroll
            for (int m = 0; m < 4; ++m)
#pragma unroll
                for (int n = 0; n < 2; ++n) acc[a][b][m][n] = (f32x4){0.f, 0.f, 0.f, 0.f};
    bf16x8 At[4][2], B0[2][2], B1[2][2];
    const char* cA = (const char*)g.A + (size_t)cur.pm * tstep; const char* cB = (const char*)g.Bt + (size_t)cur.pn * tstep;
    S.a_ready(cur);
    if constexpr (SP2) {
        PG8_STAGE(PG8_SB(0, 0), cB, voffB); PG8_STAGE(PG8_SB(0, 1), cB + hstep, voffB); PG8_STAGE(PG8_SA(0, 0), cA, voffA); PG8_STAGE(PG8_SA(0, 1), cA + hstep, voffA);
        if (wr == 1) PG8_BAR;
        PG8_WAIT_V(2); PG8_BAR;
        PG8_STAGE(PG8_SB(1, 0), cB + kstep, voffB); PG8_STAGE(PG8_SA(1, 0), cA + kstep, voffA); PG8_STAGE(PG8_SB(1, 1), cB + hstep + kstep, voffB);
        PG8_WAIT_V(6); PG8_BAR;
    } else {
        PG8_STAGE(PG8_SB(0, 0), cB, voffB); PG8_STAGE(PG8_SA(0, 0), cA, voffA); PG8_STAGE(PG8_SB(0, 1), cB + hstep, voffB); PG8_STAGE(PG8_SA(0, 1), cA + hstep, voffA);
        if (wr == 1) PG8_BAR;
        PG8_WAIT_V(4); PG8_BAR;
        PG8_STAGE(PG8_SB(1, 0), cB + kstep, voffB); PG8_STAGE(PG8_SA(1, 0), cA + kstep, voffA); PG8_STAGE(PG8_SB(1, 1), cB + hstep + kstep, voffB);
        PG8_WAIT_V(6); PG8_BAR;
    }
    for (;;) {
        const bool has_next = S.next(ui + 1, nxt);
        const char* nA = has_next ? (const char*)g.A + (size_t)nxt.pm * tstep : cA; const char* nB = has_next ? (const char*)g.Bt + (size_t)nxt.pn * tstep : cB;
        for (int t = 0; t < nt; t += 2) {
            const bool last = (t == nt - 2);
            const char* a1 = cA + (size_t)(t + 1) * kstep;
            const char* a2 = last ? nA : cA + (size_t)(t + 2) * kstep; const char* b2 = last ? nB : cB + (size_t)(t + 2) * kstep;
            const char* a3 = a2 + kstep; const char* b3 = b2 + kstep;
            if (last && has_next) S.a_ready(nxt);
            if constexpr (SP2) {
            PG8_LDB(B0, 0, 0); PG8_LDB(B1, 0, 1); PG8_SCHED; PG8_LDA(At, 0, 0); PG8_STAGE(PG8_SA(1, 1), a1 + hstep, voffA);
            PG8_WAIT_V(8); PG8_WAIT_L(0); PG8_BAR; PG8_MMA(0, 0, At, B0); PG8_MMA(0, 1, At, B1); PG8_BAR; PG8_SCHED;
            PG8_LDA(At, 0, 1); PG8_STAGE(PG8_SB(0, 0), b2, voffB); PG8_STAGE(PG8_SB(0, 1), b2 + hstep, voffB); PG8_STAGE(PG8_SA(0, 0), a2, voffA);
            PG8_WAIT_V(8); PG8_WAIT_L(0); PG8_BAR; PG8_MMA(1, 0, At, B0); PG8_MMA(1, 1, At, B1); PG8_BAR; PG8_SCHED;
            PG8_LDB(B0, 1, 0); PG8_LDB(B1, 1, 1); PG8_SCHED; PG8_LDA(At, 1, 0); PG8_STAGE(PG8_SA(0, 1), a2 + hstep, voffA);
            PG8_WAIT_V(8); PG8_WAIT_L(0); PG8_BAR; PG8_MMA(0, 0, At, B0); PG8_MMA(0, 1, At, B1); PG8_BAR; PG8_SCHED;
            PG8_LDA(At, 1, 1); PG8_STAGE(PG8_SB(1, 0), b3, voffB); PG8_STAGE(PG8_SB(1, 1), b3 + hstep, voffB); PG8_STAGE(PG8_SA(1, 0), a3, voffA);
            PG8_WAIT_V(8); PG8_WAIT_L(0); PG8_BAR; PG8_MMA(1, 0, At, B0); PG8_MMA(1, 1, At, B1); PG8_BAR; PG8_SCHED;
            } else {
            PG8_LDB(B0, 0, 0); PG8_SCHED; PG8_LDA(At, 0, 0); PG8_STAGE(PG8_SA(1, 1), a1 + hstep, voffA);
            PG8_WAIT_L(8); PG8_BAR; PG8_WAIT_L(0); PG8_MMA(0, 0, At, B0); PG8_BAR; PG8_SCHED;
            PG8_LDB(B1, 0, 1); PG8_STAGE(PG8_SB(0, 0), b2, voffB);
            PG8_BAR; PG8_WAIT_L(0); PG8_MMA(0, 1, At, B1); PG8_BAR;
            PG8_LDA(At, 0, 1); PG8_STAGE(PG8_SA(0, 0), a2, voffA);
            PG8_BAR; PG8_WAIT_L(0); PG8_MMA(1, 0, At, B0); PG8_BAR; PG8_SCHED;
            PG8_STAGE(PG8_SB(0, 1), b2 + hstep, voffB);
            PG8_WAIT_V(6); PG8_BAR; PG8_MMA(1, 1, At, B1); PG8_BAR;
            PG8_LDB(B0, 1, 0); PG8_SCHED; PG8_LDA(At, 1, 0); PG8_STAGE(PG8_SA(0, 1), a2 + hstep, voffA);
            PG8_WAIT_L(8); PG8_BAR; PG8_WAIT_L(0); PG8_MMA(0, 0, At, B0); PG8_BAR; PG8_SCHED;
            PG8_LDB(B1, 1, 1); PG8_STAGE(PG8_SB(1, 0), b3, voffB);
            PG8_BAR; PG8_WAIT_L(0); PG8_MMA(0, 1, At, B1); PG8_BAR;
            PG8_LDA(At, 1, 1); PG8_STAGE(PG8_SA(1, 0), a3, voffA);
            PG8_BAR; PG8_WAIT_L(0); PG8_MMA(1, 0, At, B0); PG8_BAR; PG8_SCHED;
            PG8_STAGE(PG8_SB(1, 1), b3 + hstep, voffB);
            PG8_WAIT_V(6); PG8_BAR; PG8_MMA(1, 1, At, B1); PG8_BAR;
            }
        }
        if constexpr (ALIGN_EPI) { if (wr == 0) PG8_BAR; }
        if constexpr (!Epi::AFTER_DRAIN) { E(acc, cur, wr, wc, fr, fq); S.done(cur); }
        if (!has_next) break;
#pragma unroll
        for (int a = 0; a < 2; ++a)
#pragma unroll
            for (int b = 0; b < 2; ++b)
#pragma unroll
                for (int m = 0; m < 4; ++m)
#pragma unroll
                    for (int n = 0; n < 2; ++n) acc[a][b][m][n] = (f32x4){0.f, 0.f, 0.f, 0.f};
        cur = nxt; cA = nA; cB = nB; ++ui;
        if constexpr (ALIGN_EPI) { if (wr == 1) PG8_BAR; }
    }
    PG8_WAIT_V(0);
    if constexpr (!ALIGN_EPI) { if (wr == 0) PG8_BAR; }
    PG8_BAR;
    if constexpr (Epi::AFTER_DRAIN) { E.fused(acc, cur, wr, wc, fr, fq, lds, wid, lane); S.done(cur); }
#undef PG8_SA
#undef PG8_SB
#undef PG8_STAGE
#undef PG8_LDA
#undef PG8_LDB
#undef PG8_MMA
#undef PG8_WAIT_V
#undef PG8_WAIT_L
#undef PG8_BAR
#undef PG8_SCHED
}
}

#define LAS __attribute__((address_space(3)))
typedef unsigned short bf16;
typedef float f32x4 __attribute__((ext_vector_type(4)));
typedef short bf16x8 __attribute__((ext_vector_type(8)));
typedef unsigned u32x4 __attribute__((ext_vector_type(4)));
typedef unsigned long long u64;

constexpr int NB = 4, SEQ = 8192, DM = 1024, T = NB * SEQ, DFF = 2816, NH = 16, NG = 4, HD = 64;
constexpr int NQP = 1280;
constexpr int NKV = 1536;
constexpr int NCB = 512;
constexpr float RMS_EPS = 1e-6f;
constexpr float LOG2E = 1.4426950408889634f;
constexpr int LDS_BYTES = 151552;

constexpr size_t MiB = 1u << 20;
constexpr size_t SZ_WIN = (size_t)2 * DFF * DM * 2, SZ_WOUT = (size_t)DM * DFF * 2;
constexpr size_t WS_WIN = 1 * MiB;
constexpr size_t WS_WOUT = WS_WIN + 4 * SZ_WIN;
constexpr size_t WS_CWIN = WS_WOUT + 4 * SZ_WOUT;
constexpr size_t WS_CWOUT = WS_CWIN + (size_t)3072 * 1024 * 2;
constexpr size_t WS_WQ = WS_CWOUT + (size_t)1024 * 1024 * 2;
constexpr size_t WS_WO = WS_WQ + (size_t)NQP * 1024 * 2;
constexpr size_t WS_WKV = WS_WO + (size_t)1024 * 1024 * 2;
constexpr size_t WS_W1K = WS_WKV + (size_t)NKV * 1024 * 2;
constexpr size_t WS_W1V = WS_W1K + (size_t)128 * 2048 * 2;
constexpr size_t WS_W2K = WS_W1V + (size_t)128 * 2048 * 2;
constexpr size_t WS_W2V = WS_W2K + (size_t)64 * 128 * 2;
constexpr size_t WS_B1 = WS_W2V + (size_t)64 * 128 * 2;
constexpr size_t WS_WEND = WS_B1 + 1024;
static_assert(WS_WEND <= 90 * MiB, "weights region");
constexpr size_t WS_HN = 96 * MiB;
constexpr size_t WS_HN2 = 160 * MiB;
constexpr size_t WS_ACT = 224 * MiB;
constexpr size_t WS_BG = WS_ACT, WS_U = WS_ACT + 64 * MiB;
constexpr size_t WS_Q = WS_ACT;
constexpr size_t KV_BYTES = (size_t)16 * SEQ * 64 * 2;
constexpr size_t WS_KCR = 400 * MiB, WS_KS = WS_KCR + KV_BYTES, WS_KW = WS_KS + KV_BYTES;
constexpr size_t WS_VCR = WS_KW + KV_BYTES, WS_VST = WS_VCR + KV_BYTES, WS_VWT = WS_VST + KV_BYTES;
constexpr size_t WS_KC = 90 * MiB, WS_VCT = 91 * MiB;
constexpr size_t WS_GATES = WS_VWT + KV_BYTES;
constexpr size_t WS_AO = WS_HN2;
constexpr size_t WS_END = WS_GATES + 6 * MiB;
static_assert(WS_END <= 512 * MiB, "workspace");

struct Args {
    const float* in[24];
    float* out; unsigned char* ws;
};
typedef const __attribute__((address_space(4))) Args* KArgsP;
__device__ __forceinline__ KArgsP KA() { KArgsP p = (KArgsP)__builtin_amdgcn_kernarg_segment_ptr(); asm volatile("" : "+s"(p)); return p; }
#define IN(i) ((const float*)KA()->in[i])
#define WSP ((unsigned char*)KA()->ws)

typedef float f32x2_t __attribute__((ext_vector_type(2)));
typedef __bf16 bf16x2_t __attribute__((ext_vector_type(2)));
__device__ __forceinline__ unsigned cvt_pk(float lo, float hi) { const f32x2_t v = {lo, hi}; const bf16x2_t b = __builtin_convertvector(v, bf16x2_t); return __builtin_bit_cast(unsigned, b); }
__device__ __forceinline__ float bf2f(unsigned short b) { return __builtin_bit_cast(float, (unsigned)b << 16); }
__device__ __forceinline__ float wave_sum(float v) {
#pragma unroll
    for (int o = 1; o < 64; o <<= 1) v += __shfl_xor(v, o);
    return v;
}
__device__ __forceinline__ float wave_max(float v) {
#pragma unroll
    for (int o = 1; o < 64; o <<= 1) v = fmaxf(v, __shfl_xor(v, o));
    return v;
}

enum { MK_IDENT = 0, MK_FFN_IN = 1, MK_CONV_IN = 2, MK_HEADPERM = 3, MK_Q = 4 };
__device__ __forceinline__ int srcmap(int kind, int np) {
    const int pn = np >> 8, r = np & 255, bj = r >> 7, c = r & 127;
    if (kind == MK_FFN_IN) return bj * DFF + 128 * pn + c;
    if (kind == MK_CONV_IN) return pn < 4 ? np : 1024 * (1 + bj) + 128 * (pn - 4) + c;
    if (kind == MK_HEADPERM) return 256 * pn + 64 * (c >> 5) + 32 * bj;
    if (kind == MK_Q) return pn < 4 ? 256 * pn + 64 * (c >> 5) + 32 * bj : (r < 32 ? 1024 : (r < 64 ? 1056 : -1));
    return np;
}
struct MatDesc { const float* W; bf16* WT; int K, N, NP, kind; const float* gain; };

__device__ __forceinline__ void prep_load(const MatDesc& d, int item, int tid, float (&v)[16]) {
    const int nblk = d.NP >> 6, kb = item / nblk, nb = item - kb * nblk;
    const int n = tid & 31, kk = tid >> 5;
#pragma unroll
    for (int s = 0; s < 2; ++s) {
        const int sc = srcmap(d.kind, nb * 64 + s * 32);
        const bool ok = sc >= 0 && (sc + n) < d.N;
        const float* p = d.W + (size_t)(kb * 128 + kk) * d.N + sc + n;
#pragma unroll
        for (int i = 0; i < 8; ++i) v[s * 8 + i] = ok ? p[(size_t)(16 * i) * d.N] * (d.gain ? d.gain[kb * 128 + kk + 16 * i] : 1.f) : 0.f;
    }
}
__device__ __forceinline__ void prep_store_lds(LAS float* scr, int tid, const float (&v)[16]) {
    const int n = tid & 31, kk = tid >> 5;
#pragma unroll
    for (int s = 0; s < 2; ++s)
#pragma unroll
        for (int i = 0; i < 8; ++i) scr[(kk + 16 * i) * 65 + s * 32 + n] = v[s * 8 + i];
}
__device__ __forceinline__ void prep_write(const MatDesc& d, int item, int tid, const LAS float* scr) {
    const int nblk = d.NP >> 6, kb = item / nblk, nb = item - kb * nblk;
#pragma unroll
    for (int s = 0; s < 2; ++s) {
        const int n = (tid >> 4) + 32 * s, c = tid & 15;
        const LAS float* p = scr + (8 * c) * 65 + n;
        u32x4 o; o.x = cvt_pk(p[0], p[65]); o.y = cvt_pk(p[2 * 65], p[3 * 65]); o.z = cvt_pk(p[4 * 65], p[5 * 65]); o.w = cvt_pk(p[6 * 65], p[7 * 65]);
        *(u32x4*)(d.WT + (size_t)(nb * 64 + n) * d.K + kb * 128 + 8 * c) = o;
    }
}

__device__ __forceinline__ MatDesc get_mat(const Args& a, int mi) {
    unsigned char* ws = WSP;
    MatDesc d; d.gain = nullptr;
    if (mi < 4) { const int layer = mi >> 1, f2 = mi & 1;
        d.gain = IN(f2 ? 5 : 1) + layer * DM;
        d.W = IN(f2 ? 6 : 2) + (size_t)layer * DM * 2 * DFF; d.WT = (bf16*)(ws + WS_WIN + (size_t)mi * SZ_WIN); d.K = DM; d.N = 2 * DFF; d.NP = 2 * DFF; d.kind = MK_FFN_IN; return d; }
    if (mi < 8) { const int s = mi - 4, layer = s >> 1, f2 = s & 1;
        d.W = IN(f2 ? 7 : 3) + (size_t)layer * DFF * DM; d.WT = (bf16*)(ws + WS_WOUT + (size_t)s * SZ_WOUT); d.K = DFF; d.N = DM; d.NP = DM; d.kind = MK_IDENT; return d; }
    switch (mi) {
    case 8:  d.W = IN(8);  d.WT = (bf16*)(ws + WS_CWIN);  d.K = DM; d.N = 3072; d.NP = 3072; d.kind = MK_CONV_IN; d.gain = IN(4); break;
    case 9:  d.W = IN(10); d.WT = (bf16*)(ws + WS_CWOUT); d.K = DM; d.N = DM;   d.NP = DM;   d.kind = MK_IDENT; break;
    case 10: d.W = IN(11); d.WT = (bf16*)(ws + WS_WQ);    d.K = DM; d.N = 1072; d.NP = NQP;  d.kind = MK_Q; d.gain = IN(4) + DM; break;
    case 11: d.W = IN(13); d.WT = (bf16*)(ws + WS_WO);    d.K = DM; d.N = DM;   d.NP = DM;   d.kind = MK_IDENT; break;
    case 12: d.W = IN(15); d.WT = (bf16*)(ws + WS_WKV);   d.K = DM; d.N = NKV;  d.NP = NKV;  d.kind = MK_HEADPERM; d.gain = IN(14); break;
    case 13: d.W = IN(19); d.WT = (bf16*)(ws + WS_W1K);   d.K = 2048; d.N = 128; d.NP = 128; d.kind = MK_IDENT; break;
    case 14: d.W = IN(21); d.WT = (bf16*)(ws + WS_W1V);   d.K = 2048; d.N = 128; d.NP = 128; d.kind = MK_IDENT; break;
    case 15: d.W = IN(20); d.WT = (bf16*)(ws + WS_W2K);   d.K = 128; d.N = 64; d.NP = 64; d.kind = MK_IDENT; break;
    default: d.W = IN(22); d.WT = (bf16*)(ws + WS_W2V);   d.K = 128; d.N = 64; d.NP = 64; d.kind = MK_IDENT; break;
    }
    return d;
}
constexpr int N_MATS = 17;
__device__ __forceinline__ int mat_items(int mi) {
    if (mi < 4) return 8 * 88; if (mi < 8) return 22 * 16;
    switch (mi) { case 8: return 8 * 48; case 9: return 8 * 16; case 10: return 8 * 20; case 11: return 8 * 16; case 12: return 8 * 24; case 13: case 14: return 16 * 2; default: return 1; }
}
__device__ __forceinline__ bool prep_locate(int g, int& mi, int& item) {
    for (int m = 0; m < N_MATS; ++m) { const int n = mat_items(m); if (g < n) { mi = m; item = g; return true; } g -= n; }
    return false;
}

__device__ __forceinline__ void phase_prep(const Args& a, LAS unsigned char* lds) {
    LAS float* scr = (LAS float*)lds;
    int tid_ = threadIdx.x; asm volatile("" : "+v"(tid_)); const int tid = tid_, G = gridDim.x;
    float v[16]; int mi, item;
    int g = blockIdx.x;
    bool have = prep_locate(g, mi, item);
    MatDesc d = {};
    if (have) { d = get_mat(a, mi); prep_load(d, item, tid, v); }
    while (have) {
        prep_store_lds(scr, tid, v);
        __syncthreads();
        const MatDesc dc = d; const int itc = item;
        g += G; have = prep_locate(g, mi, item);
        if (have) { d = get_mat(a, mi); prep_load(d, item, tid, v); }
        prep_write(dc, itc, tid, scr);
        __syncthreads();
    }
    if (blockIdx.x < 2) {
        const int kv = blockIdx.x; const float* pe = IN(kv ? 18 : 17); const float* w1 = IN(kv ? 21 : 19);
        const int col = tid & 127, part = tid >> 7; float s = 0.f;
        for (int k = part * 512; k < part * 512 + 512; ++k) s += pe[k] * w1[(size_t)k * 128 + col];
        scr[tid] = s; __syncthreads();
        if (tid < 128) ((float*)(WSP + WS_B1))[kv * 128 + tid] = scr[tid] + scr[tid + 128] + scr[tid + 256] + scr[tid + 384];
        __syncthreads();
    }
}

__device__ __forceinline__ void phase_norm(const float* h, const float* g1, bf16* o1, const float* g2, bf16* o2) {
    int tid_ = threadIdx.x; asm volatile("" : "+v"(tid_));
    const int lane = tid_ & 63, wave = tid_ >> 6;
    const int gw = blockIdx.x * 8 + wave, NGW = gridDim.x * 8;
    f32x4 ga[4], gb[4];
#pragma unroll
    for (int j = 0; j < 4; ++j) { ga[j] = *(const f32x4*)(g1 + 4 * lane + 256 * j); gb[j] = g2 ? *(const f32x4*)(g2 + 4 * lane + 256 * j) : ga[j]; }
    for (int m = gw; m < T; m += NGW) {
        const f32x4* xr = (const f32x4*)(h + (size_t)m * DM) + lane;
        f32x4 v[4]; float s = 0.f;
#pragma unroll
        for (int j = 0; j < 4; ++j) { v[j] = xr[64 * j]; s += (v[j].x * v[j].x + v[j].y * v[j].y) + (v[j].z * v[j].z + v[j].w * v[j].w); }
        const float rstd = __builtin_amdgcn_rsqf(wave_sum(s) * (1.f / DM) + RMS_EPS);
        u64* p1 = (u64*)(o1 + (size_t)m * DM) + lane;
#pragma unroll
        for (int j = 0; j < 4; ++j) { const f32x4 y = v[j] * rstd * ga[j]; p1[64 * j] = (u64)cvt_pk(y.x, y.y) | ((u64)cvt_pk(y.z, y.w) << 32); }
        if (g2) { u64* p2 = (u64*)(o2 + (size_t)m * DM) + lane;
#pragma unroll
            for (int j = 0; j < 4; ++j) { const f32x4 y = v[j] * rstd * gb[j]; p2[64 * j] = (u64)cvt_pk(y.x, y.y) | ((u64)cvt_pk(y.z, y.w) << 32); } }
    }
}

constexpr size_t WS_SS = 131072;
__device__ __forceinline__ void phase_x(const float* x, bf16* hb, float* ss) {
    int tid_ = threadIdx.x; asm volatile("" : "+v"(tid_));
    const int lane = tid_ & 63, wave = tid_ >> 6;
    const int gw = blockIdx.x * 8 + wave, NGW = gridDim.x * 8;
    for (int i = blockIdx.x * 512 + tid_; i < 5 * T; i += gridDim.x * 512) ss[T + i] = 0.f;
    for (int m = gw; m < T; m += NGW) {
        const f32x4* xr = (const f32x4*)(x + (size_t)m * DM) + lane;
        f32x4 v[4]; float s = 0.f;
#pragma unroll
        for (int j = 0; j < 4; ++j) { v[j] = xr[64 * j]; s += (v[j].x * v[j].x + v[j].y * v[j].y) + (v[j].z * v[j].z + v[j].w * v[j].w); }
        s = wave_sum(s);
        u64* p1 = (u64*)(hb + (size_t)m * DM) + lane;
#pragma unroll
        for (int j = 0; j < 4; ++j) p1[64 * j] = (u64)cvt_pk(v[j].x, v[j].y) | ((u64)cvt_pk(v[j].z, v[j].w) << 32);
        if (lane == 0) ss[m] = s;
    }
}

__device__ __forceinline__ void unpack8(const u32x4 w, float (&f)[8]) {
    f[0] = __builtin_bit_cast(float, w.x << 16); f[1] = __builtin_bit_cast(float, w.x & 0xffff0000u); f[2] = __builtin_bit_cast(float, w.y << 16); f[3] = __builtin_bit_cast(float, w.y & 0xffff0000u);
    f[4] = __builtin_bit_cast(float, w.z << 16); f[5] = __builtin_bit_cast(float, w.z & 0xffff0000u); f[6] = __builtin_bit_cast(float, w.w << 16); f[7] = __builtin_bit_cast(float, w.w & 0xffff0000u);
}
__device__ __forceinline__ void phase_conv(const bf16* Bg, const bf16* U, const float* cw, bf16* Z) {
    int tid_ = threadIdx.x; asm volatile("" : "+v"(tid_));
    const int tid = tid_, cc = tid & 127, trow = tid >> 7;
    float w0[8], w1[8], w2[8];
#pragma unroll
    for (int e = 0; e < 8; ++e) { w0[e] = cw[8 * cc + e]; w1[e] = cw[1024 + 8 * cc + e]; w2[e] = cw[2048 + 8 * cc + e]; }
    for (int tb = blockIdx.x; tb < T / 128; tb += gridDim.x) {
        const int tbeg = tb * 128 + trow * 32;
        float u1[8], u2[8];
        if ((tbeg & (SEQ - 1)) == 0) {
#pragma unroll
            for (int e = 0; e < 8; ++e) { u1[e] = 0.f; u2[e] = 0.f; }
        } else {
            unpack8(*(const u32x4*)(U + (size_t)(tbeg - 1) * DM + 8 * cc), u1);
            unpack8(*(const u32x4*)(U + (size_t)(tbeg - 2) * DM + 8 * cc), u2);
        }
#pragma unroll 4
        for (int i = 0; i < 32; ++i) {
            const size_t p = (size_t)(tbeg + i) * DM + 8 * cc;
            float u0[8], bgv[8], z[8];
            unpack8(*(const u32x4*)(U + p), u0); unpack8(*(const u32x4*)(Bg + p), bgv);
#pragma unroll
            for (int e = 0; e < 8; ++e) { z[e] = bgv[e] * (w0[e] * u2[e] + w1[e] * u1[e] + w2[e] * u0[e]); u2[e] = u1[e]; u1[e] = u0[e]; }
            u32x4 o; o.x = cvt_pk(z[0], z[1]); o.y = cvt_pk(z[2], z[3]); o.z = cvt_pk(z[4], z[5]); o.w = cvt_pk(z[6], z[7]);
            *(u32x4*)(Z + p) = o;
        }
    }
}

__device__ __forceinline__ void phase_compress(const Args& a, LAS unsigned char* lds, size_t off_kc = WS_KC, size_t off_vct = WS_VCT) {
    unsigned char* ws = WSP;
    int tid_ = threadIdx.x; asm volatile("" : "+v"(tid_));
    const int tid = tid_, lane = tid & 63, w = tid >> 6, lc = lane & 15, lg = lane >> 4;
    LAS bf16* hid = (LAS bf16*)lds;
    LAS float* outf = (LAS float*)(lds + 32 * 136 * 2);
    for (int u2 = blockIdx.x * 2; u2 < 512; u2 += gridDim.x * 2)
    for (int uu = u2; uu < u2 + 2; ++uu) {
        const int kv = uu >> 8, R0 = (uu & 255) * 32;
        const bf16* raw = (const bf16*)(ws + (kv ? WS_VCR : WS_KCR));
        const bf16* w1t = (const bf16*)(ws + (kv ? WS_W1V : WS_W1K));
        const bf16* w2t = (const bf16*)(ws + (kv ? WS_W2V : WS_W2K));
        const float* b1 = (const float*)(ws + WS_B1) + kv * 128;
        f32x4 acc[2] = {{0.f, 0.f, 0.f, 0.f}, {0.f, 0.f, 0.f, 0.f}};
        const bf16* ap0 = raw + (size_t)(R0 + lc) * 1024 + 8 * lg;
        const bf16* ap1 = ap0 + (size_t)16 * 1024;
        const bf16* bp = w1t + (size_t)(16 * w + lc) * 2048 + 8 * lg;
        bf16x8 A0[4], A1[4], B[4];
#pragma unroll
        for (int s = 0; s < 4; ++s) { A0[s] = *(const bf16x8*)(ap0 + 32 * s); A1[s] = *(const bf16x8*)(ap1 + 32 * s); B[s] = *(const bf16x8*)(bp + 32 * s); }
        for (int k0 = 0; k0 < 2048; k0 += 128) {
            bf16x8 nA0[4], nA1[4], nB[4];
            const int kn = (k0 + 128 < 2048) ? k0 + 128 : k0;
#pragma unroll
            for (int s = 0; s < 4; ++s) { nA0[s] = *(const bf16x8*)(ap0 + kn + 32 * s); nA1[s] = *(const bf16x8*)(ap1 + kn + 32 * s); nB[s] = *(const bf16x8*)(bp + kn + 32 * s); }
#pragma unroll
            for (int s = 0; s < 4; ++s) { acc[0] = __builtin_amdgcn_mfma_f32_16x16x32_bf16(A0[s], B[s], acc[0], 0, 0, 0); acc[1] = __builtin_amdgcn_mfma_f32_16x16x32_bf16(A1[s], B[s], acc[1], 0, 0, 0); }
#pragma unroll
            for (int s = 0; s < 4; ++s) { A0[s] = nA0[s]; A1[s] = nA1[s]; B[s] = nB[s]; }
        }
        { const int col = 16 * w + lc; const float bb = b1[col];
#pragma unroll
          for (int rt = 0; rt < 2; ++rt)
#pragma unroll
            for (int r = 0; r < 4; ++r) { const float x = acc[rt][r] + bb; const float y = 2.f * 0.7978845608028654f * (x + 0.044715f * x * x * x);
                const float gl = x * __builtin_amdgcn_rcpf(1.f + __builtin_amdgcn_exp2f(-LOG2E * y));
                hid[(16 * rt + 4 * lg + r) * 136 + col] = (bf16)(cvt_pk(gl, 0.f) & 0xffffu); } }
        __syncthreads();
        { const int rt = w >> 2, ct = w & 3; f32x4 o = {0.f, 0.f, 0.f, 0.f};
#pragma unroll
          for (int ks = 0; ks < 4; ++ks) { const bf16x8 A = *(const LAS bf16x8*)(hid + (16 * rt + lc) * 136 + 32 * ks + 8 * lg); const bf16x8 B = *(const bf16x8*)(w2t + (size_t)(16 * ct + lc) * 128 + 32 * ks + 8 * lg);
              o = __builtin_amdgcn_mfma_f32_16x16x32_bf16(A, B, o, 0, 0, 0); }
#pragma unroll
          for (int r = 0; r < 4; ++r) outf[(16 * rt + 4 * lg + r) * 65 + 16 * ct + lc] = o[r]; }
        __syncthreads();
        { const int row = tid >> 4, d0 = 4 * (tid & 15); const int R = R0 + row, bg = R >> 9, i = R & 511;
          float v[4]; float ss = 0.f;
#pragma unroll
          for (int e = 0; e < 4; ++e) { v[e] = outf[row * 65 + d0 + e]; ss += v[e] * v[e]; }
          if (kv == 0) {
              ss += __shfl_xor(ss, 1); ss += __shfl_xor(ss, 2); ss += __shfl_xor(ss, 4); ss += __shfl_xor(ss, 8);
              const float rstd = __builtin_amdgcn_rsqf(ss * (1.f / 64.f) + RMS_EPS); const float* kn = IN(16);
#pragma unroll
              for (int e = 0; e < 4; ++e) v[e] = (i == 511) ? 0.f : v[e] * rstd * kn[d0 + e];
              bf16* dst = (bf16*)(ws + off_kc) + ((size_t)bg * NCB + i) * 64 + d0;
              *(u64*)dst = (u64)cvt_pk(v[0], v[1]) | ((u64)cvt_pk(v[2], v[3]) << 32);
          } else {
              bf16* dst = (bf16*)(ws + off_vct) + ((size_t)bg * 64 + d0) * NCB + i;
#pragma unroll
              for (int e = 0; e < 4; ++e) dst[(size_t)e * NCB] = (i == 511) ? (bf16)0 : (bf16)(cvt_pk(v[e], 0.f) & 0xffffu);
          } }
        __syncthreads();
    }
}

constexpr int A_IMP = 0, A_RING = 32768, TILE_PITCH = 192  , TILE_B = 64 * TILE_PITCH, STAGE_B = 2 * TILE_B,
              A_SELQ = A_RING + 2 * STAGE_B, A_BIAS = A_SELQ + 1024, A_MB = A_BIAS + 512, A_OUT = A_MB + 512;
constexpr int RELMAX_BIG = 0x40000000;

template <int MODE, int BM = 0, bool SEL = false>
__device__ __forceinline__ void attn_core(const bf16x8 (&kf)[4][2], const bf16x8 (&vf)[4][2], const bf16x8 (&qf)[2], int tq, int pbase, int pstride, int relmax,
                                          const LAS float* biasrow, float pscale, f32x4 (&oacc)[4], float& lsum, LAS float* improw, int jbase, int lg, int h, float pbias = 0.f, float pbias2 = 0.f, int thr = 0) {
    f32x4 s[4];
#pragma unroll
    for (int kt = 0; kt < 4; ++kt) {
        s[kt] = __builtin_amdgcn_mfma_f32_16x16x32_bf16(kf[kt][0], qf[0], (f32x4){0.f, 0.f, 0.f, 0.f}, 0, 0, 0);
        s[kt] = __builtin_amdgcn_mfma_f32_16x16x32_bf16(kf[kt][1], qf[1], s[kt], 0, 0, 0);
    }
#pragma unroll
    for (int kt = 0; kt < 4; ++kt) {
        const int kap0 = 32 * (kt >> 1) + 8 * lg + 4 * (kt & 1);
        const int rel0 = tq - (pbase + kap0 * pstride);
#pragma unroll
        for (int r = 0; r < 4; ++r) {
            float p;
            if (BM == 1) {
                p = __builtin_amdgcn_exp2f(s[kt][r] + pbias);
            } else if (BM == 2) {
                const int rel = rel0 - r * pstride;
                p = __builtin_amdgcn_exp2f(s[kt][r] + (rel >= thr ? pbias2 : pbias));
            } else if (BM == 3) {
                const int rel = rel0 - r * pstride;
                int bk = 39 - __clz((int)__umul24((unsigned)rel, (unsigned)rel)); bk = bk > 31 ? 31 : bk;
                p = __builtin_amdgcn_exp2f(s[kt][r] + biasrow[bk]);
                if (SEL) p = tq >= 0 ? p : 0.f;
            } else {
            const int rel = rel0 - r * pstride;
            const bool valid = (unsigned)rel < (unsigned)relmax;
            const int n = valid ? rel : 0;
            const int nn = (int)__umul24((unsigned)n, (unsigned)n);
            int bk = 39 - __clz(nn); bk = bk > 31 ? 31 : bk; bk = n < 16 ? n : bk;
            const float x = s[kt][r] + biasrow[bk];
            p = valid ? __builtin_amdgcn_exp2f(x) : 0.f;
            }
            if (MODE == 2) p *= pscale;
            s[kt][r] = p; lsum += p;
        }
        __builtin_amdgcn_sched_barrier(0);
        if (MODE == 2) {
            float av = 2.f * (s[kt][0] + s[kt][1] + s[kt][2]) + s[kt][3], bv = s[kt][3];
            av += __shfl_xor(av, 1); av += __shfl_xor(av, 2); bv += __shfl_xor(bv, 1); bv += __shfl_xor(bv, 2);
            if (h == 0) { const int j = jbase + (kap0 >> 2);
                improw[j] = improw[j] + av;
                if (j + 1 < 128) improw[j + 1] = improw[j + 1] + bv; }
        }
    }
    if (MODE >= 1) {
#pragma unroll
        for (int hh = 0; hh < 2; ++hh) {
            u32x4 pw; pw.x = cvt_pk(s[2 * hh][0], s[2 * hh][1]); pw.y = cvt_pk(s[2 * hh][2], s[2 * hh][3]); pw.z = cvt_pk(s[2 * hh + 1][0], s[2 * hh + 1][1]); pw.w = cvt_pk(s[2 * hh + 1][2], s[2 * hh + 1][3]);
            const bf16x8 pf = __builtin_bit_cast(bf16x8, pw);
#pragma unroll
            for (int dt = 0; dt < 4; ++dt) oacc[dt] = __builtin_amdgcn_mfma_f32_16x16x32_bf16(vf[dt][hh], pf, oacc[dt], 0, 0, 0);
        }
    }
}
__device__ __forceinline__ int rel_bucket_i(int n) { int bk = 39 - __clz((int)((unsigned)n * (unsigned)n)); bk = bk > 31 ? 31 : bk; return n < 16 ? n : bk; }
template <int MODE, bool SEL>
__device__ __forceinline__ void tile_stream(LAS unsigned char* ring, const bf16* Kbase, const bf16* Vbase, int ldv, int nt, int pb0, int pbstep, int pstride, int relmax,
                                            const bf16x8 (&qf)[2][2], const int (&tq)[2], const LAS float* biasrow, const float (&psc)[2], f32x4 (&oacc)[2][4], float (&ls)[2],
                                            LAS float* imp0, LAS float* imp1, const LAS u64* selA, const LAS u64* selB, int tid, int lc, int lg, int h) {
    const int row = tid >> 3, ch = tid & 7;
    const bf16* kp = Kbase + row * 64 + ch * 8;
    const bf16* vp = Vbase + (size_t)row * ldv + ch * 8;
    const int woff = row * TILE_PITCH + ch * 16;
    const float bfar = biasrow[31]; const int tqlo = __builtin_amdgcn_readfirstlane(tq[0]) ;
    u32x4 rk = {0u, 0u, 0u, 0u}, rv = {0u, 0u, 0u, 0u};
    if (nt > 0) { rk = *(const u32x4*)kp; if (MODE > 0) rv = *(const u32x4*)vp; }
#define TILE_STEP(t, rk, rv) do { \
        LAS unsigned char* st = ring + (t & 1) * STAGE_B; \
        *(LAS u32x4*)(st + woff) = rk; if (MODE > 0) *(LAS u32x4*)(st + TILE_B + woff) = rv; \
        asm volatile("s_waitcnt lgkmcnt(0)" ::: "memory"); __builtin_amdgcn_s_barrier(); asm volatile("" ::: "memory"); \
        if (t + 2 < nt) { rk = *(const u32x4*)(kp + (size_t)(t + 2) * 4096); if (MODE > 0) rv = *(const u32x4*)(vp + (t + 2) * 64); } \
        int tq0 = tq[0], tq1 = tq[1]; bool do0 = true, do1 = true; \
        if (SEL) { \
            const bool b0 = ((selA[t >> 6] >> (t & 63)) & 1ull) != 0ull, b1 = ((selB[t >> 6] >> (t & 63)) & 1ull) != 0ull; \
            tq0 = b0 ? tq0 : -1; tq1 = b1 ? tq1 : -1; do0 = __ballot(b0) != 0ull; do1 = __ballot(b1) != 0ull; \
        } \
        if (do0 || do1) { \
            bf16x8 kf[4][2], vf[4][2]; \
_Pragma("unroll") \
            for (int kt = 0; kt < 4; ++kt) { const LAS unsigned char* p = st + (32 * (kt >> 1) + 8 * (lc >> 2) + 4 * (kt & 1) + (lc & 3)) * TILE_PITCH + 16 * lg; \
                kf[kt][0] = *(const LAS bf16x8*)p; kf[kt][1] = *(const LAS bf16x8*)(p + 64); } \
            if (MODE > 0) { \
_Pragma("unroll") \
                for (int dt = 0; dt < 4; ++dt) { const LAS unsigned char* p = st + TILE_B + (16 * dt + lc) * TILE_PITCH + 16 * lg; \
                    vf[dt][0] = *(const LAS bf16x8*)p; vf[dt][1] = *(const LAS bf16x8*)(p + 64); } \
            } \
            const int pbase = pb0 + t * pbstep; \
            { \
 \
                const int rlo = tqlo - (pbase + 63 * pstride), rhi = tqlo + 7 - pbase; \
                const int blo = rel_bucket_i(rlo < 0 ? 0 : rlo), bhi = rel_bucket_i(rhi < 0 ? 0 : rhi); \
                if (rlo >= 0 && rhi < relmax && bhi - blo <= 1) { \
                    int thr = 0x7fffffff; \
                    if (bhi != blo) { int a = rlo, b = rhi; \
                        while (b - a > 1) { const int mid = (a + b) >> 1; if (rel_bucket_i(mid) == blo) a = mid; else b = mid; } \
                        thr = b; } \
                    const float pb1 = biasrow[blo], pb2 = biasrow[bhi]; \
                    const float pa0 = (!SEL || tq0 >= 0) ? pb1 : -1e30f, pa1 = (!SEL || tq0 >= 0) ? pb2 : -1e30f, pc0 = (!SEL || tq1 >= 0) ? pb1 : -1e30f, pc1 = (!SEL || tq1 >= 0) ? pb2 : -1e30f; \
                    if (bhi == blo) { \
                        if (do0) attn_core<MODE, 1, SEL>(kf, vf, qf[0], tq0, pbase, pstride, relmax, biasrow, psc[0], oacc[0], ls[0], imp0, 16 * t, lg, h, pa0); \
                        if (do1) attn_core<MODE, 1, SEL>(kf, vf, qf[1], tq1, pbase, pstride, relmax, biasrow, psc[1], oacc[1], ls[1], imp1, 16 * t, lg, h, pc0); \
                    } else { \
                        if (do0) attn_core<MODE, 2, SEL>(kf, vf, qf[0], tq[0], pbase, pstride, relmax, biasrow, psc[0], oacc[0], ls[0], imp0, 16 * t, lg, h, pa0, pa1, thr); \
                        if (do1) attn_core<MODE, 2, SEL>(kf, vf, qf[1], tq[1], pbase, pstride, relmax, biasrow, psc[1], oacc[1], ls[1], imp1, 16 * t, lg, h, pc0, pc1, thr); \
                    } \
                } else if (rlo >= 16 && rhi < relmax) { \
                    if (do0) attn_core<MODE, 3, SEL>(kf, vf, qf[0], tq0, pbase, pstride, relmax, biasrow, psc[0], oacc[0], ls[0], imp0, 16 * t, lg, h); \
                    if (do1) attn_core<MODE, 3, SEL>(kf, vf, qf[1], tq1, pbase, pstride, relmax, biasrow, psc[1], oacc[1], ls[1], imp1, 16 * t, lg, h); \
                } else { \
                    if (do0) attn_core<MODE>(kf, vf, qf[0], tq0, pbase, pstride, relmax, biasrow, psc[0], oacc[0], ls[0], imp0, 16 * t, lg, h); \
                    if (do1) attn_core<MODE>(kf, vf, qf[1], tq1, pbase, pstride, relmax, biasrow, psc[1], oacc[1], ls[1], imp1, 16 * t, lg, h); \
                } \
            } \
        } \
    } while (0)
    u32x4 rk1 = {0u, 0u, 0u, 0u}, rv1 = {0u, 0u, 0u, 0u};
    if (nt > 1) { rk1 = *(const u32x4*)(kp + 4096); if (MODE > 0) rv1 = *(const u32x4*)(vp + 64); }
    for (int t2 = 0; t2 < nt; t2 += 2) {
        { const int t = t2; TILE_STEP(t, rk, rv); }
        if (t2 + 1 < nt) { const int t = t2 + 1; TILE_STEP(t, rk1, rv1); }
    }
#undef TILE_STEP
    __syncthreads();
}

__device__ __forceinline__ void phase_attn(const Args& a, LAS unsigned char* lds) {
    unsigned char* ws = WSP;
    int tid_ = threadIdx.x; asm volatile("" : "+v"(tid_));
    const int w = __builtin_amdgcn_readfirstlane(tid_ >> 6);
    LAS float* imp = (LAS float*)(lds + A_IMP);
    LAS unsigned char* ring = lds + A_RING;
    LAS u64* selq = (LAS u64*)(lds + A_SELQ);
    LAS float* biasL = (LAS float*)(lds + A_BIAS);
    LAS float* mbound = (LAS float*)(lds + A_MB);
    const bf16* Q = (const bf16*)(ws + WS_Q);
    const float* gates = (const float*)(ws + WS_GATES);
    const float* relb = IN(23);
    if (w == 0) {
        const int lane = tid_ & 63;
        float mq = fabsf(IN(12)[lane]);
        float mk = fmaxf(fabsf(IN(16)[lane]), fmaxf(fabsf(IN(16)[64 + lane]), fabsf(IN(16)[128 + lane])));
        mq = wave_max(mq); mk = wave_max(mk);
        float mb = -1e30f;
        if (lane < 16) { for (int bk = 0; bk < 32; ++bk) mb = fmaxf(mb, relb[bk * 16 + lane]); mbound[lane] = mb + 8.f * mq * mk; }
    }
    __syncthreads();
    const int nunits = 2048, G = gridDim.x, bx = blockIdx.x;
    for (int it = 0; ; ++it) {
        int bg, qb;
        if (G == 256) {
            if (it >= 8) break;
            const int slot = bx >> 3, oo = slot >> 1; bg = 2 * (bx & 7) + (slot & 1);
            qb = (it & 1) ? 127 - 16 * (it >> 1) - oo : 16 * (it >> 1) + oo;
        } else {
            const int u = bx + it * G; if (u >= nunits) break;
            const int rr = u >> 4, ui = rr >> 4, oo = rr & 15; bg = u & 15;
            qb = (ui & 1) ? 127 - 16 * (ui >> 1) - oo : 16 * (ui >> 1) + oo;
        }
        const int b = bg >> 2, grp = bg & 3, t0 = 64 * qb, tokbase = b * SEQ + t0;
        int tidu = tid_; asm volatile("" : "+v"(tidu));
        const int tid = tidu, lane = tid & 63, lc = lane & 15, lg = lane >> 4, hq = lc >> 2, h = lc & 3;
        const u64 ltmask = (1ull << lane) - 1ull;
        for (int i = tid; i < 8192; i += 512) imp[i] = 0.f;
        if (tid < 128) { const int hh = tid >> 5, bk = tid & 31; biasL[tid] = (relb[bk * 16 + grp * 4 + hh] - mbound[grp * 4 + hh]) * LOG2E; }
        __syncthreads();
        const LAS float* biasrow = biasL + h * 32;
        bf16x8 qf[2][2]; int tqd[2]; float g0[2], g1[2], g2[2];
#pragma unroll
        for (int ct = 0; ct < 2; ++ct) { const int q = 8 * w + 4 * ct + hq; tqd[ct] = t0 + q;
            const bf16* qp = Q + (size_t)(tokbase + q) * DM + (grp * 4 + h) * 64 + 8 * lg; qf[ct][0] = *(const bf16x8*)qp; qf[ct][1] = *(const bf16x8*)(qp + 32);
            const float* gp = gates + (size_t)(tokbase + q) * 48 + (grp * 4 + h) * 3; g0[ct] = gp[0]; g1[ct] = gp[1]; g2[ct] = gp[2]; }
        LAS float* imp0 = imp + (8 * w + hq) * 128; LAS float* imp1 = imp + (8 * w + 4 + hq) * 128;
        LAS float* outp[2] = {(LAS float*)(lds + A_OUT) + ((8 * w + hq) * 4 + h) * 64 + 4 * lg, (LAS float*)(lds + A_OUT) + ((8 * w + 4 + hq) * 4 + h) * 64 + 4 * lg};
        const float one2[2] = {1.f, 1.f};
        {
            const int ncb = 4 * qb + 3, ntc = (ncb + 63) >> 6;
            const bf16* Kc = (const bf16*)(ws + WS_KC) + (size_t)bg * NCB * 64;
            const bf16* VcT = (const bf16*)(ws + WS_VCT) + (size_t)bg * 64 * NCB;
            float ls[2] = {0.f, 0.f}; f32x4 oc[2][4];
#pragma unroll
            for (int ct = 0; ct < 2; ++ct)
#pragma unroll
                for (int dt = 0; dt < 4; ++dt) oc[ct][dt] = (f32x4){0.f, 0.f, 0.f, 0.f};
            tile_stream<0, false>(ring, Kc, VcT, NCB, ntc, 31, 1024, 16, RELMAX_BIG, qf, tqd, biasrow, one2, oc, ls, imp0, imp1, selq, selq, tid, lc, lg, h);
            float inv[2];
#pragma unroll
            for (int ct = 0; ct < 2; ++ct) { float l = ls[ct]; l += __shfl_xor(l, 16); l += __shfl_xor(l, 32); inv[ct] = l > 0.f ? 1.f / l : 0.f; }
            float dummy[2] = {0.f, 0.f};
            tile_stream<2, false>(ring, Kc, VcT, NCB, ntc, 31, 1024, 16, RELMAX_BIG, qf, tqd, biasrow, inv, oc, dummy, imp0, imp1, selq, selq, tid, lc, lg, h);
#pragma unroll
            for (int ct = 0; ct < 2; ++ct)
#pragma unroll
                for (int dt = 0; dt < 4; ++dt) *(LAS f32x4*)(outp[ct] + 16 * dt) = oc[ct][dt] * g0[ct];
        }
        for (int qi = 0; qi < 8; ++qi) {
            const int q = 8 * w + qi; u64 lo, hi;
            if (qb < 16) { lo = (2ull << qb) - 1ull; hi = 0ull; }
            else {
                const int j0 = lane, j1 = lane + 64;
                const bool c0 = (j0 >= 1 && j0 <= qb - 2), c1 = (j1 <= qb - 2);
                const unsigned key0 = c0 ? __builtin_bit_cast(unsigned, imp[q * 128 + j0]) : 0u, key1 = c1 ? __builtin_bit_cast(unsigned, imp[q * 128 + j1]) : 0u;
                unsigned Tk = 0u;
                for (int bit = 30; bit >= 0; --bit) { const unsigned trial = Tk | (1u << bit);
                    const int cnt = __popcll(__ballot(key0 >= trial)) + __popcll(__ballot(key1 >= trial)); if (cnt >= 13) Tk = trial; }
                const bool gt0 = key0 > Tk, gt1 = key1 > Tk, e0 = (key0 == Tk) && c0, e1 = (key1 == Tk) && c1;
                const int need = 13 - (__popcll(__ballot(gt0)) + __popcll(__ballot(gt1)));
                const u64 m0 = __ballot(e0), m1 = __ballot(e1);
                const int r0 = __popcll(m0 & ltmask), r1 = __popcll(m0) + __popcll(m1 & ltmask);
                const bool s0 = gt0 || (e0 && r0 < need) || j0 == 0 || j0 == qb || j0 == qb - 1;
                const bool s1 = gt1 || (e1 && r1 < need) || j1 == qb || j1 == qb - 1;
                lo = __ballot(s0); hi = __ballot(s1);
            }
            if (lane == 0) { selq[q * 2] = lo; selq[q * 2 + 1] = hi; }
        }
        __builtin_amdgcn_wave_barrier();
        {
            const int tf = qb >= 8 ? 0 : 8 - qb, p0 = t0 - 512 + 64 * tf;
            const bf16* Kw = (const bf16*)(ws + WS_KW) + ((size_t)bg * SEQ + p0) * 64;
            const bf16* VwT = (const bf16*)(ws + WS_VWT) + (size_t)bg * 64 * SEQ + p0;
            float ls[2] = {0.f, 0.f}; f32x4 ow[2][4];
#pragma unroll
            for (int ct = 0; ct < 2; ++ct)
#pragma unroll
                for (int dt = 0; dt < 4; ++dt) ow[ct][dt] = (f32x4){0.f, 0.f, 0.f, 0.f};
            tile_stream<1, false>(ring, Kw, VwT, SEQ, 9 - tf, p0, 64, 1, 512, qf, tqd, biasrow, one2, ow, ls, imp0, imp1, selq, selq, tid, lc, lg, h);
#pragma unroll
            for (int ct = 0; ct < 2; ++ct) { float l = ls[ct]; l += __shfl_xor(l, 16); l += __shfl_xor(l, 32); const float sc = g2[ct] / l;
#pragma unroll
                for (int dt = 0; dt < 4; ++dt) *(LAS f32x4*)(outp[ct] + 16 * dt) = *(LAS f32x4*)(outp[ct] + 16 * dt) + ow[ct][dt] * sc; }
        }
        {
            const bf16* Ks = (const bf16*)(ws + WS_KS) + (size_t)bg * SEQ * 64;
            const bf16* VsT = (const bf16*)(ws + WS_VST) + (size_t)bg * 64 * SEQ;
            float ls[2] = {0.f, 0.f}; f32x4 os[2][4];
#pragma unroll
            for (int ct = 0; ct < 2; ++ct)
#pragma unroll
                for (int dt = 0; dt < 4; ++dt) os[ct][dt] = (f32x4){0.f, 0.f, 0.f, 0.f};
            tile_stream<1, true>(ring, Ks, VsT, SEQ, qb + 1, 0, 64, 1, RELMAX_BIG, qf, tqd, biasrow, one2, os, ls, imp0, imp1, selq + (8 * w + hq) * 2, selq + (8 * w + 4 + hq) * 2, tid, lc, lg, h);
            bf16* AO = (bf16*)(ws + WS_AO);
#pragma unroll
            for (int ct = 0; ct < 2; ++ct) { float l = ls[ct]; l += __shfl_xor(l, 16); l += __shfl_xor(l, 32); const float sc = g1[ct] / l;
                bf16* op = AO + (size_t)(tokbase + 8 * w + 4 * ct + hq) * DM + (grp * 4 + h) * 64 + 4 * lg;
#pragma unroll
                for (int dt = 0; dt < 4; ++dt) { const f32x4 v = *(LAS f32x4*)(outp[ct] + 16 * dt) + os[ct][dt] * sc; *(u64*)(op + 16 * dt) = (u64)cvt_pk(v[0], v[1]) | ((u64)cvt_pk(v[2], v[3]) << 32); } }
        }
    }
}

#define XB_TMO      128
#define XB_XCNT(j)  (256  + 64 * (j))
#define XB_XSUB(j)  (1280 + 64 * (j))
#define XB_XGEN(j)  (2304 + 64 * (j))
#define XB_TOP      3328
#define XB_TOPGEN   3392
#define XCD_BAR_WORDS 3456
#define XB_SPIN_CAP (1u << 23)

__device__ __forceinline__ unsigned xb_ld(unsigned* p)              { return __hip_atomic_load(p, __ATOMIC_RELAXED, __HIP_MEMORY_SCOPE_AGENT); }
__device__ __forceinline__ unsigned xb_add(unsigned* p, unsigned v) { return __hip_atomic_fetch_add(p, v, __ATOMIC_RELAXED, __HIP_MEMORY_SCOPE_AGENT); }
__device__ __forceinline__ unsigned xb_xcc_id() { return (unsigned)__builtin_amdgcn_s_getreg((3 << 11) | 20) & 0xFu; }
#define XB_SPIN(cond, bar) do { unsigned _sp = 0; while (cond) { __builtin_amdgcn_s_sleep(1); \
    if ((++_sp & 255u) == 0u) { if (xb_ld(&(bar)[XB_TMO])) break; if (_sp > XB_SPIN_CAP) { atomicAdd(&(bar)[XB_TMO], 1u); break; } } } } while (0)

struct XcdBarrier {
    unsigned* bar; unsigned x;
    volatile LAS unsigned* st;
};

__device__ __forceinline__ XcdBarrier xcd_barrier_post(unsigned* bar, volatile LAS unsigned* st) {
    XcdBarrier b; b.bar = bar; b.x = xb_xcc_id(); b.st = st;
    if (threadIdx.x == 0) (void)xb_add(&bar[XB_XCNT(b.x)], 1u);
    return b;
}
__device__ __forceinline__ void xcd_barrier_complete(unsigned* bar, unsigned x, unsigned& nloc, unsigned& nx) {
    const unsigned G = gridDim.x * gridDim.y * gridDim.z;
    unsigned sum, cnt, mine, sp = 0u;
    for (;;) {
        sum = 0u; cnt = 0u; mine = 0u;
#pragma unroll
        for (unsigned j = 0; j < 16; ++j) { const unsigned c = xb_ld(&bar[XB_XCNT(j)]); sum += c; cnt += (c > 0u) ? 1u : 0u; mine = (j == x) ? c : mine; }
        if (sum == G) break;
        __builtin_amdgcn_s_sleep(1);
        if ((++sp & 255u) == 0u) { if (xb_ld(&bar[XB_TMO])) break; if (sp > XB_SPIN_CAP) { atomicAdd(&bar[XB_TMO], 1u); break; } }
    }
    nloc = mine > 0u ? mine : 1u; nx = cnt > 0u ? cnt : 1u;
}

__device__ __forceinline__ void xcd_barrier(const XcdBarrier& b) {
    asm volatile("s_waitcnt vmcnt(0)" ::: "memory");
    __syncthreads();
    if (threadIdx.x == 0) {
        unsigned* bar = b.bar;
        __builtin_amdgcn_s_waitcnt(0);
        unsigned nloc = b.st[0], nx = b.st[1];
        if (nloc == 0u) { xcd_barrier_complete(bar, b.x, nloc, nx); b.st[0] = nloc; b.st[1] = nx; }
        const unsigned old = xb_add(&bar[XB_XSUB(b.x)], 1u);
        const unsigned gen = old / nloc;
        if (old + 1u == (gen + 1u) * nloc) {
            __builtin_amdgcn_fence(__ATOMIC_RELEASE, "agent");
            asm volatile("s_waitcnt vmcnt(0)" ::: "memory");
            const unsigned og = xb_add(&bar[XB_TOP], 1u);
            const unsigned tg = og / nx;
            if (og + 1u == (tg + 1u) * nx) xb_add(&bar[XB_TOPGEN], 1u);
            else XB_SPIN(xb_ld(&bar[XB_TOPGEN]) == tg, bar);
            __builtin_amdgcn_fence(__ATOMIC_ACQUIRE, "agent");
            xb_add(&bar[XB_XGEN(b.x)], 1u);
            asm volatile("s_waitcnt vmcnt(0)" ::: "memory");
        } else {
            XB_SPIN(xb_ld(&bar[XB_XGEN(b.x)]) == gen, bar);
            __builtin_amdgcn_fence(__ATOMIC_ACQUIRE, "agent");
            asm volatile("s_waitcnt vmcnt(0)" ::: "memory");
        }
    }
    __syncthreads();
}


__global__ void __launch_bounds__(512, 2) mk_fwd(Args a) {
    extern __shared__ __attribute__((aligned(16))) unsigned char lds_raw[];
    LAS unsigned char* lds = (LAS unsigned char*)lds_raw;
    cg::grid_group grid = cg::this_grid();
    unsigned char* ws = WSP;
    const float* x = IN(0); float* hout = KA()->out;
    bf16* HN = (bf16*)(ws + WS_HN); bf16* HN2 = (bf16*)(ws + WS_HN2); bf16* ACT = (bf16*)(ws + WS_ACT);
    const int G = gridDim.x, bx = blockIdx.x;
#define GRID_SYNC() do { \
        if (sync_no == 0u) { asm volatile("s_waitcnt vmcnt(0) lgkmcnt(0)" ::: "memory"); grid.sync(); \
            if (threadIdx.x == 0) { __builtin_amdgcn_fence(__ATOMIC_ACQUIRE, "agent"); asm volatile("s_waitcnt vmcnt(0)" ::: "memory"); } __syncthreads(); \
            xb = xcd_barrier_post(bar_words, xb_st); } \
        else xcd_barrier(xb); \
        ++sync_no; } while (0)
#define GEMM(EPI, Aptr, Bptr, N_, K_, E) do { pg8::Gemm g_{(const pg8::bf16_t*)(Aptr), (const pg8::bf16_t*)(Bptr), T, (N_), (K_)}; pg8::StaticOrder S_; S_.init(T, (N_), G, bx); \
        pg8::gemm_phase<std::remove_cv_t<std::remove_reference_t<decltype(E)>>, pg8::StaticOrder, true, true>((PG8_LAS unsigned char*)lds, g_, S_, (E)); } while (0)

    unsigned* bar_words = (unsigned*)(ws + 4096); unsigned sync_no = 0u;
    for (int i = bx * 512 + threadIdx.x; i < XCD_BAR_WORDS; i += G * 512) __hip_atomic_store(bar_words + i, 0u, __ATOMIC_RELAXED, __HIP_MEMORY_SCOPE_AGENT);
    volatile LAS unsigned* xb_st = (volatile LAS unsigned*)(lds + LDS_BYTES - 16);
    if (threadIdx.x < 2) xb_st[threadIdx.x] = 0u;
    XcdBarrier xb; xb.bar = bar_words; xb.x = 0u; xb.st = xb_st;
    float* SS = (float*)(ws + WS_SS);
#define SSK(k) (SS + (size_t)(k) * T)
    phase_prep(a, lds);
    phase_x(x, HN, SS);
    GRID_SYNC();
    { pg8::EpiSwiglu E{ACT, DFF, SSK(0)}; GEMM(pg8::EpiSwiglu, HN, ws + WS_WIN, 2 * DFF, DM, E); }
    GRID_SYNC();
    { pg8::EpiResid<true, 1, 0, false> E{x, hout, HN, SSK(1)}; GEMM((pg8::EpiResid<true, 1, 0, false>), ACT, ws + WS_WOUT, DM, DFF, E); }
    GRID_SYNC();
    { pg8::EpiConvIn E{(bf16*)(ws + WS_BG), (bf16*)(ws + WS_U), SSK(1)}; GEMM(pg8::EpiConvIn, HN, ws + WS_CWIN, 3072, DM, E); }
    GRID_SYNC();
    phase_conv((const bf16*)(ws + WS_BG), (const bf16*)(ws + WS_U), IN(9), HN2);
    GRID_SYNC();
    { pg8::EpiResid<true, 2, 1, false> E{hout, hout, HN, SSK(2)}; GEMM((pg8::EpiResid<true, 2, 1, false>), HN2, ws + WS_CWOUT, DM, DM, E); }
    GRID_SYNC();
    { pg8::EpiSwiglu E{ACT, DFF, SSK(2)}; GEMM(pg8::EpiSwiglu, HN, ws + WS_WIN + SZ_WIN, 2 * DFF, DM, E); }
    GRID_SYNC();
    { pg8::EpiResid<true, 1, 1, false> E{hout, hout, HN, SSK(3)}; GEMM((pg8::EpiResid<true, 1, 1, false>), ACT, ws + WS_WOUT + SZ_WOUT, DM, DFF, E); }
    GRID_SYNC();
    { pg8::EpiKV E; E.Kb = (bf16*)(ws + WS_KCR); E.Vb = (bf16*)(ws + WS_VCR); E.brstride = KV_BYTES / 2; E.knorm = IN(16); E.ss = SSK(3);
      GEMM(pg8::EpiKV, HN, ws + WS_WKV, NKV, DM, E); }
    GRID_SYNC();
    phase_compress(a, lds);
    { pg8::EpiSwiglu E{ACT, DFF, SSK(3)}; GEMM(pg8::EpiSwiglu, HN, ws + WS_WIN + 2 * SZ_WIN, 2 * DFF, DM, E); }
    GRID_SYNC();
    { pg8::EpiResid<true, 1, 1, false> E{hout, hout, HN, SSK(4)}; GEMM((pg8::EpiResid<true, 1, 1, false>), ACT, ws + WS_WOUT + 2 * SZ_WOUT, DM, DFF, E); }
    GRID_SYNC();
    { pg8::EpiQ E{(bf16*)(ws + WS_Q), (float*)(ws + WS_GATES), IN(12), 0.125f * LOG2E, SSK(4)}; GEMM(pg8::EpiQ, HN, ws + WS_WQ, NQP, DM, E); }
    GRID_SYNC();
    phase_attn(a, lds);
    GRID_SYNC();
    { pg8::EpiResid<true, 2, 1, false> E{hout, hout, HN, SSK(5)}; GEMM((pg8::EpiResid<true, 2, 1, false>), ws + WS_AO, ws + WS_WO, DM, DM, E); }
    GRID_SYNC();
    { pg8::EpiSwiglu E{ACT, DFF, SSK(5)}; GEMM(pg8::EpiSwiglu, HN, ws + WS_WIN + 3 * SZ_WIN, 2 * DFF, DM, E); }
    GRID_SYNC();
    { pg8::EpiResid<false, 1, 1, true> E{hout, hout, HN, nullptr}; GEMM((pg8::EpiResid<false, 1, 1, true>), ACT, ws + WS_WOUT + 3 * SZ_WOUT, DM, DFF, E); }
#undef SSK
#undef GEMM
}

extern "C" void kernel_launch(void* const* d_in, const int* in_sizes, int n_in, void* d_out, int out_size, void* d_ws, size_t ws_size, hipStream_t stream) {
    static int grid = 0;
    if (grid == 0) {
        if (n_in != 24 || out_size != T * DM || ws_size < WS_END) { fprintf(stderr, "kernel_launch: unexpected problem (n_in %d out %d ws %zu)\n", n_in, out_size, ws_size); grid = -1; return; }
        int dev = 0, cus = 0, per_cu = 0;
        (void)hipGetDevice(&dev);
        (void)hipDeviceGetAttribute(&cus, hipDeviceAttributeMultiprocessorCount, dev);
        (void)hipFuncSetAttribute((const void*)mk_fwd, hipFuncAttributeMaxDynamicSharedMemorySize, LDS_BYTES);
        (void)hipOccupancyMaxActiveBlocksPerMultiprocessor(&per_cu, (const void*)mk_fwd, 512, LDS_BYTES);
        if (per_cu < 1) per_cu = 1;
        grid = cus * per_cu;
    }
    if (grid < 0) return;
    Args a{};
    for (int i = 0; i < 24; ++i) a.in[i] = (const float*)d_in[i];
    a.out = (float*)d_out; a.ws = (unsigned char*)d_ws;
    void* args[] = {&a};
    hipError_t e = hipLaunchCooperativeKernel((const void*)mk_fwd, dim3(grid), dim3(512), args, LDS_BYTES, stream);
    if (e != hipSuccess) fprintf(stderr, "cooperative launch failed: %s (grid %d)\n", hipGetErrorString(e), grid);
}
```

```cpp
#include <hip/hip_runtime.h>
#include <hip/hip_cooperative_groups.h>
#include <cstdio>
#include <cstdint>
#include <type_traits>
namespace cg = cooperative_groups;
namespace pg8 {
#define PG8_LAS __attribute__((address_space(3)))
typedef unsigned short bf16_t;
typedef short bf16x8 __attribute__((ext_vector_type(8)));
typedef float f32x4 __attribute__((ext_vector_type(4)));
typedef unsigned u32x4 __attribute__((ext_vector_type(4)));
constexpr int BM = 256, BK = 64, HALF = 128, HTB = HALF * BK * 2  , STAGE_BYTES = 8 * HTB, NXCD = 8, WGM = 8;

__host__ __device__ __forceinline__ int lds_byte(int r, int c) { const int st = (r >> 4) * 2 + (c >> 5), rr = r & 15, cc = c & 31, ob = rr * 64 + cc * 2; return st * 1024 + (ob ^ (((ob >> 9) & 1) << 5)); }
__host__ __device__ __forceinline__ void stage_rc(int b, int& R, int& C) { const int st = b / 1024, sb = b % 1024, swz = sb ^ (((sb >> 9) & 1) << 5); R = (st >> 1) * 16 + swz / 64; C = (st & 1) * 32 + (swz % 64) / 2; }
__host__ __device__ __forceinline__ int perm32(int rho) { const int n = rho >> 4, i = rho & 15; return 8 * (i >> 2) + 4 * n + (i & 3); }

struct Unit { int pm, pn; };
struct Gemm { const bf16_t* A; const bf16_t* Bt; int M, N, K; };

struct StaticOrder {
    int nM, nN, nwg, G, c;
    __host__ __device__ void init(int M, int N, int G_, int c_) { nM = M / BM; nN = N / BM; nwg = nM * nN; G = G_; c = c_; }
    __host__ __device__ bool next(int i, Unit& u) const {
        const long L = (long)i * G + c; if (L >= nwg) return false;
        int wgid = (int)L; { const int q = nwg / NXCD, r = nwg % NXCD, xcd = wgid % NXCD, off = wgid / NXCD; wgid = (xcd < r ? xcd * (q + 1) : r * (q + 1) + (xcd - r) * q) + off; }
        const int nig = WGM * nN, gid = wgid / nig, fm = gid * WGM, gsz = (nM - fm) < WGM ? (nM - fm) : WGM;
        u.pm = fm + ((wgid % nig) % gsz); u.pn = (wgid % nig) / gsz; return true;
    }
    __device__ __forceinline__ void a_ready(const Unit&) const {}
    __device__ __forceinline__ void done(const Unit&) const {}
};

__device__ __forceinline__ unsigned cvt_pk_bf16(float lo, float hi) { unsigned r; asm volatile("v_cvt_pk_bf16_f32 %0, %1, %2" : "=v"(r) : "v"(lo), "v"(hi)); return r; }
__device__ __forceinline__ float fast_sigmoid(float x) { return __builtin_amdgcn_rcpf(1.f + __builtin_amdgcn_exp2f(-1.4426950408889634f * x)); }
__device__ __forceinline__ u32x4 pack8(const f32x4 a, const f32x4 b) { u32x4 w; w.x = cvt_pk_bf16(a[0], a[1]); w.y = cvt_pk_bf16(a[2], a[3]); w.z = cvt_pk_bf16(b[0], b[1]); w.w = cvt_pk_bf16(b[2], b[3]); return w; }

struct EpiSwiglu {
    static constexpr bool PERM = true, AFTER_DRAIN = false;
    bf16_t* O; int ldo; const float* ss;
    __device__ __forceinline__ void operator()(const f32x4 (&acc)[2][2][4][2], const Unit& u, int wr, int wc, int fr, int fq) const {
        const int row0 = u.pm * BM + wr * 64 + fr, col0 = u.pn * HALF + wc * 32 + 8 * fq;
#pragma unroll
        for (int ai = 0; ai < 2; ++ai)
#pragma unroll
            for (int m = 0; m < 4; ++m) {
                f32x4 v[2]; const float rs = __builtin_amdgcn_rsqf(ss[row0 + ai * HALF + m * 16] * (1.f / 1024.f) + 1e-6f);
#pragma unroll
                for (int n = 0; n < 2; ++n) { const f32x4 g = acc[ai][0][m][n] * rs, up = acc[ai][1][m][n] * rs;
#pragma unroll
                    for (int e = 0; e < 4; ++e) v[n][e] = g[e] * fast_sigmoid(g[e]) * up[e]; }
                *(u32x4*)(O + (size_t)(row0 + ai * HALF + m * 16) * ldo + col0) = pack8(v[0], v[1]);
            }
    }
};

template <bool NORM, int ALPHA2  , int HIN, bool FOUT> struct EpiResid {
    static constexpr bool PERM = true, AFTER_DRAIN = false;
    const float* hin; float* hout; bf16_t* HB; float* ssout;
    __device__ __forceinline__ void operator()(const f32x4 (&acc)[2][2][4][2], const Unit& u, int wr, int wc, int fr, int fq) const {
        const int row0 = u.pm * BM + wr * 64 + fr, col0 = u.pn * BM + wc * 32 + 8 * fq; constexpr float alpha = 0.5f * ALPHA2;
#pragma unroll
        for (int ai = 0; ai < 2; ++ai) {
            u32x4 hv[4][2]; f32x4 xv[4][2][2];
#pragma unroll
            for (int m = 0; m < 4; ++m)
#pragma unroll
                for (int bj = 0; bj < 2; ++bj) { const size_t p = (size_t)(row0 + ai * HALF + m * 16) * 1024 + col0 + bj * HALF;
                    if (HIN == 0) { xv[m][bj][0] = *(const f32x4*)(hin + p); xv[m][bj][1] = *(const f32x4*)(hin + p + 4); } else hv[m][bj] = *(const u32x4*)(HB + p); }
#pragma unroll
            for (int m = 0; m < 4; ++m) {
                float sq = 0.f;
#pragma unroll
                for (int bj = 0; bj < 2; ++bj) {
                    const size_t p = (size_t)(row0 + ai * HALF + m * 16) * 1024 + col0 + bj * HALF;
                    f32x4 a0, a1;
                    if (HIN == 0) { a0 = xv[m][bj][0]; a1 = xv[m][bj][1]; }
                    else { const u32x4 w = hv[m][bj];
                        a0 = (f32x4){__builtin_bit_cast(float, w.x << 16), __builtin_bit_cast(float, w.x & 0xffff0000u), __builtin_bit_cast(float, w.y << 16), __builtin_bit_cast(float, w.y & 0xffff0000u)};
                        a1 = (f32x4){__builtin_bit_cast(float, w.z << 16), __builtin_bit_cast(float, w.z & 0xffff0000u), __builtin_bit_cast(float, w.w << 16), __builtin_bit_cast(float, w.w & 0xffff0000u)}; }
                    a0 = a0 + acc[ai][bj][m][0] * alpha; a1 = a1 + acc[ai][bj][m][1] * alpha;
                    if (FOUT) { *(f32x4*)(hout + p) = a0; *(f32x4*)(hout + p + 4) = a1; }
                    if (NORM) { *(u32x4*)(HB + p) = pack8(a0, a1);
                        sq += (a0[0] * a0[0] + a0[1] * a0[1]) + (a0[2] * a0[2] + a0[3] * a0[3]) + (a1[0] * a1[0] + a1[1] * a1[1]) + (a1[2] * a1[2] + a1[3] * a1[3]); }
                }
                if (NORM) { sq += __shfl_xor(sq, 16); sq += __shfl_xor(sq, 32);
                    if (fq == 0) __hip_atomic_fetch_add(ssout + row0 + ai * HALF + m * 16, sq, __ATOMIC_RELAXED, __HIP_MEMORY_SCOPE_AGENT); }
            }
        }
    }
};

struct EpiConvIn {
    static constexpr bool PERM = true, AFTER_DRAIN = false;
    bf16_t* Bg; bf16_t* U; const float* ss;
    __device__ __forceinline__ void operator()(const f32x4 (&acc)[2][2][4][2], const Unit& u, int wr, int wc, int fr, int fq) const {
        const int row0 = u.pm * BM + wr * 64 + fr;
        if (u.pn < 4) {
            const int col0 = u.pn * BM + wc * 32 + 8 * fq;
#pragma unroll
            for (int ai = 0; ai < 2; ++ai)
#pragma unroll
                for (int m = 0; m < 4; ++m)
#pragma unroll
                    for (int bj = 0; bj < 2; ++bj) { const float rs = __builtin_amdgcn_rsqf(ss[row0 + ai * HALF + m * 16] * (1.f / 1024.f) + 1e-6f);
                        *(u32x4*)(Bg + (size_t)(row0 + ai * HALF + m * 16) * 1024 + col0 + bj * HALF) = pack8(acc[ai][bj][m][0] * rs, acc[ai][bj][m][1] * rs); }
        } else {
            const int col0 = (u.pn - 4) * HALF + wc * 32 + 8 * fq;
#pragma unroll
            for (int ai = 0; ai < 2; ++ai)
#pragma unroll
                for (int m = 0; m < 4; ++m) { const float r2 = __builtin_amdgcn_rcpf(ss[row0 + ai * HALF + m * 16] * (1.f / 1024.f) + 1e-6f);
                    *(u32x4*)(U + (size_t)(row0 + ai * HALF + m * 16) * 1024 + col0) = pack8(acc[ai][0][m][0] * acc[ai][1][m][0] * r2, acc[ai][0][m][1] * acc[ai][1][m][1] * r2); }
        }
    }
};

struct EpiKV {
    static constexpr bool PERM = true, AFTER_DRAIN = false;
    bf16_t *Kb, *Vb; size_t brstride; const float* knorm; const float* ss;
    __device__ __forceinline__ void operator()(const f32x4 (&acc)[2][2][4][2], const Unit& u, int wr, int wc, int fr, int fq) const {
        const int br = u.pn >> 1, kv = u.pn & 1;
        const int row0 = u.pm * BM + wr * 64 + fr;
#pragma unroll
        for (int ai = 0; ai < 2; ++ai)
#pragma unroll
            for (int m = 0; m < 4; ++m) {
                const int row = row0 + ai * HALF + m * 16, b = row >> 13, s = row & 8191, bg = b * 4 + wc;
                const float rs = __builtin_amdgcn_rsqf(ss[row] * (1.f / 1024.f) + 1e-6f);
                if (kv == 0) {
                    float rstd = rs;
                    if (br > 0) { float ss = 0.f;
#pragma unroll
                        for (int bj = 0; bj < 2; ++bj)
#pragma unroll
                            for (int n = 0; n < 2; ++n)
#pragma unroll
                                for (int e = 0; e < 4; ++e) ss += acc[ai][bj][m][n][e] * acc[ai][bj][m][n][e];
                        ss += __shfl_xor(ss, 16); ss += __shfl_xor(ss, 32);
                        rstd = rs * __builtin_amdgcn_rsqf(ss * rs * rs * (1.f / 64.f) + 1e-6f); }
                    bf16_t* dst = Kb + (size_t)br * brstride + ((size_t)bg * 8192 + s) * 64 + 8 * fq;
#pragma unroll
                    for (int bj = 0; bj < 2; ++bj) {
                        f32x4 v0 = acc[ai][bj][m][0] * rstd, v1 = acc[ai][bj][m][1] * rstd;
                        if (br > 0) { const float* gp = knorm + br * 64 + bj * 32 + 8 * fq; v0 = v0 * *(const f32x4*)gp; v1 = v1 * *(const f32x4*)(gp + 4); }
                        *(u32x4*)(dst + bj * 32) = pack8(v0, v1);
                    }
                } else if (br == 0) {
                    bf16_t* dst = Vb + ((size_t)bg * 8192 + s) * 64 + 8 * fq;
#pragma unroll
                    for (int bj = 0; bj < 2; ++bj) *(u32x4*)(dst + bj * 32) = pack8(acc[ai][bj][m][0] * rs, acc[ai][bj][m][1] * rs);
                } else {
                    bf16_t* dst = Vb + (size_t)br * brstride + ((size_t)bg * 64 + 8 * fq) * 8192 + s;
#pragma unroll
                    for (int bj = 0; bj < 2; ++bj)
#pragma unroll
                        for (int n = 0; n < 2; ++n) { const f32x4 v = acc[ai][bj][m][n] * rs;
                            const unsigned p0 = cvt_pk_bf16(v[0], v[1]), p1 = cvt_pk_bf16(v[2], v[3]);
                            bf16_t* d = dst + (size_t)(bj * 32 + 4 * n) * 8192;
                            d[0] = (bf16_t)(p0 & 0xffffu); d[8192] = (bf16_t)(p0 >> 16); d[2 * 8192] = (bf16_t)(p1 & 0xffffu); d[3 * 8192] = (bf16_t)(p1 >> 16); }
                }
            }
    }
};

struct EpiQ {
    static constexpr bool PERM = true, AFTER_DRAIN = false;
    bf16_t* Q; float* gates; const float* qnorm; float qscale; const float* ss;
    __device__ __forceinline__ void operator()(const f32x4 (&acc)[2][2][4][2], const Unit& u, int wr, int wc, int fr, int fq) const {
        const int row0 = u.pm * BM + wr * 64 + fr;
        if (u.pn < 4) {
            const int head = u.pn * 4 + wc;
#pragma unroll
            for (int ai = 0; ai < 2; ++ai)
#pragma unroll
                for (int m = 0; m < 4; ++m) {
                    float ss = 0.f;
#pragma unroll
                    for (int bj = 0; bj < 2; ++bj)
#pragma unroll
                        for (int n = 0; n < 2; ++n)
#pragma unroll
                            for (int e = 0; e < 4; ++e) ss += acc[ai][bj][m][n][e] * acc[ai][bj][m][n][e];
                    ss += __shfl_xor(ss, 16); ss += __shfl_xor(ss, 32);
                    const float rs = __builtin_amdgcn_rsqf(this->ss[row0 + ai * HALF + m * 16] * (1.f / 1024.f) + 1e-6f);
                    const float rstd = rs * __builtin_amdgcn_rsqf(ss * rs * rs * (1.f / 64.f) + 1e-6f) * qscale;
                    bf16_t* dst = Q + (size_t)(row0 + ai * HALF + m * 16) * 1024 + head * 64 + 8 * fq;
#pragma unroll
                    for (int bj = 0; bj < 2; ++bj) { const float* gp = qnorm + bj * 32 + 8 * fq;
                        const f32x4 v0 = acc[ai][bj][m][0] * rstd * *(const f32x4*)gp, v1 = acc[ai][bj][m][1] * rstd * *(const f32x4*)(gp + 4);
                        *(u32x4*)(dst + bj * 32) = pack8(v0, v1); }
                }
        } else {
            if (wc < 2) {
#pragma unroll
                for (int ai = 0; ai < 2; ++ai)
#pragma unroll
                    for (int m = 0; m < 4; ++m) {
                        const int c0 = wc * 32 + 8 * fq;
                        if (c0 < 48) { float* dst = gates + (size_t)(row0 + ai * HALF + m * 16) * 48 + c0; const float rs = __builtin_amdgcn_rsqf(this->ss[row0 + ai * HALF + m * 16] * (1.f / 1024.f) + 1e-6f);
                            f32x4 a = acc[ai][0][m][0] * rs, b = acc[ai][0][m][1] * rs;
#pragma unroll
                            for (int e = 0; e < 4; ++e) { a[e] = fast_sigmoid(a[e]); b[e] = fast_sigmoid(b[e]); }
                            *(f32x4*)dst = a; *(f32x4*)(dst + 4) = b; }
                    }
            }
        }
    }
};
template <class Epi, class Sched, bool ALIGN_EPI = false, bool SP2 = false>
__device__ __forceinline__ void gemm_phase(PG8_LAS unsigned char* lds, const Gemm g, const Sched& S, const Epi& E) {
    int tid_ = threadIdx.x; asm volatile("" : "+v"(tid_));
    const int tid = tid_, wid = __builtin_amdgcn_readfirstlane(tid >> 6), lane = tid & 63, wr = wid >> 2, wc = wid & 3, fr = lane & 15, fq = lane >> 4;
    const int K = g.K, nt = K / BK;
    unsigned voffA[2], voffB[2];
#pragma unroll
    for (int i = 0; i < 2; ++i) { int R, C; stage_rc(tid * 16 + i * 8192, R, C); const int Rb = Epi::PERM ? ((R & ~31) + perm32(R & 31)) : R;
        voffA[i] = (unsigned)(R * K + C) * 2u; voffB[i] = (unsigned)(Rb * K + C) * 2u; }
    const size_t kstep = (size_t)(BK * 2);
    const size_t hstep = (size_t)HALF * K * 2;
    const size_t tstep = 2 * hstep;
    const unsigned ldsw = (unsigned)wid * 1024u;
    const int aoff = lds_byte(wr * 64 + fr, fq * 8), boff = lds_byte(wc * 32 + fr, fq * 8);
#define PG8_SA(b, h) (((b) * 2 + (h)) * HTB)
#define PG8_SB(b, h) ((4 + (b) * 2 + (h)) * HTB)
#define PG8_STAGE(bufoff, gbase, voff) do { _Pragma("unroll") for (int _i = 0; _i < 2; ++_i) \
        __builtin_amdgcn_global_load_lds((const unsigned*)((const char*)(gbase) + (voff)[_i]), (PG8_LAS unsigned*)(lds + (bufoff) + ldsw + _i * 8192), 16, 0, 0); } while (0)
#define PG8_LDA(dst, b, h) do { _Pragma("unroll") for (int m = 0; m < 4; ++m) _Pragma("unroll") for (int k = 0; k < 2; ++k) dst[m][k] = *(const PG8_LAS bf16x8*)(lds + PG8_SA(b, h) + aoff + m * 2048 + k * 1024); } while (0)
#define PG8_LDB(dst, b, h) do { _Pragma("unroll") for (int n = 0; n < 2; ++n) _Pragma("unroll") for (int k = 0; k < 2; ++k) dst[n][k] = *(const PG8_LAS bf16x8*)(lds + PG8_SB(b, h) + boff + n * 2048 + k * 1024); } while (0)
#define PG8_MMA(ai, bj, At, Bt) do { __builtin_amdgcn_s_setprio(1); _Pragma("unroll") for (int m = 0; m < 4; ++m) _Pragma("unroll") for (int n = 0; n < 2; ++n) _Pragma("unroll") for (int k = 0; k < 2; ++k) \
        acc[ai][bj][m][n] = __builtin_amdgcn_mfma_f32_16x16x32_bf16(Bt[n][k], At[m][k], acc[ai][bj][m][n], 0, 0, 0); __builtin_amdgcn_s_setprio(0); } while (0)
#define PG8_WAIT_V(n) asm volatile("s_waitcnt vmcnt(" #n ")" ::: "memory")
#define PG8_WAIT_L(n) asm volatile("s_waitcnt lgkmcnt(" #n ")" ::: "memory")
#define PG8_BAR __builtin_amdgcn_s_barrier()
#define PG8_SCHED __builtin_amdgcn_sched_barrier(0)
    Unit cur, nxt; int ui = 0;
    if (!S.next(0, cur)) return;
    f32x4 acc[2][2][4][2];
#pragma unroll
    for (int a = 0; a < 2; ++a)
#pragma unroll
        for (int b = 0; b < 2; ++b)
#pragma unroll
            for (int m = 0; m < 4; ++m)
#pragma unroll
                for (int n = 0; n < 2; ++n) acc[a][b][m][n] = (f32x4){0.f, 0.f, 0.f, 0.f};
    bf16x8 At[4][2], B0[2][2], B1[2][2];
    const char* cA = (const char*)g.A + (size_t)cur.pm * tstep; const char* cB = (const char*)g.Bt + (size_t)cur.pn * tstep;
    S.a_ready(cur);
    if constexpr (SP2) {
        PG8_STAGE(PG8_SB(0, 0), cB, voffB); PG8_STAGE(PG8_SB(0, 1), cB + hstep, voffB); PG8_STAGE(PG8_SA(0, 0), cA, voffA); PG8_STAGE(PG8_SA(0, 1), cA + hstep, voffA);
        if (wr == 1) PG8_BAR;
        PG8_WAIT_V(2); PG8_BAR;
        PG8_STAGE(PG8_SB(1, 0), cB + kstep, voffB); PG8_STAGE(PG8_SA(1, 0), cA + kstep, voffA); PG8_STAGE(PG8_SB(1, 1), cB + hstep + kstep, voffB);
        PG8_WAIT_V(6); PG8_BAR;
    } else {
        PG8_STAGE(PG8_SB(0, 0), cB, voffB); PG8_STAGE(PG8_SA(0, 0), cA, voffA); PG8_STAGE(PG8_SB(0, 1), cB + hstep, voffB); PG8_STAGE(PG8_SA(0, 1), cA + hstep, voffA);
        if (wr == 1) PG8_BAR;
        PG8_WAIT_V(4); PG8_BAR;
        PG8_STAGE(PG8_SB(1, 0), cB + kstep, voffB); PG8_STAGE(PG8_SA(1, 0), cA + kstep, voffA); PG8_STAGE(PG8_SB(1, 1), cB + hstep + kstep, voffB);
        PG8_WAIT_V(6); PG8_BAR;
    }
    for (;;) {
        const bool has_next = S.next(ui + 1, nxt);
        const char* nA = has_next ? (const char*)g.A + (size_t)nxt.pm * tstep : cA; const char* nB = has_next ? (const char*)g.Bt + (size_t)nxt.pn * tstep : cB;
        for (int t = 0; t < nt; t += 2) {
            const bool last = (t == nt - 2);
            const char* a1 = cA + (size_t)(t + 1) * kstep;
            const char* a2 = last ? nA : cA + (size_t)(t + 2) * kstep; const char* b2 = last ? nB : cB + (size_t)(t + 2) * kstep;
            const char* a3 = a2 + kstep; const char* b3 = b2 + kstep;
            if (last && has_next) S.a_ready(nxt);
            if constexpr (SP2) {
            PG8_LDB(B0, 0, 0); PG8_LDB(B1, 0, 1); PG8_SCHED; PG8_LDA(At, 0, 0); PG8_STAGE(PG8_SA(1, 1), a1 + hstep, voffA);
            PG8_WAIT_V(8); PG8_WAIT_L(0); PG8_BAR; PG8_MMA(0, 0, At, B0); PG8_MMA(0, 1, At, B1); PG8_BAR; PG8_SCHED;
            PG8_LDA(At, 0, 1); PG8_STAGE(PG8_SB(0, 0), b2, voffB); PG8_STAGE(PG8_SB(0, 1), b2 + hstep, voffB); PG8_STAGE(PG8_SA(0, 0), a2, voffA);
            PG8_WAIT_V(8); PG8_WAIT_L(0); PG8_BAR; PG8_MMA(1, 0, At, B0); PG8_MMA(1, 1, At, B1); PG8_BAR; PG8_SCHED;
            PG8_LDB(B0, 1, 0); PG8_LDB(B1, 1, 1); PG8_SCHED; PG8_LDA(At, 1, 0); PG8_STAGE(PG8_SA(0, 1), a2 + hstep, voffA);
            PG8_WAIT_V(8); PG8_WAIT_L(0); PG8_BAR; PG8_MMA(0, 0, At, B0); PG8_MMA(0, 1, At, B1); PG8_BAR; PG8_SCHED;
            PG8_LDA(At, 1, 1); PG8_STAGE(PG8_SB(1, 0), b3, voffB); PG8_STAGE(PG8_SB(1, 1), b3 + hstep, voffB); PG8_STAGE(PG8_SA(1, 0), a3, voffA);
            PG8_WAIT_V(8); PG8_WAIT_L(0); PG8_BAR; PG8_MMA(1, 0, At, B0); PG8_MMA(1, 1, At, B1); PG8_BAR; PG8_SCHED;
            } else {
            PG8_LDB(B0, 0, 0); PG8_SCHED; PG8_LDA(At, 0, 0); PG8_STAGE(PG8_SA(1, 1), a1 + hstep, voffA);
            PG8_WAIT_L(8); PG8_BAR; PG8_WAIT_L(0); PG8_MMA(0, 0, At, B0); PG8_BAR; PG8_SCHED;
            PG8_LDB(B1, 0, 1); PG8_STAGE(PG8_SB(0, 0), b2, voffB);
            PG8_BAR; PG8_WAIT_L(0); PG8_MMA(0, 1, At, B1); PG8_BAR;
            PG8_LDA(At, 0, 1); PG8_STAGE(PG8_SA(0, 0), a2, voffA);
            PG8_BAR; PG8_WAIT_L(0); PG8_MMA(1, 0, At, B0); PG8_BAR; PG8_SCHED;
            PG8_STAGE(PG8_SB(0, 1), b2 + hstep, voffB);
            PG8_WAIT_V(6); PG8_BAR; PG8_MMA(1, 1, At, B1); PG8_BAR;
            PG8_LDB(B0, 1, 0); PG8_SCHED; PG8_LDA(At, 1, 0); PG8_STAGE(PG8_SA(0, 1), a2 + hstep, voffA);
            PG8_WAIT_L(8); PG8_BAR; PG8_WAIT_L(0); PG8_MMA(0, 0, At, B0); PG8_BAR; PG8_SCHED;
            PG8_LDB(B1, 1, 1); PG8_STAGE(PG8_SB(1, 0), b3, voffB);
            PG8_BAR; PG8_WAIT_L(0); PG8_MMA(0, 1, At, B1); PG8_BAR;
            PG8_LDA(At, 1, 1); PG8_STAGE(PG8_SA(1, 0), a3, voffA);
            PG8_BAR; PG8_WAIT_L(0); PG8_MMA(1, 0, At, B0); PG8_BAR; PG8_SCHED;
            PG8_STAGE(PG8_SB(1, 1), b3 + hstep, voffB);
            PG8_WAIT_V(6); PG8_BAR; PG8_MMA(1, 1, At, B1); PG8_BAR;
            }
        }
        if constexpr (ALIGN_EPI) { if (wr == 0) PG8_BAR; }
        if constexpr (!Epi::AFTER_DRAIN) { E(acc, cur, wr, wc, fr, fq); S.done(cur); }
        if (!has_next) break;
#pragma unroll
        for (int a = 0; a < 2; ++a)
#pragma unroll
            for (int b = 0; b < 2; ++b)
#pragma unroll
                for (int m = 0; m < 4; ++m)
#pragma unroll
                    for (int n = 0; n < 2; ++n) acc[a][b][m][n] = (f32x4){0.f, 0.f, 0.f, 0.f};
        cur = nxt; cA = nA; cB = nB; ++ui;
        if constexpr (ALIGN_EPI) { if (wr == 1) PG8_BAR; }
    }
    PG8_WAIT_V(0);
    if constexpr (!ALIGN_EPI) { if (wr == 0) PG8_BAR; }
    PG8_BAR;
    if constexpr (Epi::AFTER_DRAIN) { E.fused(acc, cur, wr, wc, fr, fq, lds, wid, lane); S.done(cur); }
#undef PG8_SA
#undef PG8_SB
#undef PG8_STAGE
#undef PG8_LDA
#undef PG8_LDB
#undef PG8_MMA
#undef PG8_WAIT_V
#undef PG8_WAIT_L
#undef PG8_BAR
#undef PG8_SCHED
}
}

#define LAS __attribute__((address_space(3)))
typedef unsigned short bf16;
typedef float f32x4 __attribute__((ext_vector_type(4)));
typedef short bf16x8 __attribute__((ext_vector_type(8)));
typedef unsigned u32x4 __attribute__((ext_vector_type(4)));
typedef unsigned long long u64;

constexpr int NB = 4, SEQ = 8192, DM = 1024, T = NB * SEQ, DFF = 2816, NH = 16, NG = 4, HD = 64;
constexpr int NQP = 1280;
constexpr int NKV = 1536;
constexpr int NCB = 512;
constexpr float RMS_EPS = 1e-6f;
constexpr float LOG2E = 1.4426950408889634f;
constexpr int LDS_BYTES = 151552;

constexpr size_t MiB = 1u << 20;
constexpr size_t SZ_WIN = (size_t)2 * DFF * DM * 2, SZ_WOUT = (size_t)DM * DFF * 2;
constexpr size_t WS_WIN = 1 * MiB;
constexpr size_t WS_WOUT = WS_WIN + 4 * SZ_WIN;
constexpr size_t WS_CWIN = WS_WOUT + 4 * SZ_WOUT;
constexpr size_t WS_CWOUT = WS_CWIN + (size_t)3072 * 1024 * 2;
constexpr size_t WS_WQ = WS_CWOUT + (size_t)1024 * 1024 * 2;
constexpr size_t WS_WO = WS_WQ + (size_t)NQP * 1024 * 2;
constexpr size_t WS_WKV = WS_WO + (size_t)1024 * 1024 * 2;
constexpr size_t WS_W1K = WS_WKV + (size_t)NKV * 1024 * 2;
constexpr size_t WS_W1V = WS_W1K + (size_t)128 * 2048 * 2;
constexpr size_t WS_W2K = WS_W1V + (size_t)128 * 2048 * 2;
constexpr size_t WS_W2V = WS_W2K + (size_t)64 * 128 * 2;
constexpr size_t WS_B1 = WS_W2V + (size_t)64 * 128 * 2;
constexpr size_t WS_WEND = WS_B1 + 1024;
static_assert(WS_WEND <= 90 * MiB, "weights region");
constexpr size_t WS_HN = 96 * MiB;
constexpr size_t WS_HN2 = 160 * MiB;
constexpr size_t WS_ACT = 224 * MiB;
constexpr size_t WS_BG = WS_ACT, WS_U = WS_ACT + 64 * MiB;
constexpr size_t WS_Q = WS_ACT;
constexpr size_t KV_BYTES = (size_t)16 * SEQ * 64 * 2;
constexpr size_t WS_KCR = 400 * MiB, WS_KS = WS_KCR + KV_BYTES, WS_KW = WS_KS + KV_BYTES;
constexpr size_t WS_VCR = WS_KW + KV_BYTES, WS_VST = WS_VCR + KV_BYTES, WS_VWT = WS_VST + KV_BYTES;
constexpr size_t WS_KC = 90 * MiB, WS_VCT = 91 * MiB;
constexpr size_t WS_GATES = WS_VWT + KV_BYTES;
constexpr size_t WS_AO = WS_HN2;
constexpr size_t WS_END = WS_GATES + 6 * MiB;
static_assert(WS_END <= 512 * MiB, "workspace");

struct Args {
    const float* in[24];
    float* out; unsigned char* ws;
};
typedef const __attribute__((address_space(4))) Args* KArgsP;
__device__ __forceinline__ KArgsP KA() { KArgsP p = (KArgsP)__builtin_amdgcn_kernarg_segment_ptr(); asm volatile("" : "+s"(p)); return p; }
#define IN(i) ((const float*)KA()->in[i])
#define WSP ((unsigned char*)KA()->ws)

typedef float f32x2_t __attribute__((ext_vector_type(2)));
typedef __bf16 bf16x2_t __attribute__((ext_vector_type(2)));
__device__ __forceinline__ unsigned cvt_pk(float lo, float hi) { const f32x2_t v = {lo, hi}; const bf16x2_t b = __builtin_convertvector(v, bf16x2_t); return __builtin_bit_cast(unsigned, b); }
__device__ __forceinline__ float bf2f(unsigned short b) { return __builtin_bit_cast(float, (unsigned)b << 16); }
__device__ __forceinline__ float wave_sum(float v) {
#pragma unroll
    for (int o = 1; o < 64; o <<= 1) v += __shfl_xor(v, o);
    return v;
}
__device__ __forceinline__ float wave_max(float v) {
#pragma unroll
    for (int o = 1; o < 64; o <<= 1) v = fmaxf(v, __shfl_xor(v, o));
    return v;
}

enum { MK_IDENT = 0, MK_FFN_IN = 1, MK_CONV_IN = 2, MK_HEADPERM = 3, MK_Q = 4 };
__device__ __forceinline__ int srcmap(int kind, int np) {
    const int pn = np >> 8, r = np & 255, bj = r >> 7, c = r & 127;
    if (kind == MK_FFN_IN) return bj * DFF + 128 * pn + c;
    if (kind == MK_CONV_IN) return pn < 4 ? np : 1024 * (1 + bj) + 128 * (pn - 4) + c;
    if (kind == MK_HEADPERM) return 256 * pn + 64 * (c >> 5) + 32 * bj;
    if (kind == MK_Q) return pn < 4 ? 256 * pn + 64 * (c >> 5) + 32 * bj : (r < 32 ? 1024 : (r < 64 ? 1056 : -1));
    return np;
}
struct MatDesc { const float* W; bf16* WT; int K, N, NP, kind; const float* gain; };

__device__ __forceinline__ void prep_load(const MatDesc& d, int item, int tid, float (&v)[16]) {
    const int nblk = d.NP >> 6, kb = item / nblk, nb = item - kb * nblk;
    const int n = tid & 31, kk = tid >> 5;
#pragma unroll
    for (int s = 0; s < 2; ++s) {
        const int sc = srcmap(d.kind, nb * 64 + s * 32);
        const bool ok = sc >= 0 && (sc + n) < d.N;
        const float* p = d.W + (size_t)(kb * 128 + kk) * d.N + sc + n;
#pragma unroll
        for (int i = 0; i < 8; ++i) v[s * 8 + i] = ok ? p[(size_t)(16 * i) * d.N] * (d.gain ? d.gain[kb * 128 + kk + 16 * i] : 1.f) : 0.f;
    }
}
__device__ __forceinline__ void prep_store_lds(LAS float* scr, int tid, const float (&v)[16]) {
    const int n = tid & 31, kk = tid >> 5;
#pragma unroll
    for (int s = 0; s < 2; ++s)
#pragma unroll
        for (int i = 0; i < 8; ++i) scr[(kk + 16 * i) * 65 + s * 32 + n] = v[s * 8 + i];
}
__device__ __forceinline__ void prep_write(const MatDesc& d, int item, int tid, const LAS float* scr) {
    const int nblk = d.NP >> 6, kb = item / nblk, nb = item - kb * nblk;
#pragma unroll
    for (int s = 0; s < 2; ++s) {
        const int n = (tid >> 4) + 32 * s, c = tid & 15;
        const LAS float* p = scr + (8 * c) * 65 + n;
        u32x4 o; o.x = cvt_pk(p[0], p[65]); o.y = cvt_pk(p[2 * 65], p[3 * 65]); o.z = cvt_pk(p[4 * 65], p[5 * 65]); o.w = cvt_pk(p[6 * 65], p[7 * 65]);
        *(u32x4*)(d.WT + (size_t)(nb * 64 + n) * d.K + kb * 128 + 8 * c) = o;
    }
}

__device__ __forceinline__ MatDesc get_mat(const Args& a, int mi) {
    unsigned char* ws = WSP;
    MatDesc d; d.gain = nullptr;
    if (mi < 4) { const int layer = mi >> 1, f2 = mi & 1;
        d.gain = IN(f2 ? 5 : 1) + layer * DM;
        d.W = IN(f2 ? 6 : 2) + (size_t)layer * DM * 2 * DFF; d.WT = (bf16*)(ws + WS_WIN + (size_t)mi * SZ_WIN); d.K = DM; d.N = 2 * DFF; d.NP = 2 * DFF; d.kind = MK_FFN_IN; return d; }
    if (mi < 8) { const int s = mi - 4, layer = s >> 1, f2 = s & 1;
        d.W = IN(f2 ? 7 : 3) + (size_t)layer * DFF * DM; d.WT = (bf16*)(ws + WS_WOUT + (size_t)s * SZ_WOUT); d.K = DFF; d.N = DM; d.NP = DM; d.kind = MK_IDENT; return d; }
    switch (mi) {
    case 8:  d.W = IN(8);  d.WT = (bf16*)(ws + WS_CWIN);  d.K = DM; d.N = 3072; d.NP = 3072; d.kind = MK_CONV_IN; d.gain = IN(4); break;
    case 9:  d.W = IN(10); d.WT = (bf16*)(ws + WS_CWOUT); d.K = DM; d.N = DM;   d.NP = DM;   d.kind = MK_IDENT; break;
    case 10: d.W = IN(11); d.WT = (bf16*)(ws + WS_WQ);    d.K = DM; d.N = 1072; d.NP = NQP;  d.kind = MK_Q; d.gain = IN(4) + DM; break;
    case 11: d.W = IN(13); d.WT = (bf16*)(ws + WS_WO);    d.K = DM; d.N = DM;   d.NP = DM;   d.kind = MK_IDENT; break;
    case 12: d.W = IN(15); d.WT = (bf16*)(ws + WS_WKV);   d.K = DM; d.N = NKV;  d.NP = NKV;  d.kind = MK_HEADPERM; d.gain = IN(14); break;
    case 13: d.W = IN(19); d.WT = (bf16*)(ws + WS_W1K);   d.K = 2048; d.N = 128; d.NP = 128; d.kind = MK_IDENT; break;
    case 14: d.W = IN(21); d.WT = (bf16*)(ws + WS_W1V);   d.K = 2048; d.N = 128; d.NP = 128; d.kind = MK_IDENT; break;
    case 15: d.W = IN(20); d.WT = (bf16*)(ws + WS_W2K);   d.K = 128; d.N = 64; d.NP = 64; d.kind = MK_IDENT; break;
    default: d.W = IN(22); d.WT = (bf16*)(ws + WS_W2V);   d.K = 128; d.N = 64; d.NP = 64; d.kind = MK_IDENT; break;
    }
    return d;
}
constexpr int N_MATS = 17;
__device__ __forceinline__ int mat_items(int mi) {
    if (mi < 4) return 8 * 88; if (mi < 8) return 22 * 16;
    switch (mi) { case 8: return 8 * 48; case 9: return 8 * 16; case 10: return 8 * 20; case 11: return 8 * 16; case 12: return 8 * 24; case 13: case 14: return 16 * 2; default: return 1; }
}
__device__ __forceinline__ bool prep_locate(int g, int& mi, int& item) {
    for (int m = 0; m < N_MATS; ++m) { const int n = mat_items(m); if (g < n) { mi = m; item = g; return true; } g -= n; }
    return false;
}

__device__ __forceinline__ void phase_prep(const Args& a, LAS unsigned char* lds) {
    LAS float* scr = (LAS float*)lds;
    int tid_ = threadIdx.x; asm volatile("" : "+v"(tid_)); const int tid = tid_, G = gridDim.x;
    float v[16]; int mi, item;
    int g = blockIdx.x;
    bool have = prep_locate(g, mi, item);
    MatDesc d = {};
    if (have) { d = get_mat(a, mi); prep_load(d, item, tid, v); }
    while (have) {
        prep_store_lds(scr, tid, v);
        __syncthreads();
        const MatDesc dc = d; const int itc = item;
        g += G; have = prep_locate(g, mi, item);
        if (have) { d = get_mat(a, mi); prep_load(d, item, tid, v); }
        prep_write(dc, itc, tid, scr);
        __syncthreads();
    }
    if (blockIdx.x < 2) {
        const int kv = blockIdx.x; const float* pe = IN(kv ? 18 : 17); const float* w1 = IN(kv ? 21 : 19);
        const int col = tid & 127, part = tid >> 7; float s = 0.f;
        for (int k = part * 512; k < part * 512 + 512; ++k) s += pe[k] * w1[(size_t)k * 128 + col];
        scr[tid] = s; __syncthreads();
        if (tid < 128) ((float*)(WSP + WS_B1))[kv * 128 + tid] = scr[tid] + scr[tid + 128] + scr[tid + 256] + scr[tid + 384];
        __syncthreads();
    }
}

__device__ __forceinline__ void phase_norm(const float* h, const float* g1, bf16* o1, const float* g2, bf16* o2) {
    int tid_ = threadIdx.x; asm volatile("" : "+v"(tid_));
    const int lane = tid_ & 63, wave = tid_ >> 6;
    const int gw = blockIdx.x * 8 + wave, NGW = gridDim.x * 8;
    f32x4 ga[4], gb[4];
#pragma unroll
    for (int j = 0; j < 4; ++j) { ga[j] = *(const f32x4*)(g1 + 4 * lane + 256 * j); gb[j] = g2 ? *(const f32x4*)(g2 + 4 * lane + 256 * j) : ga[j]; }
    for (int m = gw; m < T; m += NGW) {
        const f32x4* xr = (const f32x4*)(h + (size_t)m * DM) + lane;
        f32x4 v[4]; float s = 0.f;
#pragma unroll
        for (int j = 0; j < 4; ++j) { v[j] = xr[64 * j]; s += (v[j].x * v[j].x + v[j].y * v[j].y) + (v[j].z * v[j].z + v[j].w * v[j].w); }
        const float rstd = __builtin_amdgcn_rsqf(wave_sum(s) * (1.f / DM) + RMS_EPS);
        u64* p1 = (u64*)(o1 + (size_t)m * DM) + lane;
#pragma unroll
        for (int j = 0; j < 4; ++j) { const f32x4 y = v[j] * rstd * ga[j]; p1[64 * j] = (u64)cvt_pk(y.x, y.y) | ((u64)cvt_pk(y.z, y.w) << 32); }
        if (g2) { u64* p2 = (u64*)(o2 + (size_t)m * DM) + lane;
#pragma unroll
            for (int j = 0; j < 4; ++j) { const f32x4 y = v[j] * rstd * gb[j]; p2[64 * j] = (u64)cvt_pk(y.x, y.y) | ((u64)cvt_pk(y.z, y.w) << 32); } }
    }
}

constexpr size_t WS_SS = 131072;
__device__ __forceinline__ void phase_x(const float* x, bf16* hb, float* ss) {
    int tid_ = threadIdx.x; asm volatile("" : "+v"(tid_));
    const int lane = tid_ & 63, wave = tid_ >> 6;
    const int gw = blockIdx.x * 8 + wave, NGW = gridDim.x * 8;
    for (int i = blockIdx.x * 512 + tid_; i < 5 * T; i += gridDim.x * 512) ss[T + i] = 0.f;
    for (int m = gw; m < T; m += NGW) {
        const f32x4* xr = (const f32x4*)(x + (size_t)m * DM) + lane;
        f32x4 v[4]; float s = 0.f;
#pragma unroll
        for (int j = 0; j < 4; ++j) { v[j] = xr[64 * j]; s += (v[j].x * v[j].x + v[j].y * v[j].y) + (v[j].z * v[j].z + v[j].w * v[j].w); }
        s = wave_sum(s);
        u64* p1 = (u64*)(hb + (size_t)m * DM) + lane;
#pragma unroll
        for (int j = 0; j < 4; ++j) p1[64 * j] = (u64)cvt_pk(v[j].x, v[j].y) | ((u64)cvt_pk(v[j].z, v[j].w) << 32);
        if (lane == 0) ss[m] = s;
    }
}

__device__ __forceinline__ void unpack8(const u32x4 w, float (&f)[8]) {
    f[0] = __builtin_bit_cast(float, w.x << 16); f[1] = __builtin_bit_cast(float, w.x & 0xffff0000u); f[2] = __builtin_bit_cast(float, w.y << 16); f[3] = __builtin_bit_cast(float, w.y & 0xffff0000u);
    f[4] = __builtin_bit_cast(float, w.z << 16); f[5] = __builtin_bit_cast(float, w.z & 0xffff0000u); f[6] = __builtin_bit_cast(float, w.w << 16); f[7] = __builtin_bit_cast(float, w.w & 0xffff0000u);
}
__device__ __forceinline__ void phase_conv(const bf16* Bg, const bf16* U, const float* cw, bf16* Z) {
    int tid_ = threadIdx.x; asm volatile("" : "+v"(tid_));
    const int tid = tid_, cc = tid & 127, trow = tid >> 7;
    float w0[8], w1[8], w2[8];
#pragma unroll
    for (int e = 0; e < 8; ++e) { w0[e] = cw[8 * cc + e]; w1[e] = cw[1024 + 8 * cc + e]; w2[e] = cw[2048 + 8 * cc + e]; }
    for (int tb = blockIdx.x; tb < T / 128; tb += gridDim.x) {
        const int tbeg = tb * 128 + trow * 32;
        float u1[8], u2[8];
        if ((tbeg & (SEQ - 1)) == 0) {
#pragma unroll
            for (int e = 0; e < 8; ++e) { u1[e] = 0.f; u2[e] = 0.f; }
        } else {
            unpack8(*(const u32x4*)(U + (size_t)(tbeg - 1) * DM + 8 * cc), u1);
            unpack8(*(const u32x4*)(U + (size_t)(tbeg - 2) * DM + 8 * cc), u2);
        }
#pragma unroll 4
        for (int i = 0; i < 32; ++i) {
            const size_t p = (size_t)(tbeg + i) * DM + 8 * cc;
            float u0[8], bgv[8], z[8];
            unpack8(*(const u32x4*)(U + p), u0); unpack8(*(const u32x4*)(Bg + p), bgv);
#pragma unroll
            for (int e = 0; e < 8; ++e) { z[e] = bgv[e] * (w0[e] * u2[e] + w1[e] * u1[e] + w2[e] * u0[e]); u2[e] = u1[e]; u1[e] = u0[e]; }
            u32x4 o; o.x = cvt_pk(z[0], z[1]); o.y = cvt_pk(z[2], z[3]); o.z = cvt_pk(z[4], z[5]); o.w = cvt_pk(z[6], z[7]);
            *(u32x4*)(Z + p) = o;
        }
    }
}

__device__ __forceinline__ void phase_compress(const Args& a, LAS unsigned char* lds, size_t off_kc = WS_KC, size_t off_vct = WS_VCT) {
    unsigned char* ws = WSP;
    int tid_ = threadIdx.x; asm volatile("" : "+v"(tid_));
    const int tid = tid_, lane = tid & 63, w = tid >> 6, lc = lane & 15, lg = lane >> 4;
    LAS bf16* hid = (LAS bf16*)lds;
    LAS float* outf = (LAS float*)(lds + 32 * 136 * 2);
    for (int u2 = blockIdx.x * 2; u2 < 512; u2 += gridDim.x * 2)
    for (int uu = u2; uu < u2 + 2; ++uu) {
        const int kv = uu >> 8, R0 = (uu & 255) * 32;
        const bf16* raw = (const bf16*)(ws + (kv ? WS_VCR : WS_KCR));
        const bf16* w1t = (const bf16*)(ws + (kv ? WS_W1V : WS_W1K));
        const bf16* w2t = (const bf16*)(ws + (kv ? WS_W2V : WS_W2K));
        const float* b1 = (const float*)(ws + WS_B1) + kv * 128;
        f32x4 acc[2] = {{0.f, 0.f, 0.f, 0.f}, {0.f, 0.f, 0.f, 0.f}};
        const bf16* ap0 = raw + (size_t)(R0 + lc) * 1024 + 8 * lg;
        const bf16* ap1 = ap0 + (size_t)16 * 1024;
        const bf16* bp = w1t + (size_t)(16 * w + lc) * 2048 + 8 * lg;
        bf16x8 A0[4], A1[4], B[4];
#pragma unroll
        for (int s = 0; s < 4; ++s) { A0[s] = *(const bf16x8*)(ap0 + 32 * s); A1[s] = *(const bf16x8*)(ap1 + 32 * s); B[s] = *(const bf16x8*)(bp + 32 * s); }
        for (int k0 = 0; k0 < 2048; k0 += 128) {
            bf16x8 nA0[4], nA1[4], nB[4];
            const int kn = (k0 + 128 < 2048) ? k0 + 128 : k0;
#pragma unroll
            for (int s = 0; s < 4; ++s) { nA0[s] = *(const bf16x8*)(ap0 + kn + 32 * s); nA1[s] = *(const bf16x8*)(ap1 + kn + 32 * s); nB[s] = *(const bf16x8*)(bp + kn + 32 * s); }
#pragma unroll
            for (int s = 0; s < 4; ++s) { acc[0] = __builtin_amdgcn_mfma_f32_16x16x32_bf16(A0[s], B[s], acc[0], 0, 0, 0); acc[1] = __builtin_amdgcn_mfma_f32_16x16x32_bf16(A1[s], B[s], acc[1], 0, 0, 0); }
#pragma unroll
            for (int s = 0; s < 4; ++s) { A0[s] = nA0[s]; A1[s] = nA1[s]; B[s] = nB[s]; }
        }
        { const int col = 16 * w + lc; const float bb = b1[col];
#pragma unroll
          for (int rt = 0; rt < 2; ++rt)
#pragma unroll
            for (int r = 0; r < 4; ++r) { const float x = acc[rt][r] + bb; const float y = 2.f * 0.7978845608028654f * (x + 0.044715f * x * x * x);
                const float gl = x * __builtin_amdgcn_rcpf(1.f + __builtin_amdgcn_exp2f(-LOG2E * y));
                hid[(16 * rt + 4 * lg + r) * 136 + col] = (bf16)(cvt_pk(gl, 0.f) & 0xffffu); } }
        __syncthreads();
        { const int rt = w >> 2, ct = w & 3; f32x4 o = {0.f, 0.f, 0.f, 0.f};
#pragma unroll
          for (int ks = 0; ks < 4; ++ks) { const bf16x8 A = *(const LAS bf16x8*)(hid + (16 * rt + lc) * 136 + 32 * ks + 8 * lg); const bf16x8 B = *(const bf16x8*)(w2t + (size_t)(16 * ct + lc) * 128 + 32 * ks + 8 * lg);
              o = __builtin_amdgcn_mfma_f32_16x16x32_bf16(A, B, o, 0, 0, 0); }
#pragma unroll
          for (int r = 0; r < 4; ++r) outf[(16 * rt + 4 * lg + r) * 65 + 16 * ct + lc] = o[r]; }
        __syncthreads();
        { const int row = tid >> 4, d0 = 4 * (tid & 15); const int R = R0 + row, bg = R >> 9, i = R & 511;
          float v[4]; float ss = 0.f;
#pragma unroll
          for (int e = 0; e < 4; ++e) { v[e] = outf[row * 65 + d0 + e]; ss += v[e] * v[e]; }
          if (kv == 0) {
              ss += __shfl_xor(ss, 1); ss += __shfl_xor(ss, 2); ss += __shfl_xor(ss, 4); ss += __shfl_xor(ss, 8);
              const float rstd = __builtin_amdgcn_rsqf(ss * (1.f / 64.f) + RMS_EPS); const float* kn = IN(16);
#pragma unroll
              for (int e = 0; e < 4; ++e) v[e] = (i == 511) ? 0.f : v[e] * rstd * kn[d0 + e];
              bf16* dst = (bf16*)(ws + off_kc) + ((size_t)bg * NCB + i) * 64 + d0;
              *(u64*)dst = (u64)cvt_pk(v[0], v[1]) | ((u64)cvt_pk(v[2], v[3]) << 32);
          } else {
              bf16* dst = (bf16*)(ws + off_vct) + ((size_t)bg * 64 + d0) * NCB + i;
#pragma unroll
              for (int e = 0; e < 4; ++e) dst[(size_t)e * NCB] = (i == 511) ? (bf16)0 : (bf16)(cvt_pk(v[e], 0.f) & 0xffffu);
          } }
        __syncthreads();
    }
}

constexpr int A_IMP = 0, A_RING = 32768, TILE_PITCH = 192  , TILE_B = 64 * TILE_PITCH, STAGE_B = 2 * TILE_B,
              A_SELQ = A_RING + 2 * STAGE_B, A_BIAS = A_SELQ + 1024, A_MB = A_BIAS + 512, A_OUT = A_MB + 512;
constexpr int RELMAX_BIG = 0x40000000;

template <int MODE, int BM = 0, bool SEL = false>
__device__ __forceinline__ void attn_core(const bf16x8 (&kf)[4][2], const bf16x8 (&vf)[4][2], const bf16x8 (&qf)[2], int tq, int pbase, int pstride, int relmax,
                                          const LAS float* biasrow, float pscale, f32x4 (&oacc)[4], float& lsum, LAS float* improw, int jbase, int lg, int h, float pbias = 0.f, float pbias2 = 0.f, int thr = 0) {
    f32x4 s[4];
#pragma unroll
    for (int kt = 0; kt < 4; ++kt) {
        s[kt] = __builtin_amdgcn_mfma_f32_16x16x32_bf16(kf[kt][0], qf[0], (f32x4){0.f, 0.f, 0.f, 0.f}, 0, 0, 0);
        s[kt] = __builtin_amdgcn_mfma_f32_16x16x32_bf16(kf[kt][1], qf[1], s[kt], 0, 0, 0);
    }
#pragma unroll
    for (int kt = 0; kt < 4; ++kt) {
        const int kap0 = 32 * (kt >> 1) + 8 * lg + 4 * (kt & 1);
        const int rel0 = tq - (pbase + kap0 * pstride);
#pragma unroll
        for (int r = 0; r < 4; ++r) {
            float p;
            if (BM == 1) {
                p = __builtin_amdgcn_exp2f(s[kt][r] + pbias);
            } else if (BM == 2) {
                const int rel = rel0 - r * pstride;
                p = __builtin_amdgcn_exp2f(s[kt][r] + (rel >= thr ? pbias2 : pbias));
            } else if (BM == 3) {
                const int rel = rel0 - r * pstride;
                int bk = 39 - __clz((int)__umul24((unsigned)rel, (unsigned)rel)); bk = bk > 31 ? 31 : bk;
                p = __builtin_amdgcn_exp2f(s[kt][r] + biasrow[bk]);
                if (SEL) p = tq >= 0 ? p : 0.f;
            } else {
            const int rel = rel0 - r * pstride;
            const bool valid = (unsigned)rel < (unsigned)relmax;
            const int n = valid ? rel : 0;
            const int nn = (int)__umul24((unsigned)n, (unsigned)n);
            int bk = 39 - __clz(nn); bk = bk > 31 ? 31 : bk; bk = n < 16 ? n : bk;
            const float x = s[kt][r] + biasrow[bk];
            p = valid ? __builtin_amdgcn_exp2f(x) : 0.f;
            }
            if (MODE == 2) p *= pscale;
            s[kt][r] = p; lsum += p;
        }
        __builtin_amdgcn_sched_barrier(0);
        if (MODE == 2) {
            float av = 2.f * (s[kt][0] + s[kt][1] + s[kt][2]) + s[kt][3], bv = s[kt][3];
            av += __shfl_xor(av, 1); av += __shfl_xor(av, 2); bv += __shfl_xor(bv, 1); bv += __shfl_xor(bv, 2);
            if (h == 0) { const int j = jbase + (kap0 >> 2);
                improw[j] = improw[j] + av;
                if (j + 1 < 128) improw[j + 1] = improw[j + 1] + bv; }
        }
    }
    if (MODE >= 1) {
#pragma unroll
        for (int hh = 0; hh < 2; ++hh) {
            u32x4 pw; pw.x = cvt_pk(s[2 * hh][0], s[2 * hh][1]); pw.y = cvt_pk(s[2 * hh][2], s[2 * hh][3]); pw.z = cvt_pk(s[2 * hh + 1][0], s[2 * hh + 1][1]); pw.w = cvt_pk(s[2 * hh + 1][2], s[2 * hh + 1][3]);
            const bf16x8 pf = __builtin_bit_cast(bf16x8, pw);
#pragma unroll
            for (int dt = 0; dt < 4; ++dt) oacc[dt] = __builtin_amdgcn_mfma_f32_16x16x32_bf16(vf[dt][hh], pf, oacc[dt], 0, 0, 0);
        }
    }
}
__device__ __forceinline__ int rel_bucket_i(int n) { int bk = 39 - __clz((int)((unsigned)n * (unsigned)n)); bk = bk > 31 ? 31 : bk; return n < 16 ? n : bk; }
template <int MODE, bool SEL>
__device__ __forceinline__ void tile_stream(LAS unsigned char* ring, const bf16* Kbase, const bf16* Vbase, int ldv, int nt, int pb0, int pbstep, int pstride, int relmax,
                                            const bf16x8 (&qf)[2][2], const int (&tq)[2], const LAS float* biasrow, const float (&psc)[2], f32x4 (&oacc)[2][4], float (&ls)[2],
                                            LAS float* imp0, LAS float* imp1, const LAS u64* selA, const LAS u64* selB, int tid, int lc, int lg, int h) {
    const int row = tid >> 3, ch = tid & 7;
    const bf16* kp = Kbase + row * 64 + ch * 8;
    const bf16* vp = Vbase + (size_t)row * ldv + ch * 8;
    const int woff = row * TILE_PITCH + ch * 16;
    const float bfar = biasrow[31]; const int tqlo = __builtin_amdgcn_readfirstlane(tq[0]) ;
    u32x4 rk = {0u, 0u, 0u, 0u}, rv = {0u, 0u, 0u, 0u};
    if (nt > 0) { rk = *(const u32x4*)kp; if (MODE > 0) rv = *(const u32x4*)vp; }
    for (int t = 0; t < nt; ++t) {
        LAS unsigned char* st = ring + (t & 1) * STAGE_B;
        *(LAS u32x4*)(st + woff) = rk; if (MODE > 0) *(LAS u32x4*)(st + TILE_B + woff) = rv;
        __syncthreads();
        if (t + 1 < nt) { rk = *(const u32x4*)(kp + (size_t)(t + 1) * 4096); if (MODE > 0) rv = *(const u32x4*)(vp + (t + 1) * 64); }
        int tq0 = tq[0], tq1 = tq[1]; bool do0 = true, do1 = true;
        if (SEL) {
            const bool b0 = ((selA[t >> 6] >> (t & 63)) & 1ull) != 0ull, b1 = ((selB[t >> 6] >> (t & 63)) & 1ull) != 0ull;
            tq0 = b0 ? tq0 : -1; tq1 = b1 ? tq1 : -1; do0 = __ballot(b0) != 0ull; do1 = __ballot(b1) != 0ull;
        }
        if (do0 || do1) {
            bf16x8 kf[4][2], vf[4][2];
#pragma unroll
            for (int kt = 0; kt < 4; ++kt) { const LAS unsigned char* p = st + (32 * (kt >> 1) + 8 * (lc >> 2) + 4 * (kt & 1) + (lc & 3)) * TILE_PITCH + 16 * lg;
                kf[kt][0] = *(const LAS bf16x8*)p; kf[kt][1] = *(const LAS bf16x8*)(p + 64); }
            if (MODE > 0) {
#pragma unroll
                for (int dt = 0; dt < 4; ++dt) { const LAS unsigned char* p = st + TILE_B + (16 * dt + lc) * TILE_PITCH + 16 * lg;
                    vf[dt][0] = *(const LAS bf16x8*)p; vf[dt][1] = *(const LAS bf16x8*)(p + 64); }
            }
            const int pbase = pb0 + t * pbstep;
            {
                const int rlo = tqlo - (pbase + 63 * pstride), rhi = tqlo + 7 - pbase;
                const int blo = rel_bucket_i(rlo < 0 ? 0 : rlo), bhi = rel_bucket_i(rhi < 0 ? 0 : rhi);
                if (rlo >= 0 && rhi < relmax && bhi - blo <= 1) {
                    int thr = 0x7fffffff;
                    if (bhi != blo) { int a = rlo, b = rhi;
                        while (b - a > 1) { const int mid = (a + b) >> 1; if (rel_bucket_i(mid) == blo) a = mid; else b = mid; }
                        thr = b; }
                    const float pb1 = biasrow[blo], pb2 = biasrow[bhi];
                    const float pa0 = (!SEL || tq0 >= 0) ? pb1 : -1e30f, pa1 = (!SEL || tq0 >= 0) ? pb2 : -1e30f, pc0 = (!SEL || tq1 >= 0) ? pb1 : -1e30f, pc1 = (!SEL || tq1 >= 0) ? pb2 : -1e30f;
                    if (bhi == blo) {
                        if (do0) attn_core<MODE, 1, SEL>(kf, vf, qf[0], tq0, pbase, pstride, relmax, biasrow, psc[0], oacc[0], ls[0], imp0, 16 * t, lg, h, pa0);
                        if (do1) attn_core<MODE, 1, SEL>(kf, vf, qf[1], tq1, pbase, pstride, relmax, biasrow, psc[1], oacc[1], ls[1], imp1, 16 * t, lg, h, pc0);
                    } else {
                        if (do0) attn_core<MODE, 2, SEL>(kf, vf, qf[0], tq[0], pbase, pstride, relmax, biasrow, psc[0], oacc[0], ls[0], imp0, 16 * t, lg, h, pa0, pa1, thr);
                        if (do1) attn_core<MODE, 2, SEL>(kf, vf, qf[1], tq[1], pbase, pstride, relmax, biasrow, psc[1], oacc[1], ls[1], imp1, 16 * t, lg, h, pc0, pc1, thr);
                    }
                } else if (rlo >= 16 && rhi < relmax) {
                    if (do0) attn_core<MODE, 3, SEL>(kf, vf, qf[0], tq0, pbase, pstride, relmax, biasrow, psc[0], oacc[0], ls[0], imp0, 16 * t, lg, h);
                    if (do1) attn_core<MODE, 3, SEL>(kf, vf, qf[1], tq1, pbase, pstride, relmax, biasrow, psc[1], oacc[1], ls[1], imp1, 16 * t, lg, h);
                } else {
                    if (do0) attn_core<MODE>(kf, vf, qf[0], tq0, pbase, pstride, relmax, biasrow, psc[0], oacc[0], ls[0], imp0, 16 * t, lg, h);
                    if (do1) attn_core<MODE>(kf, vf, qf[1], tq1, pbase, pstride, relmax, biasrow, psc[1], oacc[1], ls[1], imp1, 16 * t, lg, h);
                }
            }
        }
    }
    __syncthreads();
}

__device__ __forceinline__ void phase_attn(const Args& a, LAS unsigned char* lds) {
    unsigned char* ws = WSP;
    int tid_ = threadIdx.x; asm volatile("" : "+v"(tid_));
    const int w = __builtin_amdgcn_readfirstlane(tid_ >> 6);
    LAS float* imp = (LAS float*)(lds + A_IMP);
    LAS unsigned char* ring = lds + A_RING;
    LAS u64* selq = (LAS u64*)(lds + A_SELQ);
    LAS float* biasL = (LAS float*)(lds + A_BIAS);
    LAS float* mbound = (LAS float*)(lds + A_MB);
    const bf16* Q = (const bf16*)(ws + WS_Q);
    const float* gates = (const float*)(ws + WS_GATES);
    const float* relb = IN(23);
    if (w == 0) {
        const int lane = tid_ & 63;
        float mq = fabsf(IN(12)[lane]);
        float mk = fmaxf(fabsf(IN(16)[lane]), fmaxf(fabsf(IN(16)[64 + lane]), fabsf(IN(16)[128 + lane])));
        mq = wave_max(mq); mk = wave_max(mk);
        float mb = -1e30f;
        if (lane < 16) { for (int bk = 0; bk < 32; ++bk) mb = fmaxf(mb, relb[bk * 16 + lane]); mbound[lane] = mb + 8.f * mq * mk; }
    }
    __syncthreads();
    const int nunits = 2048, G = gridDim.x, bx = blockIdx.x;
    for (int it = 0; ; ++it) {
        int bg, qb;
        if (G == 256) {
            if (it >= 8) break;
            const int slot = bx >> 3, oo = slot >> 1; bg = 2 * (bx & 7) + (slot & 1);
            qb = (it & 1) ? 127 - 16 * (it >> 1) - oo : 16 * (it >> 1) + oo;
        } else {
            const int u = bx + it * G; if (u >= nunits) break;
            const int rr = u >> 4, ui = rr >> 4, oo = rr & 15; bg = u & 15;
            qb = (ui & 1) ? 127 - 16 * (ui >> 1) - oo : 16 * (ui >> 1) + oo;
        }
        const int b = bg >> 2, grp = bg & 3, t0 = 64 * qb, tokbase = b * SEQ + t0;
        int tidu = tid_; asm volatile("" : "+v"(tidu));
        const int tid = tidu, lane = tid & 63, lc = lane & 15, lg = lane >> 4, hq = lc >> 2, h = lc & 3;
        const u64 ltmask = (1ull << lane) - 1ull;
        for (int i = tid; i < 8192; i += 512) imp[i] = 0.f;
        if (tid < 128) { const int hh = tid >> 5, bk = tid & 31; biasL[tid] = (relb[bk * 16 + grp * 4 + hh] - mbound[grp * 4 + hh]) * LOG2E; }
        __syncthreads();
        const LAS float* biasrow = biasL + h * 32;
        bf16x8 qf[2][2]; int tqd[2]; float g0[2], g1[2], g2[2];
#pragma unroll
        for (int ct = 0; ct < 2; ++ct) { const int q = 8 * w + 4 * ct + hq; tqd[ct] = t0 + q;
            const bf16* qp = Q + (size_t)(tokbase + q) * DM + (grp * 4 + h) * 64 + 8 * lg; qf[ct][0] = *(const bf16x8*)qp; qf[ct][1] = *(const bf16x8*)(qp + 32);
            const float* gp = gates + (size_t)(tokbase + q) * 48 + (grp * 4 + h) * 3; g0[ct] = gp[0]; g1[ct] = gp[1]; g2[ct] = gp[2]; }
        LAS float* imp0 = imp + (8 * w + hq) * 128; LAS float* imp1 = imp + (8 * w + 4 + hq) * 128;
        LAS float* outp[2] = {(LAS float*)(lds + A_OUT) + ((8 * w + hq) * 4 + h) * 64 + 4 * lg, (LAS float*)(lds + A_OUT) + ((8 * w + 4 + hq) * 4 + h) * 64 + 4 * lg};
        const float one2[2] = {1.f, 1.f};
        {
            const int ncb = 4 * qb + 3, ntc = (ncb + 63) >> 6;
            const bf16* Kc = (const bf16*)(ws + WS_KC) + (size_t)bg * NCB * 64;
            const bf16* VcT = (const bf16*)(ws + WS_VCT) + (size_t)bg * 64 * NCB;
            float ls[2] = {0.f, 0.f}; f32x4 oc[2][4];
#pragma unroll
            for (int ct = 0; ct < 2; ++ct)
#pragma unroll
                for (int dt = 0; dt < 4; ++dt) oc[ct][dt] = (f32x4){0.f, 0.f, 0.f, 0.f};
            tile_stream<0, false>(ring, Kc, VcT, NCB, ntc, 31, 1024, 16, RELMAX_BIG, qf, tqd, biasrow, one2, oc, ls, imp0, imp1, selq, selq, tid, lc, lg, h);
            float inv[2];
#pragma unroll
            for (int ct = 0; ct < 2; ++ct) { float l = ls[ct]; l += __shfl_xor(l, 16); l += __shfl_xor(l, 32); inv[ct] = l > 0.f ? 1.f / l : 0.f; }
            float dummy[2] = {0.f, 0.f};
            tile_stream<2, false>(ring, Kc, VcT, NCB, ntc, 31, 1024, 16, RELMAX_BIG, qf, tqd, biasrow, inv, oc, dummy, imp0, imp1, selq, selq, tid, lc, lg, h);
#pragma unroll
            for (int ct = 0; ct < 2; ++ct)
#pragma unroll
                for (int dt = 0; dt < 4; ++dt) *(LAS f32x4*)(outp[ct] + 16 * dt) = oc[ct][dt] * g0[ct];
        }
        for (int qi = 0; qi < 8; ++qi) {
            const int q = 8 * w + qi; u64 lo, hi;
            if (qb < 16) { lo = (2ull << qb) - 1ull; hi = 0ull; }
            else {
                const int j0 = lane, j1 = lane + 64;
                const bool c0 = (j0 >= 1 && j0 <= qb - 2), c1 = (j1 <= qb - 2);
                const unsigned key0 = c0 ? __builtin_bit_cast(unsigned, imp[q * 128 + j0]) : 0u, key1 = c1 ? __builtin_bit_cast(unsigned, imp[q * 128 + j1]) : 0u;
                unsigned Tk = 0u;
                for (int bit = 30; bit >= 0; --bit) { const unsigned trial = Tk | (1u << bit);
                    const int cnt = __popcll(__ballot(key0 >= trial)) + __popcll(__ballot(key1 >= trial)); if (cnt >= 13) Tk = trial; }
                const bool gt0 = key0 > Tk, gt1 = key1 > Tk, e0 = (key0 == Tk) && c0, e1 = (key1 == Tk) && c1;
                const int need = 13 - (__popcll(__ballot(gt0)) + __popcll(__ballot(gt1)));
                const u64 m0 = __ballot(e0), m1 = __ballot(e1);
                const int r0 = __popcll(m0 & ltmask), r1 = __popcll(m0) + __popcll(m1 & ltmask);
                const bool s0 = gt0 || (e0 && r0 < need) || j0 == 0 || j0 == qb || j0 == qb - 1;
                const bool s1 = gt1 || (e1 && r1 < need) || j1 == qb || j1 == qb - 1;
                lo = __ballot(s0); hi = __ballot(s1);
            }
            if (lane == 0) { selq[q * 2] = lo; selq[q * 2 + 1] = hi; }
        }
        __builtin_amdgcn_wave_barrier();
        {
            const int tf = qb >= 8 ? 0 : 8 - qb, p0 = t0 - 512 + 64 * tf;
            const bf16* Kw = (const bf16*)(ws + WS_KW) + ((size_t)bg * SEQ + p0) * 64;
            const bf16* VwT = (const bf16*)(ws + WS_VWT) + (size_t)bg * 64 * SEQ + p0;
            float ls[2] = {0.f, 0.f}; f32x4 ow[2][4];
#pragma unroll
            for (int ct = 0; ct < 2; ++ct)
#pragma unroll
                for (int dt = 0; dt < 4; ++dt) ow[ct][dt] = (f32x4){0.f, 0.f, 0.f, 0.f};
            tile_stream<1, false>(ring, Kw, VwT, SEQ, 9 - tf, p0, 64, 1, 512, qf, tqd, biasrow, one2, ow, ls, imp0, imp1, selq, selq, tid, lc, lg, h);
#pragma unroll
            for (int ct = 0; ct < 2; ++ct) { float l = ls[ct]; l += __shfl_xor(l, 16); l += __shfl_xor(l, 32); const float sc = g2[ct] / l;
#pragma unroll
                for (int dt = 0; dt < 4; ++dt) *(LAS f32x4*)(outp[ct] + 16 * dt) = *(LAS f32x4*)(outp[ct] + 16 * dt) + ow[ct][dt] * sc; }
        }
        {
            const bf16* Ks = (const bf16*)(ws + WS_KS) + (size_t)bg * SEQ * 64;
            const bf16* VsT = (const bf16*)(ws + WS_VST) + (size_t)bg * 64 * SEQ;
            float ls[2] = {0.f, 0.f}; f32x4 os[2][4];
#pragma unroll
            for (int ct = 0; ct < 2; ++ct)
#pragma unroll
                for (int dt = 0; dt < 4; ++dt) os[ct][dt] = (f32x4){0.f, 0.f, 0.f, 0.f};
            tile_stream<1, true>(ring, Ks, VsT, SEQ, qb + 1, 0, 64, 1, RELMAX_BIG, qf, tqd, biasrow, one2, os, ls, imp0, imp1, selq + (8 * w + hq) * 2, selq + (8 * w + 4 + hq) * 2, tid, lc, lg, h);
            bf16* AO = (bf16*)(ws + WS_AO);
#pragma unroll
            for (int ct = 0; ct < 2; ++ct) { float l = ls[ct]; l += __shfl_xor(l, 16); l += __shfl_xor(l, 32); const float sc = g1[ct] / l;
                bf16* op = AO + (size_t)(tokbase + 8 * w + 4 * ct + hq) * DM + (grp * 4 + h) * 64 + 4 * lg;
#pragma unroll
                for (int dt = 0; dt < 4; ++dt) { const f32x4 v = *(LAS f32x4*)(outp[ct] + 16 * dt) + os[ct][dt] * sc; *(u64*)(op + 16 * dt) = (u64)cvt_pk(v[0], v[1]) | ((u64)cvt_pk(v[2], v[3]) << 32); } }
        }
    }
}

#define XB_TMO      128
#define XB_XCNT(j)  (256  + 64 * (j))
#define XB_XSUB(j)  (1280 + 64 * (j))
#define XB_XGEN(j)  (2304 + 64 * (j))
#define XB_TOP      3328
#define XB_TOPGEN   3392
#define XCD_BAR_WORDS 3456
#define XB_SPIN_CAP (1u << 23)

__device__ __forceinline__ unsigned xb_ld(unsigned* p)              { return __hip_atomic_load(p, __ATOMIC_RELAXED, __HIP_MEMORY_SCOPE_AGENT); }
__device__ __forceinline__ unsigned xb_add(unsigned* p, unsigned v) { return __hip_atomic_fetch_add(p, v, __ATOMIC_RELAXED, __HIP_MEMORY_SCOPE_AGENT); }
__device__ __forceinline__ unsigned xb_xcc_id() { return (unsigned)__builtin_amdgcn_s_getreg((3 << 11) | 20) & 0xFu; }
#define XB_SPIN(cond, bar) do { unsigned _sp = 0; while (cond) { __builtin_amdgcn_s_sleep(1); \
    if ((++_sp & 255u) == 0u) { if (xb_ld(&(bar)[XB_TMO])) break; if (_sp > XB_SPIN_CAP) { atomicAdd(&(bar)[XB_TMO], 1u); break; } } } } while (0)

struct XcdBarrier {
    unsigned* bar; unsigned x;
    volatile LAS unsigned* st;
};

__device__ __forceinline__ XcdBarrier xcd_barrier_post(unsigned* bar, volatile LAS unsigned* st) {
    XcdBarrier b; b.bar = bar; b.x = xb_xcc_id(); b.st = st;
    if (threadIdx.x == 0) (void)xb_add(&bar[XB_XCNT(b.x)], 1u);
    return b;
}
__device__ __forceinline__ void xcd_barrier_complete(unsigned* bar, unsigned x, unsigned& nloc, unsigned& nx) {
    const unsigned G = gridDim.x * gridDim.y * gridDim.z;
    unsigned sum, cnt, mine, sp = 0u;
    for (;;) {
        sum = 0u; cnt = 0u; mine = 0u;
#pragma unroll
        for (unsigned j = 0; j < 16; ++j) { const unsigned c = xb_ld(&bar[XB_XCNT(j)]); sum += c; cnt += (c > 0u) ? 1u : 0u; mine = (j == x) ? c : mine; }
        if (sum == G) break;
        __builtin_amdgcn_s_sleep(1);
        if ((++sp & 255u) == 0u) { if (xb_ld(&bar[XB_TMO])) break; if (sp > XB_SPIN_CAP) { atomicAdd(&bar[XB_TMO], 1u); break; } }
    }
    nloc = mine > 0u ? mine : 1u; nx = cnt > 0u ? cnt : 1u;
}

__device__ __forceinline__ void xcd_barrier(const XcdBarrier& b) {
    asm volatile("s_waitcnt vmcnt(0)" ::: "memory");
    __syncthreads();
    if (threadIdx.x == 0) {
        unsigned* bar = b.bar;
        __builtin_amdgcn_s_waitcnt(0);
        unsigned nloc = b.st[0], nx = b.st[1];
        if (nloc == 0u) { xcd_barrier_complete(bar, b.x, nloc, nx); b.st[0] = nloc; b.st[1] = nx; }
        const unsigned old = xb_add(&bar[XB_XSUB(b.x)], 1u);
        const unsigned gen = old / nloc;
        if (old + 1u == (gen + 1u) * nloc) {
            __builtin_amdgcn_fence(__ATOMIC_RELEASE, "agent");
            asm volatile("s_waitcnt vmcnt(0)" ::: "memory");
            const unsigned og = xb_add(&bar[XB_TOP], 1u);
            const unsigned tg = og / nx;
            if (og + 1u == (tg + 1u) * nx) xb_add(&bar[XB_TOPGEN], 1u);
            else XB_SPIN(xb_ld(&bar[XB_TOPGEN]) == tg, bar);
            __builtin_amdgcn_fence(__ATOMIC_ACQUIRE, "agent");
            xb_add(&bar[XB_XGEN(b.x)], 1u);
            asm volatile("s_waitcnt vmcnt(0)" ::: "memory");
        } else {
            XB_SPIN(xb_ld(&bar[XB_XGEN(b.x)]) == gen, bar);
            __builtin_amdgcn_fence(__ATOMIC_ACQUIRE, "agent");
            asm volatile("s_waitcnt vmcnt(0)" ::: "memory");
        }
    }
    __syncthreads();
}


__global__ void __launch_bounds__(512, 2) mk_fwd(Args a) {
    extern __shared__ __attribute__((aligned(16))) unsigned char lds_raw[];
    LAS unsigned char* lds = (LAS unsigned char*)lds_raw;
    cg::grid_group grid = cg::this_grid();
    unsigned char* ws = WSP;
    const float* x = IN(0); float* hout = KA()->out;
    bf16* HN = (bf16*)(ws + WS_HN); bf16* HN2 = (bf16*)(ws + WS_HN2); bf16* ACT = (bf16*)(ws + WS_ACT);
    const int G = gridDim.x, bx = blockIdx.x;
#define GRID_SYNC() do { \
        if (sync_no == 0u) { asm volatile("s_waitcnt vmcnt(0) lgkmcnt(0)" ::: "memory"); grid.sync(); \
            if (threadIdx.x == 0) { __builtin_amdgcn_fence(__ATOMIC_ACQUIRE, "agent"); asm volatile("s_waitcnt vmcnt(0)" ::: "memory"); } __syncthreads(); \
            xb = xcd_barrier_post(bar_words, xb_st); } \
        else xcd_barrier(xb); \
        ++sync_no; } while (0)
#define GEMM(EPI, Aptr, Bptr, N_, K_, E) do { pg8::Gemm g_{(const pg8::bf16_t*)(Aptr), (const pg8::bf16_t*)(Bptr), T, (N_), (K_)}; pg8::StaticOrder S_; S_.init(T, (N_), G, bx); \
        pg8::gemm_phase<std::remove_cv_t<std::remove_reference_t<decltype(E)>>, pg8::StaticOrder, true, true>((PG8_LAS unsigned char*)lds, g_, S_, (E)); } while (0)

    unsigned* bar_words = (unsigned*)(ws + 4096); unsigned sync_no = 0u;
    for (int i = bx * 512 + threadIdx.x; i < XCD_BAR_WORDS; i += G * 512) __hip_atomic_store(bar_words + i, 0u, __ATOMIC_RELAXED, __HIP_MEMORY_SCOPE_AGENT);
    volatile LAS unsigned* xb_st = (volatile LAS unsigned*)(lds + LDS_BYTES - 16);
    if (threadIdx.x < 2) xb_st[threadIdx.x] = 0u;
    XcdBarrier xb; xb.bar = bar_words; xb.x = 0u; xb.st = xb_st;
    float* SS = (float*)(ws + WS_SS);
#define SSK(k) (SS + (size_t)(k) * T)
    phase_prep(a, lds);
    phase_x(x, HN, SS);
    GRID_SYNC();
    { pg8::EpiSwiglu E{ACT, DFF, SSK(0)}; GEMM(pg8::EpiSwiglu, HN, ws + WS_WIN, 2 * DFF, DM, E); }
    GRID_SYNC();
    { pg8::EpiResid<true, 1, 0, false> E{x, hout, HN, SSK(1)}; GEMM((pg8::EpiResid<true, 1, 0, false>), ACT, ws + WS_WOUT, DM, DFF, E); }
    GRID_SYNC();
    { pg8::EpiConvIn E{(bf16*)(ws + WS_BG), (bf16*)(ws + WS_U), SSK(1)}; GEMM(pg8::EpiConvIn, HN, ws + WS_CWIN, 3072, DM, E); }
    GRID_SYNC();
    phase_conv((const bf16*)(ws + WS_BG), (const bf16*)(ws + WS_U), IN(9), HN2);
    GRID_SYNC();
    { pg8::EpiResid<true, 2, 1, false> E{hout, hout, HN, SSK(2)}; GEMM((pg8::EpiResid<true, 2, 1, false>), HN2, ws + WS_CWOUT, DM, DM, E); }
    GRID_SYNC();
    { pg8::EpiSwiglu E{ACT, DFF, SSK(2)}; GEMM(pg8::EpiSwiglu, HN, ws + WS_WIN + SZ_WIN, 2 * DFF, DM, E); }
    GRID_SYNC();
    { pg8::EpiResid<true, 1, 1, false> E{hout, hout, HN, SSK(3)}; GEMM((pg8::EpiResid<true, 1, 1, false>), ACT, ws + WS_WOUT + SZ_WOUT, DM, DFF, E); }
    GRID_SYNC();
    { pg8::EpiKV E; E.Kb = (bf16*)(ws + WS_KCR); E.Vb = (bf16*)(ws + WS_VCR); E.brstride = KV_BYTES / 2; E.knorm = IN(16); E.ss = SSK(3);
      GEMM(pg8::EpiKV, HN, ws + WS_WKV, NKV, DM, E); }
    GRID_SYNC();
    phase_compress(a, lds);
    { pg8::EpiSwiglu E{ACT, DFF, SSK(3)}; GEMM(pg8::EpiSwiglu, HN, ws + WS_WIN + 2 * SZ_WIN, 2 * DFF, DM, E); }
    GRID_SYNC();
    { pg8::EpiResid<true, 1, 1, false> E{hout, hout, HN, SSK(4)}; GEMM((pg8::EpiResid<true, 1, 1, false>), ACT, ws + WS_WOUT + 2 * SZ_WOUT, DM, DFF, E); }
    GRID_SYNC();
    { pg8::EpiQ E{(bf16*)(ws + WS_Q), (float*)(ws + WS_GATES), IN(12), 0.125f * LOG2E, SSK(4)}; GEMM(pg8::EpiQ, HN, ws + WS_WQ, NQP, DM, E); }
    GRID_SYNC();
    phase_attn(a, lds);
    GRID_SYNC();
    { pg8::EpiResid<true, 2, 1, false> E{hout, hout, HN, SSK(5)}; GEMM((pg8::EpiResid<true, 2, 1, false>), ws + WS_AO, ws + WS_WO, DM, DM, E); }
    GRID_SYNC();
    { pg8::EpiSwiglu E{ACT, DFF, SSK(5)}; GEMM(pg8::EpiSwiglu, HN, ws + WS_WIN + 3 * SZ_WIN, 2 * DFF, DM, E); }
    GRID_SYNC();
    { pg8::EpiResid<false, 1, 1, true> E{hout, hout, HN, nullptr}; GEMM((pg8::EpiResid<false, 1, 1, true>), ACT, ws + WS_WOUT + 3 * SZ_WOUT, DM, DFF, E); }
#undef SSK
#undef GEMM
}

extern "C" void kernel_launch(void* const* d_in, const int* in_sizes, int n_in, void* d_out, int out_size, void* d_ws, size_t ws_size, hipStream_t stream) {
    static int grid = 0;
    if (grid == 0) {
        if (n_in != 24 || out_size != T * DM || ws_size < WS_END) { fprintf(stderr, "kernel_launch: unexpected problem (n_in %d out %d ws %zu)\n", n_in, out_size, ws_size); grid = -1; return; }
        int dev = 0, cus = 0, per_cu = 0;
        (void)hipGetDevice(&dev);
        (void)hipDeviceGetAttribute(&cus, hipDeviceAttributeMultiprocessorCount, dev);
        (void)hipFuncSetAttribute((const void*)mk_fwd, hipFuncAttributeMaxDynamicSharedMemorySize, LDS_BYTES);
        (void)hipOccupancyMaxActiveBlocksPerMultiprocessor(&per_cu, (const void*)mk_fwd, 512, LDS_BYTES);
        if (per_cu < 1) per_cu = 1;
        grid = cus * per_cu;
    }
    if (grid < 0) return;
    Args a{};
    for (int i = 0; i < 24; ++i) a.in[i] = (const float*)d_in[i];
    a.out = (float*)d_out; a.ws = (unsigned char*)d_ws;
    void* args[] = {&a};
    hipError_t e = hipLaunchCooperativeKernel((const void*)mk_fwd, dim3(grid), dim3(512), args, LDS_BYTES, stream);
    if (e != hipSuccess) fprintf(stderr, "cooperative launch failed: %s (grid %d)\n", hipGetErrorString(e), grid);
}
```

```cpp
#include <hip/hip_runtime.h>
#include <hip/hip_cooperative_groups.h>
#include <cstdio>
#include <cstdint>
#include <type_traits>
namespace cg = cooperative_groups;
namespace pg8 {
#define PG8_LAS __attribute__((address_space(3)))
typedef unsigned short bf16_t;
typedef short bf16x8 __attribute__((ext_vector_type(8)));
typedef float f32x4 __attribute__((ext_vector_type(4)));
typedef unsigned u32x4 __attribute__((ext_vector_type(4)));
constexpr int BM = 256, BK = 64, HALF = 128, HTB = HALF * BK * 2  , STAGE_BYTES = 8 * HTB, NXCD = 8, WGM = 8;

__host__ __device__ __forceinline__ int lds_byte(int r, int c) { const int st = (r >> 4) * 2 + (c >> 5), rr = r & 15, cc = c & 31, ob = rr * 64 + cc * 2; return st * 1024 + (ob ^ (((ob >> 9) & 1) << 5)); }
__host__ __device__ __forceinline__ void stage_rc(int b, int& R, int& C) { const int st = b / 1024, sb = b % 1024, swz = sb ^ (((sb >> 9) & 1) << 5); R = (st >> 1) * 16 + swz / 64; C = (st & 1) * 32 + (swz % 64) / 2; }
__host__ __device__ __forceinline__ int perm32(int rho) { const int n = rho >> 4, i = rho & 15; return 8 * (i >> 2) + 4 * n + (i & 3); }

struct Unit { int pm, pn; };
struct Gemm { const bf16_t* A; const bf16_t* Bt; int M, N, K; };

struct StaticOrder {
    int nM, nN, nwg, G, c;
    __host__ __device__ void init(int M, int N, int G_, int c_) { nM = M / BM; nN = N / BM; nwg = nM * nN; G = G_; c = c_; }
    __host__ __device__ bool next(int i, Unit& u) const {
        const long L = (long)i * G + c; if (L >= nwg) return false;
        int wgid = (int)L; { const int q = nwg / NXCD, r = nwg % NXCD, xcd = wgid % NXCD, off = wgid / NXCD; wgid = (xcd < r ? xcd * (q + 1) : r * (q + 1) + (xcd - r) * q) + off; }
        const int nig = WGM * nN, gid = wgid / nig, fm = gid * WGM, gsz = (nM - fm) < WGM ? (nM - fm) : WGM;
        u.pm = fm + ((wgid % nig) % gsz); u.pn = (wgid % nig) / gsz; return true;
    }
    __device__ __forceinline__ void a_ready(const Unit&) const {}
    __device__ __forceinline__ void done(const Unit&) const {}
};

__device__ __forceinline__ unsigned cvt_pk_bf16(float lo, float hi) { unsigned r; asm volatile("v_cvt_pk_bf16_f32 %0, %1, %2" : "=v"(r) : "v"(lo), "v"(hi)); return r; }
__device__ __forceinline__ float fast_sigmoid(float x) { return __builtin_amdgcn_rcpf(1.f + __builtin_amdgcn_exp2f(-1.4426950408889634f * x)); }
__device__ __forceinline__ u32x4 pack8(const f32x4 a, const f32x4 b) { u32x4 w; w.x = cvt_pk_bf16(a[0], a[1]); w.y = cvt_pk_bf16(a[2], a[3]); w.z = cvt_pk_bf16(b[0], b[1]); w.w = cvt_pk_bf16(b[2], b[3]); return w; }

struct EpiSwiglu {
    static constexpr bool PERM = true, AFTER_DRAIN = false;
    bf16_t* O; int ldo; const float* ss;
    __device__ __forceinline__ void operator()(const f32x4 (&acc)[2][2][4][2], const Unit& u, int wr, int wc, int fr, int fq) const {
        const int row0 = u.pm * BM + wr * 64 + fr, col0 = u.pn * HALF + wc * 32 + 8 * fq;
#pragma unroll
        for (int ai = 0; ai < 2; ++ai)
#pragma unroll
            for (int m = 0; m < 4; ++m) {
                f32x4 v[2]; const float rs = __builtin_amdgcn_rsqf(ss[row0 + ai * HALF + m * 16] * (1.f / 1024.f) + 1e-6f);
#pragma unroll
                for (int n = 0; n < 2; ++n) { const f32x4 g = acc[ai][0][m][n] * rs, up = acc[ai][1][m][n] * rs;
#pragma unroll
                    for (int e = 0; e < 4; ++e) v[n][e] = g[e] * fast_sigmoid(g[e]) * up[e]; }
                *(u32x4*)(O + (size_t)(row0 + ai * HALF + m * 16) * ldo + col0) = pack8(v[0], v[1]);
            }
    }
};

template <bool NORM, int ALPHA2  , int HIN, bool FOUT> struct EpiResid {
    static constexpr bool PERM = true, AFTER_DRAIN = false;
    const float* hin; float* hout; bf16_t* HB; float* ssout;
    __device__ __forceinline__ void operator()(const f32x4 (&acc)[2][2][4][2], const Unit& u, int wr, int wc, int fr, int fq) const {
        const int row0 = u.pm * BM + wr * 64 + fr, col0 = u.pn * BM + wc * 32 + 8 * fq; constexpr float alpha = 0.5f * ALPHA2;
#pragma unroll
        for (int ai = 0; ai < 2; ++ai) {
            u32x4 hv[4][2]; f32x4 xv[4][2][2];
#pragma unroll
            for (int m = 0; m < 4; ++m)
#pragma unroll
                for (int bj = 0; bj < 2; ++bj) { const size_t p = (size_t)(row0 + ai * HALF + m * 16) * 1024 + col0 + bj * HALF;
                    if (HIN == 0) { xv[m][bj][0] = *(const f32x4*)(hin + p); xv[m][bj][1] = *(const f32x4*)(hin + p + 4); } else hv[m][bj] = *(const u32x4*)(HB + p); }
#pragma unroll
            for (int m = 0; m < 4; ++m) {
                float sq = 0.f;
#pragma unroll
                for (int bj = 0; bj < 2; ++bj) {
                    const size_t p = (size_t)(row0 + ai * HALF + m * 16) * 1024 + col0 + bj * HALF;
                    f32x4 a0, a1;
                    if (HIN == 0) { a0 = xv[m][bj][0]; a1 = xv[m][bj][1]; }
                    else { const u32x4 w = hv[m][bj];
                        a0 = (f32x4){__builtin_bit_cast(float, w.x << 16), __builtin_bit_cast(float, w.x & 0xffff0000u), __builtin_bit_cast(float, w.y << 16), __builtin_bit_cast(float, w.y & 0xffff0000u)};
                        a1 = (f32x4){__builtin_bit_cast(float, w.z << 16), __builtin_bit_cast(float, w.z & 0xffff0000u), __builtin_bit_cast(float, w.w << 16), __builtin_bit_cast(float, w.w & 0xffff0000u)}; }
                    a0 = a0 + acc[ai][bj][m][0] * alpha; a1 = a1 + acc[ai][bj][m][1] * alpha;
                    if (FOUT) { *(f32x4*)(hout + p) = a0; *(f32x4*)(hout + p + 4) = a1; }
                    if (NORM) { *(u32x4*)(HB + p) = pack8(a0, a1);
                        sq += (a0[0] * a0[0] + a0[1] * a0[1]) + (a0[2] * a0[2] + a0[3] * a0[3]) + (a1[0] * a1[0] + a1[1] * a1[1]) + (a1[2] * a1[2] + a1[3] * a1[3]); }
                }
                if (NORM) { sq += __shfl_xor(sq, 16); sq += __shfl_xor(sq, 32);
                    if (fq == 0) __hip_atomic_fetch_add(ssout + row0 + ai * HALF + m * 16, sq, __ATOMIC_RELAXED, __HIP_MEMORY_SCOPE_AGENT); }
            }
        }
    }
};

struct EpiConvIn {
    static constexpr bool PERM = true, AFTER_DRAIN = false;
    bf16_t* Bg; bf16_t* U; const float* ss;
    __device__ __forceinline__ void operator()(const f32x4 (&acc)[2][2][4][2], const Unit& u, int wr, int wc, int fr, int fq) const {
        const int row0 = u.pm * BM + wr * 64 + fr;
        if (u.pn < 4) {
            const int col0 = u.pn * BM + wc * 32 + 8 * fq;
#pragma unroll
            for (int ai = 0; ai < 2; ++ai)
#pragma unroll
                for (int m = 0; m < 4; ++m)
#pragma unroll
                    for (int bj = 0; bj < 2; ++bj) { const float rs = __builtin_amdgcn_rsqf(ss[row0 + ai * HALF + m * 16] * (1.f / 1024.f) + 1e-6f);
                        *(u32x4*)(Bg + (size_t)(row0 + ai * HALF + m * 16) * 1024 + col0 + bj * HALF) = pack8(acc[ai][bj][m][0] * rs, acc[ai][bj][m][1] * rs); }
        } else {
            const int col0 = (u.pn - 4) * HALF + wc * 32 + 8 * fq;
#pragma unroll
            for (int ai = 0; ai < 2; ++ai)
#pragma unroll
                for (int m = 0; m < 4; ++m) { const float r2 = __builtin_amdgcn_rcpf(ss[row0 + ai * HALF + m * 16] * (1.f / 1024.f) + 1e-6f);
                    *(u32x4*)(U + (size_t)(row0 + ai * HALF + m * 16) * 1024 + col0) = pack8(acc[ai][0][m][0] * acc[ai][1][m][0] * r2, acc[ai][0][m][1] * acc[ai][1][m][1] * r2); }
        }
    }
};

struct EpiKV {
    static constexpr bool PERM = true, AFTER_DRAIN = false;
    bf16_t *Kb, *Vb; size_t brstride; const float* knorm; const float* ss;
    __device__ __forceinline__ void operator()(const f32x4 (&acc)[2][2][4][2], const Unit& u, int wr, int wc, int fr, int fq) const {
        const int br = u.pn >> 1, kv = u.pn & 1;
        const int row0 = u.pm * BM + wr * 64 + fr;
#pragma unroll
        for (int ai = 0; ai < 2; ++ai)
#pragma unroll
            for (int m = 0; m < 4; ++m) {
                const int row = row0 + ai * HALF + m * 16, b = row >> 13, s = row & 8191, bg = b * 4 + wc;
                const float rs = __builtin_amdgcn_rsqf(ss[row] * (1.f / 1024.f) + 1e-6f);
                if (kv == 0) {
                    float rstd = rs;
                    if (br > 0) { float ss = 0.f;
#pragma unroll
                        for (int bj = 0; bj < 2; ++bj)
#pragma unroll
                            for (int n = 0; n < 2; ++n)
#pragma unroll
                                for (int e = 0; e < 4; ++e) ss += acc[ai][bj][m][n][e] * acc[ai][bj][m][n][e];
                        ss += __shfl_xor(ss, 16); ss += __shfl_xor(ss, 32);
                        rstd = rs * __builtin_amdgcn_rsqf(ss * rs * rs * (1.f / 64.f) + 1e-6f); }
                    bf16_t* dst = Kb + (size_t)br * brstride + ((size_t)bg * 8192 + s) * 64 + 8 * fq;
#pragma unroll
                    for (int bj = 0; bj < 2; ++bj) {
                        f32x4 v0 = acc[ai][bj][m][0] * rstd, v1 = acc[ai][bj][m][1] * rstd;
                        if (br > 0) { const float* gp = knorm + br * 64 + bj * 32 + 8 * fq; v0 = v0 * *(const f32x4*)gp; v1 = v1 * *(const f32x4*)(gp + 4); }
                        *(u32x4*)(dst + bj * 32) = pack8(v0, v1);
                    }
                } else if (br == 0) {
                    bf16_t* dst = Vb + ((size_t)bg * 8192 + s) * 64 + 8 * fq;
#pragma unroll
                    for (int bj = 0; bj < 2; ++bj) *(u32x4*)(dst + bj * 32) = pack8(acc[ai][bj][m][0] * rs, acc[ai][bj][m][1] * rs);
                } else {
                    bf16_t* dst = Vb + (size_t)br * brstride + ((size_t)bg * 64 + 8 * fq) * 8192 + s;
#pragma unroll
                    for (int bj = 0; bj < 2; ++bj)
#pragma unroll
                        for (int n = 0; n < 2; ++n) { const f32x4 v = acc[ai][bj][m][n] * rs;
                            const unsigned p0 = cvt_pk_bf16(v[0], v[1]), p1 = cvt_pk_bf16(v[2], v[3]);
                            bf16_t* d = dst + (size_t)(bj * 32 + 4 * n) * 8192;
                            d[0] = (bf16_t)(p0 & 0xffffu); d[8192] = (bf16_t)(p0 >> 16); d[2 * 8192] = (bf16_t)(p1 & 0xffffu); d[3 * 8192] = (bf16_t)(p1 >> 16); }
                }
            }
    }
};

struct EpiQ {
    static constexpr bool PERM = true, AFTER_DRAIN = false;
    bf16_t* Q; float* gates; const float* qnorm; float qscale; const float* ss;
    __device__ __forceinline__ void operator()(const f32x4 (&acc)[2][2][4][2], const Unit& u, int wr, int wc, int fr, int fq) const {
        const int row0 = u.pm * BM + wr * 64 + fr;
        if (u.pn < 4) {
            const int head = u.pn * 4 + wc;
#pragma unroll
            for (int ai = 0; ai < 2; ++ai)
#pragma unroll
                for (int m = 0; m < 4; ++m) {
                    float ss = 0.f;
#pragma unroll
                    for (int bj = 0; bj < 2; ++bj)
#pragma unroll
                        for (int n = 0; n < 2; ++n)
#pragma unroll
                            for (int e = 0; e < 4; ++e) ss += acc[ai][bj][m][n][e] * acc[ai][bj][m][n][e];
                    ss += __shfl_xor(ss, 16); ss += __shfl_xor(ss, 32);
                    const float rs = __builtin_amdgcn_rsqf(this->ss[row0 + ai * HALF + m * 16] * (1.f / 1024.f) + 1e-6f);
                    const float rstd = rs * __builtin_amdgcn_rsqf(ss * rs * rs * (1.f / 64.f) + 1e-6f) * qscale;
                    bf16_t* dst = Q + (size_t)(row0 + ai * HALF + m * 16) * 1024 + head * 64 + 8 * fq;
#pragma unroll
                    for (int bj = 0; bj < 2; ++bj) { const float* gp = qnorm + bj * 32 + 8 * fq;
                        const f32x4 v0 = acc[ai][bj][m][0] * rstd * *(const f32x4*)gp, v1 = acc[ai][bj][m][1] * rstd * *(const f32x4*)(gp + 4);
                        *(u32x4*)(dst + bj * 32) = pack8(v0, v1); }
                }
        } else {
            if (wc < 2) {
#pragma unroll
                for (int ai = 0; ai < 2; ++ai)
#pragma unroll
                    for (int m = 0; m < 4; ++m) {
                        const int c0 = wc * 32 + 8 * fq;
                        if (c0 < 48) { float* dst = gates + (size_t)(row0 + ai * HALF + m * 16) * 48 + c0; const float rs = __builtin_amdgcn_rsqf(this->ss[row0 + ai * HALF + m * 16] * (1.f / 1024.f) + 1e-6f);
                            f32x4 a = acc[ai][0][m][0] * rs, b = acc[ai][0][m][1] * rs;
#pragma unroll
                            for (int e = 0; e < 4; ++e) { a[e] = fast_sigmoid(a[e]); b[e] = fast_sigmoid(b[e]); }
                            *(f32x4*)dst = a; *(f32x4*)(dst + 4) = b; }
                    }
            }
        }
    }
};
template <class Epi, class Sched, bool ALIGN_EPI = false, bool SP2 = false>
__device__ __forceinline__ void gemm_phase(PG8_LAS unsigned char* lds, const Gemm g, const Sched& S, const Epi& E) {
    int tid_ = threadIdx.x; asm volatile("" : "+v"(tid_));
    const int tid = tid_, wid = __builtin_amdgcn_readfirstlane(tid >> 6), lane = tid & 63, wr = wid >> 2, wc = wid & 3, fr = lane & 15, fq = lane >> 4;
    const int K = g.K, nt = K / BK;
    unsigned voffA[2], voffB[2];
#pragma unroll
    for (int i = 0; i < 2; ++i) { int R, C; stage_rc(tid * 16 + i * 8192, R, C); const int Rb = Epi::PERM ? ((R & ~31) + perm32(R & 31)) : R;
        voffA[i] = (unsigned)(R * K + C) * 2u; voffB[i] = (unsigned)(Rb * K + C) * 2u; }
    const size_t kstep = (size_t)(BK * 2);
    const size_t hstep = (size_t)HALF * K * 2;
    const size_t tstep = 2 * hstep;
    const unsigned ldsw = (unsigned)wid * 1024u;
    const int aoff = lds_byte(wr * 64 + fr, fq * 8), boff = lds_byte(wc * 32 + fr, fq * 8);
#define PG8_SA(b, h) (((b) * 2 + (h)) * HTB)
#define PG8_SB(b, h) ((4 + (b) * 2 + (h)) * HTB)
#define PG8_STAGE(bufoff, gbase, voff) do { _Pragma("unroll") for (int _i = 0; _i < 2; ++_i) \
        __builtin_amdgcn_global_load_lds((const unsigned*)((const char*)(gbase) + (voff)[_i]), (PG8_LAS unsigned*)(lds + (bufoff) + ldsw + _i * 8192), 16, 0, 0); } while (0)
#define PG8_LDA(dst, b, h) do { _Pragma("unroll") for (int m = 0; m < 4; ++m) _Pragma("unroll") for (int k = 0; k < 2; ++k) dst[m][k] = *(const PG8_LAS bf16x8*)(lds + PG8_SA(b, h) + aoff + m * 2048 + k * 1024); } while (0)
#define PG8_LDB(dst, b, h) do { _Pragma("unroll") for (int n = 0; n < 2; ++n) _Pragma("unroll") for (int k = 0; k < 2; ++k) dst[n][k] = *(const PG8_LAS bf16x8*)(lds + PG8_SB(b, h) + boff + n * 2048 + k * 1024); } while (0)
#define PG8_MMA(ai, bj, At, Bt) do { __builtin_amdgcn_s_setprio(1); _Pragma("unroll") for (int m = 0; m < 4; ++m) _Pragma("unroll") for (int n = 0; n < 2; ++n) _Pragma("unroll") for (int k = 0; k < 2; ++k) \
        acc[ai][bj][m][n] = __builtin_amdgcn_mfma_f32_16x16x32_bf16(Bt[n][k], At[m][k], acc[ai][bj][m][n], 0, 0, 0); __builtin_amdgcn_s_setprio(0); } while (0)
#define PG8_WAIT_V(n) asm volatile("s_waitcnt vmcnt(" #n ")" ::: "memory")
#define PG8_WAIT_L(n) asm volatile("s_waitcnt lgkmcnt(" #n ")" ::: "memory")
#define PG8_BAR __builtin_amdgcn_s_barrier()
#define PG8_SCHED __builtin_amdgcn_sched_barrier(0)
    Unit cur, nxt; int ui = 0;
    if (!S.next(0, cur)) return;
    f32x4 acc[2][2][4][2];
#pragma unroll
    for (int a = 0; a < 2; ++a)
#pragma unroll
        for (int b = 0; b < 2; ++b)
#pragma unroll
            for (int m = 0; m < 4; ++m)
#pragma unroll
                for (int n = 0; n < 2; ++n) acc[a][b][m][n] = (f32x4){0.f, 0.f, 0.f, 0.f};
    bf16x8 At[4][2], B0[2][2], B1[2][2];
    const char* cA = (const char*)g.A + (size_t)cur.pm * tstep; const char* cB = (const char*)g.Bt + (size_t)cur.pn * tstep;
    S.a_ready(cur);
    if constexpr (SP2) {
        PG8_STAGE(PG8_SB(0, 0), cB, voffB); PG8_STAGE(PG8_SB(0, 1), cB + hstep, voffB); PG8_STAGE(PG8_SA(0, 0), cA, voffA); PG8_STAGE(PG8_SA(0, 1), cA + hstep, voffA);
        if (wr == 1) PG8_BAR;
        PG8_WAIT_V(2); PG8_BAR;
        PG8_STAGE(PG8_SB(1, 0), cB + kstep, voffB); PG8_STAGE(PG8_SA(1, 0), cA + kstep, voffA); PG8_STAGE(PG8_SB(1, 1), cB + hstep + kstep, voffB);
        PG8_WAIT_V(6); PG8_BAR;
    } else {
        PG8_STAGE(PG8_SB(0, 0), cB, voffB); PG8_STAGE(PG8_SA(0, 0), cA, voffA); PG8_STAGE(PG8_SB(0, 1), cB + hstep, voffB); PG8_STAGE(PG8_SA(0, 1), cA + hstep, voffA);
        if (wr == 1) PG8_BAR;
        PG8_WAIT_V(4); PG8_BAR;
        PG8_STAGE(PG8_SB(1, 0), cB + kstep, voffB); PG8_STAGE(PG8_SA(1, 0), cA + kstep, voffA); PG8_STAGE(PG8_SB(1, 1), cB + hstep + kstep, voffB);
        PG8_WAIT_V(6); PG8_BAR;
    }
    for (;;) {
        const bool has_next = S.next(ui + 1, nxt);
        const char* nA = has_next ? (const char*)g.A + (size_t)nxt.pm * tstep : cA; const char* nB = has_next ? (const char*)g.Bt + (size_t)nxt.pn * tstep : cB;
        for (int t = 0; t < nt; t += 2) {
            const bool last = (t == nt - 2);
            const char* a1 = cA + (size_t)(t + 1) * kstep;
            const char* a2 = last ? nA : cA + (size_t)(t + 2) * kstep; const char* b2 = last ? nB : cB + (size_t)(t + 2) * kstep;
            const char* a3 = a2 + kstep; const char* b3 = b2 + kstep;
            if (last && has_next) S.a_ready(nxt);
            if constexpr (SP2) {
            PG8_LDB(B0, 0, 0); PG8_LDB(B1, 0, 1); PG8_SCHED; PG8_LDA(At, 0, 0); PG8_STAGE(PG8_SA(1, 1), a1 + hstep, voffA);
            PG8_WAIT_V(8); PG8_WAIT_L(0); PG8_BAR; PG8_MMA(0, 0, At, B0); PG8_MMA(0, 1, At, B1); PG8_BAR; PG8_SCHED;
            PG8_LDA(At, 0, 1); PG8_STAGE(PG8_SB(0, 0), b2, voffB); PG8_STAGE(PG8_SB(0, 1), b2 + hstep, voffB); PG8_STAGE(PG8_SA(0, 0), a2, voffA);
            PG8_WAIT_V(8); PG8_WAIT_L(0); PG8_BAR; PG8_MMA(1, 0, At, B0); PG8_MMA(1, 1, At, B1); PG8_BAR; PG8_SCHED;
            PG8_LDB(B0, 1, 0); PG8_LDB(B1, 1, 1); PG8_SCHED; PG8_LDA(At, 1, 0); PG8_STAGE(PG8_SA(0, 1), a2 + hstep, voffA);
            PG8_WAIT_V(8); PG8_WAIT_L(0); PG8_BAR; PG8_MMA(0, 0, At, B0); PG8_MMA(0, 1, At, B1); PG8_BAR; PG8_SCHED;
            PG8_LDA(At, 1, 1); PG8_STAGE(PG8_SB(1, 0), b3, voffB); PG8_STAGE(PG8_SB(1, 1), b3 + hstep, voffB); PG8_STAGE(PG8_SA(1, 0), a3, voffA);
            PG8_WAIT_V(8); PG8_WAIT_L(0); PG8_BAR; PG8_MMA(1, 0, At, B0); PG8_MMA(1, 1, At, B1); PG8_BAR; PG8_SCHED;
            } else {
            PG8_LDB(B0, 0, 0); PG8_SCHED; PG8_LDA(At, 0, 0); PG8_STAGE(PG8_SA(1, 1), a1 + hstep, voffA);
            PG8_WAIT_L(8); PG8_BAR; PG8_WAIT_L(0); PG8_MMA(0, 0, At, B0); PG8_BAR; PG8_SCHED;
            PG8_LDB(B1, 0, 1); PG8_STAGE(PG8_SB(0, 0), b2, voffB);
            PG8_BAR; PG8_WAIT_L(0); PG8_MMA(0, 1, At, B1); PG8_BAR;
            PG8_LDA(At, 0, 1); PG8_STAGE(PG8_SA(0, 0), a2, voffA);
            PG8_BAR; PG8_WAIT_L(0); PG8_MMA(1, 0, At, B0); PG8_BAR; PG8_SCHED;
            PG8_STAGE(PG8_SB(0, 1), b2 + hstep, voffB);
            PG8_WAIT_V(6); PG8_BAR; PG8_MMA(1, 1, At, B1); PG8_BAR;
            PG8_LDB(B0, 1, 0); PG8_SCHED; PG8_LDA(At, 1, 0); PG8_STAGE(PG8_SA(0, 1), a2 + hstep, voffA);
            PG8_WAIT_L(8); PG8_BAR; PG8_WAIT_L(0); PG8_MMA(0, 0, At, B0); PG8_BAR; PG8_SCHED;
            PG8_LDB(B1, 1, 1); PG8_STAGE(PG8_SB(1, 0), b3, voffB);
            PG8_BAR; PG8_WAIT_L(0); PG8_MMA(0, 1, At, B1); PG8_BAR;
            PG8_LDA(At, 1, 1); PG8_STAGE(PG8_SA(1, 0), a3, voffA);
            PG8_BAR; PG8_WAIT_L(0); PG8_MMA(1, 0, At, B0); PG8_BAR; PG8_SCHED;
            PG8_STAGE(PG8_SB(1, 1), b3 + hstep, voffB);
            PG8_WAIT_V(6); PG8_BAR; PG8_MMA(1, 1, At, B1); PG8_BAR;
            }
        }
        if constexpr (ALIGN_EPI) { if (wr == 0) PG8_BAR; }
        if constexpr (!Epi::AFTER_DRAIN) { E(acc, cur, wr, wc, fr, fq); S.done(cur); }
        if (!has_next) break;
#pragma unroll
        for (int a = 0; a < 2; ++a)
#pragma unroll
            for (int b = 0; b < 2; ++b)
#pragma unroll
                for (int m = 0; m < 4; ++m)
#pragma unroll
                    for (int n = 0; n < 2; ++n) acc[a][b][m][n] = (f32x4){0.f, 0.f, 0.f, 0.f};
        cur = nxt; cA = nA; cB = nB; ++ui;
        if constexpr (ALIGN_EPI) { if (wr == 1) PG8_BAR; }
    }
    PG8_WAIT_V(0);
    if constexpr (!ALIGN_EPI) { if (wr == 0) PG8_BAR; }
    PG8_BAR;
    if constexpr (Epi::AFTER_DRAIN) { E.fused(acc, cur, wr, wc, fr, fq, lds, wid, lane); S.done(cur); }
#undef PG8_SA
#undef PG8_SB
#undef PG8_STAGE
#undef PG8_LDA
#undef PG8_LDB
#undef PG8_MMA
#undef PG8_WAIT_V
#undef PG8_WAIT_L
#undef PG8_BAR
#undef PG8_SCHED
}
}

#define LAS __attribute__((address_space(3)))
typedef unsigned short bf16;
typedef float f32x4 __attribute__((ext_vector_type(4)));
typedef short bf16x8 __attribute__((ext_vector_type(8)));
typedef unsigned u32x4 __attribute__((ext_vector_type(4)));
typedef unsigned long long u64;

constexpr int NB = 4, SEQ = 8192, DM = 1024, T = NB * SEQ, DFF = 2816, NH = 16, NG = 4, HD = 64;
constexpr int NQP = 1280;
constexpr int NKV = 1536;
constexpr int NCB = 512;
constexpr float RMS_EPS = 1e-6f;
constexpr float LOG2E = 1.4426950408889634f;
constexpr int LDS_BYTES = 151552;

constexpr size_t MiB = 1u << 20;
constexpr size_t SZ_WIN = (size_t)2 * DFF * DM * 2, SZ_WOUT = (size_t)DM * DFF * 2;
constexpr size_t WS_WIN = 1 * MiB;
constexpr size_t WS_WOUT = WS_WIN + 4 * SZ_WIN;
constexpr size_t WS_CWIN = WS_WOUT + 4 * SZ_WOUT;
constexpr size_t WS_CWOUT = WS_CWIN + (size_t)3072 * 1024 * 2;
constexpr size_t WS_WQ = WS_CWOUT + (size_t)1024 * 1024 * 2;
constexpr size_t WS_WO = WS_WQ + (size_t)NQP * 1024 * 2;
constexpr size_t WS_WKV = WS_WO + (size_t)1024 * 1024 * 2;
constexpr size_t WS_W1K = WS_WKV + (size_t)NKV * 1024 * 2;
constexpr size_t WS_W1V = WS_W1K + (size_t)128 * 2048 * 2;
constexpr size_t WS_W2K = WS_W1V + (size_t)128 * 2048 * 2;
constexpr size_t WS_W2V = WS_W2K + (size_t)64 * 128 * 2;
constexpr size_t WS_B1 = WS_W2V + (size_t)64 * 128 * 2;
constexpr size_t WS_WEND = WS_B1 + 1024;
static_assert(WS_WEND <= 90 * MiB, "weights region");
constexpr size_t WS_HN = 96 * MiB;
constexpr size_t WS_HN2 = 160 * MiB;
constexpr size_t WS_ACT = 224 * MiB;
constexpr size_t WS_BG = WS_ACT, WS_U = WS_ACT + 64 * MiB;
constexpr size_t WS_Q = WS_ACT;
constexpr size_t KV_BYTES = (size_t)16 * SEQ * 64 * 2;
constexpr size_t WS_KCR = 400 * MiB, WS_KS = WS_KCR + KV_BYTES, WS_KW = WS_KS + KV_BYTES;
constexpr size_t WS_VCR = WS_KW + KV_BYTES, WS_VST = WS_VCR + KV_BYTES, WS_VWT = WS_VST + KV_BYTES;
constexpr size_t WS_KC = 90 * MiB, WS_VCT = 91 * MiB;
constexpr size_t WS_GATES = WS_VWT + KV_BYTES;
constexpr size_t WS_AO = WS_HN2;
constexpr size_t WS_END = WS_GATES + 6 * MiB;
static_assert(WS_END <= 512 * MiB, "workspace");

struct Args {
    const float* in[24];
    float* out; unsigned char* ws;
};
typedef const __attribute__((address_space(4))) Args* KArgsP;
__device__ __forceinline__ KArgsP KA() { KArgsP p = (KArgsP)__builtin_amdgcn_kernarg_segment_ptr(); asm volatile("" : "+s"(p)); return p; }
#define IN(i) ((const float*)KA()->in[i])
#define WSP ((unsigned char*)KA()->ws)

typedef float f32x2_t __attribute__((ext_vector_type(2)));
typedef __bf16 bf16x2_t __attribute__((ext_vector_type(2)));
__device__ __forceinline__ unsigned cvt_pk(float lo, float hi) { const f32x2_t v = {lo, hi}; const bf16x2_t b = __builtin_convertvector(v, bf16x2_t); return __builtin_bit_cast(unsigned, b); }
__device__ __forceinline__ float bf2f(unsigned short b) { return __builtin_bit_cast(float, (unsigned)b << 16); }
__device__ __forceinline__ float wave_sum(float v) {
#pragma unroll
    for (int o = 1; o < 64; o <<= 1) v += __shfl_xor(v, o);
    return v;
}
__device__ __forceinline__ float wave_max(float v) {
#pragma unroll
    for (int o = 1; o < 64; o <<= 1) v = fmaxf(v, __shfl_xor(v, o));
    return v;
}

enum { MK_IDENT = 0, MK_FFN_IN = 1, MK_CONV_IN = 2, MK_HEADPERM = 3, MK_Q = 4 };
__device__ __forceinline__ int srcmap(int kind, int np) {
    const int pn = np >> 8, r = np & 255, bj = r >> 7, c = r & 127;
    if (kind == MK_FFN_IN) return bj * DFF + 128 * pn + c;
    if (kind == MK_CONV_IN) return pn < 4 ? np : 1024 * (1 + bj) + 128 * (pn - 4) + c;
    if (kind == MK_HEADPERM) return 256 * pn + 64 * (c >> 5) + 32 * bj;
    if (kind == MK_Q) return pn < 4 ? 256 * pn + 64 * (c >> 5) + 32 * bj : (r < 32 ? 1024 : (r < 64 ? 1056 : -1));
    return np;
}
struct MatDesc { const float* W; bf16* WT; int K, N, NP, kind; const float* gain; };

__device__ __forceinline__ void prep_load(const MatDesc& d, int item, int tid, float (&v)[16]) {
    const int nblk = d.NP >> 6, kb = item / nblk, nb = item - kb * nblk;
    const int n = tid & 31, kk = tid >> 5;
#pragma unroll
    for (int s = 0; s < 2; ++s) {
        const int sc = srcmap(d.kind, nb * 64 + s * 32);
        const bool ok = sc >= 0 && (sc + n) < d.N;
        const float* p = d.W + (size_t)(kb * 128 + kk) * d.N + sc + n;
#pragma unroll
        for (int i = 0; i < 8; ++i) v[s * 8 + i] = ok ? p[(size_t)(16 * i) * d.N] * (d.gain ? d.gain[kb * 128 + kk + 16 * i] : 1.f) : 0.f;
    }
}
__device__ __forceinline__ void prep_store_lds(LAS float* scr, int tid, const float (&v)[16]) {
    const int n = tid & 31, kk = tid >> 5;
#pragma unroll
    for (int s = 0; s < 2; ++s)
#pragma unroll
        for (int i = 0; i < 8; ++i) scr[(kk + 16 * i) * 65 + s * 32 + n] = v[s * 8 + i];
}
__device__ __forceinline__ void prep_write(const MatDesc& d, int item, int tid, const LAS float* scr) {
    const int nblk = d.NP >> 6, kb = item / nblk, nb = item - kb * nblk;
#pragma unroll
    for (int s = 0; s < 2; ++s) {
        const int n = (tid >> 4) + 32 * s, c = tid & 15;
        const LAS float* p = scr + (8 * c) * 65 + n;
        u32x4 o; o.x = cvt_pk(p[0], p[65]); o.y = cvt_pk(p[2 * 65], p[3 * 65]); o.z = cvt_pk(p[4 * 65], p[5 * 65]); o.w = cvt_pk(p[6 * 65], p[7 * 65]);
        *(u32x4*)(d.WT + (size_t)(nb * 64 + n) * d.K + kb * 128 + 8 * c) = o;
    }
}

__device__ __forceinline__ MatDesc get_mat(const Args& a, int mi) {
    unsigned char* ws = WSP;
    MatDesc d; d.gain = nullptr;
    if (mi < 4) { const int layer = mi >> 1, f2 = mi & 1;
        d.gain = IN(f2 ? 5 : 1) + layer * DM;
        d.W = IN(f2 ? 6 : 2) + (size_t)layer * DM * 2 * DFF; d.WT = (bf16*)(ws + WS_WIN + (size_t)mi * SZ_WIN); d.K = DM; d.N = 2 * DFF; d.NP = 2 * DFF; d.kind = MK_FFN_IN; return d; }
    if (mi < 8) { const int s = mi - 4, layer = s >> 1, f2 = s & 1;
        d.W = IN(f2 ? 7 : 3) + (size_t)layer * DFF * DM; d.WT = (bf16*)(ws + WS_WOUT + (size_t)s * SZ_WOUT); d.K = DFF; d.N = DM; d.NP = DM; d.kind = MK_IDENT; return d; }
    switch (mi) {
    case 8:  d.W = IN(8);  d.WT = (bf16*)(ws + WS_CWIN);  d.K = DM; d.N = 3072; d.NP = 3072; d.kind = MK_CONV_IN; d.gain = IN(4); break;
    case 9:  d.W = IN(10); d.WT = (bf16*)(ws + WS_CWOUT); d.K = DM; d.N = DM;   d.NP = DM;   d.kind = MK_IDENT; break;
    case 10: d.W = IN(11); d.WT = (bf16*)(ws + WS_WQ);    d.K = DM; d.N = 1072; d.NP = NQP;  d.kind = MK_Q; d.gain = IN(4) + DM; break;
    case 11: d.W = IN(13); d.WT = (bf16*)(ws + WS_WO);    d.K = DM; d.N = DM;   d.NP = DM;   d.kind = MK_IDENT; break;
    case 12: d.W = IN(15); d.WT = (bf16*)(ws + WS_WKV);   d.K = DM; d.N = NKV;  d.NP = NKV;  d.kind = MK_HEADPERM; d.gain = IN(14); break;
    case 13: d.W = IN(19); d.WT = (bf16*)(ws + WS_W1K);   d.K = 2048; d.N = 128; d.NP = 128; d.kind = MK_IDENT; break;
    case 14: d.W = IN(21); d.WT = (bf16*)(ws + WS_W1V);   d.K = 2048; d.N = 128; d.NP = 128; d.kind = MK_IDENT; break;
    case 15: d.W = IN(20); d.WT = (bf16*)(ws + WS_W2K);   d.K = 128; d.N = 64; d.NP = 64; d.kind = MK_IDENT; break;
    default: d.W = IN(22); d.WT = (bf16*)(ws + WS_W2V);   d.K = 128; d.N = 64; d.NP = 64; d.kind = MK_IDENT; break;
    }
    return d;
}
constexpr int N_MATS = 17;
__device__ __forceinline__ int mat_items(int mi) {
    if (mi < 4) return 8 * 88; if (mi < 8) return 22 * 16;
    switch (mi) { case 8: return 8 * 48; case 9: return 8 * 16; case 10: return 8 * 20; case 11: return 8 * 16; case 12: return 8 * 24; case 13: case 14: return 16 * 2; default: return 1; }
}
__device__ __forceinline__ bool prep_locate(int g, int& mi, int& item) {
    for (int m = 0; m < N_MATS; ++m) { const int n = mat_items(m); if (g < n) { mi = m; item = g; return true; } g -= n; }
    return false;
}

__device__ __forceinline__ void phase_prep(const Args& a, LAS unsigned char* lds) {
    LAS float* scr = (LAS float*)lds;
    int tid_ = threadIdx.x; asm volatile("" : "+v"(tid_)); const int tid = tid_, G = gridDim.x;
    float v[16]; int mi, item;
    int g = blockIdx.x;
    bool have = prep_locate(g, mi, item);
    MatDesc d = {};
    if (have) { d = get_mat(a, mi); prep_load(d, item, tid, v); }
    while (have) {
        prep_store_lds(scr, tid, v);
        __syncthreads();
        const MatDesc dc = d; const int itc = item;
        g += G; have = prep_locate(g, mi, item);
        if (have) { d = get_mat(a, mi); prep_load(d, item, tid, v); }
        prep_write(dc, itc, tid, scr);
        __syncthreads();
    }
    if (blockIdx.x < 2) {
        const int kv = blockIdx.x; const float* pe = IN(kv ? 18 : 17); const float* w1 = IN(kv ? 21 : 19);
        const int col = tid & 127, part = tid >> 7; float s = 0.f;
        for (int k = part * 512; k < part * 512 + 512; ++k) s += pe[k] * w1[(size_t)k * 128 + col];
        scr[tid] = s; __syncthreads();
        if (tid < 128) ((float*)(WSP + WS_B1))[kv * 128 + tid] = scr[tid] + scr[tid + 128] + scr[tid + 256] + scr[tid + 384];
        __syncthreads();
    }
}

__device__ __forceinline__ void phase_norm(const float* h, const float* g1, bf16* o1, const float* g2, bf16* o2) {
    int tid_ = threadIdx.x; asm volatile("" : "+v"(tid_));
    const int lane = tid_ & 63, wave = tid_ >> 6;
    const int gw = blockIdx.x * 8 + wave, NGW = gridDim.x * 8;
    f32x4 ga[4], gb[4];
#pragma unroll
    for (int j = 0; j < 4; ++j) { ga[j] = *(const f32x4*)(g1 + 4 * lane + 256 * j); gb[j] = g2 ? *(const f32x4*)(g2 + 4 * lane + 256 * j) : ga[j]; }
    for (int m = gw; m < T; m += NGW) {
        const f32x4* xr = (const f32x4*)(h + (size_t)m * DM) + lane;
        f32x4 v[4]; float s = 0.f;
#pragma unroll
        for (int j = 0; j < 4; ++j) { v[j] = xr[64 * j]; s += (v[j].x * v[j].x + v[j].y * v[j].y) + (v[j].z * v[j].z + v[j].w * v[j].w); }
        const float rstd = __builtin_amdgcn_rsqf(wave_sum(s) * (1.f / DM) + RMS_EPS);
        u64* p1 = (u64*)(o1 + (size_t)m * DM) + lane;
#pragma unroll
        for (int j = 0; j < 4; ++j) { const f32x4 y = v[j] * rstd * ga[j]; p1[64 * j] = (u64)cvt_pk(y.x, y.y) | ((u64)cvt_pk(y.z, y.w) << 32); }
        if (g2) { u64* p2 = (u64*)(o2 + (size_t)m * DM) + lane;
#pragma unroll
            for (int j = 0; j < 4; ++j) { const f32x4 y = v[j] * rstd * gb[j]; p2[64 * j] = (u64)cvt_pk(y.x, y.y) | ((u64)cvt_pk(y.z, y.w) << 32); } }
    }
}

constexpr size_t WS_SS = 131072;
__device__ __forceinline__ void phase_x(const float* x, bf16* hb, float* ss) {
    int tid_ = threadIdx.x; asm volatile("" : "+v"(tid_));
    const int lane = tid_ & 63, wave = tid_ >> 6;
    const int gw = blockIdx.x * 8 + wave, NGW = gridDim.x * 8;
    for (int i = blockIdx.x * 512 + tid_; i < 5 * T; i += gridDim.x * 512) ss[T + i] = 0.f;
    for (int m = gw; m < T; m += NGW) {
        const f32x4* xr = (const f32x4*)(x + (size_t)m * DM) + lane;
        f32x4 v[4]; float s = 0.f;
#pragma unroll
        for (int j = 0; j < 4; ++j) { v[j] = xr[64 * j]; s += (v[j].x * v[j].x + v[j].y * v[j].y) + (v[j].z * v[j].z + v[j].w * v[j].w); }
        s = wave_sum(s);
        u64* p1 = (u64*)(hb + (size_t)m * DM) + lane;
#pragma unroll
        for (int j = 0; j < 4; ++j) p1[64 * j] = (u64)cvt_pk(v[j].x, v[j].y) | ((u64)cvt_pk(v[j].z, v[j].w) << 32);
        if (lane == 0) ss[m] = s;
    }
}

__device__ __forceinline__ void unpack8(const u32x4 w, float (&f)[8]) {
    f[0] = __builtin_bit_cast(float, w.x << 16); f[1] = __builtin_bit_cast(float, w.x & 0xffff0000u); f[2] = __builtin_bit_cast(float, w.y << 16); f[3] = __builtin_bit_cast(float, w.y & 0xffff0000u);
    f[4] = __builtin_bit_cast(float, w.z << 16); f[5] = __builtin_bit_cast(float, w.z & 0xffff0000u); f[6] = __builtin_bit_cast(float, w.w << 16); f[7] = __builtin_bit_cast(float, w.w & 0xffff0000u);
}
__device__ __forceinline__ void phase_conv(const bf16* Bg, const bf16* U, const float* cw, bf16* Z) {
    int tid_ = threadIdx.x; asm volatile("" : "+v"(tid_));
    const int tid = tid_, cc = tid & 127, trow = tid >> 7;
    float w0[8], w1[8], w2[8];
#pragma unroll
    for (int e = 0; e < 8; ++e) { w0[e] = cw[8 * cc + e]; w1[e] = cw[1024 + 8 * cc + e]; w2[e] = cw[2048 + 8 * cc + e]; }
    for (int tb = blockIdx.x; tb < T / 128; tb += gridDim.x) {
        const int tbeg = tb * 128 + trow * 32;
        float u1[8], u2[8];
        if ((tbeg & (SEQ - 1)) == 0) {
#pragma unroll
            for (int e = 0; e < 8; ++e) { u1[e] = 0.f; u2[e] = 0.f; }
        } else {
            unpack8(*(const u32x4*)(U + (size_t)(tbeg - 1) * DM + 8 * cc), u1);
            unpack8(*(const u32x4*)(U + (size_t)(tbeg - 2) * DM + 8 * cc), u2);
        }
#pragma unroll 4
        for (int i = 0; i < 32; ++i) {
            const size_t p = (size_t)(tbeg + i) * DM + 8 * cc;
            float u0[8], bgv[8], z[8];
            unpack8(*(const u32x4*)(U + p), u0); unpack8(*(const u32x4*)(Bg + p), bgv);
#pragma unroll
            for (int e = 0; e < 8; ++e) { z[e] = bgv[e] * (w0[e] * u2[e] + w1[e] * u1[e] + w2[e] * u0[e]); u2[e] = u1[e]; u1[e] = u0[e]; }
            u32x4 o; o.x = cvt_pk(z[0], z[1]); o.y = cvt_pk(z[2], z[3]); o.z = cvt_pk(z[4], z[5]); o.w = cvt_pk(z[6], z[7]);
            *(u32x4*)(Z + p) = o;
        }
    }
}

__device__ __forceinline__ void phase_compress(const Args& a, LAS unsigned char* lds, size_t off_kc = WS_KC, size_t off_vct = WS_VCT) {
    unsigned char* ws = WSP;
    int tid_ = threadIdx.x; asm volatile("" : "+v"(tid_));
    const int tid = tid_, lane = tid & 63, w = tid >> 6, lc = lane & 15, lg = lane >> 4;
    LAS bf16* hid = (LAS bf16*)lds;
    LAS float* outf = (LAS float*)(lds + 32 * 136 * 2);
    for (int u2 = blockIdx.x * 2; u2 < 512; u2 += gridDim.x * 2)
    for (int uu = u2; uu < u2 + 2; ++uu) {
        const int kv = uu >> 8, R0 = (uu & 255) * 32;
        const bf16* raw = (const bf16*)(ws + (kv ? WS_VCR : WS_KCR));
        const bf16* w1t = (const bf16*)(ws + (kv ? WS_W1V : WS_W1K));
        const bf16* w2t = (const bf16*)(ws + (kv ? WS_W2V : WS_W2K));
        const float* b1 = (const float*)(ws + WS_B1) + kv * 128;
        f32x4 acc[2] = {{0.f, 0.f, 0.f, 0.f}, {0.f, 0.f, 0.f, 0.f}};
        const bf16* ap0 = raw + (size_t)(R0 + lc) * 1024 + 8 * lg;
        const bf16* ap1 = ap0 + (size_t)16 * 1024;
        const bf16* bp = w1t + (size_t)(16 * w + lc) * 2048 + 8 * lg;
        bf16x8 A0[4], A1[4], B[4];
#pragma unroll
        for (int s = 0; s < 4; ++s) { A0[s] = *(const bf16x8*)(ap0 + 32 * s); A1[s] = *(const bf16x8*)(ap1 + 32 * s); B[s] = *(const bf16x8*)(bp + 32 * s); }
        for (int k0 = 0; k0 < 2048; k0 += 128) {
            bf16x8 nA0[4], nA1[4], nB[4];
            const int kn = (k0 + 128 < 2048) ? k0 + 128 : k0;
#pragma unroll
            for (int s = 0; s < 4; ++s) { nA0[s] = *(const bf16x8*)(ap0 + kn + 32 * s); nA1[s] = *(const bf16x8*)(ap1 + kn + 32 * s); nB[s] = *(const bf16x8*)(bp + kn + 32 * s); }
#pragma unroll
            for (int s = 0; s < 4; ++s) { acc[0] = __builtin_amdgcn_mfma_f32_16x16x32_bf16(A0[s], B[s], acc[0], 0, 0, 0); acc[1] = __builtin_amdgcn_mfma_f32_16x16x32_bf16(A1[s], B[s], acc[1], 0, 0, 0); }
#pragma unroll
            for (int s = 0; s < 4; ++s) { A0[s] = nA0[s]; A1[s] = nA1[s]; B[s] = nB[s]; }
        }
        { const int col = 16 * w + lc; const float bb = b1[col];
#pragma unroll
          for (int rt = 0; rt < 2; ++rt)
#pragma unroll
            for (int r = 0; r < 4; ++r) { const float x = acc[rt][r] + bb; const float y = 2.f * 0.7978845608028654f * (x + 0.044715f * x * x * x);
                const float gl = x * __builtin_amdgcn_rcpf(1.f + __builtin_amdgcn_exp2f(-LOG2E * y));
                hid[(16 * rt + 4 * lg + r) * 136 + col] = (bf16)(cvt_pk(gl, 0.f) & 0xffffu); } }
        __syncthreads();
        { const int rt = w >> 2, ct = w & 3; f32x4 o = {0.f, 0.f, 0.f, 0.f};
#pragma unroll
          for (int ks = 0; ks < 4; ++ks) { const bf16x8 A = *(const LAS bf16x8*)(hid + (16 * rt + lc) * 136 + 32 * ks + 8 * lg); const bf16x8 B = *(const bf16x8*)(w2t + (size_t)(16 * ct + lc) * 128 + 32 * ks + 8 * lg);
              o = __builtin_amdgcn_mfma_f32_16x16x32_bf16(A, B, o, 0, 0, 0); }
#pragma unroll
          for (int r = 0; r < 4; ++r) outf[(16 * rt + 4 * lg + r) * 65 + 16 * ct + lc] = o[r]; }
        __syncthreads();
        { const int row = tid >> 4, d0 = 4 * (tid & 15); const int R = R0 + row, bg = R >> 9, i = R & 511;
          float v[4]; float ss = 0.f;
#pragma unroll
          for (int e = 0; e < 4; ++e) { v[e] = outf[row * 65 + d0 + e]; ss += v[e] * v[e]; }
          if (kv == 0) {
              ss += __shfl_xor(ss, 1); ss += __shfl_xor(ss, 2); ss += __shfl_xor(ss, 4); ss += __shfl_xor(ss, 8);
              const float rstd = __builtin_amdgcn_rsqf(ss * (1.f / 64.f) + RMS_EPS); const float* kn = IN(16);
#pragma unroll
              for (int e = 0; e < 4; ++e) v[e] = (i == 511) ? 0.f : v[e] * rstd * kn[d0 + e];
              bf16* dst = (bf16*)(ws + off_kc) + ((size_t)bg * NCB + i) * 64 + d0;
              *(u64*)dst = (u64)cvt_pk(v[0], v[1]) | ((u64)cvt_pk(v[2], v[3]) << 32);
          } else {
              bf16* dst = (bf16*)(ws + off_vct) + ((size_t)bg * 64 + d0) * NCB + i;
#pragma unroll
              for (int e = 0; e < 4; ++e) dst[(size_t)e * NCB] = (i == 511) ? (bf16)0 : (bf16)(cvt_pk(v[e], 0.f) & 0xffffu);
          } }
        __syncthreads();
    }
}

constexpr int A_IMP = 0, A_RING = 32768, TILE_PITCH = 192  , TILE_B = 64 * TILE_PITCH, STAGE_B = 2 * TILE_B,
              A_SELQ = A_RING + 2 * STAGE_B, A_BIAS = A_SELQ + 1024, A_MB = A_BIAS + 512, A_OUT = A_MB + 512;
constexpr int RELMAX_BIG = 0x40000000;

template <int MODE, int BM = 0, bool SEL = false>
__device__ __forceinline__ void attn_core(const bf16x8 (&kf)[4][2], const bf16x8 (&vf)[4][2], const bf16x8 (&qf)[2], int tq, int pbase, int pstride, int relmax,
                                          const LAS float* biasrow, float pscale, f32x4 (&oacc)[4], float& lsum, LAS float* improw, int jbase, int lg, int h, float pbias = 0.f, float pbias2 = 0.f, int thr = 0) {
    f32x4 s[4];
#pragma unroll
    for (int kt = 0; kt < 4; ++kt) {
        s[kt] = __builtin_amdgcn_mfma_f32_16x16x32_bf16(kf[kt][0], qf[0], (f32x4){0.f, 0.f, 0.f, 0.f}, 0, 0, 0);
        s[kt] = __builtin_amdgcn_mfma_f32_16x16x32_bf16(kf[kt][1], qf[1], s[kt], 0, 0, 0);
    }
#pragma unroll
    for (int kt = 0; kt < 4; ++kt) {
        const int kap0 = 32 * (kt >> 1) + 8 * lg + 4 * (kt & 1);
        const int rel0 = tq - (pbase + kap0 * pstride);
#pragma unroll
        for (int r = 0; r < 4; ++r) {
            float p;
            if (BM == 1) {
                p = __builtin_amdgcn_exp2f(s[kt][r] + pbias);
            } else if (BM == 2) {
                const int rel = rel0 - r * pstride;
                p = __builtin_amdgcn_exp2f(s[kt][r] + (rel >= thr ? pbias2 : pbias));
            } else if (BM == 3) {
                const int rel = rel0 - r * pstride;
                int bk = 39 - __clz((int)__umul24((unsigned)rel, (unsigned)rel)); bk = bk > 31 ? 31 : bk;
                p = __builtin_amdgcn_exp2f(s[kt][r] + biasrow[bk]);
                if (SEL) p = tq >= 0 ? p : 0.f;
            } else {
            const int rel = rel0 - r * pstride;
            const bool valid = (unsigned)rel < (unsigned)relmax;
            const int n = valid ? rel : 0;
            const int nn = (int)__umul24((unsigned)n, (unsigned)n);
            int bk = 39 - __clz(nn); bk = bk > 31 ? 31 : bk; bk = n < 16 ? n : bk;
            const float x = s[kt][r] + biasrow[bk];
            p = valid ? __builtin_amdgcn_exp2f(x) : 0.f;
            }
            if (MODE == 2) p *= pscale;
            s[kt][r] = p; lsum += p;
        }
        __builtin_amdgcn_sched_barrier(0);
        if (MODE == 2) {
            float av = 2.f * (s[kt][0] + s[kt][1] + s[kt][2]) + s[kt][3], bv = s[kt][3];
            av += __shfl_xor(av, 1); av += __shfl_xor(av, 2); bv += __shfl_xor(bv, 1); bv += __shfl_xor(bv, 2);
            if (h == 0) { const int j = jbase + (kap0 >> 2);
                improw[j] = improw[j] + av;
                if (j + 1 < 128) improw[j + 1] = improw[j + 1] + bv; }
        }
    }
    if (MODE >= 1) {
#pragma unroll
        for (int hh = 0; hh < 2; ++hh) {
            u32x4 pw; pw.x = cvt_pk(s[2 * hh][0], s[2 * hh][1]); pw.y = cvt_pk(s[2 * hh][2], s[2 * hh][3]); pw.z = cvt_pk(s[2 * hh + 1][0], s[2 * hh + 1][1]); pw.w = cvt_pk(s[2 * hh + 1][2], s[2 * hh + 1][3]);
            const bf16x8 pf = __builtin_bit_cast(bf16x8, pw);
#pragma unroll
            for (int dt = 0; dt < 4; ++dt) oacc[dt] = __builtin_amdgcn_mfma_f32_16x16x32_bf16(vf[dt][hh], pf, oacc[dt], 0, 0, 0);
        }
    }
}
__device__ __forceinline__ int rel_bucket_i(int n) { int bk = 39 - __clz((int)((unsigned)n * (unsigned)n)); bk = bk > 31 ? 31 : bk; return n < 16 ? n : bk; }
template <int MODE, bool SEL>
__device__ __forceinline__ void tile_stream(LAS unsigned char* ring, const bf16* Kbase, const bf16* Vbase, int ldv, int nt, int pb0, int pbstep, int pstride, int relmax,
                                            const bf16x8 (&qf)[2][2], const int (&tq)[2], const LAS float* biasrow, const float (&psc)[2], f32x4 (&oacc)[2][4], float (&ls)[2],
                                            LAS float* imp0, LAS float* imp1, const LAS u64* selA, const LAS u64* selB, int tid, int lc, int lg, int h) {
    const int row = tid >> 3, ch = tid & 7;
    const bf16* kp = Kbase + row * 64 + ch * 8;
    const bf16* vp = Vbase + (size_t)row * ldv + ch * 8;
    const int woff = row * TILE_PITCH + ch * 16;
    const float bfar = biasrow[31]; const int tqlo = __builtin_amdgcn_readfirstlane(tq[0]) ;
    u32x4 rk = {0u, 0u, 0u, 0u}, rv = {0u, 0u, 0u, 0u};
    if (nt > 0) { rk = *(const u32x4*)kp; if (MODE > 0) rv = *(const u32x4*)vp; }
#define TILE_STEP(t, rk, rv) do { \
        LAS unsigned char* st = ring + (t & 1) * STAGE_B; \
        *(LAS u32x4*)(st + woff) = rk; if (MODE > 0) *(LAS u32x4*)(st + TILE_B + woff) = rv; \
        asm volatile("s_waitcnt lgkmcnt(0)" ::: "memory"); __builtin_amdgcn_s_barrier(); asm volatile("" ::: "memory"); \
        if (t + 2 < nt) { rk = *(const u32x4*)(kp + (size_t)(t + 2) * 4096); if (MODE > 0) rv = *(const u32x4*)(vp + (t + 2) * 64); } \
        int tq0 = tq[0], tq1 = tq[1]; bool do0 = true, do1 = true; \
        if (SEL) { \
            const bool b0 = ((selA[t >> 6] >> (t & 63)) & 1ull) != 0ull, b1 = ((selB[t >> 6] >> (t & 63)) & 1ull) != 0ull; \
            tq0 = b0 ? tq0 : -1; tq1 = b1 ? tq1 : -1; do0 = __ballot(b0) != 0ull; do1 = __ballot(b1) != 0ull; \
        } \
        if (do0 || do1) { \
            bf16x8 kf[4][2], vf[4][2]; \
_Pragma("unroll") \
            for (int kt = 0; kt < 4; ++kt) { const LAS unsigned char* p = st + (32 * (kt >> 1) + 8 * (lc >> 2) + 4 * (kt & 1) + (lc & 3)) * TILE_PITCH + 16 * lg; \
                kf[kt][0] = *(const LAS bf16x8*)p; kf[kt][1] = *(const LAS bf16x8*)(p + 64); } \
            if (MODE > 0) { \
_Pragma("unroll") \
                for (int dt = 0; dt < 4; ++dt) { const LAS unsigned char* p = st + TILE_B + (16 * dt + lc) * TILE_PITCH + 16 * lg; \
                    vf[dt][0] = *(const LAS bf16x8*)p; vf[dt][1] = *(const LAS bf16x8*)(p + 64); } \
            } \
            const int pbase = pb0 + t * pbstep; \
            { \
 \
                const int rlo = tqlo - (pbase + 63 * pstride), rhi = tqlo + 7 - pbase; \
                const int blo = rel_bucket_i(rlo < 0 ? 0 : rlo), bhi = rel_bucket_i(rhi < 0 ? 0 : rhi); \
                if (rlo >= 0 && rhi < relmax && bhi - blo <= 1) { \
                    int thr = 0x7fffffff; \
                    if (bhi != blo) { int a = rlo, b = rhi; \
                        while (b - a > 1) { const int mid = (a + b) >> 1; if (rel_bucket_i(mid) == blo) a = mid; else b = mid; } \
                        thr = b; } \
                    const float pb1 = biasrow[blo], pb2 = biasrow[bhi]; \
                    const float pa0 = (!SEL || tq0 >= 0) ? pb1 : -1e30f, pa1 = (!SEL || tq0 >= 0) ? pb2 : -1e30f, pc0 = (!SEL || tq1 >= 0) ? pb1 : -1e30f, pc1 = (!SEL || tq1 >= 0) ? pb2 : -1e30f; \
                    if (bhi == blo) { \
                        if (do0) attn_core<MODE, 1, SEL>(kf, vf, qf[0], tq0, pbase, pstride, relmax, biasrow, psc[0], oacc[0], ls[0], imp0, 16 * t, lg, h, pa0); \
                        if (do1) attn_core<MODE, 1, SEL>(kf, vf, qf[1], tq1, pbase, pstride, relmax, biasrow, psc[1], oacc[1], ls[1], imp1, 16 * t, lg, h, pc0); \
                    } else { \
                        if (do0) attn_core<MODE, 2, SEL>(kf, vf, qf[0], tq[0], pbase, pstride, relmax, biasrow, psc[0], oacc[0], ls[0], imp0, 16 * t, lg, h, pa0, pa1, thr); \
                        if (do1) attn_core<MODE, 2, SEL>(kf, vf, qf[1], tq[1], pbase, pstride, relmax, biasrow, psc[1], oacc[1], ls[1], imp1, 16 * t, lg, h, pc0, pc1, thr); \
                    } \
                } else if (rlo >= 16 && rhi < relmax) { \
                    if (do0) attn_core<MODE, 3, SEL>(kf, vf, qf[0], tq0, pbase, pstride, relmax, biasrow, psc[0], oacc[0], ls[0], imp0, 16 * t, lg, h); \
                    if (do1) attn_core<MODE, 3, SEL>(kf, vf, qf[1], tq1, pbase, pstride, relmax, biasrow, psc[1], oacc[1], ls[1], imp1, 16 * t, lg, h); \
                } else { \
                    if (do0) attn_core<MODE>(kf, vf, qf[0], tq0, pbase, pstride, relmax, biasrow, psc[0], oacc[0], ls[0], imp0, 16 * t, lg, h); \
                    if (do1) attn_core<MODE>(kf, vf, qf[1], tq1, pbase, pstride, relmax, biasrow, psc[1], oacc[1], ls[1], imp1, 16 * t, lg, h); \
                } \
            } \
        } \
    } while (0)
    u32x4 rk1 = {0u, 0u, 0u, 0u}, rv1 = {0u, 0u, 0u, 0u};
    if (nt > 1) { rk1 = *(const u32x4*)(kp + 4096); if (MODE > 0) rv1 = *(const u32x4*)(vp + 64); }
    for (int t2 = 0; t2 < nt; t2 += 2) {
        { const int t = t2; TILE_STEP(t, rk, rv); }
        if (t2 + 1 < nt) { const int t = t2 + 1; TILE_STEP(t, rk1, rv1); }
    }
#undef TILE_STEP
    __syncthreads();
}

__device__ __forceinline__ void phase_attn(const Args& a, LAS unsigned char* lds) {
    unsigned char* ws = WSP;
    int tid_ = threadIdx.x; asm volatile("" : "+v"(tid_));
    const int w = __builtin_amdgcn_readfirstlane(tid_ >> 6);
    LAS float* imp = (LAS float*)(lds + A_IMP);
    LAS unsigned char* ring = lds + A_RING;
    LAS u64* selq = (LAS u64*)(lds + A_SELQ);
    LAS float* biasL = (LAS float*)(lds + A_BIAS);
    LAS float* mbound = (LAS float*)(lds + A_MB);
    const bf16* Q = (const bf16*)(ws + WS_Q);
    const float* gates = (const float*)(ws + WS_GATES);
    const float* relb = IN(23);
    if (w == 0) {
        const int lane = tid_ & 63;
        float mq = fabsf(IN(12)[lane]);
        float mk = fmaxf(fabsf(IN(16)[lane]), fmaxf(fabsf(IN(16)[64 + lane]), fabsf(IN(16)[128 + lane])));
        mq = wave_max(mq); mk = wave_max(mk);
        float mb = -1e30f;
        if (lane < 16) { for (int bk = 0; bk < 32; ++bk) mb = fmaxf(mb, relb[bk * 16 + lane]); mbound[lane] = mb + 8.f * mq * mk; }
    }
    __syncthreads();
    const int nunits = 2048, G = gridDim.x, bx = blockIdx.x;
    for (int it = 0; ; ++it) {
        int bg, qb;
        if (G == 256) {
            if (it >= 8) break;
            const int slot = bx >> 3, oo = slot >> 1; bg = 2 * (bx & 7) + (slot & 1);
            qb = (it & 1) ? 127 - 16 * (it >> 1) - oo : 16 * (it >> 1) + oo;
        } else {
            const int u = bx + it * G; if (u >= nunits) break;
            const int rr = u >> 4, ui = rr >> 4, oo = rr & 15; bg = u & 15;
            qb = (ui & 1) ? 127 - 16 * (ui >> 1) - oo : 16 * (ui >> 1) + oo;
        }
        const int b = bg >> 2, grp = bg & 3, t0 = 64 * qb, tokbase = b * SEQ + t0;
        int tidu = tid_; asm volatile("" : "+v"(tidu));
        const int tid = tidu, lane = tid & 63, lc = lane & 15, lg = lane >> 4, hq = lc >> 2, h = lc & 3;
        const u64 ltmask = (1ull << lane) - 1ull;
        for (int i = tid; i < 8192; i += 512) imp[i] = 0.f;
        if (tid < 128) { const int hh = tid >> 5, bk = tid & 31; biasL[tid] = (relb[bk * 16 + grp * 4 + hh] - mbound[grp * 4 + hh]) * LOG2E; }
        __syncthreads();
        const LAS float* biasrow = biasL + h * 32;
        bf16x8 qf[2][2]; int tqd[2]; float g0[2], g1[2], g2[2];
#pragma unroll
        for (int ct = 0; ct < 2; ++ct) { const int q = 8 * w + 4 * ct + hq; tqd[ct] = t0 + q;
            const bf16* qp = Q + (size_t)(tokbase + q) * DM + (grp * 4 + h) * 64 + 8 * lg; qf[ct][0] = *(const bf16x8*)qp; qf[ct][1] = *(const bf16x8*)(qp + 32);
            const float* gp = gates + (size_t)(tokbase + q) * 48 + (grp * 4 + h) * 3; g0[ct] = gp[0]; g1[ct] = gp[1]; g2[ct] = gp[2]; }
        LAS float* imp0 = imp + (8 * w + hq) * 128; LAS float* imp1 = imp + (8 * w + 4 + hq) * 128;
        LAS float* outp[2] = {(LAS float*)(lds + A_OUT) + ((8 * w + hq) * 4 + h) * 64 + 4 * lg, (LAS float*)(lds + A_OUT) + ((8 * w + 4 + hq) * 4 + h) * 64 + 4 * lg};
        const float one2[2] = {1.f, 1.f};
        {
            const int ncb = 4 * qb + 3, ntc = (ncb + 63) >> 6;
            const bf16* Kc = (const bf16*)(ws + WS_KC) + (size_t)bg * NCB * 64;
            const bf16* VcT = (const bf16*)(ws + WS_VCT) + (size_t)bg * 64 * NCB;
            float ls[2] = {0.f, 0.f}; f32x4 oc[2][4];
#pragma unroll
            for (int ct = 0; ct < 2; ++ct)
#pragma unroll
                for (int dt = 0; dt < 4; ++dt) oc[ct][dt] = (f32x4){0.f, 0.f, 0.f, 0.f};
            tile_stream<0, false>(ring, Kc, VcT, NCB, ntc, 31, 1024, 16, RELMAX_BIG, qf, tqd, biasrow, one2, oc, ls, imp0, imp1, selq, selq, tid, lc, lg, h);
            float inv[2];
#pragma unroll
            for (int ct = 0; ct < 2; ++ct) { float l = ls[ct]; l += __shfl_xor(l, 16); l += __shfl_xor(l, 32); inv[ct] = l > 0.f ? 1.f / l : 0.f; }
            float dummy[2] = {0.f, 0.f};
            tile_stream<2, false>(ring, Kc, VcT, NCB, ntc, 31, 1024, 16, RELMAX_BIG, qf, tqd, biasrow, inv, oc, dummy, imp0, imp1, selq, selq, tid, lc, lg, h);
#pragma unroll
            for (int ct = 0; ct < 2; ++ct)
#pragma unroll
                for (int dt = 0; dt < 4; ++dt) *(LAS f32x4*)(outp[ct] + 16 * dt) = oc[ct][dt] * g0[ct];
        }
        for (int qi = 0; qi < 8; ++qi) {
            const int q = 8 * w + qi; u64 lo, hi;
            if (qb < 16) { lo = (2ull << qb) - 1ull; hi = 0ull; }
            else {
                const int j0 = lane, j1 = lane + 64;
                const bool c0 = (j0 >= 1 && j0 <= qb - 2), c1 = (j1 <= qb - 2);
                const unsigned key0 = c0 ? __builtin_bit_cast(unsigned, imp[q * 128 + j0]) : 0u, key1 = c1 ? __builtin_bit_cast(unsigned, imp[q * 128 + j1]) : 0u;
                unsigned Tk = 0u;
                for (int bit = 30; bit >= 0; --bit) { const unsigned trial = Tk | (1u << bit);
                    const int cnt = __popcll(__ballot(key0 >= trial)) + __popcll(__ballot(key1 >= trial)); if (cnt >= 13) Tk = trial; }
                const bool gt0 = key0 > Tk, gt1 = key1 > Tk, e0 = (key0 == Tk) && c0, e1 = (key1 == Tk) && c1;
                const int need = 13 - (__popcll(__ballot(gt0)) + __popcll(__ballot(gt1)));
                const u64 m0 = __ballot(e0), m1 = __ballot(e1);
                const int r0 = __popcll(m0 & ltmask), r1 = __popcll(m0) + __popcll(m1 & ltmask);
                const bool s0 = gt0 || (e0 && r0 < need) || j0 == 0 || j0 == qb || j0 == qb - 1;
                const bool s1 = gt1 || (e1 && r1 < need) || j1 == qb || j1 == qb - 1;
                lo = __ballot(s0); hi = __ballot(s1);
            }
            if (lane == 0) { selq[q * 2] = lo; selq[q * 2 + 1] = hi; }
        }
        __builtin_amdgcn_wave_barrier();
        {
            const int tf = qb >= 8 ? 0 : 8 - qb, p0 = t0 - 512 + 64 * tf;
            const bf16* Kw = (const bf16*)(ws + WS_KW) + ((size_t)bg * SEQ + p0) * 64;
            const bf16* VwT = (const bf16*)(ws + WS_VWT) + (size_t)bg * 64 * SEQ + p0;
            float ls[2] = {0.f, 0.f}; f32x4 ow[2][4];
#pragma unroll
            for (int ct = 0; ct < 2; ++ct)
#pragma unroll
                for (int dt = 0; dt < 4; ++dt) ow[ct][dt] = (f32x4){0.f, 0.f, 0.f, 0.f};
            tile_stream<1, false>(ring, Kw, VwT, SEQ, 9 - tf, p0, 64, 1, 512, qf, tqd, biasrow, one2, ow, ls, imp0, imp1, selq, selq, tid, lc, lg, h);
#pragma unroll
            for (int ct = 0; ct < 2; ++ct) { float l = ls[ct]; l += __shfl_xor(l, 16); l += __shfl_xor(l, 32); const float sc = g2[ct] / l;
#pragma unroll
                for (int dt = 0; dt < 4; ++dt) *(LAS f32x4*)(outp[ct] + 16 * dt) = *(LAS f32x4*)(outp[ct] + 16 * dt) + ow[ct][dt] * sc; }
        }
        {
            const bf16* Ks = (const bf16*)(ws + WS_KS) + (size_t)bg * SEQ * 64;
            const bf16* VsT = (const bf16*)(ws + WS_VST) + (size_t)bg * 64 * SEQ;
            float ls[2] = {0.f, 0.f}; f32x4 os[2][4];
#pragma unroll
            for (int ct = 0; ct < 2; ++ct)
#pragma unroll
                for (int dt = 0; dt < 4; ++dt) os[ct][dt] = (f32x4){0.f, 0.f, 0.f, 0.f};
            tile_stream<1, true>(ring, Ks, VsT, SEQ, qb + 1, 0, 64, 1, RELMAX_BIG, qf, tqd, biasrow, one2, os, ls, imp0, imp1, selq + (8 * w + hq) * 2, selq + (8 * w + 4 + hq) * 2, tid, lc, lg, h);
            bf16* AO = (bf16*)(ws + WS_AO);
#pragma unroll
            for (int ct = 0; ct < 2; ++ct) { float l = ls[ct]; l += __shfl_xor(l, 16); l += __shfl_xor(l, 32); const float sc = g1[ct] / l;
                bf16* op = AO + (size_t)(tokbase + 8 * w + 4 * ct + hq) * DM + (grp * 4 + h) * 64 + 4 * lg;
#pragma unroll
                for (int dt = 0; dt < 4; ++dt) { const f32x4 v = *(LAS f32x4*)(outp[ct] + 16 * dt) + os[ct][dt] * sc; *(u64*)(op + 16 * dt) = (u64)cvt_pk(v[0], v[1]) | ((u64)cvt_pk(v[2], v[3]) << 32); } }
        }
    }
}

#define XB_TMO      128
#define XB_XCNT(j)  (256  + 64 * (j))
#define XB_XSUB(j)  (1280 + 64 * (j))
#define XB_XGEN(j)  (2304 + 64 * (j))
#define XB_TOP      3328
#define XB_TOPGEN   3392
#define XCD_BAR_WORDS 3456
#define XB_SPIN_CAP (1u << 23)

__device__ __forceinline__ unsigned xb_ld(unsigned* p)              { return __hip_atomic_load(p, __ATOMIC_RELAXED, __HIP_MEMORY_SCOPE_AGENT); }
__device__ __forceinline__ unsigned xb_add(unsigned* p, unsigned v) { return __hip_atomic_fetch_add(p, v, __ATOMIC_RELAXED, __HIP_MEMORY_SCOPE_AGENT); }
__device__ __forceinline__ unsigned xb_xcc_id() { return (unsigned)__builtin_amdgcn_s_getreg((3 << 11) | 20) & 0xFu; }
#define XB_SPIN(cond, bar) do { unsigned _sp = 0; while (cond) { __builtin_amdgcn_s_sleep(1); \
    if ((++_sp & 255u) == 0u) { if (xb_ld(&(bar)[XB_TMO])) break; if (_sp > XB_SPIN_CAP) { atomicAdd(&(bar)[XB_TMO], 1u); break; } } } } while (0)

struct XcdBarrier {
    unsigned* bar; unsigned x;
    volatile LAS unsigned* st;
};

__device__ __forceinline__ XcdBarrier xcd_barrier_post(unsigned* bar, volatile LAS unsigned* st) {
    XcdBarrier b; b.bar = bar; b.x = xb_xcc_id(); b.st = st;
    if (threadIdx.x == 0) (void)xb_add(&bar[XB_XCNT(b.x)], 1u);
    return b;
}
__device__ __forceinline__ void xcd_barrier_complete(unsigned* bar, unsigned x, unsigned& nloc, unsigned& nx) {
    const unsigned G = gridDim.x * gridDim.y * gridDim.z;
    unsigned sum, cnt, mine, sp = 0u;
    for (;;) {
        sum = 0u; cnt = 0u; mine = 0u;
#pragma unroll
        for (unsigned j = 0; j < 16; ++j) { const unsigned c = xb_ld(&bar[XB_XCNT(j)]); sum += c; cnt += (c > 0u) ? 1u : 0u; mine = (j == x) ? c : mine; }
        if (sum == G) break;
        __builtin_amdgcn_s_sleep(1);
        if ((++sp & 255u) == 0u) { if (xb_ld(&bar[XB_TMO])) break; if (sp > XB_SPIN_CAP) { atomicAdd(&bar[XB_TMO], 1u); break; } }
    }
    nloc = mine > 0u ? mine : 1u; nx = cnt > 0u ? cnt : 1u;
}

__device__ __forceinline__ void xcd_barrier(const XcdBarrier& b) {
    asm volatile("s_waitcnt vmcnt(0)" ::: "memory");
    __syncthreads();
    if (threadIdx.x == 0) {
        unsigned* bar = b.bar;
        __builtin_amdgcn_s_waitcnt(0);
        unsigned nloc = b.st[0], nx = b.st[1];
        if (nloc == 0u) { xcd_barrier_complete(bar, b.x, nloc, nx); b.st[0] = nloc; b.st[1] = nx; }
        const unsigned old = xb_add(&bar[XB_XSUB(b.x)], 1u);
        const unsigned gen = old / nloc;
        if (old + 1u == (gen + 1u) * nloc) {
            __builtin_amdgcn_fence(__ATOMIC_RELEASE, "agent");
            asm volatile("s_waitcnt vmcnt(0)" ::: "memory");
            const unsigned og = xb_add(&bar[XB_TOP], 1u);
            const unsigned tg = og / nx;
            if (og + 1u == (tg + 1u) * nx) xb_add(&bar[XB_TOPGEN], 1u);
            else XB_SPIN(xb_ld(&bar[XB_TOPGEN]) == tg, bar);
            __builtin_amdgcn_fence(__ATOMIC_ACQUIRE, "agent");
            xb_add(&bar[XB_XGEN(b.x)], 1u);
            asm volatile("s_waitcnt vmcnt(0)" ::: "memory");
        } else {
            XB_SPIN(xb_ld(&bar[XB_XGEN(b.x)]) == gen, bar);
            __builtin_amdgcn_fence(__ATOMIC_ACQUIRE, "agent");
            asm volatile("s_waitcnt vmcnt(0)" ::: "memory");
        }
    }
    __syncthreads();
}


__global__ void __launch_bounds__(512, 2) mk_fwd(Args a) {
    extern __shared__ __attribute__((aligned(16))) unsigned char lds_raw[];
    LAS unsigned char* lds = (LAS unsigned char*)lds_raw;
    cg::grid_group grid = cg::this_grid();
    unsigned char* ws = WSP;
    const float* x = IN(0); float* hout = KA()->out;
    bf16* HN = (bf16*)(ws + WS_HN); bf16* HN2 = (bf16*)(ws + WS_HN2); bf16* ACT = (bf16*)(ws + WS_ACT);
    const int G = gridDim.x, bx = blockIdx.x;
#define GRID_SYNC() do { \
        if (sync_no == 0u) { asm volatile("s_waitcnt vmcnt(0) lgkmcnt(0)" ::: "memory"); grid.sync(); \
            if (threadIdx.x == 0) { __builtin_amdgcn_fence(__ATOMIC_ACQUIRE, "agent"); asm volatile("s_waitcnt vmcnt(0)" ::: "memory"); } __syncthreads(); \
            xb = xcd_barrier_post(bar_words, xb_st); } \
        else xcd_barrier(xb); \
        ++sync_no; } while (0)
#define GEMM(EPI, Aptr, Bptr, N_, K_, E) do { pg8::Gemm g_{(const pg8::bf16_t*)(Aptr), (const pg8::bf16_t*)(Bptr), T, (N_), (K_)}; pg8::StaticOrder S_; S_.init(T, (N_), G, bx); \
        pg8::gemm_phase<std::remove_cv_t<std::remove_reference_t<decltype(E)>>, pg8::StaticOrder, true, true>((PG8_LAS unsigned char*)lds, g_, S_, (E)); } while (0)

    unsigned* bar_words = (unsigned*)(ws + 4096); unsigned sync_no = 0u;
    for (int i = bx * 512 + threadIdx.x; i < XCD_BAR_WORDS; i += G * 512) __hip_atomic_store(bar_words + i, 0u, __ATOMIC_RELAXED, __HIP_MEMORY_SCOPE_AGENT);
    volatile LAS unsigned* xb_st = (volatile LAS unsigned*)(lds + LDS_BYTES - 16);
    if (threadIdx.x < 2) xb_st[threadIdx.x] = 0u;
    XcdBarrier xb; xb.bar = bar_words; xb.x = 0u; xb.st = xb_st;
    float* SS = (float*)(ws + WS_SS);
#define SSK(k) (SS + (size_t)(k) * T)
    phase_prep(a, lds);
    phase_x(x, HN, SS);
    GRID_SYNC();
    { pg8::EpiSwiglu E{ACT, DFF, SSK(0)}; GEMM(pg8::EpiSwiglu, HN, ws + WS_WIN, 2 * DFF, DM, E); }
    GRID_SYNC();
    { pg8::EpiResid<true, 1, 0, false> E{x, hout, HN, SSK(1)}; GEMM((pg8::EpiResid<true, 1, 0, false>), ACT, ws + WS_WOUT, DM, DFF, E); }
    GRID_SYNC();
    { pg8::EpiConvIn E{(bf16*)(ws + WS_BG), (bf16*)(ws + WS_U), SSK(1)}; GEMM(pg8::EpiConvIn, HN, ws + WS_CWIN, 3072, DM, E); }
    GRID_SYNC();
    phase_conv((const bf16*)(ws + WS_BG), (const bf16*)(ws + WS_U), IN(9), HN2);
    GRID_SYNC();
    { pg8::EpiResid<true, 2, 1, false> E{hout, hout, HN, SSK(2)}; GEMM((pg8::EpiResid<true, 2, 1, false>), HN2, ws + WS_CWOUT, DM, DM, E); }
    GRID_SYNC();
    { pg8::EpiSwiglu E{ACT, DFF, SSK(2)}; GEMM(pg8::EpiSwiglu, HN, ws + WS_WIN + SZ_WIN, 2 * DFF, DM, E); }
    GRID_SYNC();
    { pg8::EpiResid<true, 1, 1, false> E{hout, hout, HN, SSK(3)}; GEMM((pg8::EpiResid<true, 1, 1, false>), ACT, ws + WS_WOUT + SZ_WOUT, DM, DFF, E); }
    GRID_SYNC();
    { pg8::EpiKV E; E.Kb = (bf16*)(ws + WS_KCR); E.Vb = (bf16*)(ws + WS_VCR); E.brstride = KV_BYTES / 2; E.knorm = IN(16); E.ss = SSK(3);
      GEMM(pg8::EpiKV, HN, ws + WS_WKV, NKV, DM, E); }
    GRID_SYNC();
    phase_compress(a, lds);
    { pg8::EpiSwiglu E{ACT, DFF, SSK(3)}; GEMM(pg8::EpiSwiglu, HN, ws + WS_WIN + 2 * SZ_WIN, 2 * DFF, DM, E); }
    GRID_SYNC();
    { pg8::EpiResid<true, 1, 1, false> E{hout, hout, HN, SSK(4)}; GEMM((pg8::EpiResid<true, 1, 1, false>), ACT, ws + WS_WOUT + 2 * SZ_WOUT, DM, DFF, E); }
    GRID_SYNC();
    { pg8::EpiQ E{(bf16*)(ws + WS_Q), (float*)(ws + WS_GATES), IN(12), 0.125f * LOG2E, SSK(4)}; GEMM(pg8::EpiQ, HN, ws + WS_WQ, NQP, DM, E); }
    GRID_SYNC();
    phase_attn(a, lds);
    GRID_SYNC();
    { pg8::EpiResid<true, 2, 1, false> E{hout, hout, HN, SSK(5)}; GEMM((pg8::EpiResid<true, 2, 1, false>), ws + WS_AO, ws + WS_WO, DM, DM, E); }
    GRID_SYNC();
    { pg8::EpiSwiglu E{ACT, DFF, SSK(5)}; GEMM(pg8::EpiSwiglu, HN, ws + WS_WIN + 3 * SZ_WIN, 2 * DFF, DM, E); }
    GRID_SYNC();
    { pg8::EpiResid<false, 1, 1, true> E{hout, hout, HN, nullptr}; GEMM((pg8::EpiResid<false, 1, 1, true>), ACT, ws + WS_WOUT + 3 * SZ_WOUT, DM, DFF, E); }
#undef SSK
#undef GEMM
}

extern "C" void kernel_launch(void* const* d_in, const int* in_sizes, int n_in, void* d_out, int out_size, void* d_ws, size_t ws_size, hipStream_t stream) {
    static int grid = 0;
    if (grid == 0) {
        if (n_in != 24 || out_size != T * DM || ws_size < WS_END) { fprintf(stderr, "kernel_launch: unexpected problem (n_in %d out %d ws %zu)\n", n_in, out_size, ws_size); grid = -1; return; }
        int dev = 0, cus = 0, per_cu = 0;
        (void)hipGetDevice(&dev);
        (void)hipDeviceGetAttribute(&cus, hipDeviceAttributeMultiprocessorCount, dev);
        (void)hipFuncSetAttribute((const void*)mk_fwd, hipFuncAttributeMaxDynamicSharedMemorySize, LDS_BYTES);
        (void)hipOccupancyMaxActiveBlocksPerMultiprocessor(&per_cu, (const void*)mk_fwd, 512, LDS_BYTES);
        if (per_cu < 1) per_cu = 1;
        grid = cus * per_cu;
    }
    if (grid < 0) return;
    Args a{};
    for (int i = 0; i < 24; ++i) a.in[i] = (const float*)d_in[i];
    a.out = (float*)d_out; a.ws = (unsigned char*)d_ws;
    void* args[] = {&a};
    hipError_t e = hipLaunchCooperativeKernel((const void*)mk_fwd, dim3(grid), dim3(512), args, LDS_BYTES, stream);
    if (e != hipSuccess) fprintf(stderr, "cooperative launch failed: %s (grid %d)\n", hipGetErrorString(e), grid);
}
```

```cpp
#include <hip/hip_runtime.h>
#include <hip/hip_cooperative_groups.h>
#include <cstdio>
#include <cstdint>
#include <type_traits>
namespace cg = cooperative_groups;
namespace pg8 {
#define PG8_LAS __attribute__((address_space(3)))
typedef unsigned short bf16_t;
typedef short bf16x8 __attribute__((ext_vector_type(8)));
typedef float f32x4 __attribute__((ext_vector_type(4)));
typedef unsigned u32x4 __attribute__((ext_vector_type(4)));
constexpr int BM = 256, BK = 64, HALF = 128, HTB = HALF * BK * 2  , STAGE_BYTES = 8 * HTB, NXCD = 8, WGM = 8;

__host__ __device__ __forceinline__ int lds_byte(int r, int c) { const int st = (r >> 4) * 2 + (c >> 5), rr = r & 15, cc = c & 31, ob = rr * 64 + cc * 2; return st * 1024 + (ob ^ (((ob >> 9) & 1) << 5)); }
__host__ __device__ __forceinline__ void stage_rc(int b, int& R, int& C) { const int st = b / 1024, sb = b % 1024, swz = sb ^ (((sb >> 9) & 1) << 5); R = (st >> 1) * 16 + swz / 64; C = (st & 1) * 32 + (swz % 64) / 2; }
__host__ __device__ __forceinline__ int perm32(int rho) { const int n = rho >> 4, i = rho & 15; return 8 * (i >> 2) + 4 * n + (i & 3); }

struct Unit { int pm, pn; };
struct Gemm { const bf16_t* A; const bf16_t* Bt; int M, N, K; };

struct StaticOrder {
    int nM, nN, nwg, G, c;
    __host__ __device__ void init(int M, int N, int G_, int c_) { nM = M / BM; nN = N / BM; nwg = nM * nN; G = G_; c = c_; }
    __host__ __device__ bool next(int i, Unit& u) const {
        const long L = (long)i * G + c; if (L >= nwg) return false;
        int wgid = (int)L; { const int q = nwg / NXCD, r = nwg % NXCD, xcd = wgid % NXCD, off = wgid / NXCD; wgid = (xcd < r ? xcd * (q + 1) : r * (q + 1) + (xcd - r) * q) + off; }
        const int nig = WGM * nN, gid = wgid / nig, fm = gid * WGM, gsz = (nM - fm) < WGM ? (nM - fm) : WGM;
        u.pm = fm + ((wgid % nig) % gsz); u.pn = (wgid % nig) / gsz; return true;
    }
    __device__ __forceinline__ void a_ready(const Unit&) const {}
    __device__ __forceinline__ void done(const Unit&) const {}
};

__device__ __forceinline__ unsigned cvt_pk_bf16(float lo, float hi) { unsigned r; asm volatile("v_cvt_pk_bf16_f32 %0, %1, %2" : "=v"(r) : "v"(lo), "v"(hi)); return r; }
__device__ __forceinline__ float fast_sigmoid(float x) { return __builtin_amdgcn_rcpf(1.f + __builtin_amdgcn_exp2f(-1.4426950408889634f * x)); }
__device__ __forceinline__ u32x4 pack8(const f32x4 a, const f32x4 b) { u32x4 w; w.x = cvt_pk_bf16(a[0], a[1]); w.y = cvt_pk_bf16(a[2], a[3]); w.z = cvt_pk_bf16(b[0], b[1]); w.w = cvt_pk_bf16(b[2], b[3]); return w; }

struct EpiSwiglu {
    static constexpr bool PERM = true, AFTER_DRAIN = false;
    bf16_t* O; int ldo; const float* ss;
    __device__ __forceinline__ void operator()(const f32x4 (&acc)[2][2][4][2], const Unit& u, int wr, int wc, int fr, int fq) const {
        const int row0 = u.pm * BM + wr * 64 + fr, col0 = u.pn * HALF + wc * 32 + 8 * fq;
#pragma unroll
        for (int ai = 0; ai < 2; ++ai)
#pragma unroll
            for (int m = 0; m < 4; ++m) {
                f32x4 v[2]; const float rs = __builtin_amdgcn_rsqf(ss[row0 + ai * HALF + m * 16] * (1.f / 1024.f) + 1e-6f);
#pragma unroll
                for (int n = 0; n < 2; ++n) { const f32x4 g = acc[ai][0][m][n] * rs, up = acc[ai][1][m][n] * rs;
#pragma unroll
                    for (int e = 0; e < 4; ++e) v[n][e] = g[e] * fast_sigmoid(g[e]) * up[e]; }
                *(u32x4*)(O + (size_t)(row0 + ai * HALF + m * 16) * ldo + col0) = pack8(v[0], v[1]);
            }
    }
};

template <bool NORM, int ALPHA2  , int HIN, bool FOUT> struct EpiResid {
    static constexpr bool PERM = true, AFTER_DRAIN = false;
    const float* hin; float* hout; bf16_t* HB; float* ssout;
    __device__ __forceinline__ void operator()(const f32x4 (&acc)[2][2][4][2], const Unit& u, int wr, int wc, int fr, int fq) const {
        const int row0 = u.pm * BM + wr * 64 + fr, col0 = u.pn * BM + wc * 32 + 8 * fq; constexpr float alpha = 0.5f * ALPHA2;
#pragma unroll
        for (int ai = 0; ai < 2; ++ai) {
            u32x4 hv[4][2]; f32x4 xv[4][2][2];
#pragma unroll
            for (int m = 0; m < 4; ++m)
#pragma unroll
                for (int bj = 0; bj < 2; ++bj) { const size_t p = (size_t)(row0 + ai * HALF + m * 16) * 1024 + col0 + bj * HALF;
                    if (HIN == 0) { xv[m][bj][0] = *(const f32x4*)(hin + p); xv[m][bj][1] = *(const f32x4*)(hin + p + 4); } else hv[m][bj] = *(const u32x4*)(HB + p); }
#pragma unroll
            for (int m = 0; m < 4; ++m) {
                float sq = 0.f;
#pragma unroll
                for (int bj = 0; bj < 2; ++bj) {
                    const size_t p = (size_t)(row0 + ai * HALF + m * 16) * 1024 + col0 + bj * HALF;
                    f32x4 a0, a1;
                    if (HIN == 0) { a0 = xv[m][bj][0]; a1 = xv[m][bj][1]; }
                    else { const u32x4 w = hv[m][bj];
                        a0 = (f32x4){__builtin_bit_cast(float, w.x << 16), __builtin_bit_cast(float, w.x & 0xffff0000u), __builtin_bit_cast(float, w.y << 16), __builtin_bit_cast(float, w.y & 0xffff0000u)};
                        a1 = (f32x4){__builtin_bit_cast(float, w.z << 16), __builtin_bit_cast(float, w.z & 0xffff0000u), __builtin_bit_cast(float, w.w << 16), __builtin_bit_cast(float, w.w & 0xffff0000u)}; }
                    a0 = a0 + acc[ai][bj][m][0] * alpha; a1 = a1 + acc[ai][bj][m][1] * alpha;
                    if (FOUT) { *(f32x4*)(hout + p) = a0; *(f32x4*)(hout + p + 4) = a1; }
                    if (NORM) { *(u32x4*)(HB + p) = pack8(a0, a1);
                        sq += (a0[0] * a0[0] + a0[1] * a0[1]) + (a0[2] * a0[2] + a0[3] * a0[3]) + (a1[0] * a1[0] + a1[1] * a1[1]) + (a1[2] * a1[2] + a1[3] * a1[3]); }
                }
                if (NORM) { sq += __shfl_xor(sq, 16); sq += __shfl_xor(sq, 32);
                    if (fq == 0) __hip_atomic_fetch_add(ssout + row0 + ai * HALF + m * 16, sq, __ATOMIC_RELAXED, __HIP_MEMORY_SCOPE_AGENT); }
            }
        }
    }
};

struct EpiConvIn {
    static constexpr bool PERM = true, AFTER_DRAIN = false;
    bf16_t* Bg; bf16_t* U; const float* ss;
    __device__ __forceinline__ void operator()(const f32x4 (&acc)[2][2][4][2], const Unit& u, int wr, int wc, int fr, int fq) const {
        const int row0 = u.pm * BM + wr * 64 + fr;
        if (u.pn < 4) {
            const int col0 = u.pn * BM + wc * 32 + 8 * fq;
#pragma unroll
            for (int ai = 0; ai < 2; ++ai)
#pragma unroll
                for (int m = 0; m < 4; ++m)
#pragma unroll
                    for (int bj = 0; bj < 2; ++bj) { const float rs = __builtin_amdgcn_rsqf(ss[row0 + ai * HALF + m * 16] * (1.f / 1024.f) + 1e-6f);
                        *(u32x4*)(Bg + (size_t)(row0 + ai * HALF + m * 16) * 1024 + col0 + bj * HALF) = pack8(acc[ai][bj][m][0] * rs, acc[ai][bj][m][1] * rs); }
        } else {
            const int col0 = (u.pn - 4) * HALF + wc * 32 + 8 * fq;
#pragma unroll
            for (int ai = 0; ai < 2; ++ai)
#pragma unroll
                for (int m = 0; m < 4; ++m) { const float r2 = __builtin_amdgcn_rcpf(ss[row0 + ai * HALF + m * 16] * (1.f / 1024.f) + 1e-6f);
                    *(u32x4*)(U + (size_t)(row0 + ai * HALF + m * 16) * 1024 + col0) = pack8(acc[ai][0][m][0] * acc[ai][1][m][0] * r2, acc[ai][0][m][1] * acc[ai][1][m][1] * r2); }
        }
    }
};

struct EpiKV {
    static constexpr bool PERM = true, AFTER_DRAIN = false;
    bf16_t *Kb, *Vb; size_t brstride; const float* knorm; const float* ss;
    __device__ __forceinline__ void operator()(const f32x4 (&acc)[2][2][4][2], const Unit& u, int wr, int wc, int fr, int fq) const {
        const int br = u.pn >> 1, kv = u.pn & 1;
        const int row0 = u.pm * BM + wr * 64 + fr;
#pragma unroll
        for (int ai = 0; ai < 2; ++ai)
#pragma unroll
            for (int m = 0; m < 4; ++m) {
                const int row = row0 + ai * HALF + m * 16, b = row >> 13, s = row & 8191, bg = b * 4 + wc;
                const float rs = __builtin_amdgcn_rsqf(ss[row] * (1.f / 1024.f) + 1e-6f);
                if (kv == 0) {
                    float rstd = rs;
                    if (br > 0) { float ss = 0.f;
#pragma unroll
                        for (int bj = 0; bj < 2; ++bj)
#pragma unroll
                            for (int n = 0; n < 2; ++n)
#pragma unroll
                                for (int e = 0; e < 4; ++e) ss += acc[ai][bj][m][n][e] * acc[ai][bj][m][n][e];
                        ss += __shfl_xor(ss, 16); ss += __shfl_xor(ss, 32);
                        rstd = rs * __builtin_amdgcn_rsqf(ss * rs * rs * (1.f / 64.f) + 1e-6f); }
                    bf16_t* dst = Kb + (size_t)br * brstride + ((size_t)bg * 8192 + s) * 64 + 8 * fq;
#pragma unroll
                    for (int bj = 0; bj < 2; ++bj) {
                        f32x4 v0 = acc[ai][bj][m][0] * rstd, v1 = acc[ai][bj][m][1] * rstd;
                        if (br > 0) { const float* gp = knorm + br * 64 + bj * 32 + 8 * fq; v0 = v0 * *(const f32x4*)gp; v1 = v1 * *(const f32x4*)(gp + 4); }
                        *(u32x4*)(dst + bj * 32) = pack8(v0, v1);
                    }
                } else if (br == 0) {
                    bf16_t* dst = Vb + ((size_t)bg * 8192 + s) * 64 + 8 * fq;
#pragma unroll
                    for (int bj = 0; bj < 2; ++bj) *(u32x4*)(dst + bj * 32) = pack8(acc[ai][bj][m][0] * rs, acc[ai][bj][m][1] * rs);
                } else {
                    bf16_t* dst = Vb + (size_t)br * brstride + ((size_t)bg * 64 + 8 * fq) * 8192 + s;
#pragma unroll
                    for (int bj = 0; bj < 2; ++bj)
#pragma unroll
                        for (int n = 0; n < 2; ++n) { const f32x4 v = acc[ai][bj][m][n] * rs;
                            const unsigned p0 = cvt_pk_bf16(v[0], v[1]), p1 = cvt_pk_bf16(v[2], v[3]);
                            bf16_t* d = dst + (size_t)(bj * 32 + 4 * n) * 8192;
                            d[0] = (bf16_t)(p0 & 0xffffu); d[8192] = (bf16_t)(p0 >> 16); d[2 * 8192] = (bf16_t)(p1 & 0xffffu); d[3 * 8192] = (bf16_t)(p1 >> 16); }
                }
            }
    }
};

struct EpiQ {
    static constexpr bool PERM = true, AFTER_DRAIN = false;
    bf16_t* Q; float* gates; const float* qnorm; float qscale; const float* ss;
    __device__ __forceinline__ void operator()(const f32x4 (&acc)[2][2][4][2], const Unit& u, int wr, int wc, int fr, int fq) const {
        const int row0 = u.pm * BM + wr * 64 + fr;
        if (u.pn < 4) {
            const int head = u.pn * 4 + wc;
#pragma unroll
            for (int ai = 0; ai < 2; ++ai)
#pragma unroll
                for (int m = 0; m < 4; ++m) {
                    float ss = 0.f;
#pragma unroll
                    for (int bj = 0; bj < 2; ++bj)
#pragma unroll
                        for (int n = 0; n < 2; ++n)
#pragma unroll
                            for (int e = 0; e < 4; ++e) ss += acc[ai][bj][m][n][e] * acc[ai][bj][m][n][e];
                    ss += __shfl_xor(ss, 16); ss += __shfl_xor(ss, 32);
                    const float rs = __builtin_amdgcn_rsqf(this->ss[row0 + ai * HALF + m * 16] * (1.f / 1024.f) + 1e-6f);
                    const float rstd = rs * __builtin_amdgcn_rsqf(ss * rs * rs * (1.f / 64.f) + 1e-6f) * qscale;
                    bf16_t* dst = Q + (size_t)(row0 + ai * HALF + m * 16) * 1024 + head * 64 + 8 * fq;
#pragma unroll
                    for (int bj = 0; bj < 2; ++bj) { const float* gp = qnorm + bj * 32 + 8 * fq;
                        const f32x4 v0 = acc[ai][bj][m][0] * rstd * *(const f32x4*)gp, v1 = acc[ai][bj][m][1] * rstd * *(const f32x4*)(gp + 4);
                        *(u32x4*)(dst + bj * 32) = pack8(v0, v1); }
                }
        } else {
            if (wc < 2) {
#pragma unroll
                for (int ai = 0; ai < 2; ++ai)
#pragma unroll
                    for (int m = 0; m < 4; ++m) {
                        const int c0 = wc * 32 + 8 * fq;
                        if (c0 < 48) { float* dst = gates + (size_t)(row0 + ai * HALF + m * 16) * 48 + c0; const float rs = __builtin_amdgcn_rsqf(this->ss[row0 + ai * HALF + m * 16] * (1.f / 1024.f) + 1e-6f);
                            f32x4 a = acc[ai][0][m][0] * rs, b = acc[ai][0][m][1] * rs;
#pragma unroll
                            for (int e = 0; e < 4; ++e) { a[e] = fast_sigmoid(a[e]); b[e] = fast_sigmoid(b[e]); }
                            *(f32x4*)dst = a; *(f32x4*)(dst + 4) = b; }
                    }
            }
        }
    }
};
template <class Epi, class Sched, bool ALIGN_EPI = false, bool SP2 = false>
__device__ __forceinline__ void gemm_phase(PG8_LAS unsigned char* lds, const Gemm g, const Sched& S, const Epi& E) {
    int tid_ = threadIdx.x; asm volatile("" : "+v"(tid_));
    const int tid = tid_, wid = __builtin_amdgcn_readfirstlane(tid >> 6), lane = tid & 63, wr = wid >> 2, wc = wid & 3, fr = lane & 15, fq = lane >> 4;
    const int K = g.K, nt = K / BK;
    unsigned voffA[2], voffB[2];
#pragma unroll
    for (int i = 0; i < 2; ++i) { int R, C; stage_rc(tid * 16 + i * 8192, R, C); const int Rb = Epi::PERM ? ((R & ~31) + perm32(R & 31)) : R;
        voffA[i] = (unsigned)(R * K + C) * 2u; voffB[i] = (unsigned)(Rb * K + C) * 2u; }
    const size_t kstep = (size_t)(BK * 2);
    const size_t hstep = (size_t)HALF * K * 2;
    const size_t tstep = 2 * hstep;
    const unsigned ldsw = (unsigned)wid * 1024u;
    const int aoff = lds_byte(wr * 64 + fr, fq * 8), boff = lds_byte(wc * 32 + fr, fq * 8);
#define PG8_SA(b, h) (((b) * 2 + (h)) * HTB)
#define PG8_SB(b, h) ((4 + (b) * 2 + (h)) * HTB)
#define PG8_STAGE(bufoff, gbase, voff) do { _Pragma("unroll") for (int _i = 0; _i < 2; ++_i) \
        __builtin_amdgcn_global_load_lds((const unsigned*)((const char*)(gbase) + (voff)[_i]), (PG8_LAS unsigned*)(lds + (bufoff) + ldsw + _i * 8192), 16, 0, 0); } while (0)
#define PG8_LDA(dst, b, h) do { _Pragma("unroll") for (int m = 0; m < 4; ++m) _Pragma("unroll") for (int k = 0; k < 2; ++k) dst[m][k] = *(const PG8_LAS bf16x8*)(lds + PG8_SA(b, h) + aoff + m * 2048 + k * 1024); } while (0)
#define PG8_LDB(dst, b, h) do { _Pragma("unroll") for (int n = 0; n < 2; ++n) _Pragma("unroll") for (int k = 0; k < 2; ++k) dst[n][k] = *(const PG8_LAS bf16x8*)(lds + PG8_SB(b, h) + boff + n * 2048 + k * 1024); } while (0)
#define PG8_MMA(ai, bj, At, Bt) do { __builtin_amdgcn_s_setprio(1); _Pragma("unroll") for (int m = 0; m < 4; ++m) _Pragma("unroll") for (int n = 0; n < 2; ++n) _Pragma("unroll") for (int k = 0; k < 2; ++k) \
        acc[ai][bj][m][n] = __builtin_amdgcn_mfma_f32_16x16x32_bf16(Bt[n][k], At[m][k], acc[ai][bj][m][n], 0, 0, 0); __builtin_amdgcn_s_setprio(0); } while (0)
#define PG8_WAIT_V(n) asm volatile("s_waitcnt vmcnt(" #n ")" ::: "memory")
#define PG8_WAIT_L(n) asm volatile("s_waitcnt lgkmcnt(" #n ")" ::: "memory")
#define PG8_BAR __builtin_amdgcn_s_barrier()
#define PG8_SCHED __builtin_amdgcn_sched_barrier(0)
    Unit cur, nxt; int ui = 0;
    if (!S.next(0, cur)) return;
    f32x4 acc[2][2][4][2];
#pragma unroll
    for (int a = 0; a < 2; ++a)
#pragma unroll
        for (int b = 0; b < 2; ++b)
#pragma unroll
            for (int m = 0; m < 4; ++m)
#pragma unroll
                for (int n = 0; n < 2; ++n) acc[a][b][m][n] = (f32x4){0.f, 0.f, 0.f, 0.f};
    bf16x8 At[4][2], B0[2][2], B1[2][2];
    const char* cA = (const char*)g.A + (size_t)cur.pm * tstep; const char* cB = (const char*)g.Bt + (size_t)cur.pn * tstep;
    S.a_ready(cur);
    if constexpr (SP2) {
        PG8_STAGE(PG8_SB(0, 0), cB, voffB); PG8_STAGE(PG8_SB(0, 1), cB + hstep, voffB); PG8_STAGE(PG8_SA(0, 0), cA, voffA); PG8_STAGE(PG8_SA(0, 1), cA + hstep, voffA);
        if (wr == 1) PG8_BAR;
        PG8_WAIT_V(2); PG8_BAR;
        PG8_STAGE(PG8_SB(1, 0), cB + kstep, voffB); PG8_STAGE(PG8_SA(1, 0), cA + kstep, voffA); PG8_STAGE(PG8_SB(1, 1), cB + hstep + kstep, voffB);
        PG8_WAIT_V(6); PG8_BAR;
    } else {
        PG8_STAGE(PG8_SB(0, 0), cB, voffB); PG8_STAGE(PG8_SA(0, 0), cA, voffA); PG8_STAGE(PG8_SB(0, 1), cB + hstep, voffB); PG8_STAGE(PG8_SA(0, 1), cA + hstep, voffA);
        if (wr == 1) PG8_BAR;
        PG8_WAIT_V(4); PG8_BAR;
        PG8_STAGE(PG8_SB(1, 0), cB + kstep, voffB); PG8_STAGE(PG8_SA(1, 0), cA + kstep, voffA); PG8_STAGE(PG8_SB(1, 1), cB + hstep + kstep, voffB);
        PG8_WAIT_V(6); PG8_BAR;
    }
    for (;;) {
        const bool has_next = S.next(ui + 1, nxt);
        const char* nA = has_next ? (const char*)g.A + (size_t)nxt.pm * tstep : cA; const char* nB = has_next ? (const char*)g.Bt + (size_t)nxt.pn * tstep : cB;
        for (int t = 0; t < nt; t += 2) {
            const bool last = (t == nt - 2);
            const char* a1 = cA + (size_t)(t + 1) * kstep;
            const char* a2 = last ? nA : cA + (size_t)(t + 2) * kstep; const char* b2 = last ? nB : cB + (size_t)(t + 2) * kstep;
            const char* a3 = a2 + kstep; const char* b3 = b2 + kstep;
            if (last && has_next) S.a_ready(nxt);
            if constexpr (SP2) {
            PG8_LDB(B0, 0, 0); PG8_LDB(B1, 0, 1); PG8_SCHED; PG8_LDA(At, 0, 0); PG8_STAGE(PG8_SA(1, 1), a1 + hstep, voffA);
            PG8_WAIT_V(8); PG8_WAIT_L(0); PG8_BAR; PG8_MMA(0, 0, At, B0); PG8_MMA(0, 1, At, B1); PG8_BAR; PG8_SCHED;
            PG8_LDA(At, 0, 1); PG8_STAGE(PG8_SB(0, 0), b2, voffB); PG8_STAGE(PG8_SB(0, 1), b2 + hstep, voffB); PG8_STAGE(PG8_SA(0, 0), a2, voffA);
            PG8_WAIT_V(8); PG8_WAIT_L(0); PG8_BAR; PG8_MMA(1, 0, At, B0); PG8_MMA(1, 1, At, B1); PG8_BAR; PG8_SCHED;
            PG8_LDB(B0, 1, 0); PG8_LDB(B1, 1, 1); PG8_SCHED; PG8_LDA(At, 1, 0); PG8_STAGE(PG8_SA(0, 1), a2 + hstep, voffA);
            PG8_WAIT_V(8); PG8_WAIT_L(0); PG8_BAR; PG8_MMA(0, 0, At, B0); PG8_MMA(0, 1, At, B1); PG8_BAR; PG8_SCHED;
            PG8_LDA(At, 1, 1); PG8_STAGE(PG8_SB(1, 0), b3, voffB); PG8_STAGE(PG8_SB(1, 1), b3 + hstep, voffB); PG8_STAGE(PG8_SA(1, 0), a3, voffA);
            PG8_WAIT_V(8); PG8_WAIT_L(0); PG8_BAR; PG8_MMA(1, 0, At, B0); PG8_MMA(1, 1, At, B1); PG8_BAR; PG8_SCHED;
            } else {
            PG8_LDB(B0, 0, 0); PG8_SCHED; PG8_LDA(At, 0, 0); PG8_STAGE(PG8_SA(1, 1), a1 + hstep, voffA);
            PG8_WAIT_L(8); PG8_BAR; PG8_WAIT_L(0); PG8_MMA(0, 0, At, B0); PG8_BAR; PG8_SCHED;
            PG8_LDB(B1, 0, 1); PG8_STAGE(PG8_SB(0, 0), b2, voffB);
            PG8_BAR; PG8_WAIT_L(0); PG8_MMA(0, 1, At, B1); PG8_BAR;
            PG8_LDA(At, 0, 1); PG8_STAGE(PG8_SA(0, 0), a2, voffA);
            PG8_BAR; PG8_WAIT_L(0); PG8_MMA(1, 0, At, B0); PG8_BAR; PG8_SCHED;
            PG8_STAGE(PG8_SB(0, 1), b2 + hstep, voffB);
            PG8_WAIT_V(6); PG8_BAR; PG8_MMA(1, 1, At, B1); PG8_BAR;
            PG8_LDB(B0, 1, 0); PG8_SCHED; PG8_LDA(At, 1, 0); PG8_STAGE(PG8_SA(0, 1), a2 + hstep, voffA);
            PG8_WAIT_L(8); PG8_BAR; PG8_WAIT_L(0); PG8_MMA(0, 0, At, B0); PG8_BAR; PG8_SCHED;
            PG8_LDB(B1, 1, 1); PG8_STAGE(PG8_SB(1, 0), b3, voffB);
            PG8_BAR; PG8_WAIT_L(0); PG8_MMA(0, 1, At, B1); PG8_BAR;
            PG8_LDA(At, 1, 1); PG8_STAGE(PG8_SA(1, 0), a3, voffA);
            PG8_BAR; PG8_WAIT_L(0); PG8_MMA(1, 0, At, B0); PG8_BAR; PG8_SCHED;
            PG8_STAGE(PG8_SB(1, 1), b3 + hstep, voffB);
            PG8_WAIT_V(6); PG8_BAR; PG8_MMA(1, 1, At, B1); PG8_BAR;
            }
        }
        if constexpr (ALIGN_EPI) { if (wr == 0) PG8_BAR; }
        if constexpr (!Epi::AFTER_DRAIN) { E(acc, cur, wr, wc, fr, fq); S.done(cur); }
        if (!has_next) break;
#pragma unroll
        for (int a = 0; a < 2; ++a)
#pragma unroll
            for (int b = 0; b < 2; ++b)
#pragma unroll
                for (int m = 0; m < 4; ++m)
#pragma unroll
                    for (int n = 0; n < 2; ++n) acc[a][b][m][n] = (f32x4){0.f, 0.f, 0.f, 0.f};
        cur = nxt; cA = nA; cB = nB; ++ui;
        if constexpr (ALIGN_EPI) { if (wr == 1) PG8_BAR; }
    }
    PG8_WAIT_V(0);
    if constexpr (!ALIGN_EPI) { if (wr == 0) PG8_BAR; }
    PG8_BAR;
    if constexpr (Epi::AFTER_DRAIN) { E.fused(acc, cur, wr, wc, fr, fq, lds, wid, lane); S.done(cur); }
#undef PG8_SA
#undef PG8_SB
#undef PG8_STAGE
#undef PG8_LDA
#undef PG8_LDB
#undef PG8_MMA
#undef PG8_WAIT_V
#undef PG8_WAIT_L
#undef PG8_BAR
#undef PG8_SCHED
}
}

#define LAS __attribute__((address_space(3)))
typedef unsigned short bf16;
typedef float f32x4 __attribute__((ext_vector_type(4)));
typedef short bf16x8 __attribute__((ext_vector_type(8)));
typedef unsigned u32x4 __attribute__((ext_vector_type(4)));
typedef unsigned long long u64;

constexpr int NB = 4, SEQ = 8192, DM = 1024, T = NB * SEQ, DFF = 2816, NH = 16, NG = 4, HD = 64;
constexpr int NQP = 1280;
constexpr int NKV = 1536;
constexpr int NCB = 512;
constexpr float RMS_EPS = 1e-6f;
constexpr float LOG2E = 1.4426950408889634f;
constexpr int LDS_BYTES = 151552;

constexpr size_t MiB = 1u << 20;
constexpr size_t SZ_WIN = (size_t)2 * DFF * DM * 2, SZ_WOUT = (size_t)DM * DFF * 2;
constexpr size_t WS_WIN = 1 * MiB;
constexpr size_t WS_WOUT = WS_WIN + 4 * SZ_WIN;
constexpr size_t WS_CWIN = WS_WOUT + 4 * SZ_WOUT;
constexpr size_t WS_CWOUT = WS_CWIN + (size_t)3072 * 1024 * 2;
constexpr size_t WS_WQ = WS_CWOUT + (size_t)1024 * 1024 * 2;
constexpr size_t WS_WO = WS_WQ + (size_t)NQP * 1024 * 2;
constexpr size_t WS_WKV = WS_WO + (size_t)1024 * 1024 * 2;
constexpr size_t WS_W1K = WS_WKV + (size_t)NKV * 1024 * 2;
constexpr size_t WS_W1V = WS_W1K + (size_t)128 * 2048 * 2;
constexpr size_t WS_W2K = WS_W1V + (size_t)128 * 2048 * 2;
constexpr size_t WS_W2V = WS_W2K + (size_t)64 * 128 * 2;
constexpr size_t WS_B1 = WS_W2V + (size_t)64 * 128 * 2;
constexpr size_t WS_WEND = WS_B1 + 1024;
static_assert(WS_WEND <= 90 * MiB, "weights region");
constexpr size_t WS_HN = 96 * MiB;
constexpr size_t WS_HN2 = 160 * MiB;
constexpr size_t WS_ACT = 224 * MiB;
constexpr size_t WS_BG = WS_ACT, WS_U = WS_ACT + 64 * MiB;
constexpr size_t WS_Q = WS_ACT;
constexpr size_t KV_BYTES = (size_t)16 * SEQ * 64 * 2;
constexpr size_t WS_KCR = 400 * MiB, WS_KS = WS_KCR + KV_BYTES, WS_KW = WS_KS + KV_BYTES;
constexpr size_t WS_VCR = WS_KW + KV_BYTES, WS_VST = WS_VCR + KV_BYTES, WS_VWT = WS_VST + KV_BYTES;
constexpr size_t WS_KC = 90 * MiB, WS_VCT = 91 * MiB;
constexpr size_t WS_GATES = WS_VWT + KV_BYTES;
constexpr size_t WS_AO = WS_HN2;
constexpr size_t WS_END = WS_GATES + 6 * MiB;
static_assert(WS_END <= 512 * MiB, "workspace");

struct Args {
    const float* in[24];
    float* out; unsigned char* ws;
};
typedef const __attribute__((address_space(4))) Args* KArgsP;
__device__ __forceinline__ KArgsP KA() { KArgsP p = (KArgsP)__builtin_amdgcn_kernarg_segment_ptr(); asm volatile("" : "+s"(p)); return p; }
#define IN(i) ((const float*)KA()->in[i])
#define WSP ((unsigned char*)KA()->ws)

typedef float f32x2_t __attribute__((ext_vector_type(2)));
typedef __bf16 bf16x2_t __attribute__((ext_vector_type(2)));
__device__ __forceinline__ unsigned cvt_pk(float lo, float hi) { const f32x2_t v = {lo, hi}; const bf16x2_t b = __builtin_convertvector(v, bf16x2_t); return __builtin_bit_cast(unsigned, b); }
__device__ __forceinline__ float bf2f(unsigned short b) { return __builtin_bit_cast(float, (unsigned)b << 16); }
__device__ __forceinline__ float wave_sum(float v) {
#pragma unroll
    for (int o = 1; o < 64; o <<= 1) v += __shfl_xor(v, o);
    return v;
}
__device__ __forceinline__ float wave_max(float v) {
#pragma unroll
    for (int o = 1; o < 64; o <<= 1) v = fmaxf(v, __shfl_xor(v, o));
    return v;
}

enum { MK_IDENT = 0, MK_FFN_IN = 1, MK_CONV_IN = 2, MK_HEADPERM = 3, MK_Q = 4 };
__device__ __forceinline__ int srcmap(int kind, int np) {
    const int pn = np >> 8, r = np & 255, bj = r >> 7, c = r & 127;
    if (kind == MK_FFN_IN) return bj * DFF + 128 * pn + c;
    if (kind == MK_CONV_IN) return pn < 4 ? np : 1024 * (1 + bj) + 128 * (pn - 4) + c;
    if (kind == MK_HEADPERM) return 256 * pn + 64 * (c >> 5) + 32 * bj;
    if (kind == MK_Q) return pn < 4 ? 256 * pn + 64 * (c >> 5) + 32 * bj : (r < 32 ? 1024 : (r < 64 ? 1056 : -1));
    return np;
}
struct MatDesc { const float* W; bf16* WT; int K, N, NP, kind; const float* gain; };

__device__ __forceinline__ void prep_load(const MatDesc& d, int item, int tid, f32x4 (&v)[4]) {
    const int nblk = d.NP >> 6, kb = item / nblk, nb = item - kb * nblk;
    const int n4 = tid & 15, kk = tid >> 4, s = n4 >> 3, n = 4 * (n4 & 7);
    const int sc = srcmap(d.kind, nb * 64 + s * 32);
    const bool ok = sc >= 0 && (sc + n) < d.N;
    const float* p = d.W + (size_t)(kb * 128 + kk) * d.N + sc + n;
#pragma unroll
    for (int i = 0; i < 4; ++i) { v[i] = ok ? *(const f32x4*)(p + (size_t)(32 * i) * d.N) : (f32x4){0.f, 0.f, 0.f, 0.f}; if (d.gain) v[i] = v[i] * d.gain[kb * 128 + kk + 32 * i]; }
}
__device__ __forceinline__ void prep_store_lds(LAS float* scr, int tid, const f32x4 (&v)[4]) {
    const int n4 = tid & 15, kk = tid >> 4;
#pragma unroll
    for (int i = 0; i < 4; ++i)
#pragma unroll
        for (int e = 0; e < 4; ++e) scr[(kk + 32 * i) * 65 + 4 * n4 + e] = v[i][e];
}
__device__ __forceinline__ void prep_write(const MatDesc& d, int item, int tid, const LAS float* scr) {
    const int nblk = d.NP >> 6, kb = item / nblk, nb = item - kb * nblk;
#pragma unroll
    for (int s = 0; s < 2; ++s) {
        const int n = (tid >> 4) + 32 * s, c = tid & 15;
        const LAS float* p = scr + (8 * c) * 65 + n;
        u32x4 o; o.x = cvt_pk(p[0], p[65]); o.y = cvt_pk(p[2 * 65], p[3 * 65]); o.z = cvt_pk(p[4 * 65], p[5 * 65]); o.w = cvt_pk(p[6 * 65], p[7 * 65]);
        *(u32x4*)(d.WT + (size_t)(nb * 64 + n) * d.K + kb * 128 + 8 * c) = o;
    }
}

__device__ __forceinline__ MatDesc get_mat(const Args& a, int mi) {
    unsigned char* ws = WSP;
    MatDesc d; d.gain = nullptr;
    if (mi < 4) { const int layer = mi >> 1, f2 = mi & 1;
        d.gain = IN(f2 ? 5 : 1) + layer * DM;
        d.W = IN(f2 ? 6 : 2) + (size_t)layer * DM * 2 * DFF; d.WT = (bf16*)(ws + WS_WIN + (size_t)mi * SZ_WIN); d.K = DM; d.N = 2 * DFF; d.NP = 2 * DFF; d.kind = MK_FFN_IN; return d; }
    if (mi < 8) { const int s = mi - 4, layer = s >> 1, f2 = s & 1;
        d.W = IN(f2 ? 7 : 3) + (size_t)layer * DFF * DM; d.WT = (bf16*)(ws + WS_WOUT + (size_t)s * SZ_WOUT); d.K = DFF; d.N = DM; d.NP = DM; d.kind = MK_IDENT; return d; }
    switch (mi) {
    case 8:  d.W = IN(8);  d.WT = (bf16*)(ws + WS_CWIN);  d.K = DM; d.N = 3072; d.NP = 3072; d.kind = MK_CONV_IN; d.gain = IN(4); break;
    case 9:  d.W = IN(10); d.WT = (bf16*)(ws + WS_CWOUT); d.K = DM; d.N = DM;   d.NP = DM;   d.kind = MK_IDENT; break;
    case 10: d.W = IN(11); d.WT = (bf16*)(ws + WS_WQ);    d.K = DM; d.N = 1072; d.NP = NQP;  d.kind = MK_Q; d.gain = IN(4) + DM; break;
    case 11: d.W = IN(13); d.WT = (bf16*)(ws + WS_WO);    d.K = DM; d.N = DM;   d.NP = DM;   d.kind = MK_IDENT; break;
    case 12: d.W = IN(15); d.WT = (bf16*)(ws + WS_WKV);   d.K = DM; d.N = NKV;  d.NP = NKV;  d.kind = MK_HEADPERM; d.gain = IN(14); break;
    case 13: d.W = IN(19); d.WT = (bf16*)(ws + WS_W1K);   d.K = 2048; d.N = 128; d.NP = 128; d.kind = MK_IDENT; break;
    case 14: d.W = IN(21); d.WT = (bf16*)(ws + WS_W1V);   d.K = 2048; d.N = 128; d.NP = 128; d.kind = MK_IDENT; break;
    case 15: d.W = IN(20); d.WT = (bf16*)(ws + WS_W2K);   d.K = 128; d.N = 64; d.NP = 64; d.kind = MK_IDENT; break;
    default: d.W = IN(22); d.WT = (bf16*)(ws + WS_W2V);   d.K = 128; d.N = 64; d.NP = 64; d.kind = MK_IDENT; break;
    }
    return d;
}
constexpr int N_MATS = 17;
__device__ __forceinline__ int mat_items(int mi) {
    if (mi < 4) return 8 * 88; if (mi < 8) return 22 * 16;
    switch (mi) { case 8: return 8 * 48; case 9: return 8 * 16; case 10: return 8 * 20; case 11: return 8 * 16; case 12: return 8 * 24; case 13: case 14: return 16 * 2; default: return 1; }
}
__device__ __forceinline__ bool prep_locate(int g, int& mi, int& item) {
    for (int m = 0; m < N_MATS; ++m) { const int n = mat_items(m); if (g < n) { mi = m; item = g; return true; } g -= n; }
    return false;
}

__device__ __forceinline__ void phase_prep(const Args& a, LAS unsigned char* lds) {
    LAS float* scr = (LAS float*)lds;
    int tid_ = threadIdx.x; asm volatile("" : "+v"(tid_)); const int tid = tid_, G = gridDim.x;
    f32x4 v[4]; int mi, item;
    int g = blockIdx.x;
    bool have = prep_locate(g, mi, item);
    MatDesc d = {};
    if (have) { d = get_mat(a, mi); prep_load(d, item, tid, v); }
    while (have) {
        prep_store_lds(scr, tid, v);
        __syncthreads();
        const MatDesc dc = d; const int itc = item;
        g += G; have = prep_locate(g, mi, item);
        if (have) { d = get_mat(a, mi); prep_load(d, item, tid, v); }
        prep_write(dc, itc, tid, scr);
        __syncthreads();
    }
    if (blockIdx.x < 2) {
        const int kv = blockIdx.x; const float* pe = IN(kv ? 18 : 17); const float* w1 = IN(kv ? 21 : 19);
        const int col = tid & 127, part = tid >> 7; float s = 0.f;
        for (int k = part * 512; k < part * 512 + 512; ++k) s += pe[k] * w1[(size_t)k * 128 + col];
        scr[tid] = s; __syncthreads();
        if (tid < 128) ((float*)(WSP + WS_B1))[kv * 128 + tid] = scr[tid] + scr[tid + 128] + scr[tid + 256] + scr[tid + 384];
        __syncthreads();
    }
}

__device__ __forceinline__ void phase_norm(const float* h, const float* g1, bf16* o1, const float* g2, bf16* o2) {
    int tid_ = threadIdx.x; asm volatile("" : "+v"(tid_));
    const int lane = tid_ & 63, wave = tid_ >> 6;
    const int gw = blockIdx.x * 8 + wave, NGW = gridDim.x * 8;
    f32x4 ga[4], gb[4];
#pragma unroll
    for (int j = 0; j < 4; ++j) { ga[j] = *(const f32x4*)(g1 + 4 * lane + 256 * j); gb[j] = g2 ? *(const f32x4*)(g2 + 4 * lane + 256 * j) : ga[j]; }
    for (int m = gw; m < T; m += NGW) {
        const f32x4* xr = (const f32x4*)(h + (size_t)m * DM) + lane;
        f32x4 v[4]; float s = 0.f;
#pragma unroll
        for (int j = 0; j < 4; ++j) { v[j] = xr[64 * j]; s += (v[j].x * v[j].x + v[j].y * v[j].y) + (v[j].z * v[j].z + v[j].w * v[j].w); }
        const float rstd = __builtin_amdgcn_rsqf(wave_sum(s) * (1.f / DM) + RMS_EPS);
        u64* p1 = (u64*)(o1 + (size_t)m * DM) + lane;
#pragma unroll
        for (int j = 0; j < 4; ++j) { const f32x4 y = v[j] * rstd * ga[j]; p1[64 * j] = (u64)cvt_pk(y.x, y.y) | ((u64)cvt_pk(y.z, y.w) << 32); }
        if (g2) { u64* p2 = (u64*)(o2 + (size_t)m * DM) + lane;
#pragma unroll
            for (int j = 0; j < 4; ++j) { const f32x4 y = v[j] * rstd * gb[j]; p2[64 * j] = (u64)cvt_pk(y.x, y.y) | ((u64)cvt_pk(y.z, y.w) << 32); } }
    }
}

constexpr size_t WS_SS = 131072;
__device__ __forceinline__ void phase_x(const float* x, bf16* hb, float* ss) {
    int tid_ = threadIdx.x; asm volatile("" : "+v"(tid_));
    const int lane = tid_ & 63, wave = tid_ >> 6;
    const int gw = blockIdx.x * 8 + wave, NGW = gridDim.x * 8;
    for (int i = blockIdx.x * 512 + tid_; i < 5 * T; i += gridDim.x * 512) ss[T + i] = 0.f;
    for (int m = gw; m < T; m += NGW) {
        const f32x4* xr = (const f32x4*)(x + (size_t)m * DM) + lane;
        f32x4 v[4]; float s = 0.f;
#pragma unroll
        for (int j = 0; j < 4; ++j) { v[j] = xr[64 * j]; s += (v[j].x * v[j].x + v[j].y * v[j].y) + (v[j].z * v[j].z + v[j].w * v[j].w); }
        s = wave_sum(s);
        u64* p1 = (u64*)(hb + (size_t)m * DM) + lane;
#pragma unroll
        for (int j = 0; j < 4; ++j) p1[64 * j] = (u64)cvt_pk(v[j].x, v[j].y) | ((u64)cvt_pk(v[j].z, v[j].w) << 32);
        if (lane == 0) ss[m] = s;
    }
}

__device__ __forceinline__ void unpack8(const u32x4 w, float (&f)[8]) {
    f[0] = __builtin_bit_cast(float, w.x << 16); f[1] = __builtin_bit_cast(float, w.x & 0xffff0000u); f[2] = __builtin_bit_cast(float, w.y << 16); f[3] = __builtin_bit_cast(float, w.y & 0xffff0000u);
    f[4] = __builtin_bit_cast(float, w.z << 16); f[5] = __builtin_bit_cast(float, w.z & 0xffff0000u); f[6] = __builtin_bit_cast(float, w.w << 16); f[7] = __builtin_bit_cast(float, w.w & 0xffff0000u);
}
__device__ __forceinline__ void phase_conv(const bf16* Bg, const bf16* U, const float* cw, bf16* Z) {
    int tid_ = threadIdx.x; asm volatile("" : "+v"(tid_));
    const int tid = tid_, cc = tid & 127, trow = tid >> 7;
    float w0[8], w1[8], w2[8];
#pragma unroll
    for (int e = 0; e < 8; ++e) { w0[e] = cw[8 * cc + e]; w1[e] = cw[1024 + 8 * cc + e]; w2[e] = cw[2048 + 8 * cc + e]; }
    for (int tb = blockIdx.x; tb < T / 128; tb += gridDim.x) {
        const int tbeg = tb * 128 + trow * 32;
        float u1[8], u2[8];
        if ((tbeg & (SEQ - 1)) == 0) {
#pragma unroll
            for (int e = 0; e < 8; ++e) { u1[e] = 0.f; u2[e] = 0.f; }
        } else {
            unpack8(*(const u32x4*)(U + (size_t)(tbeg - 1) * DM + 8 * cc), u1);
            unpack8(*(const u32x4*)(U + (size_t)(tbeg - 2) * DM + 8 * cc), u2);
        }
#pragma unroll 4
        for (int i = 0; i < 32; ++i) {
            const size_t p = (size_t)(tbeg + i) * DM + 8 * cc;
            float u0[8], bgv[8], z[8];
            unpack8(*(const u32x4*)(U + p), u0); unpack8(*(const u32x4*)(Bg + p), bgv);
#pragma unroll
            for (int e = 0; e < 8; ++e) { z[e] = bgv[e] * (w0[e] * u2[e] + w1[e] * u1[e] + w2[e] * u0[e]); u2[e] = u1[e]; u1[e] = u0[e]; }
            u32x4 o; o.x = cvt_pk(z[0], z[1]); o.y = cvt_pk(z[2], z[3]); o.z = cvt_pk(z[4], z[5]); o.w = cvt_pk(z[6], z[7]);
            *(u32x4*)(Z + p) = o;
        }
    }
}

__device__ __forceinline__ void phase_compress(const Args& a, LAS unsigned char* lds, size_t off_kc = WS_KC, size_t off_vct = WS_VCT) {
    unsigned char* ws = WSP;
    int tid_ = threadIdx.x; asm volatile("" : "+v"(tid_));
    const int tid = tid_, lane = tid & 63, w = tid >> 6, lc = lane & 15, lg = lane >> 4;
    LAS bf16* hid = (LAS bf16*)lds;
    LAS float* outf = (LAS float*)(lds + 32 * 136 * 2);
    for (int u2 = blockIdx.x * 2; u2 < 512; u2 += gridDim.x * 2)
    for (int uu = u2; uu < u2 + 2; ++uu) {
        const int kv = uu >> 8, R0 = (uu & 255) * 32;
        const bf16* raw = (const bf16*)(ws + (kv ? WS_VCR : WS_KCR));
        const bf16* w1t = (const bf16*)(ws + (kv ? WS_W1V : WS_W1K));
        const bf16* w2t = (const bf16*)(ws + (kv ? WS_W2V : WS_W2K));
        const float* b1 = (const float*)(ws + WS_B1) + kv * 128;
        f32x4 acc[2] = {{0.f, 0.f, 0.f, 0.f}, {0.f, 0.f, 0.f, 0.f}};
        const bf16* ap0 = raw + (size_t)(R0 + lc) * 1024 + 8 * lg;
        const bf16* ap1 = ap0 + (size_t)16 * 1024;
        const bf16* bp = w1t + (size_t)(16 * w + lc) * 2048 + 8 * lg;
        bf16x8 A0[4], A1[4], B[4];
#pragma unroll
        for (int s = 0; s < 4; ++s) { A0[s] = *(const bf16x8*)(ap0 + 32 * s); A1[s] = *(const bf16x8*)(ap1 + 32 * s); B[s] = *(const bf16x8*)(bp + 32 * s); }
        for (int k0 = 0; k0 < 2048; k0 += 128) {
            bf16x8 nA0[4], nA1[4], nB[4];
            const int kn = (k0 + 128 < 2048) ? k0 + 128 : k0;
#pragma unroll
            for (int s = 0; s < 4; ++s) { nA0[s] = *(const bf16x8*)(ap0 + kn + 32 * s); nA1[s] = *(const bf16x8*)(ap1 + kn + 32 * s); nB[s] = *(const bf16x8*)(bp + kn + 32 * s); }
#pragma unroll
            for (int s = 0; s < 4; ++s) { acc[0] = __builtin_amdgcn_mfma_f32_16x16x32_bf16(A0[s], B[s], acc[0], 0, 0, 0); acc[1] = __builtin_amdgcn_mfma_f32_16x16x32_bf16(A1[s], B[s], acc[1], 0, 0, 0); }
#pragma unroll
            for (int s = 0; s < 4; ++s) { A0[s] = nA0[s]; A1[s] = nA1[s]; B[s] = nB[s]; }
        }
        { const int col = 16 * w + lc; const float bb = b1[col];
#pragma unroll
          for (int rt = 0; rt < 2; ++rt)
#pragma unroll
            for (int r = 0; r < 4; ++r) { const float x = acc[rt][r] + bb; const float y = 2.f * 0.7978845608028654f * (x + 0.044715f * x * x * x);
                const float gl = x * __builtin_amdgcn_rcpf(1.f + __builtin_amdgcn_exp2f(-LOG2E * y));
                hid[(16 * rt + 4 * lg + r) * 136 + col] = (bf16)(cvt_pk(gl, 0.f) & 0xffffu); } }
        __syncthreads();
        { const int rt = w >> 2, ct = w & 3; f32x4 o = {0.f, 0.f, 0.f, 0.f};
#pragma unroll
          for (int ks = 0; ks < 4; ++ks) { const bf16x8 A = *(const LAS bf16x8*)(hid + (16 * rt + lc) * 136 + 32 * ks + 8 * lg); const bf16x8 B = *(const bf16x8*)(w2t + (size_t)(16 * ct + lc) * 128 + 32 * ks + 8 * lg);
              o = __builtin_amdgcn_mfma_f32_16x16x32_bf16(A, B, o, 0, 0, 0); }
#pragma unroll
          for (int r = 0; r < 4; ++r) outf[(16 * rt + 4 * lg + r) * 65 + 16 * ct + lc] = o[r]; }
        __syncthreads();
        { const int row = tid >> 4, d0 = 4 * (tid & 15); const int R = R0 + row, bg = R >> 9, i = R & 511;
          float v[4]; float ss = 0.f;
#pragma unroll
          for (int e = 0; e < 4; ++e) { v[e] = outf[row * 65 + d0 + e]; ss += v[e] * v[e]; }
          if (kv == 0) {
              ss += __shfl_xor(ss, 1); ss += __shfl_xor(ss, 2); ss += __shfl_xor(ss, 4); ss += __shfl_xor(ss, 8);
              const float rstd = __builtin_amdgcn_rsqf(ss * (1.f / 64.f) + RMS_EPS); const float* kn = IN(16);
#pragma unroll
              for (int e = 0; e < 4; ++e) v[e] = (i == 511) ? 0.f : v[e] * rstd * kn[d0 + e];
              bf16* dst = (bf16*)(ws + off_kc) + ((size_t)bg * NCB + i) * 64 + d0;
              *(u64*)dst = (u64)cvt_pk(v[0], v[1]) | ((u64)cvt_pk(v[2], v[3]) << 32);
          } else {
              bf16* dst = (bf16*)(ws + off_vct) + ((size_t)bg * 64 + d0) * NCB + i;
#pragma unroll
              for (int e = 0; e < 4; ++e) dst[(size_t)e * NCB] = (i == 511) ? (bf16)0 : (bf16)(cvt_pk(v[e], 0.f) & 0xffffu);
          } }
        __syncthreads();
    }
}

constexpr int A_IMP = 0, A_RING = 32768, TILE_PITCH = 192  , TILE_B = 64 * TILE_PITCH, STAGE_B = 2 * TILE_B,
              A_SELQ = A_RING + 2 * STAGE_B, A_BIAS = A_SELQ + 1024, A_MB = A_BIAS + 512, A_OUT = A_MB + 512;
constexpr int RELMAX_BIG = 0x40000000;

template <int MODE, int BM = 0, bool SEL = false>
__device__ __forceinline__ void attn_core(const bf16x8 (&kf)[4][2], const bf16x8 (&vf)[4][2], const bf16x8 (&qf)[2], int tq, int pbase, int pstride, int relmax,
                                          const LAS float* biasrow, float pscale, f32x4 (&oacc)[4], float& lsum, LAS float* improw, int jbase, int lg, int h, float pbias = 0.f, float pbias2 = 0.f, int thr = 0) {
    f32x4 s[4];
#pragma unroll
    for (int kt = 0; kt < 4; ++kt) {
        s[kt] = __builtin_amdgcn_mfma_f32_16x16x32_bf16(kf[kt][0], qf[0], (f32x4){0.f, 0.f, 0.f, 0.f}, 0, 0, 0);
        s[kt] = __builtin_amdgcn_mfma_f32_16x16x32_bf16(kf[kt][1], qf[1], s[kt], 0, 0, 0);
    }
#pragma unroll
    for (int kt = 0; kt < 4; ++kt) {
        const int kap0 = 32 * (kt >> 1) + 8 * lg + 4 * (kt & 1);
        const int rel0 = tq - (pbase + kap0 * pstride);
#pragma unroll
        for (int r = 0; r < 4; ++r) {
            float p;
            if (BM == 1) {
                p = __builtin_amdgcn_exp2f(s[kt][r] + pbias);
            } else if (BM == 2) {
                const int rel = rel0 - r * pstride;
                p = __builtin_amdgcn_exp2f(s[kt][r] + (rel >= thr ? pbias2 : pbias));
            } else if (BM == 3) {
                const int rel = rel0 - r * pstride;
                int bk = 39 - __clz((int)__umul24((unsigned)rel, (unsigned)rel)); bk = bk > 31 ? 31 : bk;
                p = __builtin_amdgcn_exp2f(s[kt][r] + biasrow[bk]);
                if (SEL) p = tq >= 0 ? p : 0.f;
            } else {
            const int rel = rel0 - r * pstride;
            const bool valid = (unsigned)rel < (unsigned)relmax;
            const int n = valid ? rel : 0;
            const int nn = (int)__umul24((unsigned)n, (unsigned)n);
            int bk = 39 - __clz(nn); bk = bk > 31 ? 31 : bk; bk = n < 16 ? n : bk;
            const float x = s[kt][r] + biasrow[bk];
            p = valid ? __builtin_amdgcn_exp2f(x) : 0.f;
            }
            if (MODE == 2) p *= pscale;
            s[kt][r] = p; lsum += p;
        }
        __builtin_amdgcn_sched_barrier(0);
        if (MODE == 2) {
            float av = 2.f * (s[kt][0] + s[kt][1] + s[kt][2]) + s[kt][3], bv = s[kt][3];
            av += __shfl_xor(av, 1); av += __shfl_xor(av, 2); bv += __shfl_xor(bv, 1); bv += __shfl_xor(bv, 2);
            if (h == 0) { const int j = jbase + (kap0 >> 2);
                improw[j] = improw[j] + av;
                if (j + 1 < 128) improw[j + 1] = improw[j + 1] + bv; }
        }
    }
    if (MODE >= 1) {
#pragma unroll
        for (int hh = 0; hh < 2; ++hh) {
            u32x4 pw; pw.x = cvt_pk(s[2 * hh][0], s[2 * hh][1]); pw.y = cvt_pk(s[2 * hh][2], s[2 * hh][3]); pw.z = cvt_pk(s[2 * hh + 1][0], s[2 * hh + 1][1]); pw.w = cvt_pk(s[2 * hh + 1][2], s[2 * hh + 1][3]);
            const bf16x8 pf = __builtin_bit_cast(bf16x8, pw);
#pragma unroll
            for (int dt = 0; dt < 4; ++dt) oacc[dt] = __builtin_amdgcn_mfma_f32_16x16x32_bf16(vf[dt][hh], pf, oacc[dt], 0, 0, 0);
        }
    }
}
__device__ __forceinline__ int rel_bucket_i(int n) { int bk = 39 - __clz((int)((unsigned)n * (unsigned)n)); bk = bk > 31 ? 31 : bk; return n < 16 ? n : bk; }
template <int MODE, bool SEL>
__device__ __forceinline__ void tile_stream(LAS unsigned char* ring, const bf16* Kbase, const bf16* Vbase, int ldv, int nt, int pb0, int pbstep, int pstride, int relmax,
                                            const bf16x8 (&qf)[2][2], const int (&tq)[2], const LAS float* biasrow, const float (&psc)[2], f32x4 (&oacc)[2][4], float (&ls)[2],
                                            LAS float* imp0, LAS float* imp1, const LAS u64* selA, const LAS u64* selB, int tid, int lc, int lg, int h) {
    const int row = tid >> 3, ch = tid & 7;
    const bf16* kp = Kbase + row * 64 + ch * 8;
    const bf16* vp = Vbase + (size_t)row * ldv + ch * 8;
    const int woff = row * TILE_PITCH + ch * 16;
    const float bfar = biasrow[31]; const int tqlo = __builtin_amdgcn_readfirstlane(tq[0]) ;
    u32x4 rk = {0u, 0u, 0u, 0u}, rv = {0u, 0u, 0u, 0u};
    if (nt > 0) { rk = *(const u32x4*)kp; if (MODE > 0) rv = *(const u32x4*)vp; }
#define TILE_STEP(t, rk, rv) do { \
        LAS unsigned char* st = ring + (t & 1) * STAGE_B; \
        *(LAS u32x4*)(st + woff) = rk; if (MODE > 0) *(LAS u32x4*)(st + TILE_B + woff) = rv; \
        asm volatile("s_waitcnt lgkmcnt(0)" ::: "memory"); __builtin_amdgcn_s_barrier(); asm volatile("" ::: "memory"); \
        if (t + 2 < nt) { rk = *(const u32x4*)(kp + (size_t)(t + 2) * 4096); if (MODE > 0) rv = *(const u32x4*)(vp + (t + 2) * 64); } \
        int tq0 = tq[0], tq1 = tq[1]; bool do0 = true, do1 = true; \
        if (SEL) { \
            const bool b0 = ((selA[t >> 6] >> (t & 63)) & 1ull) != 0ull, b1 = ((selB[t >> 6] >> (t & 63)) & 1ull) != 0ull; \
            tq0 = b0 ? tq0 : -1; tq1 = b1 ? tq1 : -1; do0 = __ballot(b0) != 0ull; do1 = __ballot(b1) != 0ull; \
        } \
        if (do0 || do1) { \
            bf16x8 kf[4][2], vf[4][2]; \
_Pragma("unroll") \
            for (int kt = 0; kt < 4; ++kt) { const LAS unsigned char* p = st + (32 * (kt >> 1) + 8 * (lc >> 2) + 4 * (kt & 1) + (lc & 3)) * TILE_PITCH + 16 * lg; \
                kf[kt][0] = *(const LAS bf16x8*)p; kf[kt][1] = *(const LAS bf16x8*)(p + 64); } \
            if (MODE > 0) { \
_Pragma("unroll") \
                for (int dt = 0; dt < 4; ++dt) { const LAS unsigned char* p = st + TILE_B + (16 * dt + lc) * TILE_PITCH + 16 * lg; \
                    vf[dt][0] = *(const LAS bf16x8*)p; vf[dt][1] = *(const LAS bf16x8*)(p + 64); } \
            } \
            const int pbase = pb0 + t * pbstep; \
            { \
 \
                const int rlo = tqlo - (pbase + 63 * pstride), rhi = tqlo + 7 - pbase; \
                const int blo = rel_bucket_i(rlo < 0 ? 0 : rlo), bhi = rel_bucket_i(rhi < 0 ? 0 : rhi); \
                if (rlo >= 0 && rhi < relmax && bhi - blo <= 1) { \
                    int thr = 0x7fffffff; \
                    if (bhi != blo) { int a = rlo, b = rhi; \
                        while (b - a > 1) { const int mid = (a + b) >> 1; if (rel_bucket_i(mid) == blo) a = mid; else b = mid; } \
                        thr = b; } \
                    const float pb1 = biasrow[blo], pb2 = biasrow[bhi]; \
                    const float pa0 = (!SEL || tq0 >= 0) ? pb1 : -1e30f, pa1 = (!SEL || tq0 >= 0) ? pb2 : -1e30f, pc0 = (!SEL || tq1 >= 0) ? pb1 : -1e30f, pc1 = (!SEL || tq1 >= 0) ? pb2 : -1e30f; \
                    if (bhi == blo) { \
                        if (do0) attn_core<MODE, 1, SEL>(kf, vf, qf[0], tq0, pbase, pstride, relmax, biasrow, psc[0], oacc[0], ls[0], imp0, 16 * t, lg, h, pa0); \
                        if (do1) attn_core<MODE, 1, SEL>(kf, vf, qf[1], tq1, pbase, pstride, relmax, biasrow, psc[1], oacc[1], ls[1], imp1, 16 * t, lg, h, pc0); \
                    } else { \
                        if (do0) attn_core<MODE, 2, SEL>(kf, vf, qf[0], tq[0], pbase, pstride, relmax, biasrow, psc[0], oacc[0], ls[0], imp0, 16 * t, lg, h, pa0, pa1, thr); \
                        if (do1) attn_core<MODE, 2, SEL>(kf, vf, qf[1], tq[1], pbase, pstride, relmax, biasrow, psc[1], oacc[1], ls[1], imp1, 16 * t, lg, h, pc0, pc1, thr); \
                    } \
                } else if (rlo >= 16 && rhi < relmax) { \
                    if (do0) attn_core<MODE, 3, SEL>(kf, vf, qf[0], tq0, pbase, pstride, relmax, biasrow, psc[0], oacc[0], ls[0], imp0, 16 * t, lg, h); \
                    if (do1) attn_core<MODE, 3, SEL>(kf, vf, qf[1], tq1, pbase, pstride, relmax, biasrow, psc[1], oacc[1], ls[1], imp1, 16 * t, lg, h); \
                } else { \
                    if (do0) attn_core<MODE>(kf, vf, qf[0], tq0, pbase, pstride, relmax, biasrow, psc[0], oacc[0], ls[0], imp0, 16 * t, lg, h); \
                    if (do1) attn_core<MODE>(kf, vf, qf[1], tq1, pbase, pstride, relmax, biasrow, psc[1], oacc[1], ls[1], imp1, 16 * t, lg, h); \
                } \
            } \
        } \
    } while (0)
    u32x4 rk1 = {0u, 0u, 0u, 0u}, rv1 = {0u, 0u, 0u, 0u};
    if (nt > 1) { rk1 = *(const u32x4*)(kp + 4096); if (MODE > 0) rv1 = *(const u32x4*)(vp + 64); }
    for (int t2 = 0; t2 < nt; t2 += 2) {
        { const int t = t2; TILE_STEP(t, rk, rv); }
        if (t2 + 1 < nt) { const int t = t2 + 1; TILE_STEP(t, rk1, rv1); }
    }
#undef TILE_STEP
    __syncthreads();
}

__device__ __forceinline__ void phase_attn(const Args& a, LAS unsigned char* lds) {
    unsigned char* ws = WSP;
    int tid_ = threadIdx.x; asm volatile("" : "+v"(tid_));
    const int w = __builtin_amdgcn_readfirstlane(tid_ >> 6);
    LAS float* imp = (LAS float*)(lds + A_IMP);
    LAS unsigned char* ring = lds + A_RING;
    LAS u64* selq = (LAS u64*)(lds + A_SELQ);
    LAS float* biasL = (LAS float*)(lds + A_BIAS);
    LAS float* mbound = (LAS float*)(lds + A_MB);
    const bf16* Q = (const bf16*)(ws + WS_Q);
    const float* gates = (const float*)(ws + WS_GATES);
    const float* relb = IN(23);
    if (w == 0) {
        const int lane = tid_ & 63;
        float mq = fabsf(IN(12)[lane]);
        float mk = fmaxf(fabsf(IN(16)[lane]), fmaxf(fabsf(IN(16)[64 + lane]), fabsf(IN(16)[128 + lane])));
        mq = wave_max(mq); mk = wave_max(mk);
        float mb = -1e30f;
        if (lane < 16) { for (int bk = 0; bk < 32; ++bk) mb = fmaxf(mb, relb[bk * 16 + lane]); mbound[lane] = mb + 8.f * mq * mk; }
    }
    __syncthreads();
    const int nunits = 2048, G = gridDim.x, bx = blockIdx.x;
    for (int it = 0; ; ++it) {
        int bg, qb;
        if (G == 256) {
            if (it >= 8) break;
            const int slot = bx >> 3, oo = slot >> 1; bg = 2 * (bx & 7) + (slot & 1);
            qb = (it & 1) ? 127 - 16 * (it >> 1) - oo : 16 * (it >> 1) + oo;
        } else {
            const int u = bx + it * G; if (u >= nunits) break;
            const int rr = u >> 4, ui = rr >> 4, oo = rr & 15; bg = u & 15;
            qb = (ui & 1) ? 127 - 16 * (ui >> 1) - oo : 16 * (ui >> 1) + oo;
        }
        const int b = bg >> 2, grp = bg & 3, t0 = 64 * qb, tokbase = b * SEQ + t0;
        int tidu = tid_; asm volatile("" : "+v"(tidu));
        const int tid = tidu, lane = tid & 63, lc = lane & 15, lg = lane >> 4, hq = lc >> 2, h = lc & 3;
        const u64 ltmask = (1ull << lane) - 1ull;
        for (int i = tid; i < 8192; i += 512) imp[i] = 0.f;
        if (tid < 128) { const int hh = tid >> 5, bk = tid & 31; biasL[tid] = (relb[bk * 16 + grp * 4 + hh] - mbound[grp * 4 + hh]) * LOG2E; }
        __syncthreads();
        const LAS float* biasrow = biasL + h * 32;
        bf16x8 qf[2][2]; int tqd[2]; float g0[2], g1[2], g2[2];
#pragma unroll
        for (int ct = 0; ct < 2; ++ct) { const int q = 8 * w + 4 * ct + hq; tqd[ct] = t0 + q;
            const bf16* qp = Q + (size_t)(tokbase + q) * DM + (grp * 4 + h) * 64 + 8 * lg; qf[ct][0] = *(const bf16x8*)qp; qf[ct][1] = *(const bf16x8*)(qp + 32);
            const float* gp = gates + (size_t)(tokbase + q) * 48 + (grp * 4 + h) * 3; g0[ct] = gp[0]; g1[ct] = gp[1]; g2[ct] = gp[2]; }
        LAS float* imp0 = imp + (8 * w + hq) * 128; LAS float* imp1 = imp + (8 * w + 4 + hq) * 128;
        LAS float* outp[2] = {(LAS float*)(lds + A_OUT) + ((8 * w + hq) * 4 + h) * 64 + 4 * lg, (LAS float*)(lds + A_OUT) + ((8 * w + 4 + hq) * 4 + h) * 64 + 4 * lg};
        const float one2[2] = {1.f, 1.f};
        {
            const int ncb = 4 * qb + 3, ntc = (ncb + 63) >> 6;
            const bf16* Kc = (const bf16*)(ws + WS_KC) + (size_t)bg * NCB * 64;
            const bf16* VcT = (const bf16*)(ws + WS_VCT) + (size_t)bg * 64 * NCB;
            float ls[2] = {0.f, 0.f}; f32x4 oc[2][4];
#pragma unroll
            for (int ct = 0; ct < 2; ++ct)
#pragma unroll
                for (int dt = 0; dt < 4; ++dt) oc[ct][dt] = (f32x4){0.f, 0.f, 0.f, 0.f};
            tile_stream<0, false>(ring, Kc, VcT, NCB, ntc, 31, 1024, 16, RELMAX_BIG, qf, tqd, biasrow, one2, oc, ls, imp0, imp1, selq, selq, tid, lc, lg, h);
            float inv[2];
#pragma unroll
            for (int ct = 0; ct < 2; ++ct) { float l = ls[ct]; l += __shfl_xor(l, 16); l += __shfl_xor(l, 32); inv[ct] = l > 0.f ? 1.f / l : 0.f; }
            float dummy[2] = {0.f, 0.f};
            tile_stream<2, false>(ring, Kc, VcT, NCB, ntc, 31, 1024, 16, RELMAX_BIG, qf, tqd, biasrow, inv, oc, dummy, imp0, imp1, selq, selq, tid, lc, lg, h);
#pragma unroll
            for (int ct = 0; ct < 2; ++ct)
#pragma unroll
                for (int dt = 0; dt < 4; ++dt) *(LAS f32x4*)(outp[ct] + 16 * dt) = oc[ct][dt] * g0[ct];
        }
        for (int qi = 0; qi < 8; ++qi) {
            const int q = 8 * w + qi; u64 lo, hi;
            if (qb < 16) { lo = (2ull << qb) - 1ull; hi = 0ull; }
            else {
                const int j0 = lane, j1 = lane + 64;
                const bool c0 = (j0 >= 1 && j0 <= qb - 2), c1 = (j1 <= qb - 2);
                const unsigned key0 = c0 ? __builtin_bit_cast(unsigned, imp[q * 128 + j0]) : 0u, key1 = c1 ? __builtin_bit_cast(unsigned, imp[q * 128 + j1]) : 0u;
                unsigned Tk = 0u;
                for (int bit = 30; bit >= 0; --bit) { const unsigned trial = Tk | (1u << bit);
                    const int cnt = __popcll(__ballot(key0 >= trial)) + __popcll(__ballot(key1 >= trial)); if (cnt >= 13) Tk = trial; }
                const bool gt0 = key0 > Tk, gt1 = key1 > Tk, e0 = (key0 == Tk) && c0, e1 = (key1 == Tk) && c1;
                const int need = 13 - (__popcll(__ballot(gt0)) + __popcll(__ballot(gt1)));
                const u64 m0 = __ballot(e0), m1 = __ballot(e1);
                const int r0 = __popcll(m0 & ltmask), r1 = __popcll(m0) + __popcll(m1 & ltmask);
                const bool s0 = gt0 || (e0 && r0 < need) || j0 == 0 || j0 == qb || j0 == qb - 1;
                const bool s1 = gt1 || (e1 && r1 < need) || j1 == qb || j1 == qb - 1;
                lo = __ballot(s0); hi = __ballot(s1);
            }
            if (lane == 0) { selq[q * 2] = lo; selq[q * 2 + 1] = hi; }
        }
        __builtin_amdgcn_wave_barrier();
        {
            const int tf = qb >= 8 ? 0 : 8 - qb, p0 = t0 - 512 + 64 * tf;
            const bf16* Kw = (const bf16*)(ws + WS_KW) + ((size_t)bg * SEQ + p0) * 64;
            const bf16* VwT = (const bf16*)(ws + WS_VWT) + (size_t)bg * 64 * SEQ + p0;
            float ls[2] = {0.f, 0.f}; f32x4 ow[2][4];
#pragma unroll
            for (int ct = 0; ct < 2; ++ct)
#pragma unroll
                for (int dt = 0; dt < 4; ++dt) ow[ct][dt] = (f32x4){0.f, 0.f, 0.f, 0.f};
            tile_stream<1, false>(ring, Kw, VwT, SEQ, 9 - tf, p0, 64, 1, 512, qf, tqd, biasrow, one2, ow, ls, imp0, imp1, selq, selq, tid, lc, lg, h);
#pragma unroll
            for (int ct = 0; ct < 2; ++ct) { float l = ls[ct]; l += __shfl_xor(l, 16); l += __shfl_xor(l, 32); const float sc = g2[ct] / l;
#pragma unroll
                for (int dt = 0; dt < 4; ++dt) *(LAS f32x4*)(outp[ct] + 16 * dt) = *(LAS f32x4*)(outp[ct] + 16 * dt) + ow[ct][dt] * sc; }
        }
        {
            const bf16* Ks = (const bf16*)(ws + WS_KS) + (size_t)bg * SEQ * 64;
            const bf16* VsT = (const bf16*)(ws + WS_VST) + (size_t)bg * 64 * SEQ;
            float ls[2] = {0.f, 0.f}; f32x4 os[2][4];
#pragma unroll
            for (int ct = 0; ct < 2; ++ct)
#pragma unroll
                for (int dt = 0; dt < 4; ++dt) os[ct][dt] = (f32x4){0.f, 0.f, 0.f, 0.f};
            tile_stream<1, true>(ring, Ks, VsT, SEQ, qb + 1, 0, 64, 1, RELMAX_BIG, qf, tqd, biasrow, one2, os, ls, imp0, imp1, selq + (8 * w + hq) * 2, selq + (8 * w + 4 + hq) * 2, tid, lc, lg, h);
            bf16* AO = (bf16*)(ws + WS_AO);
#pragma unroll
            for (int ct = 0; ct < 2; ++ct) { float l = ls[ct]; l += __shfl_xor(l, 16); l += __shfl_xor(l, 32); const float sc = g1[ct] / l;
                bf16* op = AO + (size_t)(tokbase + 8 * w + 4 * ct + hq) * DM + (grp * 4 + h) * 64 + 4 * lg;
#pragma unroll
                for (int dt = 0; dt < 4; ++dt) { const f32x4 v = *(LAS f32x4*)(outp[ct] + 16 * dt) + os[ct][dt] * sc; *(u64*)(op + 16 * dt) = (u64)cvt_pk(v[0], v[1]) | ((u64)cvt_pk(v[2], v[3]) << 32); } }
        }
    }
}

#define XB_TMO      128
#define XB_XCNT(j)  (256  + 64 * (j))
#define XB_XSUB(j)  (1280 + 64 * (j))
#define XB_XGEN(j)  (2304 + 64 * (j))
#define XB_TOP      3328
#define XB_TOPGEN   3392
#define XCD_BAR_WORDS 3456
#define XB_SPIN_CAP (1u << 23)

__device__ __forceinline__ unsigned xb_ld(unsigned* p)              { return __hip_atomic_load(p, __ATOMIC_RELAXED, __HIP_MEMORY_SCOPE_AGENT); }
__device__ __forceinline__ unsigned xb_add(unsigned* p, unsigned v) { return __hip_atomic_fetch_add(p, v, __ATOMIC_RELAXED, __HIP_MEMORY_SCOPE_AGENT); }
__device__ __forceinline__ unsigned xb_xcc_id() { return (unsigned)__builtin_amdgcn_s_getreg((3 << 11) | 20) & 0xFu; }
#define XB_SPIN(cond, bar) do { unsigned _sp = 0; while (cond) { __builtin_amdgcn_s_sleep(1); \
    if ((++_sp & 255u) == 0u) { if (xb_ld(&(bar)[XB_TMO])) break; if (_sp > XB_SPIN_CAP) { atomicAdd(&(bar)[XB_TMO], 1u); break; } } } } while (0)

struct XcdBarrier {
    unsigned* bar; unsigned x;
    volatile LAS unsigned* st;
};

__device__ __forceinline__ XcdBarrier xcd_barrier_post(unsigned* bar, volatile LAS unsigned* st) {
    XcdBarrier b; b.bar = bar; b.x = xb_xcc_id(); b.st = st;
    if (threadIdx.x == 0) (void)xb_add(&bar[XB_XCNT(b.x)], 1u);
    return b;
}
__device__ __forceinline__ void xcd_barrier_complete(unsigned* bar, unsigned x, unsigned& nloc, unsigned& nx) {
    const unsigned G = gridDim.x * gridDim.y * gridDim.z;
    unsigned sum, cnt, mine, sp = 0u;
    for (;;) {
        sum = 0u; cnt = 0u; mine = 0u;
#pragma unroll
        for (unsigned j = 0; j < 16; ++j) { const unsigned c = xb_ld(&bar[XB_XCNT(j)]); sum += c; cnt += (c > 0u) ? 1u : 0u; mine = (j == x) ? c : mine; }
        if (sum == G) break;
        __builtin_amdgcn_s_sleep(1);
        if ((++sp & 255u) == 0u) { if (xb_ld(&bar[XB_TMO])) break; if (sp > XB_SPIN_CAP) { atomicAdd(&bar[XB_TMO], 1u); break; } }
    }
    nloc = mine > 0u ? mine : 1u; nx = cnt > 0u ? cnt : 1u;
}

__device__ __forceinline__ void xcd_barrier(const XcdBarrier& b) {
    asm volatile("s_waitcnt vmcnt(0)" ::: "memory");
    __syncthreads();
    if (threadIdx.x == 0) {
        unsigned* bar = b.bar;
        __builtin_amdgcn_s_waitcnt(0);
        unsigned nloc = b.st[0], nx = b.st[1];
        if (nloc == 0u) { xcd_barrier_complete(bar, b.x, nloc, nx); b.st[0] = nloc; b.st[1] = nx; }
        const unsigned old = xb_add(&bar[XB_XSUB(b.x)], 1u);
        const unsigned gen = old / nloc;
        if (old + 1u == (gen + 1u) * nloc) {
            __builtin_amdgcn_fence(__ATOMIC_RELEASE, "agent");
            asm volatile("s_waitcnt vmcnt(0)" ::: "memory");
            const unsigned og = xb_add(&bar[XB_TOP], 1u);
            const unsigned tg = og / nx;
            if (og + 1u == (tg + 1u) * nx) xb_add(&bar[XB_TOPGEN], 1u);
            else XB_SPIN(xb_ld(&bar[XB_TOPGEN]) == tg, bar);
            __builtin_amdgcn_fence(__ATOMIC_ACQUIRE, "agent");
            xb_add(&bar[XB_XGEN(b.x)], 1u);
            asm volatile("s_waitcnt vmcnt(0)" ::: "memory");
        } else {
            XB_SPIN(xb_ld(&bar[XB_XGEN(b.x)]) == gen, bar);
            __builtin_amdgcn_fence(__ATOMIC_ACQUIRE, "agent");
            asm volatile("s_waitcnt vmcnt(0)" ::: "memory");
        }
    }
    __syncthreads();
}


__global__ void __launch_bounds__(512, 2) mk_fwd(Args a) {
    extern __shared__ __attribute__((aligned(16))) unsigned char lds_raw[];
    LAS unsigned char* lds = (LAS unsigned char*)lds_raw;
    cg::grid_group grid = cg::this_grid();
    unsigned char* ws = WSP;
    const float* x = IN(0); float* hout = KA()->out;
    bf16* HN = (bf16*)(ws + WS_HN); bf16* HN2 = (bf16*)(ws + WS_HN2); bf16* ACT = (bf16*)(ws + WS_ACT);
    const int G = gridDim.x, bx = blockIdx.x;
#define GRID_SYNC() do { \
        if (sync_no == 0u) { asm volatile("s_waitcnt vmcnt(0) lgkmcnt(0)" ::: "memory"); grid.sync(); \
            if (threadIdx.x == 0) { __builtin_amdgcn_fence(__ATOMIC_ACQUIRE, "agent"); asm volatile("s_waitcnt vmcnt(0)" ::: "memory"); } __syncthreads(); \
            xb = xcd_barrier_post(bar_words, xb_st); } \
        else xcd_barrier(xb); \
        ++sync_no; } while (0)
#define GEMM(EPI, Aptr, Bptr, N_, K_, E) do { pg8::Gemm g_{(const pg8::bf16_t*)(Aptr), (const pg8::bf16_t*)(Bptr), T, (N_), (K_)}; pg8::StaticOrder S_; S_.init(T, (N_), G, bx); \
        pg8::gemm_phase<std::remove_cv_t<std::remove_reference_t<decltype(E)>>, pg8::StaticOrder, true, true>((PG8_LAS unsigned char*)lds, g_, S_, (E)); } while (0)

    unsigned* bar_words = (unsigned*)(ws + 4096); unsigned sync_no = 0u;
    for (int i = bx * 512 + threadIdx.x; i < XCD_BAR_WORDS; i += G * 512) __hip_atomic_store(bar_words + i, 0u, __ATOMIC_RELAXED, __HIP_MEMORY_SCOPE_AGENT);
    volatile LAS unsigned* xb_st = (volatile LAS unsigned*)(lds + LDS_BYTES - 16);
    if (threadIdx.x < 2) xb_st[threadIdx.x] = 0u;
    XcdBarrier xb; xb.bar = bar_words; xb.x = 0u; xb.st = xb_st;
    float* SS = (float*)(ws + WS_SS);
#define SSK(k) (SS + (size_t)(k) * T)
    phase_prep(a, lds);
    phase_x(x, HN, SS);
    GRID_SYNC();
    { pg8::EpiSwiglu E{ACT, DFF, SSK(0)}; GEMM(pg8::EpiSwiglu, HN, ws + WS_WIN, 2 * DFF, DM, E); }
    GRID_SYNC();
    { pg8::EpiResid<true, 1, 0, false> E{x, hout, HN, SSK(1)}; GEMM((pg8::EpiResid<true, 1, 0, false>), ACT, ws + WS_WOUT, DM, DFF, E); }
    GRID_SYNC();
    { pg8::EpiConvIn E{(bf16*)(ws + WS_BG), (bf16*)(ws + WS_U), SSK(1)}; GEMM(pg8::EpiConvIn, HN, ws + WS_CWIN, 3072, DM, E); }
    GRID_SYNC();
    phase_conv((const bf16*)(ws + WS_BG), (const bf16*)(ws + WS_U), IN(9), HN2);
    GRID_SYNC();
    { pg8::EpiResid<true, 2, 1, false> E{hout, hout, HN, SSK(2)}; GEMM((pg8::EpiResid<true, 2, 1, false>), HN2, ws + WS_CWOUT, DM, DM, E); }
    GRID_SYNC();
    { pg8::EpiSwiglu E{ACT, DFF, SSK(2)}; GEMM(pg8::EpiSwiglu, HN, ws + WS_WIN + SZ_WIN, 2 * DFF, DM, E); }
    GRID_SYNC();
    { pg8::EpiResid<true, 1, 1, false> E{hout, hout, HN, SSK(3)}; GEMM((pg8::EpiResid<true, 1, 1, false>), ACT, ws + WS_WOUT + SZ_WOUT, DM, DFF, E); }
    GRID_SYNC();
    { pg8::EpiKV E; E.Kb = (bf16*)(ws + WS_KCR); E.Vb = (bf16*)(ws + WS_VCR); E.brstride = KV_BYTES / 2; E.knorm = IN(16); E.ss = SSK(3);
      GEMM(pg8::EpiKV, HN, ws + WS_WKV, NKV, DM, E); }
    GRID_SYNC();
    phase_compress(a, lds);
    { pg8::EpiSwiglu E{ACT, DFF, SSK(3)}; GEMM(pg8::EpiSwiglu, HN, ws + WS_WIN + 2 * SZ_WIN, 2 * DFF, DM, E); }
    GRID_SYNC();
    { pg8::EpiResid<true, 1, 1, false> E{hout, hout, HN, SSK(4)}; GEMM((pg8::EpiResid<true, 1, 1, false>), ACT, ws + WS_WOUT + 2 * SZ_WOUT, DM, DFF, E); }
    GRID_SYNC();
    { pg8::EpiQ E{(bf16*)(ws + WS_Q), (float*)(ws + WS_GATES), IN(12), 0.125f * LOG2E, SSK(4)}; GEMM(pg8::EpiQ, HN, ws + WS_WQ, NQP, DM, E); }
    GRID_SYNC();
    phase_attn(a, lds);
    GRID_SYNC();
    { pg8::EpiResid<true, 2, 1, false> E{hout, hout, HN, SSK(5)}; GEMM((pg8::EpiResid<true, 2, 1, false>), ws + WS_AO, ws + WS_WO, DM, DM, E); }
    GRID_SYNC();
    { pg8::EpiSwiglu E{ACT, DFF, SSK(5)}; GEMM(pg8::EpiSwiglu, HN, ws + WS_WIN + 3 * SZ_WIN, 2 * DFF, DM, E); }
    GRID_SYNC();
    { pg8::EpiResid<false, 1, 1, true> E{hout, hout, HN, nullptr}; GEMM((pg8::EpiResid<false, 1, 1, true>), ACT, ws + WS_WOUT + 3 * SZ_WOUT, DM, DFF, E); }
#undef SSK
#undef GEMM
}

extern "C" void kernel_launch(void* const* d_in, const int* in_sizes, int n_in, void* d_out, int out_size, void* d_ws, size_t ws_size, hipStream_t stream) {
    static int grid = 0;
    if (grid == 0) {
        if (n_in != 24 || out_size != T * DM || ws_size < WS_END) { fprintf(stderr, "kernel_launch: unexpected problem (n_in %d out %d ws %zu)\n", n_in, out_size, ws_size); grid = -1; return; }
        int dev = 0, cus = 0, per_cu = 0;
        (void)hipGetDevice(&dev);
        (void)hipDeviceGetAttribute(&cus, hipDeviceAttributeMultiprocessorCount, dev);
        (void)hipFuncSetAttribute((const void*)mk_fwd, hipFuncAttributeMaxDynamicSharedMemorySize, LDS_BYTES);
        (void)hipOccupancyMaxActiveBlocksPerMultiprocessor(&per_cu, (const void*)mk_fwd, 512, LDS_BYTES);
        if (per_cu < 1) per_cu = 1;
        grid = cus * per_cu;
    }
    if (grid < 0) return;
    Args a{};
    for (int i = 0; i < 24; ++i) a.in[i] = (const float*)d_in[i];
    a.out = (float*)d_out; a.ws = (unsigned char*)d_ws;
    void* args[] = {&a};
    hipError_t e = hipLaunchCooperativeKernel((const void*)mk_fwd, dim3(grid), dim3(512), args, LDS_BYTES, stream);
    if (e != hipSuccess) fprintf(stderr, "cooperative launch failed: %s (grid %d)\n", hipGetErrorString(e), grid);
}
```

```cpp
#include <hip/hip_runtime.h>
#include <hip/hip_cooperative_groups.h>
#include <cstdio>
#include <cstdint>
#include <type_traits>
namespace cg = cooperative_groups;
namespace pg8 {
#define PG8_LAS __attribute__((address_space(3)))
typedef unsigned short bf16_t;
typedef short bf16x8 __attribute__((ext_vector_type(8)));
typedef float f32x4 __attribute__((ext_vector_type(4)));
typedef unsigned u32x4 __attribute__((ext_vector_type(4)));
constexpr int BM = 256, BK = 64, HALF = 128, HTB = HALF * BK * 2  , STAGE_BYTES = 8 * HTB, NXCD = 8, WGM = 8;

__host__ __device__ __forceinline__ int lds_byte(int r, int c) { const int st = (r >> 4) * 2 + (c >> 5), rr = r & 15, cc = c & 31, ob = rr * 64 + cc * 2; return st * 1024 + (ob ^ (((ob >> 9) & 1) << 5)); }
__host__ __device__ __forceinline__ void stage_rc(int b, int& R, int& C) { const int st = b / 1024, sb = b % 1024, swz = sb ^ (((sb >> 9) & 1) << 5); R = (st >> 1) * 16 + swz / 64; C = (st & 1) * 32 + (swz % 64) / 2; }
__host__ __device__ __forceinline__ int perm32(int rho) { const int n = rho >> 4, i = rho & 15; return 8 * (i >> 2) + 4 * n + (i & 3); }

struct Unit { int pm, pn; };
struct Gemm { const bf16_t* A; const bf16_t* Bt; int M, N, K; };

struct StaticOrder {
    int nM, nN, nwg, G, c;
    __host__ __device__ void init(int M, int N, int G_, int c_) { nM = M / BM; nN = N / BM; nwg = nM * nN; G = G_; c = c_; }
    __host__ __device__ bool next(int i, Unit& u) const {
        const long L = (long)i * G + c; if (L >= nwg) return false;
        int wgid = (int)L; { const int q = nwg / NXCD, r = nwg % NXCD, xcd = wgid % NXCD, off = wgid / NXCD; wgid = (xcd < r ? xcd * (q + 1) : r * (q + 1) + (xcd - r) * q) + off; }
        const int nig = WGM * nN, gid = wgid / nig, fm = gid * WGM, gsz = (nM - fm) < WGM ? (nM - fm) : WGM;
        u.pm = fm + ((wgid % nig) % gsz); u.pn = (wgid % nig) / gsz; return true;
    }
    __device__ __forceinline__ void a_ready(const Unit&) const {}
    __device__ __forceinline__ void done(const Unit&) const {}
};

__device__ __forceinline__ unsigned cvt_pk_bf16(float lo, float hi) { unsigned r; asm volatile("v_cvt_pk_bf16_f32 %0, %1, %2" : "=v"(r) : "v"(lo), "v"(hi)); return r; }
__device__ __forceinline__ float fast_sigmoid(float x) { return __builtin_amdgcn_rcpf(1.f + __builtin_amdgcn_exp2f(-1.4426950408889634f * x)); }
__device__ __forceinline__ u32x4 pack8(const f32x4 a, const f32x4 b) { u32x4 w; w.x = cvt_pk_bf16(a[0], a[1]); w.y = cvt_pk_bf16(a[2], a[3]); w.z = cvt_pk_bf16(b[0], b[1]); w.w = cvt_pk_bf16(b[2], b[3]); return w; }

struct EpiSwiglu {
    static constexpr bool PERM = true, AFTER_DRAIN = false;
    bf16_t* O; int ldo; const float* ss;
    __device__ __forceinline__ void operator()(const f32x4 (&acc)[2][2][4][2], const Unit& u, int wr, int wc, int fr, int fq) const {
        const int row0 = u.pm * BM + wr * 64 + fr, col0 = u.pn * HALF + wc * 32 + 8 * fq;
#pragma unroll
        for (int ai = 0; ai < 2; ++ai)
#pragma unroll
            for (int m = 0; m < 4; ++m) {
                f32x4 v[2]; const float rs = __builtin_amdgcn_rsqf(ss[row0 + ai * HALF + m * 16] * (1.f / 1024.f) + 1e-6f);
#pragma unroll
                for (int n = 0; n < 2; ++n) { const f32x4 g = acc[ai][0][m][n] * rs, up = acc[ai][1][m][n] * rs;
#pragma unroll
                    for (int e = 0; e < 4; ++e) v[n][e] = g[e] * fast_sigmoid(g[e]) * up[e]; }
                *(u32x4*)(O + (size_t)(row0 + ai * HALF + m * 16) * ldo + col0) = pack8(v[0], v[1]);
            }
    }
};

template <bool NORM, int ALPHA2  , int HIN, bool FOUT> struct EpiResid {
    static constexpr bool PERM = true, AFTER_DRAIN = false;
    const float* hin; float* hout; bf16_t* HB; float* ssout;
    __device__ __forceinline__ void operator()(const f32x4 (&acc)[2][2][4][2], const Unit& u, int wr, int wc, int fr, int fq) const {
        const int row0 = u.pm * BM + wr * 64 + fr, col0 = u.pn * BM + wc * 32 + 8 * fq; constexpr float alpha = 0.5f * ALPHA2;
#pragma unroll
        for (int ai = 0; ai < 2; ++ai) {
            u32x4 hv[4][2]; f32x4 xv[4][2][2];
#pragma unroll
            for (int m = 0; m < 4; ++m)
#pragma unroll
                for (int bj = 0; bj < 2; ++bj) { const size_t p = (size_t)(row0 + ai * HALF + m * 16) * 1024 + col0 + bj * HALF;
                    if (HIN == 0) { xv[m][bj][0] = *(const f32x4*)(hin + p); xv[m][bj][1] = *(const f32x4*)(hin + p + 4); } else hv[m][bj] = *(const u32x4*)(HB + p); }
#pragma unroll
            for (int m = 0; m < 4; ++m) {
                float sq = 0.f;
#pragma unroll
                for (int bj = 0; bj < 2; ++bj) {
                    const size_t p = (size_t)(row0 + ai * HALF + m * 16) * 1024 + col0 + bj * HALF;
                    f32x4 a0, a1;
                    if (HIN == 0) { a0 = xv[m][bj][0]; a1 = xv[m][bj][1]; }
                    else { const u32x4 w = hv[m][bj];
                        a0 = (f32x4){__builtin_bit_cast(float, w.x << 16), __builtin_bit_cast(float, w.x & 0xffff0000u), __builtin_bit_cast(float, w.y << 16), __builtin_bit_cast(float, w.y & 0xffff0000u)};
                        a1 = (f32x4){__builtin_bit_cast(float, w.z << 16), __builtin_bit_cast(float, w.z & 0xffff0000u), __builtin_bit_cast(float, w.w << 16), __builtin_bit_cast(float, w.w & 0xffff0000u)}; }
                    a0 = a0 + acc[ai][bj][m][0] * alpha; a1 = a1 + acc[ai][bj][m][1] * alpha;
                    if (FOUT) { *(f32x4*)(hout + p) = a0; *(f32x4*)(hout + p + 4) = a1; }
                    if (NORM) { *(u32x4*)(HB + p) = pack8(a0, a1);
                        sq += (a0[0] * a0[0] + a0[1] * a0[1]) + (a0[2] * a0[2] + a0[3] * a0[3]) + (a1[0] * a1[0] + a1[1] * a1[1]) + (a1[2] * a1[2] + a1[3] * a1[3]); }
                }
                if (NORM) { sq += __shfl_xor(sq, 16); sq += __shfl_xor(sq, 32);
                    if (fq == 0) __hip_atomic_fetch_add(ssout + row0 + ai * HALF + m * 16, sq, __ATOMIC_RELAXED, __HIP_MEMORY_SCOPE_AGENT); }
            }
        }
    }
};

struct EpiConvIn {
    static constexpr bool PERM = true, AFTER_DRAIN = false;
    bf16_t* Bg; bf16_t* U; const float* ss;
    __device__ __forceinline__ void operator()(const f32x4 (&acc)[2][2][4][2], const Unit& u, int wr, int wc, int fr, int fq) const {
        const int row0 = u.pm * BM + wr * 64 + fr;
        if (u.pn < 4) {
            const int col0 = u.pn * BM + wc * 32 + 8 * fq;
#pragma unroll
            for (int ai = 0; ai < 2; ++ai)
#pragma unroll
                for (int m = 0; m < 4; ++m)
#pragma unroll
                    for (int bj = 0; bj < 2; ++bj) { const float rs = __builtin_amdgcn_rsqf(ss[row0 + ai * HALF + m * 16] * (1.f / 1024.f) + 1e-6f);
                        *(u32x4*)(Bg + (size_t)(row0 + ai * HALF + m * 16) * 1024 + col0 + bj * HALF) = pack8(acc[ai][bj][m][0] * rs, acc[ai][bj][m][1] * rs); }
        } else {
            const int col0 = (u.pn - 4) * HALF + wc * 32 + 8 * fq;
#pragma unroll
            for (int ai = 0; ai < 2; ++ai)
#pragma unroll
                for (int m = 0; m < 4; ++m) { const float r2 = __builtin_amdgcn_rcpf(ss[row0 + ai * HALF + m * 16] * (1.f / 1024.f) + 1e-6f);
                    *(u32x4*)(U + (size_t)(row0 + ai * HALF + m * 16) * 1024 + col0) = pack8(acc[ai][0][m][0] * acc[ai][1][m][0] * r2, acc[ai][0][m][1] * acc[ai][1][m][1] * r2); }
        }
    }
};

struct EpiKV {
    static constexpr bool PERM = true, AFTER_DRAIN = false;
    bf16_t *Kb, *Vb; size_t brstride; const float* knorm; const float* ss;
    __device__ __forceinline__ void operator()(const f32x4 (&acc)[2][2][4][2], const Unit& u, int wr, int wc, int fr, int fq) const {
        const int br = u.pn >> 1, kv = u.pn & 1;
        const int row0 = u.pm * BM + wr * 64 + fr;
#pragma unroll
        for (int ai = 0; ai < 2; ++ai)
#pragma unroll
            for (int m = 0; m < 4; ++m) {
                const int row = row0 + ai * HALF + m * 16, b = row >> 13, s = row & 8191, bg = b * 4 + wc;
                const float rs = __builtin_amdgcn_rsqf(ss[row] * (1.f / 1024.f) + 1e-6f);
                if (kv == 0) {
                    float rstd = rs;
                    if (br > 0) { float ss = 0.f;
#pragma unroll
                        for (int bj = 0; bj < 2; ++bj)
#pragma unroll
                            for (int n = 0; n < 2; ++n)
#pragma unroll
                                for (int e = 0; e < 4; ++e) ss += acc[ai][bj][m][n][e] * acc[ai][bj][m][n][e];
                        ss += __shfl_xor(ss, 16); ss += __shfl_xor(ss, 32);
                        rstd = rs * __builtin_amdgcn_rsqf(ss * rs * rs * (1.f / 64.f) + 1e-6f); }
                    bf16_t* dst = Kb + (size_t)br * brstride + ((size_t)bg * 8192 + s) * 64 + 8 * fq;
#pragma unroll
                    for (int bj = 0; bj < 2; ++bj) {
                        f32x4 v0 = acc[ai][bj][m][0] * rstd, v1 = acc[ai][bj][m][1] * rstd;
                        if (br > 0) { const float* gp = knorm + br * 64 + bj * 32 + 8 * fq; v0 = v0 * *(const f32x4*)gp; v1 = v1 * *(const f32x4*)(gp + 4); }
                        *(u32x4*)(dst + bj * 32) = pack8(v0, v1);
                    }
                } else if (br == 0) {
                    bf16_t* dst = Vb + ((size_t)bg * 8192 + s) * 64 + 8 * fq;
#pragma unroll
                    for (int bj = 0; bj < 2; ++bj) *(u32x4*)(dst + bj * 32) = pack8(acc[ai][bj][m][0] * rs, acc[ai][bj][m][1] * rs);
                } else {
                    bf16_t* dst = Vb + (size_t)br * brstride + ((size_t)bg * 64 + 8 * fq) * 8192 + s;
#pragma unroll
                    for (int bj = 0; bj < 2; ++bj)
#pragma unroll
                        for (int n = 0; n < 2; ++n) { const f32x4 v = acc[ai][bj][m][n] * rs;
                            const unsigned p0 = cvt_pk_bf16(v[0], v[1]), p1 = cvt_pk_bf16(v[2], v[3]);
                            bf16_t* d = dst + (size_t)(bj * 32 + 4 * n) * 8192;
                            d[0] = (bf16_t)(p0 & 0xffffu); d[8192] = (bf16_t)(p0 >> 16); d[2 * 8192] = (bf16_t)(p1 & 0xffffu); d[3 * 8192] = (bf16_t)(p1 >> 16); }
                }
            }
    }
};

struct EpiQ {
    static constexpr bool PERM = true, AFTER_DRAIN = false;
    bf16_t* Q; float* gates; const float* qnorm; float qscale; const float* ss;
    __device__ __forceinline__ void operator()(const f32x4 (&acc)[2][2][4][2], const Unit& u, int wr, int wc, int fr, int fq) const {
        const int row0 = u.pm * BM + wr * 64 + fr;
        if (u.pn < 4) {
            const int head = u.pn * 4 + wc;
#pragma unroll
            for (int ai = 0; ai < 2; ++ai)
#pragma unroll
                for (int m = 0; m < 4; ++m) {
                    float ss = 0.f;
#pragma unroll
                    for (int bj = 0; bj < 2; ++bj)
#pragma unroll
                        for (int n = 0; n < 2; ++n)
#pragma unroll
                            for (int e = 0; e < 4; ++e) ss += acc[ai][bj][m][n][e] * acc[ai][bj][m][n][e];
                    ss += __shfl_xor(ss, 16); ss += __shfl_xor(ss, 32);
                    const float rs = __builtin_amdgcn_rsqf(this->ss[row0 + ai * HALF + m * 16] * (1.f / 1024.f) + 1e-6f);
                    const float rstd = rs * __builtin_amdgcn_rsqf(ss * rs * rs * (1.f / 64.f) + 1e-6f) * qscale;
                    bf16_t* dst = Q + (size_t)(row0 + ai * HALF + m * 16) * 1024 + head * 64 + 8 * fq;
#pragma unroll
                    for (int bj = 0; bj < 2; ++bj) { const float* gp = qnorm + bj * 32 + 8 * fq;
                        const f32x4 v0 = acc[ai][bj][m][0] * rstd * *(const f32x4*)gp, v1 = acc[ai][bj][m][1] * rstd * *(const f32x4*)(gp + 4);
                        *(u32x4*)(dst + bj * 32) = pack8(v0, v1); }
                }
        } else {
            if (wc < 2) {
#pragma unroll
                for (int ai = 0; ai < 2; ++ai)
#pragma unroll
                    for (int m = 0; m < 4; ++m) {
                        const int c0 = wc * 32 + 8 * fq;
                        if (c0 < 48) { float* dst = gates + (size_t)(row0 + ai * HALF + m * 16) * 48 + c0; const float rs = __builtin_amdgcn_rsqf(this->ss[row0 + ai * HALF + m * 16] * (1.f / 1024.f) + 1e-6f);
                            f32x4 a = acc[ai][0][m][0] * rs, b = acc[ai][0][m][1] * rs;
#pragma unroll
                            for (int e = 0; e < 4; ++e) { a[e] = fast_sigmoid(a[e]); b[e] = fast_sigmoid(b[e]); }
                            *(f32x4*)dst = a; *(f32x4*)(dst + 4) = b; }
                    }
            }
        }
    }
};
template <class Epi, class Sched, bool ALIGN_EPI = false, bool SP2 = false>
__device__ __forceinline__ void gemm_phase(PG8_LAS unsigned char* lds, const Gemm g, const Sched& S, const Epi& E) {
    int tid_ = threadIdx.x; asm volatile("" : "+v"(tid_));
    const int tid = tid_, wid = __builtin_amdgcn_readfirstlane(tid >> 6), lane = tid & 63, wr = wid >> 2, wc = wid & 3, fr = lane & 15, fq = lane >> 4;
    const int K = g.K, nt = K / BK;
    unsigned voffA[2], voffB[2];
#pragma unroll
    for (int i = 0; i < 2; ++i) { int R, C; stage_rc(tid * 16 + i * 8192, R, C); const int Rb = Epi::PERM ? ((R & ~31) + perm32(R & 31)) : R;
        voffA[i] = (unsigned)(R * K + C) * 2u; voffB[i] = (unsigned)(Rb * K + C) * 2u; }
    const size_t kstep = (size_t)(BK * 2);
    const size_t hstep = (size_t)HALF * K * 2;
    const size_t tstep = 2 * hstep;
    const unsigned ldsw = (unsigned)wid * 1024u;
    const int aoff = lds_byte(wr * 64 + fr, fq * 8), boff = lds_byte(wc * 32 + fr, fq * 8);
#define PG8_SA(b, h) (((b) * 2 + (h)) * HTB)
#define PG8_SB(b, h) ((4 + (b) * 2 + (h)) * HTB)
#define PG8_STAGE(bufoff, gbase, voff) do { _Pragma("unroll") for (int _i = 0; _i < 2; ++_i) \
        __builtin_amdgcn_global_load_lds((const unsigned*)((const char*)(gbase) + (voff)[_i]), (PG8_LAS unsigned*)(lds + (bufoff) + ldsw + _i * 8192), 16, 0, 0); } while (0)
#define PG8_LDA(dst, b, h) do { _Pragma("unroll") for (int m = 0; m < 4; ++m) _Pragma("unroll") for (int k = 0; k < 2; ++k) dst[m][k] = *(const PG8_LAS bf16x8*)(lds + PG8_SA(b, h) + aoff + m * 2048 + k * 1024); } while (0)
#define PG8_LDB(dst, b, h) do { _Pragma("unroll") for (int n = 0; n < 2; ++n) _Pragma("unroll") for (int k = 0; k < 2; ++k) dst[n][k] = *(const PG8_LAS bf16x8*)(lds + PG8_SB(b, h) + boff + n * 2048 + k * 1024); } while (0)
#define PG8_MMA(ai, bj, At, Bt) do { __builtin_amdgcn_s_setprio(1); _Pragma("unroll") for (int m = 0; m < 4; ++m) _Pragma("unroll") for (int n = 0; n < 2; ++n) _Pragma("unroll") for (int k = 0; k < 2; ++k) \
        acc[ai][bj][m][n] = __builtin_amdgcn_mfma_f32_16x16x32_bf16(Bt[n][k], At[m][k], acc[ai][bj][m][n], 0, 0, 0); __builtin_amdgcn_s_setprio(0); } while (0)
#define PG8_WAIT_V(n) asm volatile("s_waitcnt vmcnt(" #n ")" ::: "memory")
#define PG8_WAIT_L(n) asm volatile("s_waitcnt lgkmcnt(" #n ")" ::: "memory")
#define PG8_BAR __builtin_amdgcn_s_barrier()
#define PG8_SCHED __builtin_amdgcn_sched_barrier(0)
    Unit cur, nxt; int ui = 0;
    if (!S.next(0, cur)) return;
    f32x4 acc[2][2][4][2];
#pragma unroll
    for (int a = 0; a < 2; ++a)
#pragma unroll
        for (int b = 0; b < 2; ++b)
#pragma unroll
            for (int m = 0; m < 4; ++m)
#pragma unroll
                for (int n = 0; n < 2; ++n) acc[a][b][m][n] = (f32x4){0.f, 0.f, 0.f, 0.f};
    bf16x8 At[4][2], B0[2][2], B1[2][2];
    const char* cA = (const char*)g.A + (size_t)cur.pm * tstep; const char* cB = (const char*)g.Bt + (size_t)cur.pn * tstep;
    S.a_ready(cur);
    if constexpr (SP2) {
        PG8_STAGE(PG8_SB(0, 0), cB, voffB); PG8_STAGE(PG8_SB(0, 1), cB + hstep, voffB); PG8_STAGE(PG8_SA(0, 0), cA, voffA); PG8_STAGE(PG8_SA(0, 1), cA + hstep, voffA);
        if (wr == 1) PG8_BAR;
        PG8_WAIT_V(2); PG8_BAR;
        PG8_STAGE(PG8_SB(1, 0), cB + kstep, voffB); PG8_STAGE(PG8_SA(1, 0), cA + kstep, voffA); PG8_STAGE(PG8_SB(1, 1), cB + hstep + kstep, voffB);
        PG8_WAIT_V(6); PG8_BAR;
    } else {
        PG8_STAGE(PG8_SB(0, 0), cB, voffB); PG8_STAGE(PG8_SA(0, 0), cA, voffA); PG8_STAGE(PG8_SB(0, 1), cB + hstep, voffB); PG8_STAGE(PG8_SA(0, 1), cA + hstep, voffA);
        if (wr == 1) PG8_BAR;
        PG8_WAIT_V(4); PG8_BAR;
        PG8_STAGE(PG8_SB(1, 0), cB + kstep, voffB); PG8_STAGE(PG8_SA(1, 0), cA + kstep, voffA); PG8_STAGE(PG8_SB(1, 1), cB + hstep + kstep, voffB);
        PG8_WAIT_V(6); PG8_BAR;
    }
    for (;;) {
        const bool has_next = S.next(ui + 1, nxt);
        const char* nA = has_next ? (const char*)g.A + (size_t)nxt.pm * tstep : cA; const char* nB = has_next ? (const char*)g.Bt + (size_t)nxt.pn * tstep : cB;
        for (int t = 0; t < nt; t += 2) {
            const bool last = (t == nt - 2);
            const char* a1 = cA + (size_t)(t + 1) * kstep;
            const char* a2 = last ? nA : cA + (size_t)(t + 2) * kstep; const char* b2 = last ? nB : cB + (size_t)(t + 2) * kstep;
            const char* a3 = a2 + kstep; const char* b3 = b2 + kstep;
            if (last && has_next) S.a_ready(nxt);
            if constexpr (SP2) {
            PG8_LDB(B0, 0, 0); PG8_LDB(B1, 0, 1); PG8_SCHED; PG8_LDA(At, 0, 0); PG8_STAGE(PG8_SA(1, 1), a1 + hstep, voffA);
            PG8_WAIT_V(8); PG8_WAIT_L(0); PG8_BAR; PG8_MMA(0, 0, At, B0); PG8_MMA(0, 1, At, B1); PG8_BAR; PG8_SCHED;
            PG8_LDA(At, 0, 1); PG8_STAGE(PG8_SB(0, 0), b2, voffB); PG8_STAGE(PG8_SB(0, 1), b2 + hstep, voffB); PG8_STAGE(PG8_SA(0, 0), a2, voffA);
            PG8_WAIT_V(8); PG8_WAIT_L(0); PG8_BAR; PG8_MMA(1, 0, At, B0); PG8_MMA(1, 1, At, B1); PG8_BAR; PG8_SCHED;
            PG8_LDB(B0, 1, 0); PG8_LDB(B1, 1, 1); PG8_SCHED; PG8_LDA(At, 1, 0); PG8_STAGE(PG8_SA(0, 1), a2 + hstep, voffA);
            PG8_WAIT_V(8); PG8_WAIT_L(0); PG8_BAR; PG8_MMA(0, 0, At, B0); PG8_MMA(0, 1, At, B1); PG8_BAR; PG8_SCHED;
            PG8_LDA(At, 1, 1); PG8_STAGE(PG8_SB(1, 0), b3, voffB); PG8_STAGE(PG8_SB(1, 1), b3 + hstep, voffB); PG8_STAGE(PG8_SA(1, 0), a3, voffA);
            PG8_WAIT_V(8); PG8_WAIT_L(0); PG8_BAR; PG8_MMA(1, 0, At, B0); PG8_MMA(1, 1, At, B1); PG8_BAR; PG8_SCHED;
            } else {
            PG8_LDB(B0, 0, 0); PG8_SCHED; PG8_LDA(At, 0, 0); PG8_STAGE(PG8_SA(1, 1), a1 + hstep, voffA);
            PG8_WAIT_L(8); PG8_BAR; PG8_WAIT_L(0); PG8_MMA(0, 0, At, B0); PG8_BAR; PG8_SCHED;
            PG8_LDB(B1, 0, 1); PG8_STAGE(PG8_SB(0, 0), b2, voffB);
            PG8_BAR; PG8_WAIT_L(0); PG8_MMA(0, 1, At, B1); PG8_BAR;
            PG8_LDA(At, 0, 1); PG8_STAGE(PG8_SA(0, 0), a2, voffA);
            PG8_BAR; PG8_WAIT_L(0); PG8_MMA(1, 0, At, B0); PG8_BAR; PG8_SCHED;
            PG8_STAGE(PG8_SB(0, 1), b2 + hstep, voffB);
            PG8_WAIT_V(6); PG8_BAR; PG8_MMA(1, 1, At, B1); PG8_BAR;
            PG8_LDB(B0, 1, 0); PG8_SCHED; PG8_LDA(At, 1, 0); PG8_STAGE(PG8_SA(0, 1), a2 + hstep, voffA);
            PG8_WAIT_L(8); PG8_BAR; PG8_WAIT_L(0); PG8_MMA(0, 0, At, B0); PG8_BAR; PG8_SCHED;
            PG8_LDB(B1, 1, 1); PG8_STAGE(PG8_SB(1, 0), b3, voffB);
            PG8_BAR; PG8_WAIT_L(0); PG8_MMA(0, 1, At, B1); PG8_BAR;
            PG8_LDA(At, 1, 1); PG8_STAGE(PG8_SA(1, 0), a3, voffA);
            PG8_BAR; PG8_WAIT_L(0); PG8_MMA(1, 0, At, B0); PG8_BAR; PG8_SCHED;
            PG8_STAGE(PG8_SB(1, 1), b3 + hstep, voffB);
            PG8_WAIT_V(6); PG8_BAR; PG8_MMA(1, 1, At, B1); PG8_BAR;
            }
        }
        if constexpr (ALIGN_EPI) { if (wr == 0) PG8_BAR; }
        if constexpr (!Epi::AFTER_DRAIN) { E(acc, cur, wr, wc, fr, fq); S.done(cur); }
        if (!has_next) break;
#pragma unroll
        for (int a = 0; a < 2; ++a)
#pragma unroll
            for (int b = 0; b < 2; ++b)
#pragma unroll
                for (int m = 0; m < 4; ++m)
#pragma unroll
                    for (int n = 0; n < 2; ++n) acc[a][b][m][n] = (f32x4){0.f, 0.f, 0.f, 0.f};
        cur = nxt; cA = nA; cB = nB; ++ui;
        if constexpr (ALIGN_EPI) { if (wr == 1) PG8_BAR; }
    }
    PG8_WAIT_V(0);
    if constexpr (!ALIGN_EPI) { if (wr == 0) PG8_BAR; }
    PG8_BAR;
    if constexpr (Epi::AFTER_DRAIN) { E.fused(acc, cur, wr, wc, fr, fq, lds, wid, lane); S.done(cur); }
#undef PG8_SA
#undef PG8_SB
#undef PG8_STAGE
#undef PG8_LDA
#undef PG8_LDB
#undef PG8_MMA
#undef PG8_WAIT_V
#undef PG8_WAIT_L
#undef PG8_BAR
#undef PG8_SCHED
}
}

#define LAS __attribute__((address_space(3)))
typedef unsigned short bf16;
typedef float f32x4 __attribute__((ext_vector_type(4)));
typedef short bf16x8 __attribute__((ext_vector_type(8)));
typedef unsigned u32x4 __attribute__((ext_vector_type(4)));
typedef unsigned long long u64;

constexpr int NB = 4, SEQ = 8192, DM = 1024, T = NB * SEQ, DFF = 2816, NH = 16, NG = 4, HD = 64;
constexpr int NQP = 1280;
constexpr int NKV = 1536;
constexpr int NCB = 512;
constexpr float RMS_EPS = 1e-6f;
constexpr float LOG2E = 1.4426950408889634f;
constexpr int LDS_BYTES = 151552;

constexpr size_t MiB = 1u << 20;
constexpr size_t SZ_WIN = (size_t)2 * DFF * DM * 2, SZ_WOUT = (size_t)DM * DFF * 2;
constexpr size_t WS_WIN = 1 * MiB;
constexpr size_t WS_WOUT = WS_WIN + 4 * SZ_WIN;
constexpr size_t WS_CWIN = WS_WOUT + 4 * SZ_WOUT;
constexpr size_t WS_CWOUT = WS_CWIN + (size_t)3072 * 1024 * 2;
constexpr size_t WS_WQ = WS_CWOUT + (size_t)1024 * 1024 * 2;
constexpr size_t WS_WO = WS_WQ + (size_t)NQP * 1024 * 2;
constexpr size_t WS_WKV = WS_WO + (size_t)1024 * 1024 * 2;
constexpr size_t WS_W1K = WS_WKV + (size_t)NKV * 1024 * 2;
constexpr size_t WS_W1V = WS_W1K + (size_t)128 * 2048 * 2;
constexpr size_t WS_W2K = WS_W1V + (size_t)128 * 2048 * 2;
constexpr size_t WS_W2V = WS_W2K + (size_t)64 * 128 * 2;
constexpr size_t WS_B1 = WS_W2V + (size_t)64 * 128 * 2;
constexpr size_t WS_WEND = WS_B1 + 1024;
static_assert(WS_WEND <= 90 * MiB, "weights region");
constexpr size_t WS_HN = 96 * MiB;
constexpr size_t WS_HN2 = 160 * MiB;
constexpr size_t WS_ACT = 224 * MiB;
constexpr size_t WS_BG = WS_ACT, WS_U = WS_ACT + 64 * MiB;
constexpr size_t WS_Q = WS_ACT;
constexpr size_t KV_BYTES = (size_t)16 * SEQ * 64 * 2;
constexpr size_t WS_KCR = 400 * MiB, WS_KS = WS_KCR + KV_BYTES, WS_KW = WS_KS + KV_BYTES;
constexpr size_t WS_VCR = WS_KW + KV_BYTES, WS_VST = WS_VCR + KV_BYTES, WS_VWT = WS_VST + KV_BYTES;
constexpr size_t WS_KC = 90 * MiB, WS_VCT = 91 * MiB;
constexpr size_t WS_GATES = WS_VWT + KV_BYTES;
constexpr size_t WS_AO = WS_HN2;
constexpr size_t WS_END = WS_GATES + 6 * MiB;
static_assert(WS_END <= 512 * MiB, "workspace");

struct Args {
    const float* in[24];
    float* out; unsigned char* ws;
};
typedef const __attribute__((address_space(4))) Args* KArgsP;
__device__ __forceinline__ KArgsP KA() { KArgsP p = (KArgsP)__builtin_amdgcn_kernarg_segment_ptr(); asm volatile("" : "+s"(p)); return p; }
#define IN(i) ((const float*)KA()->in[i])
#define WSP ((unsigned char*)KA()->ws)

typedef float f32x2_t __attribute__((ext_vector_type(2)));
typedef __bf16 bf16x2_t __attribute__((ext_vector_type(2)));
__device__ __forceinline__ unsigned cvt_pk(float lo, float hi) { const f32x2_t v = {lo, hi}; const bf16x2_t b = __builtin_convertvector(v, bf16x2_t); return __builtin_bit_cast(unsigned, b); }
__device__ __forceinline__ float bf2f(unsigned short b) { return __builtin_bit_cast(float, (unsigned)b << 16); }
__device__ __forceinline__ float wave_sum(float v) {
#pragma unroll
    for (int o = 1; o < 64; o <<= 1) v += __shfl_xor(v, o);
    return v;
}
__device__ __forceinline__ float wave_max(float v) {
#pragma unroll
    for (int o = 1; o < 64; o <<= 1) v = fmaxf(v, __shfl_xor(v, o));
    return v;
}

enum { MK_IDENT = 0, MK_FFN_IN = 1, MK_CONV_IN = 2, MK_HEADPERM = 3, MK_Q = 4 };
__device__ __forceinline__ int srcmap(int kind, int np) {
    const int pn = np >> 8, r = np & 255, bj = r >> 7, c = r & 127;
    if (kind == MK_FFN_IN) return bj * DFF + 128 * pn + c;
    if (kind == MK_CONV_IN) return pn < 4 ? np : 1024 * (1 + bj) + 128 * (pn - 4) + c;
    if (kind == MK_HEADPERM) return 256 * pn + 64 * (c >> 5) + 32 * bj;
    if (kind == MK_Q) return pn < 4 ? 256 * pn + 64 * (c >> 5) + 32 * bj : (r < 32 ? 1024 : (r < 64 ? 1056 : -1));
    return np;
}
struct MatDesc { const float* W; bf16* WT; int K, N, NP, kind; const float* gain; };

__device__ __forceinline__ void prep_load(const MatDesc& d, int item, int lane, f32x4 (&v)[8]) {
    const int nblk = d.NP >> 5, kb = item / nblk, nb = item - kb * nblk;
    const int n = 4 * (lane & 7), kk = lane >> 3;
    const int sc = srcmap(d.kind, nb * 32);
    const bool ok = sc >= 0 && (sc + n) < d.N;
    const float* p = d.W + (size_t)(kb * 64 + kk) * d.N + sc + n;
#pragma unroll
    for (int i = 0; i < 8; ++i) { v[i] = ok ? *(const f32x4*)(p + (size_t)(8 * i) * d.N) : (f32x4){0.f, 0.f, 0.f, 0.f}; if (d.gain) v[i] = v[i] * d.gain[kb * 64 + kk + 8 * i]; }
}
__device__ __forceinline__ void prep_store_lds(LAS float* scr, int lane, const f32x4 (&v)[8]) {
    const int n = 4 * (lane & 7), kk = lane >> 3;
#pragma unroll
    for (int i = 0; i < 8; ++i)
#pragma unroll
        for (int e = 0; e < 4; ++e) scr[(kk + 8 * i) * 33 + n + e] = v[i][e];
}
__device__ __forceinline__ void prep_write(const MatDesc& d, int item, int lane, const LAS float* scr) {
    const int nblk = d.NP >> 5, kb = item / nblk, nb = item - kb * nblk;
    const int c = lane & 7;
#pragma unroll
    for (int j = 0; j < 4; ++j) {
        const int n = (lane >> 3) + 8 * j;
        const LAS float* p = scr + (8 * c) * 33 + n;
        u32x4 o; o.x = cvt_pk(p[0], p[33]); o.y = cvt_pk(p[2 * 33], p[3 * 33]); o.z = cvt_pk(p[4 * 33], p[5 * 33]); o.w = cvt_pk(p[6 * 33], p[7 * 33]);
        *(u32x4*)(d.WT + (size_t)(nb * 32 + n) * d.K + kb * 64 + 8 * c) = o;
    }
}

__device__ __forceinline__ MatDesc get_mat(const Args& a, int mi) {
    unsigned char* ws = WSP;
    MatDesc d; d.gain = nullptr;
    if (mi < 4) { const int layer = mi >> 1, f2 = mi & 1;
        d.gain = IN(f2 ? 5 : 1) + layer * DM;
        d.W = IN(f2 ? 6 : 2) + (size_t)layer * DM * 2 * DFF; d.WT = (bf16*)(ws + WS_WIN + (size_t)mi * SZ_WIN); d.K = DM; d.N = 2 * DFF; d.NP = 2 * DFF; d.kind = MK_FFN_IN; return d; }
    if (mi < 8) { const int s = mi - 4, layer = s >> 1, f2 = s & 1;
        d.W = IN(f2 ? 7 : 3) + (size_t)layer * DFF * DM; d.WT = (bf16*)(ws + WS_WOUT + (size_t)s * SZ_WOUT); d.K = DFF; d.N = DM; d.NP = DM; d.kind = MK_IDENT; return d; }
    switch (mi) {
    case 8:  d.W = IN(8);  d.WT = (bf16*)(ws + WS_CWIN);  d.K = DM; d.N = 3072; d.NP = 3072; d.kind = MK_CONV_IN; d.gain = IN(4); break;
    case 9:  d.W = IN(10); d.WT = (bf16*)(ws + WS_CWOUT); d.K = DM; d.N = DM;   d.NP = DM;   d.kind = MK_IDENT; break;
    case 10: d.W = IN(11); d.WT = (bf16*)(ws + WS_WQ);    d.K = DM; d.N = 1072; d.NP = NQP;  d.kind = MK_Q; d.gain = IN(4) + DM; break;
    case 11: d.W = IN(13); d.WT = (bf16*)(ws + WS_WO);    d.K = DM; d.N = DM;   d.NP = DM;   d.kind = MK_IDENT; break;
    case 12: d.W = IN(15); d.WT = (bf16*)(ws + WS_WKV);   d.K = DM; d.N = NKV;  d.NP = NKV;  d.kind = MK_HEADPERM; d.gain = IN(14); break;
    case 13: d.W = IN(19); d.WT = (bf16*)(ws + WS_W1K);   d.K = 2048; d.N = 128; d.NP = 128; d.kind = MK_IDENT; break;
    case 14: d.W = IN(21); d.WT = (bf16*)(ws + WS_W1V);   d.K = 2048; d.N = 128; d.NP = 128; d.kind = MK_IDENT; break;
    case 15: d.W = IN(20); d.WT = (bf16*)(ws + WS_W2K);   d.K = 128; d.N = 64; d.NP = 64; d.kind = MK_IDENT; break;
    default: d.W = IN(22); d.WT = (bf16*)(ws + WS_W2V);   d.K = 128; d.N = 64; d.NP = 64; d.kind = MK_IDENT; break;
    }
    return d;
}
constexpr int N_MATS = 17;
__device__ __forceinline__ int mat_items(int mi) {
    if (mi < 4) return 16 * 176; if (mi < 8) return 44 * 32;
    switch (mi) { case 8: return 16 * 96; case 9: return 16 * 32; case 10: return 16 * 40; case 11: return 16 * 32; case 12: return 16 * 48; case 13: case 14: return 32 * 4; default: return 2 * 2; }
}
__device__ __forceinline__ bool prep_locate(int g, int& mi, int& item) {
    for (int m = 0; m < N_MATS; ++m) { const int n = mat_items(m); if (g < n) { mi = m; item = g; return true; } g -= n; }
    return false;
}

__device__ __forceinline__ void phase_prep(const Args& a, LAS unsigned char* lds) {
    int tid_ = threadIdx.x; asm volatile("" : "+v"(tid_)); const int tid = tid_, lane = tid & 63, wave = tid >> 6;
    LAS float* scr = (LAS float*)lds + wave * (64 * 33);
    const int NGW = gridDim.x * 8;
    f32x4 v[8]; int mi, item;
    int g = blockIdx.x * 8 + wave;
    bool have = prep_locate(g, mi, item);
    MatDesc d = {};
    if (have) { d = get_mat(a, mi); prep_load(d, item, lane, v); }
    while (have) {
        prep_store_lds(scr, lane, v);
        const MatDesc dc = d; const int itc = item;
        g += NGW; have = prep_locate(g, mi, item);
        if (have) { d = get_mat(a, mi); prep_load(d, item, lane, v); }
        __builtin_amdgcn_wave_barrier();
        prep_write(dc, itc, lane, scr);
        __builtin_amdgcn_wave_barrier();
    }
    __syncthreads();
    scr = (LAS float*)lds;
    if (blockIdx.x < 2) {
        const int kv = blockIdx.x; const float* pe = IN(kv ? 18 : 17); const float* w1 = IN(kv ? 21 : 19);
        const int col = tid & 127, part = tid >> 7; float s = 0.f;
        for (int k = part * 512; k < part * 512 + 512; ++k) s += pe[k] * w1[(size_t)k * 128 + col];
        scr[tid] = s; __syncthreads();
        if (tid < 128) ((float*)(WSP + WS_B1))[kv * 128 + tid] = scr[tid] + scr[tid + 128] + scr[tid + 256] + scr[tid + 384];
        __syncthreads();
    }
}

__device__ __forceinline__ void phase_norm(const float* h, const float* g1, bf16* o1, const float* g2, bf16* o2) {
    int tid_ = threadIdx.x; asm volatile("" : "+v"(tid_));
    const int lane = tid_ & 63, wave = tid_ >> 6;
    const int gw = blockIdx.x * 8 + wave, NGW = gridDim.x * 8;
    f32x4 ga[4], gb[4];
#pragma unroll
    for (int j = 0; j < 4; ++j) { ga[j] = *(const f32x4*)(g1 + 4 * lane + 256 * j); gb[j] = g2 ? *(const f32x4*)(g2 + 4 * lane + 256 * j) : ga[j]; }
    for (int m = gw; m < T; m += NGW) {
        const f32x4* xr = (const f32x4*)(h + (size_t)m * DM) + lane;
        f32x4 v[4]; float s = 0.f;
#pragma unroll
        for (int j = 0; j < 4; ++j) { v[j] = xr[64 * j]; s += (v[j].x * v[j].x + v[j].y * v[j].y) + (v[j].z * v[j].z + v[j].w * v[j].w); }
        const float rstd = __builtin_amdgcn_rsqf(wave_sum(s) * (1.f / DM) + RMS_EPS);
        u64* p1 = (u64*)(o1 + (size_t)m * DM) + lane;
#pragma unroll
        for (int j = 0; j < 4; ++j) { const f32x4 y = v[j] * rstd * ga[j]; p1[64 * j] = (u64)cvt_pk(y.x, y.y) | ((u64)cvt_pk(y.z, y.w) << 32); }
        if (g2) { u64* p2 = (u64*)(o2 + (size_t)m * DM) + lane;
#pragma unroll
            for (int j = 0; j < 4; ++j) { const f32x4 y = v[j] * rstd * gb[j]; p2[64 * j] = (u64)cvt_pk(y.x, y.y) | ((u64)cvt_pk(y.z, y.w) << 32); } }
    }
}

constexpr size_t WS_SS = 131072;
__device__ __forceinline__ void phase_x(const float* x, bf16* hb, float* ss) {
    int tid_ = threadIdx.x; asm volatile("" : "+v"(tid_));
    const int lane = tid_ & 63, wave = tid_ >> 6;
    const int gw = blockIdx.x * 8 + wave, NGW = gridDim.x * 8;
    for (int i = blockIdx.x * 512 + tid_; i < 5 * T; i += gridDim.x * 512) ss[T + i] = 0.f;
    for (int m = gw; m < T; m += NGW) {
        const f32x4* xr = (const f32x4*)(x + (size_t)m * DM) + lane;
        f32x4 v[4]; float s = 0.f;
#pragma unroll
        for (int j = 0; j < 4; ++j) { v[j] = xr[64 * j]; s += (v[j].x * v[j].x + v[j].y * v[j].y) + (v[j].z * v[j].z + v[j].w * v[j].w); }
        s = wave_sum(s);
        u64* p1 = (u64*)(hb + (size_t)m * DM) + lane;
#pragma unroll
        for (int j = 0; j < 4; ++j) p1[64 * j] = (u64)cvt_pk(v[j].x, v[j].y) | ((u64)cvt_pk(v[j].z, v[j].w) << 32);
        if (lane == 0) ss[m] = s;
    }
}

__device__ __forceinline__ void unpack8(const u32x4 w, float (&f)[8]) {
    f[0] = __builtin_bit_cast(float, w.x << 16); f[1] = __builtin_bit_cast(float, w.x & 0xffff0000u); f[2] = __builtin_bit_cast(float, w.y << 16); f[3] = __builtin_bit_cast(float, w.y & 0xffff0000u);
    f[4] = __builtin_bit_cast(float, w.z << 16); f[5] = __builtin_bit_cast(float, w.z & 0xffff0000u); f[6] = __builtin_bit_cast(float, w.w << 16); f[7] = __builtin_bit_cast(float, w.w & 0xffff0000u);
}
__device__ __forceinline__ void phase_conv(const bf16* Bg, const bf16* U, const float* cw, bf16* Z) {
    int tid_ = threadIdx.x; asm volatile("" : "+v"(tid_));
    const int tid = tid_, cc = tid & 127, trow = tid >> 7;
    float w0[8], w1[8], w2[8];
#pragma unroll
    for (int e = 0; e < 8; ++e) { w0[e] = cw[8 * cc + e]; w1[e] = cw[1024 + 8 * cc + e]; w2[e] = cw[2048 + 8 * cc + e]; }
    for (int tb = blockIdx.x; tb < T / 128; tb += gridDim.x) {
        const int tbeg = tb * 128 + trow * 32;
        float u1[8], u2[8];
        if ((tbeg & (SEQ - 1)) == 0) {
#pragma unroll
            for (int e = 0; e < 8; ++e) { u1[e] = 0.f; u2[e] = 0.f; }
        } else {
            unpack8(*(const u32x4*)(U + (size_t)(tbeg - 1) * DM + 8 * cc), u1);
            unpack8(*(const u32x4*)(U + (size_t)(tbeg - 2) * DM + 8 * cc), u2);
        }
#pragma unroll 4
        for (int i = 0; i < 32; ++i) {
            const size_t p = (size_t)(tbeg + i) * DM + 8 * cc;
            float u0[8], bgv[8], z[8];
            unpack8(*(const u32x4*)(U + p), u0); unpack8(*(const u32x4*)(Bg + p), bgv);
#pragma unroll
            for (int e = 0; e < 8; ++e) { z[e] = bgv[e] * (w0[e] * u2[e] + w1[e] * u1[e] + w2[e] * u0[e]); u2[e] = u1[e]; u1[e] = u0[e]; }
            u32x4 o; o.x = cvt_pk(z[0], z[1]); o.y = cvt_pk(z[2], z[3]); o.z = cvt_pk(z[4], z[5]); o.w = cvt_pk(z[6], z[7]);
            *(u32x4*)(Z + p) = o;
        }
    }
}

__device__ __forceinline__ void phase_compress(const Args& a, LAS unsigned char* lds, size_t off_kc = WS_KC, size_t off_vct = WS_VCT) {
    unsigned char* ws = WSP;
    int tid_ = threadIdx.x; asm volatile("" : "+v"(tid_));
    const int tid = tid_, lane = tid & 63, w = tid >> 6, lc = lane & 15, lg = lane >> 4;
    LAS bf16* hid = (LAS bf16*)lds;
    LAS float* outf = (LAS float*)(lds + 32 * 136 * 2);
    for (int u2 = blockIdx.x * 2; u2 < 512; u2 += gridDim.x * 2)
    for (int uu = u2; uu < u2 + 2; ++uu) {
        const int kv = uu >> 8, R0 = (uu & 255) * 32;
        const bf16* raw = (const bf16*)(ws + (kv ? WS_VCR : WS_KCR));
        const bf16* w1t = (const bf16*)(ws + (kv ? WS_W1V : WS_W1K));
        const bf16* w2t = (const bf16*)(ws + (kv ? WS_W2V : WS_W2K));
        const float* b1 = (const float*)(ws + WS_B1) + kv * 128;
        f32x4 acc[2] = {{0.f, 0.f, 0.f, 0.f}, {0.f, 0.f, 0.f, 0.f}};
        const bf16* ap0 = raw + (size_t)(R0 + lc) * 1024 + 8 * lg;
        const bf16* ap1 = ap0 + (size_t)16 * 1024;
        const bf16* bp = w1t + (size_t)(16 * w + lc) * 2048 + 8 * lg;
        bf16x8 A0[4], A1[4], B[4];
#pragma unroll
        for (int s = 0; s < 4; ++s) { A0[s] = *(const bf16x8*)(ap0 + 32 * s); A1[s] = *(const bf16x8*)(ap1 + 32 * s); B[s] = *(const bf16x8*)(bp + 32 * s); }
        for (int k0 = 0; k0 < 2048; k0 += 128) {
            bf16x8 nA0[4], nA1[4], nB[4];
            const int kn = (k0 + 128 < 2048) ? k0 + 128 : k0;
#pragma unroll
            for (int s = 0; s < 4; ++s) { nA0[s] = *(const bf16x8*)(ap0 + kn + 32 * s); nA1[s] = *(const bf16x8*)(ap1 + kn + 32 * s); nB[s] = *(const bf16x8*)(bp + kn + 32 * s); }
#pragma unroll
            for (int s = 0; s < 4; ++s) { acc[0] = __builtin_amdgcn_mfma_f32_16x16x32_bf16(A0[s], B[s], acc[0], 0, 0, 0); acc[1] = __builtin_amdgcn_mfma_f32_16x16x32_bf16(A1[s], B[s], acc[1], 0, 0, 0); }
#pragma unroll
            for (int s = 0; s < 4; ++s) { A0[s] = nA0[s]; A1[s] = nA1[s]; B[s] = nB[s]; }
        }
        { const int col = 16 * w + lc; const float bb = b1[col];
#pragma unroll
          for (int rt = 0; rt < 2; ++rt)
#pragma unroll
            for (int r = 0; r < 4; ++r) { const float x = acc[rt][r] + bb; const float y = 2.f * 0.7978845608028654f * (x + 0.044715f * x * x * x);
                const float gl = x * __builtin_amdgcn_rcpf(1.f + __builtin_amdgcn_exp2f(-LOG2E * y));
                hid[(16 * rt + 4 * lg + r) * 136 + col] = (bf16)(cvt_pk(gl, 0.f) & 0xffffu); } }
        __syncthreads();
        { const int rt = w >> 2, ct = w & 3; f32x4 o = {0.f, 0.f, 0.f, 0.f};
#pragma unroll
          for (int ks = 0; ks < 4; ++ks) { const bf16x8 A = *(const LAS bf16x8*)(hid + (16 * rt + lc) * 136 + 32 * ks + 8 * lg); const bf16x8 B = *(const bf16x8*)(w2t + (size_t)(16 * ct + lc) * 128 + 32 * ks + 8 * lg);
              o = __builtin_amdgcn_mfma_f32_16x16x32_bf16(A, B, o, 0, 0, 0); }
#pragma unroll
          for (int r = 0; r < 4; ++r) outf[(16 * rt + 4 * lg + r) * 65 + 16 * ct + lc] = o[r]; }
        __syncthreads();
        { const int row = tid >> 4, d0 = 4 * (tid & 15); const int R = R0 + row, bg = R >> 9, i = R & 511;
          float v[4]; float ss = 0.f;
#pragma unroll
          for (int e = 0; e < 4; ++e) { v[e] = outf[row * 65 + d0 + e]; ss += v[e] * v[e]; }
          if (kv == 0) {
              ss += __shfl_xor(ss, 1); ss += __shfl_xor(ss, 2); ss += __shfl_xor(ss, 4); ss += __shfl_xor(ss, 8);
              const float rstd = __builtin_amdgcn_rsqf(ss * (1.f / 64.f) + RMS_EPS); const float* kn = IN(16);
#pragma unroll
              for (int e = 0; e < 4; ++e) v[e] = (i == 511) ? 0.f : v[e] * rstd * kn[d0 + e];
              bf16* dst = (bf16*)(ws + off_kc) + ((size_t)bg * NCB + i) * 64 + d0;
              *(u64*)dst = (u64)cvt_pk(v[0], v[1]) | ((u64)cvt_pk(v[2], v[3]) << 32);
          } else {
              bf16* dst = (bf16*)(ws + off_vct) + ((size_t)bg * 64 + d0) * NCB + i;
#pragma unroll
              for (int e = 0; e < 4; ++e) dst[(size_t)e * NCB] = (i == 511) ? (bf16)0 : (bf16)(cvt_pk(v[e], 0.f) & 0xffffu);
          } }
        __syncthreads();
    }
}

constexpr int A_IMP = 0, A_RING = 32768, TILE_PITCH = 192  , TILE_B = 64 * TILE_PITCH, STAGE_B = 2 * TILE_B,
              A_SELQ = A_RING + 2 * STAGE_B, A_BIAS = A_SELQ + 1024, A_MB = A_BIAS + 512, A_OUT = A_MB + 512;
constexpr int RELMAX_BIG = 0x40000000;

template <int MODE, int BM = 0, bool SEL = false>
__device__ __forceinline__ void attn_core(const bf16x8 (&kf)[4][2], const bf16x8 (&vf)[4][2], const bf16x8 (&qf)[2], int tq, int pbase, int pstride, int relmax,
                                          const LAS float* biasrow, float pscale, f32x4 (&oacc)[4], float& lsum, LAS float* improw, int jbase, int lg, int h, float pbias = 0.f, float pbias2 = 0.f, int thr = 0) {
    f32x4 s[4];
#pragma unroll
    for (int kt = 0; kt < 4; ++kt) {
        s[kt] = __builtin_amdgcn_mfma_f32_16x16x32_bf16(kf[kt][0], qf[0], (f32x4){0.f, 0.f, 0.f, 0.f}, 0, 0, 0);
        s[kt] = __builtin_amdgcn_mfma_f32_16x16x32_bf16(kf[kt][1], qf[1], s[kt], 0, 0, 0);
    }
#pragma unroll
    for (int kt = 0; kt < 4; ++kt) {
        const int kap0 = 32 * (kt >> 1) + 8 * lg + 4 * (kt & 1);
        const int rel0 = tq - (pbase + kap0 * pstride);
#pragma unroll
        for (int r = 0; r < 4; ++r) {
            float p;
            if (BM == 1) {
                p = __builtin_amdgcn_exp2f(s[kt][r] + pbias);
            } else if (BM == 2) {
                const int rel = rel0 - r * pstride;
                p = __builtin_amdgcn_exp2f(s[kt][r] + (rel >= thr ? pbias2 : pbias));
            } else if (BM == 3) {
                const int rel = rel0 - r * pstride;
                int bk = 39 - __clz((int)__umul24((unsigned)rel, (unsigned)rel)); bk = bk > 31 ? 31 : bk;
                p = __builtin_amdgcn_exp2f(s[kt][r] + biasrow[bk]);
                if (SEL) p = tq >= 0 ? p : 0.f;
            } else {
            const int rel = rel0 - r * pstride;
            const bool valid = (unsigned)rel < (unsigned)relmax;
            const int n = valid ? rel : 0;
            const int nn = (int)__umul24((unsigned)n, (unsigned)n);
            int bk = 39 - __clz(nn); bk = bk > 31 ? 31 : bk; bk = n < 16 ? n : bk;
            const float x = s[kt][r] + biasrow[bk];
            p = valid ? __builtin_amdgcn_exp2f(x) : 0.f;
            }
            if (MODE == 2) p *= pscale;
            s[kt][r] = p; lsum += p;
        }
        __builtin_amdgcn_sched_barrier(0);
        if (MODE == 2) {
            float av = 2.f * (s[kt][0] + s[kt][1] + s[kt][2]) + s[kt][3], bv = s[kt][3];
            av += __shfl_xor(av, 1); av += __shfl_xor(av, 2); bv += __shfl_xor(bv, 1); bv += __shfl_xor(bv, 2);
            if (h == 0) { const int j = jbase + (kap0 >> 2);
                improw[j] = improw[j] + av;
                if (j + 1 < 128) improw[j + 1] = improw[j + 1] + bv; }
        }
    }
    if (MODE >= 1) {
#pragma unroll
        for (int hh = 0; hh < 2; ++hh) {
            u32x4 pw; pw.x = cvt_pk(s[2 * hh][0], s[2 * hh][1]); pw.y = cvt_pk(s[2 * hh][2], s[2 * hh][3]); pw.z = cvt_pk(s[2 * hh + 1][0], s[2 * hh + 1][1]); pw.w = cvt_pk(s[2 * hh + 1][2], s[2 * hh + 1][3]);
            const bf16x8 pf = __builtin_bit_cast(bf16x8, pw);
#pragma unroll
            for (int dt = 0; dt < 4; ++dt) oacc[dt] = __builtin_amdgcn_mfma_f32_16x16x32_bf16(vf[dt][hh], pf, oacc[dt], 0, 0, 0);
        }
    }
}
__device__ __forceinline__ int rel_bucket_i(int n) { int bk = 39 - __clz((int)((unsigned)n * (unsigned)n)); bk = bk > 31 ? 31 : bk; return n < 16 ? n : bk; }
template <int MODE, bool SEL>
__device__ __forceinline__ void tile_stream(LAS unsigned char* ring, const bf16* Kbase, const bf16* Vbase, int ldv, int nt, int pb0, int pbstep, int pstride, int relmax,
                                            const bf16x8 (&qf)[2][2], const int (&tq)[2], const LAS float* biasrow, const float (&psc)[2], f32x4 (&oacc)[2][4], float (&ls)[2],
                                            LAS float* imp0, LAS float* imp1, const LAS u64* selA, const LAS u64* selB, int tid, int lc, int lg, int h) {
    const int row = tid >> 3, ch = tid & 7;
    const bf16* kp = Kbase + row * 64 + ch * 8;
    const bf16* vp = Vbase + (size_t)row * ldv + ch * 8;
    const int woff = row * TILE_PITCH + ch * 16;
    const float bfar = biasrow[31]; const int tqlo = __builtin_amdgcn_readfirstlane(tq[0]) ;
    u32x4 rk = {0u, 0u, 0u, 0u}, rv = {0u, 0u, 0u, 0u};
    if (nt > 0) { rk = *(const u32x4*)kp; if (MODE > 0) rv = *(const u32x4*)vp; }
#define TILE_STEP(t, rk, rv) do { \
        LAS unsigned char* st = ring + (t & 1) * STAGE_B; \
        *(LAS u32x4*)(st + woff) = rk; if (MODE > 0) *(LAS u32x4*)(st + TILE_B + woff) = rv; \
        asm volatile("s_waitcnt lgkmcnt(0)" ::: "memory"); __builtin_amdgcn_s_barrier(); asm volatile("" ::: "memory"); \
        if (t + 2 < nt) { rk = *(const u32x4*)(kp + (size_t)(t + 2) * 4096); if (MODE > 0) rv = *(const u32x4*)(vp + (t + 2) * 64); } \
        int tq0 = tq[0], tq1 = tq[1]; bool do0 = true, do1 = true; \
        if (SEL) { \
            const bool b0 = ((selA[t >> 6] >> (t & 63)) & 1ull) != 0ull, b1 = ((selB[t >> 6] >> (t & 63)) & 1ull) != 0ull; \
            tq0 = b0 ? tq0 : -1; tq1 = b1 ? tq1 : -1; do0 = __ballot(b0) != 0ull; do1 = __ballot(b1) != 0ull; \
        } \
        if (do0 || do1) { \
            bf16x8 kf[4][2], vf[4][2]; \
_Pragma("unroll") \
            for (int kt = 0; kt < 4; ++kt) { const LAS unsigned char* p = st + (32 * (kt >> 1) + 8 * (lc >> 2) + 4 * (kt & 1) + (lc & 3)) * TILE_PITCH + 16 * lg; \
                kf[kt][0] = *(const LAS bf16x8*)p; kf[kt][1] = *(const LAS bf16x8*)(p + 64); } \
            if (MODE > 0) { \
_Pragma("unroll") \
                for (int dt = 0; dt < 4; ++dt) { const LAS unsigned char* p = st + TILE_B + (16 * dt + lc) * TILE_PITCH + 16 * lg; \
                    vf[dt][0] = *(const LAS bf16x8*)p; vf[dt][1] = *(const LAS bf16x8*)(p + 64); } \
            } \
            const int pbase = pb0 + t * pbstep; \
            { \
 \
                const int rlo = tqlo - (pbase + 63 * pstride), rhi = tqlo + 7 - pbase; \
                const int blo = rel_bucket_i(rlo < 0 ? 0 : rlo), bhi = rel_bucket_i(rhi < 0 ? 0 : rhi); \
                if (rlo >= 0 && rhi < relmax && bhi - blo <= 1) { \
                    int thr = 0x7fffffff; \
                    if (bhi != blo) { int a = rlo, b = rhi; \
                        while (b - a > 1) { const int mid = (a + b) >> 1; if (rel_bucket_i(mid) == blo) a = mid; else b = mid; } \
                        thr = b; } \
                    const float pb1 = biasrow[blo], pb2 = biasrow[bhi]; \
                    const float pa0 = (!SEL || tq0 >= 0) ? pb1 : -1e30f, pa1 = (!SEL || tq0 >= 0) ? pb2 : -1e30f, pc0 = (!SEL || tq1 >= 0) ? pb1 : -1e30f, pc1 = (!SEL || tq1 >= 0) ? pb2 : -1e30f; \
                    if (bhi == blo) { \
                        if (do0) attn_core<MODE, 1, SEL>(kf, vf, qf[0], tq0, pbase, pstride, relmax, biasrow, psc[0], oacc[0], ls[0], imp0, 16 * t, lg, h, pa0); \
                        if (do1) attn_core<MODE, 1, SEL>(kf, vf, qf[1], tq1, pbase, pstride, relmax, biasrow, psc[1], oacc[1], ls[1], imp1, 16 * t, lg, h, pc0); \
                    } else { \
                        if (do0) attn_core<MODE, 2, SEL>(kf, vf, qf[0], tq[0], pbase, pstride, relmax, biasrow, psc[0], oacc[0], ls[0], imp0, 16 * t, lg, h, pa0, pa1, thr); \
                        if (do1) attn_core<MODE, 2, SEL>(kf, vf, qf[1], tq[1], pbase, pstride, relmax, biasrow, psc[1], oacc[1], ls[1], imp1, 16 * t, lg, h, pc0, pc1, thr); \
                    } \
                } else if (rlo >= 16 && rhi < relmax) { \
                    if (do0) attn_core<MODE, 3, SEL>(kf, vf, qf[0], tq0, pbase, pstride, relmax, biasrow, psc[0], oacc[0], ls[0], imp0, 16 * t, lg, h); \
                    if (do1) attn_core<MODE, 3, SEL>(kf, vf, qf[1], tq1, pbase, pstride, relmax, biasrow, psc[1], oacc[1], ls[1], imp1, 16 * t, lg, h); \
                } else { \
                    if (do0) attn_core<MODE>(kf, vf, qf[0], tq0, pbase, pstride, relmax, biasrow, psc[0], oacc[0], ls[0], imp0, 16 * t, lg, h); \
                    if (do1) attn_core<MODE>(kf, vf, qf[1], tq1, pbase, pstride, relmax, biasrow, psc[1], oacc[1], ls[1], imp1, 16 * t, lg, h); \
                } \
            } \
        } \
    } while (0)
    u32x4 rk1 = {0u, 0u, 0u, 0u}, rv1 = {0u, 0u, 0u, 0u};
    if (nt > 1) { rk1 = *(const u32x4*)(kp + 4096); if (MODE > 0) rv1 = *(const u32x4*)(vp + 64); }
    for (int t2 = 0; t2 < nt; t2 += 2) {
        { const int t = t2; TILE_STEP(t, rk, rv); }
        if (t2 + 1 < nt) { const int t = t2 + 1; TILE_STEP(t, rk1, rv1); }
    }
#undef TILE_STEP
    __syncthreads();
}

__device__ __forceinline__ void phase_attn(const Args& a, LAS unsigned char* lds) {
    unsigned char* ws = WSP;
    int tid_ = threadIdx.x; asm volatile("" : "+v"(tid_));
    const int w = __builtin_amdgcn_readfirstlane(tid_ >> 6);
    LAS float* imp = (LAS float*)(lds + A_IMP);
    LAS unsigned char* ring = lds + A_RING;
    LAS u64* selq = (LAS u64*)(lds + A_SELQ);
    LAS float* biasL = (LAS float*)(lds + A_BIAS);
    LAS float* mbound = (LAS float*)(lds + A_MB);
    const bf16* Q = (const bf16*)(ws + WS_Q);
    const float* gates = (const float*)(ws + WS_GATES);
    const float* relb = IN(23);
    if (w == 0) {
        const int lane = tid_ & 63;
        float mq = fabsf(IN(12)[lane]);
        float mk = fmaxf(fabsf(IN(16)[lane]), fmaxf(fabsf(IN(16)[64 + lane]), fabsf(IN(16)[128 + lane])));
        mq = wave_max(mq); mk = wave_max(mk);
        float mb = -1e30f;
        if (lane < 16) { for (int bk = 0; bk < 32; ++bk) mb = fmaxf(mb, relb[bk * 16 + lane]); mbound[lane] = mb + 8.f * mq * mk; }
    }
    __syncthreads();
    const int nunits = 2048, G = gridDim.x, bx = blockIdx.x;
    for (int it = 0; ; ++it) {
        int bg, qb;
        if (G == 256) {
            if (it >= 8) break;
            const int slot = bx >> 3, oo = slot >> 1; bg = 2 * (bx & 7) + (slot & 1);
            qb = (it & 1) ? 127 - 16 * (it >> 1) - oo : 16 * (it >> 1) + oo;
        } else {
            const int u = bx + it * G; if (u >= nunits) break;
            const int rr = u >> 4, ui = rr >> 4, oo = rr & 15; bg = u & 15;
            qb = (ui & 1) ? 127 - 16 * (ui >> 1) - oo : 16 * (ui >> 1) + oo;
        }
        const int b = bg >> 2, grp = bg & 3, t0 = 64 * qb, tokbase = b * SEQ + t0;
        int tidu = tid_; asm volatile("" : "+v"(tidu));
        const int tid = tidu, lane = tid & 63, lc = lane & 15, lg = lane >> 4, hq = lc >> 2, h = lc & 3;
        const u64 ltmask = (1ull << lane) - 1ull;
        for (int i = tid; i < 8192; i += 512) imp[i] = 0.f;
        if (tid < 128) { const int hh = tid >> 5, bk = tid & 31; biasL[tid] = (relb[bk * 16 + grp * 4 + hh] - mbound[grp * 4 + hh]) * LOG2E; }
        __syncthreads();
        const LAS float* biasrow = biasL + h * 32;
        bf16x8 qf[2][2]; int tqd[2]; float g0[2], g1[2], g2[2];
#pragma unroll
        for (int ct = 0; ct < 2; ++ct) { const int q = 8 * w + 4 * ct + hq; tqd[ct] = t0 + q;
            const bf16* qp = Q + (size_t)(tokbase + q) * DM + (grp * 4 + h) * 64 + 8 * lg; qf[ct][0] = *(const bf16x8*)qp; qf[ct][1] = *(const bf16x8*)(qp + 32);
            const float* gp = gates + (size_t)(tokbase + q) * 48 + (grp * 4 + h) * 3; g0[ct] = gp[0]; g1[ct] = gp[1]; g2[ct] = gp[2]; }
        LAS float* imp0 = imp + (8 * w + hq) * 128; LAS float* imp1 = imp + (8 * w + 4 + hq) * 128;
        LAS float* outp[2] = {(LAS float*)(lds + A_OUT) + ((8 * w + hq) * 4 + h) * 64 + 4 * lg, (LAS float*)(lds + A_OUT) + ((8 * w + 4 + hq) * 4 + h) * 64 + 4 * lg};
        const float one2[2] = {1.f, 1.f};
        {
            const int ncb = 4 * qb + 3, ntc = (ncb + 63) >> 6;
            const bf16* Kc = (const bf16*)(ws + WS_KC) + (size_t)bg * NCB * 64;
            const bf16* VcT = (const bf16*)(ws + WS_VCT) + (size_t)bg * 64 * NCB;
            float ls[2] = {0.f, 0.f}; f32x4 oc[2][4];
#pragma unroll
            for (int ct = 0; ct < 2; ++ct)
#pragma unroll
                for (int dt = 0; dt < 4; ++dt) oc[ct][dt] = (f32x4){0.f, 0.f, 0.f, 0.f};
            tile_stream<0, false>(ring, Kc, VcT, NCB, ntc, 31, 1024, 16, RELMAX_BIG, qf, tqd, biasrow, one2, oc, ls, imp0, imp1, selq, selq, tid, lc, lg, h);
            float inv[2];
#pragma unroll
            for (int ct = 0; ct < 2; ++ct) { float l = ls[ct]; l += __shfl_xor(l, 16); l += __shfl_xor(l, 32); inv[ct] = l > 0.f ? 1.f / l : 0.f; }
            float dummy[2] = {0.f, 0.f};
            tile_stream<2, false>(ring, Kc, VcT, NCB, ntc, 31, 1024, 16, RELMAX_BIG, qf, tqd, biasrow, inv, oc, dummy, imp0, imp1, selq, selq, tid, lc, lg, h);
#pragma unroll
            for (int ct = 0; ct < 2; ++ct)
#pragma unroll
                for (int dt = 0; dt < 4; ++dt) *(LAS f32x4*)(outp[ct] + 16 * dt) = oc[ct][dt] * g0[ct];
        }
        for (int qi = 0; qi < 8; ++qi) {
            const int q = 8 * w + qi; u64 lo, hi;
            if (qb < 16) { lo = (2ull << qb) - 1ull; hi = 0ull; }
            else {
                const int j0 = lane, j1 = lane + 64;
                const bool c0 = (j0 >= 1 && j0 <= qb - 2), c1 = (j1 <= qb - 2);
                const unsigned key0 = c0 ? __builtin_bit_cast(unsigned, imp[q * 128 + j0]) : 0u, key1 = c1 ? __builtin_bit_cast(unsigned, imp[q * 128 + j1]) : 0u;
                unsigned Tk = 0u;
                for (int bit = 30; bit >= 0; --bit) { const unsigned trial = Tk | (1u << bit);
                    const int cnt = __popcll(__ballot(key0 >= trial)) + __popcll(__ballot(key1 >= trial)); if (cnt >= 13) Tk = trial; }
                const bool gt0 = key0 > Tk, gt1 = key1 > Tk, e0 = (key0 == Tk) && c0, e1 = (key1 == Tk) && c1;
                const int need = 13 - (__popcll(__ballot(gt0)) + __popcll(__ballot(gt1)));
                const u64 m0 = __ballot(e0), m1 = __ballot(e1);
                const int r0 = __popcll(m0 & ltmask), r1 = __popcll(m0) + __popcll(m1 & ltmask);
                const bool s0 = gt0 || (e0 && r0 < need) || j0 == 0 || j0 == qb || j0 == qb - 1;
                const bool s1 = gt1 || (e1 && r1 < need) || j1 == qb || j1 == qb - 1;
                lo = __ballot(s0); hi = __ballot(s1);
            }
            if (lane == 0) { selq[q * 2] = lo; selq[q * 2 + 1] = hi; }
        }
        __builtin_amdgcn_wave_barrier();
        {
            const int tf = qb >= 8 ? 0 : 8 - qb, p0 = t0 - 512 + 64 * tf;
            const bf16* Kw = (const bf16*)(ws + WS_KW) + ((size_t)bg * SEQ + p0) * 64;
            const bf16* VwT = (const bf16*)(ws + WS_VWT) + (size_t)bg * 64 * SEQ + p0;
            float ls[2] = {0.f, 0.f}; f32x4 ow[2][4];
#pragma unroll
            for (int ct = 0; ct < 2; ++ct)
#pragma unroll
                for (int dt = 0; dt < 4; ++dt) ow[ct][dt] = (f32x4){0.f, 0.f, 0.f, 0.f};
            tile_stream<1, false>(ring, Kw, VwT, SEQ, 9 - tf, p0, 64, 1, 512, qf, tqd, biasrow, one2, ow, ls, imp0, imp1, selq, selq, tid, lc, lg, h);
#pragma unroll
            for (int ct = 0; ct < 2; ++ct) { float l = ls[ct]; l += __shfl_xor(l, 16); l += __shfl_xor(l, 32); const float sc = g2[ct] / l;
#pragma unroll
                for (int dt = 0; dt < 4; ++dt) *(LAS f32x4*)(outp[ct] + 16 * dt) = *(LAS f32x4*)(outp[ct] + 16 * dt) + ow[ct][dt] * sc; }
        }
        {
            const bf16* Ks = (const bf16*)(ws + WS_KS) + (size_t)bg * SEQ * 64;
            const bf16* VsT = (const bf16*)(ws + WS_VST) + (size_t)bg * 64 * SEQ;
            float ls[2] = {0.f, 0.f}; f32x4 os[2][4];
#pragma unroll
            for (int ct = 0; ct < 2; ++ct)
#pragma unroll
                for (int dt = 0; dt < 4; ++dt) os[ct][dt] = (f32x4){0.f, 0.f, 0.f, 0.f};
            tile_stream<1, true>(ring, Ks, VsT, SEQ, qb + 1, 0, 64, 1, RELMAX_BIG, qf, tqd, biasrow, one2, os, ls, imp0, imp1, selq + (8 * w + hq) * 2, selq + (8 * w + 4 + hq) * 2, tid, lc, lg, h);
            bf16* AO = (bf16*)(ws + WS_AO);
#pragma unroll
            for (int ct = 0; ct < 2; ++ct) { float l = ls[ct]; l += __shfl_xor(l, 16); l += __shfl_xor(l, 32); const float sc = g1[ct] / l;
                bf16* op = AO + (size_t)(tokbase + 8 * w + 4 * ct + hq) * DM + (grp * 4 + h) * 64 + 4 * lg;
#pragma unroll
                for (int dt = 0; dt < 4; ++dt) { const f32x4 v = *(LAS f32x4*)(outp[ct] + 16 * dt) + os[ct][dt] * sc; *(u64*)(op + 16 * dt) = (u64)cvt_pk(v[0], v[1]) | ((u64)cvt_pk(v[2], v[3]) << 32); } }
        }
    }
}

#define XB_TMO      128
#define XB_XCNT(j)  (256  + 64 * (j))
#define XB_XSUB(j)  (1280 + 64 * (j))
#define XB_XGEN(j)  (2304 + 64 * (j))
#define XB_TOP      3328
#define XB_TOPGEN   3392
#define XCD_BAR_WORDS 3456
#define XB_SPIN_CAP (1u << 23)

__device__ __forceinline__ unsigned xb_ld(unsigned* p)              { return __hip_atomic_load(p, __ATOMIC_RELAXED, __HIP_MEMORY_SCOPE_AGENT); }
__device__ __forceinline__ unsigned xb_add(unsigned* p, unsigned v) { return __hip_atomic_fetch_add(p, v, __ATOMIC_RELAXED, __HIP_MEMORY_SCOPE_AGENT); }
__device__ __forceinline__ unsigned xb_xcc_id() { return (unsigned)__builtin_amdgcn_s_getreg((3 << 11) | 20) & 0xFu; }
#define XB_SPIN(cond, bar) do { unsigned _sp = 0; while (cond) { __builtin_amdgcn_s_sleep(1); \
    if ((++_sp & 255u) == 0u) { if (xb_ld(&(bar)[XB_TMO])) break; if (_sp > XB_SPIN_CAP) { atomicAdd(&(bar)[XB_TMO], 1u); break; } } } } while (0)

struct XcdBarrier {
    unsigned* bar; unsigned x;
    volatile LAS unsigned* st;
};

__device__ __forceinline__ XcdBarrier xcd_barrier_post(unsigned* bar, volatile LAS unsigned* st) {
    XcdBarrier b; b.bar = bar; b.x = xb_xcc_id(); b.st = st;
    if (threadIdx.x == 0) (void)xb_add(&bar[XB_XCNT(b.x)], 1u);
    return b;
}
__device__ __forceinline__ void xcd_barrier_complete(unsigned* bar, unsigned x, unsigned& nloc, unsigned& nx) {
    const unsigned G = gridDim.x * gridDim.y * gridDim.z;
    unsigned sum, cnt, mine, sp = 0u;
    for (;;) {
        sum = 0u; cnt = 0u; mine = 0u;
#pragma unroll
        for (unsigned j = 0; j < 16; ++j) { const unsigned c = xb_ld(&bar[XB_XCNT(j)]); sum += c; cnt += (c > 0u) ? 1u : 0u; mine = (j == x) ? c : mine; }
        if (sum == G) break;
        __builtin_amdgcn_s_sleep(1);
        if ((++sp & 255u) == 0u) { if (xb_ld(&bar[XB_TMO])) break; if (sp > XB_SPIN_CAP) { atomicAdd(&bar[XB_TMO], 1u); break; } }
    }
    nloc = mine > 0u ? mine : 1u; nx = cnt > 0u ? cnt : 1u;
}

__device__ __forceinline__ void xcd_barrier(const XcdBarrier& b) {
    asm volatile("s_waitcnt vmcnt(0)" ::: "memory");
    __syncthreads();
    if (threadIdx.x == 0) {
        unsigned* bar = b.bar;
        __builtin_amdgcn_s_waitcnt(0);
        unsigned nloc = b.st[0], nx = b.st[1];
        if (nloc == 0u) { xcd_barrier_complete(bar, b.x, nloc, nx); b.st[0] = nloc; b.st[1] = nx; }
        const unsigned old = xb_add(&bar[XB_XSUB(b.x)], 1u);
        const unsigned gen = old / nloc;
        if (old + 1u == (gen + 1u) * nloc) {
            __builtin_amdgcn_fence(__ATOMIC_RELEASE, "agent");
            asm volatile("s_waitcnt vmcnt(0)" ::: "memory");
            const unsigned og = xb_add(&bar[XB_TOP], 1u);
            const unsigned tg = og / nx;
            if (og + 1u == (tg + 1u) * nx) xb_add(&bar[XB_TOPGEN], 1u);
            else XB_SPIN(xb_ld(&bar[XB_TOPGEN]) == tg, bar);
            __builtin_amdgcn_fence(__ATOMIC_ACQUIRE, "agent");
            xb_add(&bar[XB_XGEN(b.x)], 1u);
            asm volatile("s_waitcnt vmcnt(0)" ::: "memory");
        } else {
            XB_SPIN(xb_ld(&bar[XB_XGEN(b.x)]) == gen, bar);
            __builtin_amdgcn_fence(__ATOMIC_ACQUIRE, "agent");
            asm volatile("s_waitcnt vmcnt(0)" ::: "memory");
        }
    }
    __syncthreads();
}


__global__ void __launch_bounds__(512, 2) mk_fwd(Args a) {
    extern __shared__ __attribute__((aligned(16))) unsigned char lds_raw[];
    LAS unsigned char* lds = (LAS unsigned char*)lds_raw;
    cg::grid_group grid = cg::this_grid();
    unsigned char* ws = WSP;
    const float* x = IN(0); float* hout = KA()->out;
    bf16* HN = (bf16*)(ws + WS_HN); bf16* HN2 = (bf16*)(ws + WS_HN2); bf16* ACT = (bf16*)(ws + WS_ACT);
    const int G = gridDim.x, bx = blockIdx.x;
#define GRID_SYNC() do { \
        if (sync_no == 0u) { asm volatile("s_waitcnt vmcnt(0) lgkmcnt(0)" ::: "memory"); grid.sync(); \
            if (threadIdx.x == 0) { __builtin_amdgcn_fence(__ATOMIC_ACQUIRE, "agent"); asm volatile("s_waitcnt vmcnt(0)" ::: "memory"); } __syncthreads(); \
            xb = xcd_barrier_post(bar_words, xb_st); } \
        else xcd_barrier(xb); \
        ++sync_no; } while (0)
#define GEMM(EPI, Aptr, Bptr, N_, K_, E) do { pg8::Gemm g_{(const pg8::bf16_t*)(Aptr), (const pg8::bf16_t*)(Bptr), T, (N_), (K_)}; pg8::StaticOrder S_; S_.init(T, (N_), G, bx); \
        pg8::gemm_phase<std::remove_cv_t<std::remove_reference_t<decltype(E)>>, pg8::StaticOrder, true, true>((PG8_LAS unsigned char*)lds, g_, S_, (E)); } while (0)

    unsigned* bar_words = (unsigned*)(ws + 4096); unsigned sync_no = 0u;
    for (int i = bx * 512 + threadIdx.x; i < XCD_BAR_WORDS; i += G * 512) __hip_atomic_store(bar_words + i, 0u, __ATOMIC_RELAXED, __HIP_MEMORY_SCOPE_AGENT);
    volatile LAS unsigned* xb_st = (volatile LAS unsigned*)(lds + LDS_BYTES - 16);
    if (threadIdx.x < 2) xb_st[threadIdx.x] = 0u;
    XcdBarrier xb; xb.bar = bar_words; xb.x = 0u; xb.st = xb_st;
    float* SS = (float*)(ws + WS_SS);
#define SSK(k) (SS + (size_t)(k) * T)
    phase_prep(a, lds);
    phase_x(x, HN, SS);
    GRID_SYNC();
    { pg8::EpiSwiglu E{ACT, DFF, SSK(0)}; GEMM(pg8::EpiSwiglu, HN, ws + WS_WIN, 2 * DFF, DM, E); }
    GRID_SYNC();
    { pg8::EpiResid<true, 1, 0, false> E{x, hout, HN, SSK(1)}; GEMM((pg8::EpiResid<true, 1, 0, false>), ACT, ws + WS_WOUT, DM, DFF, E); }
    GRID_SYNC();
    { pg8::EpiConvIn E{(bf16*)(ws + WS_BG), (bf16*)(ws + WS_U), SSK(1)}; GEMM(pg8::EpiConvIn, HN, ws + WS_CWIN, 3072, DM, E); }
    GRID_SYNC();
    phase_conv((const bf16*)(ws + WS_BG), (const bf16*)(ws + WS_U), IN(9), HN2);
    GRID_SYNC();
    { pg8::EpiResid<true, 2, 1, false> E{hout, hout, HN, SSK(2)}; GEMM((pg8::EpiResid<true, 2, 1, false>), HN2, ws + WS_CWOUT, DM, DM, E); }
    GRID_SYNC();
    { pg8::EpiSwiglu E{ACT, DFF, SSK(2)}; GEMM(pg8::EpiSwiglu, HN, ws + WS_WIN + SZ_WIN, 2 * DFF, DM, E); }
    GRID_SYNC();
    { pg8::EpiResid<true, 1, 1, false> E{hout, hout, HN, SSK(3)}; GEMM((pg8::EpiResid<true, 1, 1, false>), ACT, ws + WS_WOUT + SZ_WOUT, DM, DFF, E); }
    GRID_SYNC();
    { pg8::EpiKV E; E.Kb = (bf16*)(ws + WS_KCR); E.Vb = (bf16*)(ws + WS_VCR); E.brstride = KV_BYTES / 2; E.knorm = IN(16); E.ss = SSK(3);
      GEMM(pg8::EpiKV, HN, ws + WS_WKV, NKV, DM, E); }
    GRID_SYNC();
    phase_compress(a, lds);
    { pg8::EpiSwiglu E{ACT, DFF, SSK(3)}; GEMM(pg8::EpiSwiglu, HN, ws + WS_WIN + 2 * SZ_WIN, 2 * DFF, DM, E); }
    GRID_SYNC();
    { pg8::EpiResid<true, 1, 1, false> E{hout, hout, HN, SSK(4)}; GEMM((pg8::EpiResid<true, 1, 1, false>), ACT, ws + WS_WOUT + 2 * SZ_WOUT, DM, DFF, E); }
    GRID_SYNC();
    { pg8::EpiQ E{(bf16*)(ws + WS_Q), (float*)(ws + WS_GATES), IN(12), 0.125f * LOG2E, SSK(4)}; GEMM(pg8::EpiQ, HN, ws + WS_WQ, NQP, DM, E); }
    GRID_SYNC();
    phase_attn(a, lds);
    GRID_SYNC();
    { pg8::EpiResid<true, 2, 1, false> E{hout, hout, HN, SSK(5)}; GEMM((pg8::EpiResid<true, 2, 1, false>), ws + WS_AO, ws + WS_WO, DM, DM, E); }
    GRID_SYNC();
    { pg8::EpiSwiglu E{ACT, DFF, SSK(5)}; GEMM(pg8::EpiSwiglu, HN, ws + WS_WIN + 3 * SZ_WIN, 2 * DFF, DM, E); }
    GRID_SYNC();
    { pg8::EpiResid<false, 1, 1, true> E{hout, hout, HN, nullptr}; GEMM((pg8::EpiResid<false, 1, 1, true>), ACT, ws + WS_WOUT + 3 * SZ_WOUT, DM, DFF, E); }
#undef SSK
#undef GEMM
}

extern "C" void kernel_launch(void* const* d_in, const int* in_sizes, int n_in, void* d_out, int out_size, void* d_ws, size_t ws_size, hipStream_t stream) {
    static int grid = 0;
    if (grid == 0) {
        if (n_in != 24 || out_size != T * DM || ws_size < WS_END) { fprintf(stderr, "kernel_launch: unexpected problem (n_in %d out %d ws %zu)\n", n_in, out_size, ws_size); grid = -1; return; }
        int dev = 0, cus = 0, per_cu = 0;
        (void)hipGetDevice(&dev);
        (void)hipDeviceGetAttribute(&cus, hipDeviceAttributeMultiprocessorCount, dev);
        (void)hipFuncSetAttribute((const void*)mk_fwd, hipFuncAttributeMaxDynamicSharedMemorySize, LDS_BYTES);
        (void)hipOccupancyMaxActiveBlocksPerMultiprocessor(&per_cu, (const void*)mk_fwd, 512, LDS_BYTES);
        if (per_cu < 1) per_cu = 1;
        grid = cus * per_cu;
    }
    if (grid < 0) return;
    Args a{};
    for (int i = 0; i < 24; ++i) a.in[i] = (const float*)d_in[i];
    a.out = (float*)d_out; a.ws = (unsigned char*)d_ws;
    void* args[] = {&a};
    hipError_t e = hipLaunchCooperativeKernel((const void*)mk_fwd, dim3(grid), dim3(512), args, LDS_BYTES, stream);
    if (e != hipSuccess) fprintf(stderr, "cooperative launch failed: %s (grid %d)\n", hipGetErrorString(e), grid);
}
```

```cpp
#include <hip/hip_runtime.h>
#include <hip/hip_cooperative_groups.h>
#include <cstdio>
#include <cstdint>
#include <type_traits>
namespace cg = cooperative_groups;
namespace pg8 {
#define PG8_LAS __attribute__((address_space(3)))
typedef unsigned short bf16_t;
typedef short bf16x8 __attribute__((ext_vector_type(8)));
typedef float f32x4 __attribute__((ext_vector_type(4)));
typedef unsigned u32x4 __attribute__((ext_vector_type(4)));
constexpr int BM = 256, BK = 64, HALF = 128, HTB = HALF * BK * 2  , STAGE_BYTES = 8 * HTB, NXCD = 8, WGM = 8;

__host__ __device__ __forceinline__ int lds_byte(int r, int c) { const int st = (r >> 4) * 2 + (c >> 5), rr = r & 15, cc = c & 31, ob = rr * 64 + cc * 2; return st * 1024 + (ob ^ (((ob >> 9) & 1) << 5)); }
__host__ __device__ __forceinline__ void stage_rc(int b, int& R, int& C) { const int st = b / 1024, sb = b % 1024, swz = sb ^ (((sb >> 9) & 1) << 5); R = (st >> 1) * 16 + swz / 64; C = (st & 1) * 32 + (swz % 64) / 2; }
__host__ __device__ __forceinline__ int perm32(int rho) { const int n = rho >> 4, i = rho & 15; return 8 * (i >> 2) + 4 * n + (i & 3); }

struct Unit { int pm, pn; };
struct Gemm { const bf16_t* A; const bf16_t* Bt; int M, N, K; };

struct StaticOrder {
    int nM, nN, nwg, G, c;
    __host__ __device__ void init(int M, int N, int G_, int c_) { nM = M / BM; nN = N / BM; nwg = nM * nN; G = G_; c = c_; }
    __host__ __device__ bool next(int i, Unit& u) const {
        const long L = (long)i * G + c; if (L >= nwg) return false;
        int wgid = (int)L; { const int q = nwg / NXCD, r = nwg % NXCD, xcd = wgid % NXCD, off = wgid / NXCD; wgid = (xcd < r ? xcd * (q + 1) : r * (q + 1) + (xcd - r) * q) + off; }
        const int nig = WGM * nN, gid = wgid / nig, fm = gid * WGM, gsz = (nM - fm) < WGM ? (nM - fm) : WGM;
        u.pm = fm + ((wgid % nig) % gsz); u.pn = (wgid % nig) / gsz; return true;
    }
    __device__ __forceinline__ void a_ready(const Unit&) const {}
    __device__ __forceinline__ void done(const Unit&) const {}
};

__device__ __forceinline__ unsigned cvt_pk_bf16(float lo, float hi) { unsigned r; asm volatile("v_cvt_pk_bf16_f32 %0, %1, %2" : "=v"(r) : "v"(lo), "v"(hi)); return r; }
__device__ __forceinline__ float fast_sigmoid(float x) { return __builtin_amdgcn_rcpf(1.f + __builtin_amdgcn_exp2f(-1.4426950408889634f * x)); }
__device__ __forceinline__ u32x4 pack8(const f32x4 a, const f32x4 b) { u32x4 w; w.x = cvt_pk_bf16(a[0], a[1]); w.y = cvt_pk_bf16(a[2], a[3]); w.z = cvt_pk_bf16(b[0], b[1]); w.w = cvt_pk_bf16(b[2], b[3]); return w; }

struct EpiSwiglu {
    static constexpr bool PERM = true, AFTER_DRAIN = false;
    bf16_t* O; int ldo; const float* ss;
    __device__ __forceinline__ void operator()(const f32x4 (&acc)[2][2][4][2], const Unit& u, int wr, int wc, int fr, int fq) const {
        const int row0 = u.pm * BM + wr * 64 + fr, col0 = u.pn * HALF + wc * 32 + 8 * fq;
#pragma unroll
        for (int ai = 0; ai < 2; ++ai)
#pragma unroll
            for (int m = 0; m < 4; ++m) {
                f32x4 v[2]; const float rs = __builtin_amdgcn_rsqf(ss[row0 + ai * HALF + m * 16] * (1.f / 1024.f) + 1e-6f);
#pragma unroll
                for (int n = 0; n < 2; ++n) { const f32x4 g = acc[ai][0][m][n] * rs, up = acc[ai][1][m][n] * rs;
#pragma unroll
                    for (int e = 0; e < 4; ++e) v[n][e] = g[e] * fast_sigmoid(g[e]) * up[e]; }
                *(u32x4*)(O + (size_t)(row0 + ai * HALF + m * 16) * ldo + col0) = pack8(v[0], v[1]);
            }
    }
};

template <bool NORM, int ALPHA2  , int HIN, bool FOUT> struct EpiResid {
    static constexpr bool PERM = true, AFTER_DRAIN = false;
    const float* hin; float* hout; bf16_t* HB; float* ssout;
    __device__ __forceinline__ void operator()(const f32x4 (&acc)[2][2][4][2], const Unit& u, int wr, int wc, int fr, int fq) const {
        const int row0 = u.pm * BM + wr * 64 + fr, col0 = u.pn * BM + wc * 32 + 8 * fq; constexpr float alpha = 0.5f * ALPHA2;
#pragma unroll
        for (int ai = 0; ai < 2; ++ai) {
            u32x4 hv[4][2]; f32x4 xv[4][2][2];
#pragma unroll
            for (int m = 0; m < 4; ++m)
#pragma unroll
                for (int bj = 0; bj < 2; ++bj) { const size_t p = (size_t)(row0 + ai * HALF + m * 16) * 1024 + col0 + bj * HALF;
                    if (HIN == 0) { xv[m][bj][0] = *(const f32x4*)(hin + p); xv[m][bj][1] = *(const f32x4*)(hin + p + 4); } else hv[m][bj] = *(const u32x4*)(HB + p); }
#pragma unroll
            for (int m = 0; m < 4; ++m) {
                float sq = 0.f;
#pragma unroll
                for (int bj = 0; bj < 2; ++bj) {
                    const size_t p = (size_t)(row0 + ai * HALF + m * 16) * 1024 + col0 + bj * HALF;
                    f32x4 a0, a1;
                    if (HIN == 0) { a0 = xv[m][bj][0]; a1 = xv[m][bj][1]; }
                    else { const u32x4 w = hv[m][bj];
                        a0 = (f32x4){__builtin_bit_cast(float, w.x << 16), __builtin_bit_cast(float, w.x & 0xffff0000u), __builtin_bit_cast(float, w.y << 16), __builtin_bit_cast(float, w.y & 0xffff0000u)};
                        a1 = (f32x4){__builtin_bit_cast(float, w.z << 16), __builtin_bit_cast(float, w.z & 0xffff0000u), __builtin_bit_cast(float, w.w << 16), __builtin_bit_cast(float, w.w & 0xffff0000u)}; }
                    a0 = a0 + acc[ai][bj][m][0] * alpha; a1 = a1 + acc[ai][bj][m][1] * alpha;
                    if (FOUT) { *(f32x4*)(hout + p) = a0; *(f32x4*)(hout + p + 4) = a1; }
                    if (NORM) { *(u32x4*)(HB + p) = pack8(a0, a1);
                        sq += (a0[0] * a0[0] + a0[1] * a0[1]) + (a0[2] * a0[2] + a0[3] * a0[3]) + (a1[0] * a1[0] + a1[1] * a1[1]) + (a1[2] * a1[2] + a1[3] * a1[3]); }
                }
                if (NORM) { sq += __shfl_xor(sq, 16); sq += __shfl_xor(sq, 32);
                    if (fq == 0) __hip_atomic_fetch_add(ssout + row0 + ai * HALF + m * 16, sq, __ATOMIC_RELAXED, __HIP_MEMORY_SCOPE_AGENT); }
            }
        }
    }
};

struct EpiConvIn {
    static constexpr bool PERM = true, AFTER_DRAIN = false;
    bf16_t* Bg; bf16_t* U; const float* ss;
    __device__ __forceinline__ void operator()(const f32x4 (&acc)[2][2][4][2], const Unit& u, int wr, int wc, int fr, int fq) const {
        const int row0 = u.pm * BM + wr * 64 + fr;
        if (u.pn < 4) {
            const int col0 = u.pn * BM + wc * 32 + 8 * fq;
#pragma unroll
            for (int ai = 0; ai < 2; ++ai)
#pragma unroll
                for (int m = 0; m < 4; ++m)
#pragma unroll
                    for (int bj = 0; bj < 2; ++bj) { const float rs = __builtin_amdgcn_rsqf(ss[row0 + ai * HALF + m * 16] * (1.f / 1024.f) + 1e-6f);
                        *(u32x4*)(Bg + (size_t)(row0 + ai * HALF + m * 16) * 1024 + col0 + bj * HALF) = pack8(acc[ai][bj][m][0] * rs, acc[ai][bj][m][1] * rs); }
        } else {
            const int col0 = (u.pn - 4) * HALF + wc * 32 + 8 * fq;
#pragma unroll
            for (int ai = 0; ai < 2; ++ai)
#pragma unroll
                for (int m = 0; m < 4; ++m) { const float r2 = __builtin_amdgcn_rcpf(ss[row0 + ai * HALF + m * 16] * (1.f / 1024.f) + 1e-6f);
                    *(u32x4*)(U + (size_t)(row0 + ai * HALF + m * 16) * 1024 + col0) = pack8(acc[ai][0][m][0] * acc[ai][1][m][0] * r2, acc[ai][0][m][1] * acc[ai][1][m][1] * r2); }
        }
    }
};

struct EpiKV {
    static constexpr bool PERM = true, AFTER_DRAIN = false;
    bf16_t *Kb, *Vb; size_t brstride; const float* knorm; const float* ss;
    __device__ __forceinline__ void operator()(const f32x4 (&acc)[2][2][4][2], const Unit& u, int wr, int wc, int fr, int fq) const {
        const int br = u.pn >> 1, kv = u.pn & 1;
        const int row0 = u.pm * BM + wr * 64 + fr;
#pragma unroll
        for (int ai = 0; ai < 2; ++ai)
#pragma unroll
            for (int m = 0; m < 4; ++m) {
                const int row = row0 + ai * HALF + m * 16, b = row >> 13, s = row & 8191, bg = b * 4 + wc;
                const float rs = __builtin_amdgcn_rsqf(ss[row] * (1.f / 1024.f) + 1e-6f);
                if (kv == 0) {
                    float rstd = rs;
                    if (br > 0) { float ss = 0.f;
#pragma unroll
                        for (int bj = 0; bj < 2; ++bj)
#pragma unroll
                            for (int n = 0; n < 2; ++n)
#pragma unroll
                                for (int e = 0; e < 4; ++e) ss += acc[ai][bj][m][n][e] * acc[ai][bj][m][n][e];
                        ss += __shfl_xor(ss, 16); ss += __shfl_xor(ss, 32);
                        rstd = rs * __builtin_amdgcn_rsqf(ss * rs * rs * (1.f / 64.f) + 1e-6f); }
                    bf16_t* dst = Kb + (size_t)br * brstride + ((size_t)bg * 8192 + s) * 64 + 8 * fq;
#pragma unroll
                    for (int bj = 0; bj < 2; ++bj) {
                        f32x4 v0 = acc[ai][bj][m][0] * rstd, v1 = acc[ai][bj][m][1] * rstd;
                        if (br > 0) { const float* gp = knorm + br * 64 + bj * 32 + 8 * fq; v0 = v0 * *(const f32x4*)gp; v1 = v1 * *(const f32x4*)(gp + 4); }
                        *(u32x4*)(dst + bj * 32) = pack8(v0, v1);
                    }
                } else if (br == 0) {
                    bf16_t* dst = Vb + ((size_t)bg * 8192 + s) * 64 + 8 * fq;
#pragma unroll
                    for (int bj = 0; bj < 2; ++bj) *(u32x4*)(dst + bj * 32) = pack8(acc[ai][bj][m][0] * rs, acc[ai][bj][m][1] * rs);
                } else {
                    bf16_t* dst = Vb + (size_t)br * brstride + ((size_t)bg * 64 + 8 * fq) * 8192 + s;
#pragma unroll
                    for (int bj = 0; bj < 2; ++bj)
#pragma unroll
                        for (int n = 0; n < 2; ++n) { const f32x4 v = acc[ai][bj][m][n] * rs;
                            const unsigned p0 = cvt_pk_bf16(v[0], v[1]), p1 = cvt_pk_bf16(v[2], v[3]);
                            bf16_t* d = dst + (size_t)(bj * 32 + 4 * n) * 8192;
                            d[0] = (bf16_t)(p0 & 0xffffu); d[8192] = (bf16_t)(p0 >> 16); d[2 * 8192] = (bf16_t)(p1 & 0xffffu); d[3 * 8192] = (bf16_t)(p1 >> 16); }
                }
            }
    }
};

struct EpiQ {
    static constexpr bool PERM = true, AFTER_DRAIN = false;
    bf16_t* Q; float* gates; const float* qnorm; float qscale; const float* ss;
    __device__ __forceinline__ void operator()(const f32x4 (&acc)[2][2][4][2], const Unit& u, int wr, int wc, int fr, int fq) const {
        const int row0 = u.pm * BM + wr * 64 + fr;
        if (u.pn < 4) {
            const int head = u.pn * 4 + wc;
#pragma unroll
            for (int ai = 0; ai < 2; ++ai)
#pragma unroll
                for (int m = 0; m < 4; ++m) {
                    float ss = 0.f;
#pragma unroll
                    for (int bj = 0; bj < 2; ++bj)
#pragma unroll
                        for (int n = 0; n < 2; ++n)
#pragma unroll
                            for (int e = 0; e < 4; ++e) ss += acc[ai][bj][m][n][e] * acc[ai][bj][m][n][e];
                    ss += __shfl_xor(ss, 16); ss += __shfl_xor(ss, 32);
                    const float rs = __builtin_amdgcn_rsqf(this->ss[row0 + ai * HALF + m * 16] * (1.f / 1024.f) + 1e-6f);
                    const float rstd = rs * __builtin_amdgcn_rsqf(ss * rs * rs * (1.f / 64.f) + 1e-6f) * qscale;
                    bf16_t* dst = Q + (size_t)(row0 + ai * HALF + m * 16) * 1024 + head * 64 + 8 * fq;
#pragma unroll
                    for (int bj = 0; bj < 2; ++bj) { const float* gp = qnorm + bj * 32 + 8 * fq;
                        const f32x4 v0 = acc[ai][bj][m][0] * rstd * *(const f32x4*)gp, v1 = acc[ai][bj][m][1] * rstd * *(const f32x4*)(gp + 4);
                        *(u32x4*)(dst + bj * 32) = pack8(v0, v1); }
                }
        } else {
            if (wc < 2) {
#pragma unroll
                for (int ai = 0; ai < 2; ++ai)
#pragma unroll
                    for (int m = 0; m < 4; ++m) {
                        const int c0 = wc * 32 + 8 * fq;
                        if (c0 < 48) { float* dst = gates + (size_t)(row0 + ai * HALF + m * 16) * 48 + c0; const float rs = __builtin_amdgcn_rsqf(this->ss[row0 + ai * HALF + m * 16] * (1.f / 1024.f) + 1e-6f);
                            f32x4 a = acc[ai][0][m][0] * rs, b = acc[ai][0][m][1] * rs;
#pragma unroll
                            for (int e = 0; e < 4; ++e) { a[e] = fast_sigmoid(a[e]); b[e] = fast_sigmoid(b[e]); }
                            *(f32x4*)dst = a; *(f32x4*)(dst + 4) = b; }
                    }
            }
        }
    }
};
template <class Epi, class Sched, bool ALIGN_EPI = false, bool SP2 = false>
__device__ __forceinline__ void gemm_phase(PG8_LAS unsigned char* lds, const Gemm g, const Sched& S, const Epi& E) {
    int tid_ = threadIdx.x; asm volatile("" : "+v"(tid_));
    const int tid = tid_, wid = __builtin_amdgcn_readfirstlane(tid >> 6), lane = tid & 63, wr = wid >> 2, wc = wid & 3, fr = lane & 15, fq = lane >> 4;
    const int K = g.K, nt = K / BK;
    unsigned voffA[2], voffB[2];
#pragma unroll
    for (int i = 0; i < 2; ++i) { int R, C; stage_rc(tid * 16 + i * 8192, R, C); const int Rb = Epi::PERM ? ((R & ~31) + perm32(R & 31)) : R;
        voffA[i] = (unsigned)(R * K + C) * 2u; voffB[i] = (unsigned)(Rb * K + C) * 2u; }
    const size_t kstep = (size_t)(BK * 2);
    const size_t hstep = (size_t)HALF * K * 2;
    const size_t tstep = 2 * hstep;
    const unsigned ldsw = (unsigned)wid * 1024u;
    const int aoff = lds_byte(wr * 64 + fr, fq * 8), boff = lds_byte(wc * 32 + fr, fq * 8);
#define PG8_SA(b, h) (((b) * 2 + (h)) * HTB)
#define PG8_SB(b, h) ((4 + (b) * 2 + (h)) * HTB)
#define PG8_STAGE(bufoff, gbase, voff) do { _Pragma("unroll") for (int _i = 0; _i < 2; ++_i) \
        __builtin_amdgcn_global_load_lds((const unsigned*)((const char*)(gbase) + (voff)[_i]), (PG8_LAS unsigned*)(lds + (bufoff) + ldsw + _i * 8192), 16, 0, 0); } while (0)
#define PG8_LDA(dst, b, h) do { _Pragma("unroll") for (int m = 0; m < 4; ++m) _Pragma("unroll") for (int k = 0; k < 2; ++k) dst[m][k] = *(const PG8_LAS bf16x8*)(lds + PG8_SA(b, h) + aoff + m * 2048 + k * 1024); } while (0)
#define PG8_LDB(dst, b, h) do { _Pragma("unroll") for (int n = 0; n < 2; ++n) _Pragma("unroll") for (int k = 0; k < 2; ++k) dst[n][k] = *(const PG8_LAS bf16x8*)(lds + PG8_SB(b, h) + boff + n * 2048 + k * 1024); } while (0)
#define PG8_MMA(ai, bj, At, Bt) do { __builtin_amdgcn_s_setprio(1); _Pragma("unroll") for (int m = 0; m < 4; ++m) _Pragma("unroll") for (int n = 0; n < 2; ++n) _Pragma("unroll") for (int k = 0; k < 2; ++k) \
        acc[ai][bj][m][n] = __builtin_amdgcn_mfma_f32_16x16x32_bf16(Bt[n][k], At[m][k], acc[ai][bj][m][n], 0, 0, 0); __builtin_amdgcn_s_setprio(0); } while (0)
#define PG8_WAIT_V(n) asm volatile("s_waitcnt vmcnt(" #n ")" ::: "memory")
#define PG8_WAIT_L(n) asm volatile("s_waitcnt lgkmcnt(" #n ")" ::: "memory")
#define PG8_BAR __builtin_amdgcn_s_barrier()
#define PG8_SCHED __builtin_amdgcn_sched_barrier(0)
    Unit cur, nxt; int ui = 0;
    if (!S.next(0, cur)) return;
    f32x4 acc[2][2][4][2];
#pragma unroll
    for (int a = 0; a < 2; ++a)
#pragma unroll
        for (int b = 0; b < 2; ++b)
#pragma unroll
            for (int m = 0; m < 4; ++m)
#pragma unroll
                for (int n = 0; n < 2; ++n) acc[a][b][m][n] = (f32x4){0.f, 0.f, 0.f, 0.f};
    bf16x8 At[4][2], B0[2][2], B1[2][2];
    const char* cA = (const char*)g.A + (size_t)cur.pm * tstep; const char* cB = (const char*)g.Bt + (size_t)cur.pn * tstep;
    S.a_ready(cur);
    if constexpr (SP2) {
        PG8_STAGE(PG8_SB(0, 0), cB, voffB); PG8_STAGE(PG8_SB(0, 1), cB + hstep, voffB); PG8_STAGE(PG8_SA(0, 0), cA, voffA); PG8_STAGE(PG8_SA(0, 1), cA + hstep, voffA);
        if (wr == 1) PG8_BAR;
        PG8_WAIT_V(2); PG8_BAR;
        PG8_STAGE(PG8_SB(1, 0), cB + kstep, voffB); PG8_STAGE(PG8_SA(1, 0), cA + kstep, voffA); PG8_STAGE(PG8_SB(1, 1), cB + hstep + kstep, voffB);
        PG8_WAIT_V(6); PG8_BAR;
    } else {
        PG8_STAGE(PG8_SB(0, 0), cB, voffB); PG8_STAGE(PG8_SA(0, 0), cA, voffA); PG8_STAGE(PG8_SB(0, 1), cB + hstep, voffB); PG8_STAGE(PG8_SA(0, 1), cA + hstep, voffA);
        if (wr == 1) PG8_BAR;
        PG8_WAIT_V(4); PG8_BAR;
        PG8_STAGE(PG8_SB(1, 0), cB + kstep, voffB); PG8_STAGE(PG8_SA(1, 0), cA + kstep, voffA); PG8_STAGE(PG8_SB(1, 1), cB + hstep + kstep, voffB);
        PG8_WAIT_V(6); PG8_BAR;
    }
    for (;;) {
        const bool has_next = S.next(ui + 1, nxt);
        const char* nA = has_next ? (const char*)g.A + (size_t)nxt.pm * tstep : cA; const char* nB = has_next ? (const char*)g.Bt + (size_t)nxt.pn * tstep : cB;
        for (int t = 0; t < nt; t += 2) {
            const bool last = (t == nt - 2);
            const char* a1 = cA + (size_t)(t + 1) * kstep;
            const char* a2 = last ? nA : cA + (size_t)(t + 2) * kstep; const char* b2 = last ? nB : cB + (size_t)(t + 2) * kstep;
            const char* a3 = a2 + kstep; const char* b3 = b2 + kstep;
            if (last && has_next) S.a_ready(nxt);
            if constexpr (SP2) {
            PG8_LDB(B0, 0, 0); PG8_LDB(B1, 0, 1); PG8_SCHED; PG8_LDA(At, 0, 0); PG8_STAGE(PG8_SA(1, 1), a1 + hstep, voffA);
            PG8_WAIT_V(8); PG8_WAIT_L(0); PG8_BAR; PG8_MMA(0, 0, At, B0); PG8_MMA(0, 1, At, B1); PG8_BAR; PG8_SCHED;
            PG8_LDA(At, 0, 1); PG8_STAGE(PG8_SB(0, 0), b2, voffB); PG8_STAGE(PG8_SB(0, 1), b2 + hstep, voffB); PG8_STAGE(PG8_SA(0, 0), a2, voffA);
            PG8_WAIT_V(8); PG8_WAIT_L(0); PG8_BAR; PG8_MMA(1, 0, At, B0); PG8_MMA(1, 1, At, B1); PG8_BAR; PG8_SCHED;
            PG8_LDB(B0, 1, 0); PG8_LDB(B1, 1, 1); PG8_SCHED; PG8_LDA(At, 1, 0); PG8_STAGE(PG8_SA(0, 1), a2 + hstep, voffA);
            PG8_WAIT_V(8); PG8_WAIT_L(0); PG8_BAR; PG8_MMA(0, 0, At, B0); PG8_MMA(0, 1, At, B1); PG8_BAR; PG8_SCHED;
            PG8_LDA(At, 1, 1); PG8_STAGE(PG8_SB(1, 0), b3, voffB); PG8_STAGE(PG8_SB(1, 1), b3 + hstep, voffB); PG8_STAGE(PG8_SA(1, 0), a3, voffA);
            PG8_WAIT_V(8); PG8_WAIT_L(0); PG8_BAR; PG8_MMA(1, 0, At, B0); PG8_MMA(1, 1, At, B1); PG8_BAR; PG8_SCHED;
            } else {
            PG8_LDB(B0, 0, 0); PG8_SCHED; PG8_LDA(At, 0, 0); PG8_STAGE(PG8_SA(1, 1), a1 + hstep, voffA);
            PG8_WAIT_L(8); PG8_BAR; PG8_WAIT_L(0); PG8_MMA(0, 0, At, B0); PG8_BAR; PG8_SCHED;
            PG8_LDB(B1, 0, 1); PG8_STAGE(PG8_SB(0, 0), b2, voffB);
            PG8_BAR; PG8_WAIT_L(0); PG8_MMA(0, 1, At, B1); PG8_BAR;
            PG8_LDA(At, 0, 1); PG8_STAGE(PG8_SA(0, 0), a2, voffA);
            PG8_BAR; PG8_WAIT_L(0); PG8_MMA(1, 0, At, B0); PG8_BAR; PG8_SCHED;
            PG8_STAGE(PG8_SB(0, 1), b2 + hstep, voffB);
            PG8_WAIT_V(6); PG8_BAR; PG8_MMA(1, 1, At, B1); PG8_BAR;
            PG8_LDB(B0, 1, 0); PG8_SCHED; PG8_LDA(At, 1, 0); PG8_STAGE(PG8_SA(0, 1), a2 + hstep, voffA);
            PG8_WAIT_L(8); PG8_BAR; PG8_WAIT_L(0); PG8_MMA(0, 0, At, B0); PG8_BAR; PG8_SCHED;
            PG8_LDB(B1, 1, 1); PG8_STAGE(PG8_SB(1, 0), b3, voffB);
            PG8_BAR; PG8_WAIT_L(0); PG8_MMA(0, 1, At, B1); PG8_BAR;
            PG8_LDA(At, 1, 1); PG8_STAGE(PG8_SA(1, 0), a3, voffA);
            PG8_BAR; PG8_WAIT_L(0); PG8_MMA(1, 0, At, B0); PG8_BAR; PG8_SCHED;
            PG8_STAGE(PG8_SB(1, 1), b3 + hstep, voffB);
            PG8_WAIT_V(6); PG8_BAR; PG8_MMA(1, 1, At, B1); PG8_BAR;
            }
        }
        if constexpr (ALIGN_EPI) { if (wr == 0) PG8_BAR; }
        if constexpr (!Epi::AFTER_DRAIN) { E(acc, cur, wr, wc, fr, fq); S.done(cur); }
        if (!has_next) break;
#pragma unroll
        for (int a = 0; a < 2; ++a)
#pragma unroll
            for (int b = 0; b < 2; ++b)
#pragma unroll
                for (int m = 0; m < 4; ++m)
#pragma unroll
                    for (int n = 0; n < 2; ++n) acc[a][b][m][n] = (f32x4){0.f, 0.f, 0.f, 0.f};
        cur = nxt; cA = nA; cB = nB; ++ui;
        if constexpr (ALIGN_EPI) { if (wr == 1) PG8_BAR; }
    }
    PG8_WAIT_V(0);
    if constexpr (!ALIGN_EPI) { if (wr == 0) PG8_BAR; }
    PG8_BAR;
    if constexpr (Epi::AFTER_DRAIN) { E.fused(acc, cur, wr, wc, fr, fq, lds, wid, lane); S.done(cur); }
#undef PG8_SA
#undef PG8_SB
#undef PG8_STAGE
#undef PG8_LDA
#undef PG8_LDB
#undef PG8_MMA
#undef PG8_WAIT_V
#undef PG8_WAIT_L
#undef PG8_BAR
#undef PG8_SCHED
}
}

#define LAS __attribute__((address_space(3)))
typedef unsigned short bf16;
typedef float f32x4 __attribute__((ext_vector_type(4)));
typedef short bf16x8 __attribute__((ext_vector_type(8)));
typedef unsigned u32x4 __attribute__((ext_vector_type(4)));
typedef unsigned long long u64;

constexpr int NB = 4, SEQ = 8192, DM = 1024, T = NB * SEQ, DFF = 2816, NH = 16, NG = 4, HD = 64;
constexpr int NQP = 1280;
constexpr int NKV = 1536;
constexpr int NCB = 512;
constexpr float RMS_EPS = 1e-6f;
constexpr float LOG2E = 1.4426950408889634f;
constexpr int LDS_BYTES = 151552;

constexpr size_t MiB = 1u << 20;
constexpr size_t SZ_WIN = (size_t)2 * DFF * DM * 2, SZ_WOUT = (size_t)DM * DFF * 2;
constexpr size_t WS_WIN = 1 * MiB;
constexpr size_t WS_WOUT = WS_WIN + 4 * SZ_WIN;
constexpr size_t WS_CWIN = WS_WOUT + 4 * SZ_WOUT;
constexpr size_t WS_CWOUT = WS_CWIN + (size_t)3072 * 1024 * 2;
constexpr size_t WS_WQ = WS_CWOUT + (size_t)1024 * 1024 * 2;
constexpr size_t WS_WO = WS_WQ + (size_t)NQP * 1024 * 2;
constexpr size_t WS_WKV = WS_WO + (size_t)1024 * 1024 * 2;
constexpr size_t WS_W1K = WS_WKV + (size_t)NKV * 1024 * 2;
constexpr size_t WS_W1V = WS_W1K + (size_t)128 * 2048 * 2;
constexpr size_t WS_W2K = WS_W1V + (size_t)128 * 2048 * 2;
constexpr size_t WS_W2V = WS_W2K + (size_t)64 * 128 * 2;
constexpr size_t WS_B1 = WS_W2V + (size_t)64 * 128 * 2;
constexpr size_t WS_WEND = WS_B1 + 1024;
static_assert(WS_WEND <= 90 * MiB, "weights region");
constexpr size_t WS_HN = 96 * MiB;
constexpr size_t WS_HN2 = 160 * MiB;
constexpr size_t WS_ACT = 224 * MiB;
constexpr size_t WS_BG = WS_ACT, WS_U = WS_ACT + 64 * MiB;
constexpr size_t WS_Q = WS_ACT;
constexpr size_t KV_BYTES = (size_t)16 * SEQ * 64 * 2;
constexpr size_t WS_KCR = 400 * MiB, WS_KS = WS_KCR + KV_BYTES, WS_KW = WS_KS + KV_BYTES;
constexpr size_t WS_VCR = WS_KW + KV_BYTES, WS_VST = WS_VCR + KV_BYTES, WS_VWT = WS_VST + KV_BYTES;
constexpr size_t WS_KC = 90 * MiB, WS_VCT = 91 * MiB;
constexpr size_t WS_GATES = WS_VWT + KV_BYTES;
constexpr size_t WS_AO = WS_HN2;
constexpr size_t WS_END = WS_GATES + 6 * MiB;
static_assert(WS_END <= 512 * MiB, "workspace");

struct Args {
    const float* in[24];
    float* out; unsigned char* ws;
};
typedef const __attribute__((address_space(4))) Args* KArgsP;
__device__ __forceinline__ KArgsP KA() { KArgsP p = (KArgsP)__builtin_amdgcn_kernarg_segment_ptr(); asm volatile("" : "+s"(p)); return p; }
#define IN(i) ((const float*)KA()->in[i])
#define WSP ((unsigned char*)KA()->ws)

typedef float f32x2_t __attribute__((ext_vector_type(2)));
typedef __bf16 bf16x2_t __attribute__((ext_vector_type(2)));
__device__ __forceinline__ unsigned cvt_pk(float lo, float hi) { const f32x2_t v = {lo, hi}; const bf16x2_t b = __builtin_convertvector(v, bf16x2_t); return __builtin_bit_cast(unsigned, b); }
__device__ __forceinline__ float bf2f(unsigned short b) { return __builtin_bit_cast(float, (unsigned)b << 16); }
__device__ __forceinline__ float wave_sum(float v) {
#pragma unroll
    for (int o = 1; o < 64; o <<= 1) v += __shfl_xor(v, o);
    return v;
}
__device__ __forceinline__ float wave_max(float v) {
#pragma unroll
    for (int o = 1; o < 64; o <<= 1) v = fmaxf(v, __shfl_xor(v, o));
    return v;
}

enum { MK_IDENT = 0, MK_FFN_IN = 1, MK_CONV_IN = 2, MK_HEADPERM = 3, MK_Q = 4 };
__device__ __forceinline__ int srcmap(int kind, int np) {
    const int pn = np >> 8, r = np & 255, bj = r >> 7, c = r & 127;
    if (kind == MK_FFN_IN) return bj * DFF + 128 * pn + c;
    if (kind == MK_CONV_IN) return pn < 4 ? np : 1024 * (1 + bj) + 128 * (pn - 4) + c;
    if (kind == MK_HEADPERM) return 256 * pn + 64 * (c >> 5) + 32 * bj;
    if (kind == MK_Q) return pn < 4 ? 256 * pn + 64 * (c >> 5) + 32 * bj : (r < 32 ? 1024 : (r < 64 ? 1056 : -1));
    return np;
}
struct MatDesc { const float* W; bf16* WT; int K, N, NP, kind; const float* gain; };

__device__ __forceinline__ void prep_load(const MatDesc& d, int item, int lane, f32x4 (&v)[8]) {
    const int nblk = d.NP >> 5, kb = item / nblk, nb = item - kb * nblk;
    const int n = 4 * (lane & 7), kk = lane >> 3;
    const int sc = srcmap(d.kind, nb * 32);
    const bool ok = sc >= 0 && (sc + n) < d.N;
    const float* p = d.W + (size_t)(kb * 64 + kk) * d.N + sc + n;
#pragma unroll
    for (int i = 0; i < 8; ++i) { v[i] = ok ? *(const f32x4*)(p + (size_t)(8 * i) * d.N) : (f32x4){0.f, 0.f, 0.f, 0.f}; if (d.gain) v[i] = v[i] * d.gain[kb * 64 + kk + 8 * i]; }
}
__device__ __forceinline__ void prep_store_lds(LAS float* scr, int lane, const f32x4 (&v)[8]) {
    const int n = 4 * (lane & 7), kk = lane >> 3;
#pragma unroll
    for (int i = 0; i < 8; ++i)
#pragma unroll
        for (int e = 0; e < 4; ++e) scr[(kk + 8 * i) * 33 + n + e] = v[i][e];
}
__device__ __forceinline__ void prep_write(const MatDesc& d, int item, int lane, const LAS float* scr) {
    const int nblk = d.NP >> 5, kb = item / nblk, nb = item - kb * nblk;
    const int c = lane & 7;
#pragma unroll
    for (int j = 0; j < 4; ++j) {
        const int n = (lane >> 3) + 8 * j;
        const LAS float* p = scr + (8 * c) * 33 + n;
        u32x4 o; o.x = cvt_pk(p[0], p[33]); o.y = cvt_pk(p[2 * 33], p[3 * 33]); o.z = cvt_pk(p[4 * 33], p[5 * 33]); o.w = cvt_pk(p[6 * 33], p[7 * 33]);
        *(u32x4*)(d.WT + (size_t)(nb * 32 + n) * d.K + kb * 64 + 8 * c) = o;
    }
}

__device__ __forceinline__ MatDesc get_mat(const Args& a, int mi) {
    unsigned char* ws = WSP;
    MatDesc d; d.gain = nullptr;
    if (mi < 4) { const int layer = mi >> 1, f2 = mi & 1;
        d.gain = IN(f2 ? 5 : 1) + layer * DM;
        d.W = IN(f2 ? 6 : 2) + (size_t)layer * DM * 2 * DFF; d.WT = (bf16*)(ws + WS_WIN + (size_t)mi * SZ_WIN); d.K = DM; d.N = 2 * DFF; d.NP = 2 * DFF; d.kind = MK_FFN_IN; return d; }
    if (mi < 8) { const int s = mi - 4, layer = s >> 1, f2 = s & 1;
        d.W = IN(f2 ? 7 : 3) + (size_t)layer * DFF * DM; d.WT = (bf16*)(ws + WS_WOUT + (size_t)s * SZ_WOUT); d.K = DFF; d.N = DM; d.NP = DM; d.kind = MK_IDENT; return d; }
    switch (mi) {
    case 8:  d.W = IN(8);  d.WT = (bf16*)(ws + WS_CWIN);  d.K = DM; d.N = 3072; d.NP = 3072; d.kind = MK_CONV_IN; d.gain = IN(4); break;
    case 9:  d.W = IN(10); d.WT = (bf16*)(ws + WS_CWOUT); d.K = DM; d.N = DM;   d.NP = DM;   d.kind = MK_IDENT; break;
    case 10: d.W = IN(11); d.WT = (bf16*)(ws + WS_WQ);    d.K = DM; d.N = 1072; d.NP = NQP;  d.kind = MK_Q; d.gain = IN(4) + DM; break;
    case 11: d.W = IN(13); d.WT = (bf16*)(ws + WS_WO);    d.K = DM; d.N = DM;   d.NP = DM;   d.kind = MK_IDENT; break;
    case 12: d.W = IN(15); d.WT = (bf16*)(ws + WS_WKV);   d.K = DM; d.N = NKV;  d.NP = NKV;  d.kind = MK_HEADPERM; d.gain = IN(14); break;
    case 13: d.W = IN(19); d.WT = (bf16*)(ws + WS_W1K);   d.K = 2048; d.N = 128; d.NP = 128; d.kind = MK_IDENT; break;
    case 14: d.W = IN(21); d.WT = (bf16*)(ws + WS_W1V);   d.K = 2048; d.N = 128; d.NP = 128; d.kind = MK_IDENT; break;
    case 15: d.W = IN(20); d.WT = (bf16*)(ws + WS_W2K);   d.K = 128; d.N = 64; d.NP = 64; d.kind = MK_IDENT; break;
    default: d.W = IN(22); d.WT = (bf16*)(ws + WS_W2V);   d.K = 128; d.N = 64; d.NP = 64; d.kind = MK_IDENT; break;
    }
    return d;
}
constexpr int N_MATS = 17;
__device__ __forceinline__ int mat_items(int mi) {
    if (mi < 4) return 16 * 176; if (mi < 8) return 44 * 32;
    switch (mi) { case 8: return 16 * 96; case 9: return 16 * 32; case 10: return 16 * 40; case 11: return 16 * 32; case 12: return 16 * 48; case 13: case 14: return 32 * 4; default: return 2 * 2; }
}
__device__ __forceinline__ bool prep_locate(int g, int& mi, int& item) {
    for (int m = 0; m < N_MATS; ++m) { const int n = mat_items(m); if (g < n) { mi = m; item = g; return true; } g -= n; }
    return false;
}

__device__ __forceinline__ void phase_prep(const Args& a, LAS unsigned char* lds) {
    int tid_ = threadIdx.x; asm volatile("" : "+v"(tid_)); const int tid = tid_, lane = tid & 63, wave = tid >> 6;
    LAS float* scr = (LAS float*)lds + wave * (64 * 33);
    const int NGW = gridDim.x * 8;
    f32x4 v[8]; int mi, item;
    int g = blockIdx.x * 8 + wave;
    bool have = prep_locate(g, mi, item);
    MatDesc d = {};
    if (have) { d = get_mat(a, mi); prep_load(d, item, lane, v); }
    while (have) {
        prep_store_lds(scr, lane, v);
        const MatDesc dc = d; const int itc = item;
        g += NGW; have = prep_locate(g, mi, item);
        if (have) { d = get_mat(a, mi); prep_load(d, item, lane, v); }
        __builtin_amdgcn_wave_barrier();
        prep_write(dc, itc, lane, scr);
        __builtin_amdgcn_wave_barrier();
    }
    __syncthreads();
    scr = (LAS float*)lds;
    if (blockIdx.x < 2) {
        const int kv = blockIdx.x; const float* pe = IN(kv ? 18 : 17); const float* w1 = IN(kv ? 21 : 19);
        const int col = tid & 127, part = tid >> 7; float s = 0.f;
        for (int k = part * 512; k < part * 512 + 512; ++k) s += pe[k] * w1[(size_t)k * 128 + col];
        scr[tid] = s; __syncthreads();
        if (tid < 128) ((float*)(WSP + WS_B1))[kv * 128 + tid] = scr[tid] + scr[tid + 128] + scr[tid + 256] + scr[tid + 384];
        __syncthreads();
    }
}

__device__ __forceinline__ void phase_norm(const float* h, const float* g1, bf16* o1, const float* g2, bf16* o2) {
    int tid_ = threadIdx.x; asm volatile("" : "+v"(tid_));
    const int lane = tid_ & 63, wave = tid_ >> 6;
    const int gw = blockIdx.x * 8 + wave, NGW = gridDim.x * 8;
    f32x4 ga[4], gb[4];
#pragma unroll
    for (int j = 0; j < 4; ++j) { ga[j] = *(const f32x4*)(g1 + 4 * lane + 256 * j); gb[j] = g2 ? *(const f32x4*)(g2 + 4 * lane + 256 * j) : ga[j]; }
    for (int m = gw; m < T; m += NGW) {
        const f32x4* xr = (const f32x4*)(h + (size_t)m * DM) + lane;
        f32x4 v[4]; float s = 0.f;
#pragma unroll
        for (int j = 0; j < 4; ++j) { v[j] = xr[64 * j]; s += (v[j].x * v[j].x + v[j].y * v[j].y) + (v[j].z * v[j].z + v[j].w * v[j].w); }
        const float rstd = __builtin_amdgcn_rsqf(wave_sum(s) * (1.f / DM) + RMS_EPS);
        u64* p1 = (u64*)(o1 + (size_t)m * DM) + lane;
#pragma unroll
        for (int j = 0; j < 4; ++j) { const f32x4 y = v[j] * rstd * ga[j]; p1[64 * j] = (u64)cvt_pk(y.x, y.y) | ((u64)cvt_pk(y.z, y.w) << 32); }
        if (g2) { u64* p2 = (u64*)(o2 + (size_t)m * DM) + lane;
#pragma unroll
            for (int j = 0; j < 4; ++j) { const f32x4 y = v[j] * rstd * gb[j]; p2[64 * j] = (u64)cvt_pk(y.x, y.y) | ((u64)cvt_pk(y.z, y.w) << 32); } }
    }
}

constexpr size_t WS_SS = 131072;
__device__ __forceinline__ void phase_x(const float* x, bf16* hb, float* ss) {
    int tid_ = threadIdx.x; asm volatile("" : "+v"(tid_));
    const int lane = tid_ & 63, wave = tid_ >> 6;
    const int gw = blockIdx.x * 8 + wave, NGW = gridDim.x * 8;
    for (int i = blockIdx.x * 512 + tid_; i < 5 * T; i += gridDim.x * 512) ss[T + i] = 0.f;
    for (int m0 = gw; m0 < T; m0 += 2 * NGW) {
        const int m1 = m0 + NGW; const bool has1 = m1 < T; const int m1c = has1 ? m1 : m0;
        const f32x4* xa = (const f32x4*)(x + (size_t)m0 * DM) + lane; const f32x4* xb = (const f32x4*)(x + (size_t)m1c * DM) + lane;
        f32x4 va[4], vb[4]; float sa = 0.f, sb = 0.f;
#pragma unroll
        for (int j = 0; j < 4; ++j) { va[j] = xa[64 * j]; vb[j] = xb[64 * j]; }
#pragma unroll
        for (int j = 0; j < 4; ++j) { sa += (va[j].x * va[j].x + va[j].y * va[j].y) + (va[j].z * va[j].z + va[j].w * va[j].w); sb += (vb[j].x * vb[j].x + vb[j].y * vb[j].y) + (vb[j].z * vb[j].z + vb[j].w * vb[j].w); }
        sa = wave_sum(sa); sb = wave_sum(sb);
        u64* pa = (u64*)(hb + (size_t)m0 * DM) + lane; u64* pb = (u64*)(hb + (size_t)m1c * DM) + lane;
#pragma unroll
        for (int j = 0; j < 4; ++j) pa[64 * j] = (u64)cvt_pk(va[j].x, va[j].y) | ((u64)cvt_pk(va[j].z, va[j].w) << 32);
        if (has1) {
#pragma unroll
            for (int j = 0; j < 4; ++j) pb[64 * j] = (u64)cvt_pk(vb[j].x, vb[j].y) | ((u64)cvt_pk(vb[j].z, vb[j].w) << 32);
        }
        if (lane == 0) { ss[m0] = sa; if (has1) ss[m1] = sb; }
    }
}

__device__ __forceinline__ void unpack8(const u32x4 w, float (&f)[8]) {
    f[0] = __builtin_bit_cast(float, w.x << 16); f[1] = __builtin_bit_cast(float, w.x & 0xffff0000u); f[2] = __builtin_bit_cast(float, w.y << 16); f[3] = __builtin_bit_cast(float, w.y & 0xffff0000u);
    f[4] = __builtin_bit_cast(float, w.z << 16); f[5] = __builtin_bit_cast(float, w.z & 0xffff0000u); f[6] = __builtin_bit_cast(float, w.w << 16); f[7] = __builtin_bit_cast(float, w.w & 0xffff0000u);
}
__device__ __forceinline__ void phase_conv(const bf16* Bg, const bf16* U, const float* cw, bf16* Z) {
    int tid_ = threadIdx.x; asm volatile("" : "+v"(tid_));
    const int tid = tid_, cc = tid & 127, trow = tid >> 7;
    float w0[8], w1[8], w2[8];
#pragma unroll
    for (int e = 0; e < 8; ++e) { w0[e] = cw[8 * cc + e]; w1[e] = cw[1024 + 8 * cc + e]; w2[e] = cw[2048 + 8 * cc + e]; }
    for (int tb = blockIdx.x; tb < T / 128; tb += gridDim.x) {
        const int tbeg = tb * 128 + trow * 32;
        float u1[8], u2[8];
        if ((tbeg & (SEQ - 1)) == 0) {
#pragma unroll
            for (int e = 0; e < 8; ++e) { u1[e] = 0.f; u2[e] = 0.f; }
        } else {
            unpack8(*(const u32x4*)(U + (size_t)(tbeg - 1) * DM + 8 * cc), u1);
            unpack8(*(const u32x4*)(U + (size_t)(tbeg - 2) * DM + 8 * cc), u2);
        }
#pragma unroll 4
        for (int i = 0; i < 32; ++i) {
            const size_t p = (size_t)(tbeg + i) * DM + 8 * cc;
            float u0[8], bgv[8], z[8];
            unpack8(*(const u32x4*)(U + p), u0); unpack8(*(const u32x4*)(Bg + p), bgv);
#pragma unroll
            for (int e = 0; e < 8; ++e) { z[e] = bgv[e] * (w0[e] * u2[e] + w1[e] * u1[e] + w2[e] * u0[e]); u2[e] = u1[e]; u1[e] = u0[e]; }
            u32x4 o; o.x = cvt_pk(z[0], z[1]); o.y = cvt_pk(z[2], z[3]); o.z = cvt_pk(z[4], z[5]); o.w = cvt_pk(z[6], z[7]);
            *(u32x4*)(Z + p) = o;
        }
    }
}

__device__ __forceinline__ void phase_compress(const Args& a, LAS unsigned char* lds, size_t off_kc = WS_KC, size_t off_vct = WS_VCT) {
    unsigned char* ws = WSP;
    int tid_ = threadIdx.x; asm volatile("" : "+v"(tid_));
    const int tid = tid_, lane = tid & 63, w = tid >> 6, lc = lane & 15, lg = lane >> 4;
    LAS bf16* hid = (LAS bf16*)lds;
    LAS float* outf = (LAS float*)(lds + 32 * 136 * 2);
    for (int u2 = blockIdx.x * 2; u2 < 512; u2 += gridDim.x * 2)
    for (int uu = u2; uu < u2 + 2; ++uu) {
        const int kv = uu >> 8, R0 = (uu & 255) * 32;
        const bf16* raw = (const bf16*)(ws + (kv ? WS_VCR : WS_KCR));
        const bf16* w1t = (const bf16*)(ws + (kv ? WS_W1V : WS_W1K));
        const bf16* w2t = (const bf16*)(ws + (kv ? WS_W2V : WS_W2K));
        const float* b1 = (const float*)(ws + WS_B1) + kv * 128;
        f32x4 acc[2] = {{0.f, 0.f, 0.f, 0.f}, {0.f, 0.f, 0.f, 0.f}};
        const bf16* ap0 = raw + (size_t)(R0 + lc) * 1024 + 8 * lg;
        const bf16* ap1 = ap0 + (size_t)16 * 1024;
        const bf16* bp = w1t + (size_t)(16 * w + lc) * 2048 + 8 * lg;
        bf16x8 A0[4], A1[4], B[4];
#pragma unroll
        for (int s = 0; s < 4; ++s) { A0[s] = *(const bf16x8*)(ap0 + 32 * s); A1[s] = *(const bf16x8*)(ap1 + 32 * s); B[s] = *(const bf16x8*)(bp + 32 * s); }
        for (int k0 = 0; k0 < 2048; k0 += 128) {
            bf16x8 nA0[4], nA1[4], nB[4];
            const int kn = (k0 + 128 < 2048) ? k0 + 128 : k0;
#pragma unroll
            for (int s = 0; s < 4; ++s) { nA0[s] = *(const bf16x8*)(ap0 + kn + 32 * s); nA1[s] = *(const bf16x8*)(ap1 + kn + 32 * s); nB[s] = *(const bf16x8*)(bp + kn + 32 * s); }
#pragma unroll
            for (int s = 0; s < 4; ++s) { acc[0] = __builtin_amdgcn_mfma_f32_16x16x32_bf16(A0[s], B[s], acc[0], 0, 0, 0); acc[1] = __builtin_amdgcn_mfma_f32_16x16x32_bf16(A1[s], B[s], acc[1], 0, 0, 0); }
#pragma unroll
            for (int s = 0; s < 4; ++s) { A0[s] = nA0[s]; A1[s] = nA1[s]; B[s] = nB[s]; }
        }
        { const int col = 16 * w + lc; const float bb = b1[col];
#pragma unroll
          for (int rt = 0; rt < 2; ++rt)
#pragma unroll
            for (int r = 0; r < 4; ++r) { const float x = acc[rt][r] + bb; const float y = 2.f * 0.7978845608028654f * (x + 0.044715f * x * x * x);
                const float gl = x * __builtin_amdgcn_rcpf(1.f + __builtin_amdgcn_exp2f(-LOG2E * y));
                hid[(16 * rt + 4 * lg + r) * 136 + col] = (bf16)(cvt_pk(gl, 0.f) & 0xffffu); } }
        __syncthreads();
        { const int rt = w >> 2, ct = w & 3; f32x4 o = {0.f, 0.f, 0.f, 0.f};
#pragma unroll
          for (int ks = 0; ks < 4; ++ks) { const bf16x8 A = *(const LAS bf16x8*)(hid + (16 * rt + lc) * 136 + 32 * ks + 8 * lg); const bf16x8 B = *(const bf16x8*)(w2t + (size_t)(16 * ct + lc) * 128 + 32 * ks + 8 * lg);
              o = __builtin_amdgcn_mfma_f32_16x16x32_bf16(A, B, o, 0, 0, 0); }
#pragma unroll
          for (int r = 0; r < 4; ++r) outf[(16 * rt + 4 * lg + r) * 65 + 16 * ct + lc] = o[r]; }
        __syncthreads();
        { const int row = tid >> 4, d0 = 4 * (tid & 15); const int R = R0 + row, bg = R >> 9, i = R & 511;
          float v[4]; float ss = 0.f;
#pragma unroll
          for (int e = 0; e < 4; ++e) { v[e] = outf[row * 65 + d0 + e]; ss += v[e] * v[e]; }
          if (kv == 0) {
              ss += __shfl_xor(ss, 1); ss += __shfl_xor(ss, 2); ss += __shfl_xor(ss, 4); ss += __shfl_xor(ss, 8);
              const float rstd = __builtin_amdgcn_rsqf(ss * (1.f / 64.f) + RMS_EPS); const float* kn = IN(16);
#pragma unroll
              for (int e = 0; e < 4; ++e) v[e] = (i == 511) ? 0.f : v[e] * rstd * kn[d0 + e];
              bf16* dst = (bf16*)(ws + off_kc) + ((size_t)bg * NCB + i) * 64 + d0;
              *(u64*)dst = (u64)cvt_pk(v[0], v[1]) | ((u64)cvt_pk(v[2], v[3]) << 32);
          } else {
              bf16* dst = (bf16*)(ws + off_vct) + ((size_t)bg * 64 + d0) * NCB + i;
#pragma unroll
              for (int e = 0; e < 4; ++e) dst[(size_t)e * NCB] = (i == 511) ? (bf16)0 : (bf16)(cvt_pk(v[e], 0.f) & 0xffffu);
          } }
        __syncthreads();
    }
}

constexpr int A_IMP = 0, A_RING = 32768, TILE_PITCH = 192  , TILE_B = 64 * TILE_PITCH, STAGE_B = 2 * TILE_B,
              A_SELQ = A_RING + 2 * STAGE_B, A_BIAS = A_SELQ + 1024, A_MB = A_BIAS + 512, A_OUT = A_MB + 512;
constexpr int RELMAX_BIG = 0x40000000;

template <int MODE, int BM = 0, bool SEL = false>
__device__ __forceinline__ void attn_core(const bf16x8 (&kf)[4][2], const bf16x8 (&vf)[4][2], const bf16x8 (&qf)[2], int tq, int pbase, int pstride, int relmax,
                                          const LAS float* biasrow, float pscale, f32x4 (&oacc)[4], float& lsum, LAS float* improw, int jbase, int lg, int h, float pbias = 0.f, float pbias2 = 0.f, int thr = 0) {
    f32x4 s[4];
#pragma unroll
    for (int kt = 0; kt < 4; ++kt) {
        s[kt] = __builtin_amdgcn_mfma_f32_16x16x32_bf16(kf[kt][0], qf[0], (f32x4){0.f, 0.f, 0.f, 0.f}, 0, 0, 0);
        s[kt] = __builtin_amdgcn_mfma_f32_16x16x32_bf16(kf[kt][1], qf[1], s[kt], 0, 0, 0);
    }
#pragma unroll
    for (int kt = 0; kt < 4; ++kt) {
        const int kap0 = 32 * (kt >> 1) + 8 * lg + 4 * (kt & 1);
        const int rel0 = tq - (pbase + kap0 * pstride);
#pragma unroll
        for (int r = 0; r < 4; ++r) {
            float p;
            if (BM == 1) {
                p = __builtin_amdgcn_exp2f(s[kt][r] + pbias);
            } else if (BM == 2) {
                const int rel = rel0 - r * pstride;
                p = __builtin_amdgcn_exp2f(s[kt][r] + (rel >= thr ? pbias2 : pbias));
            } else if (BM == 3) {
                const int rel = rel0 - r * pstride;
                int bk = 39 - __clz((int)__umul24((unsigned)rel, (unsigned)rel)); bk = bk > 31 ? 31 : bk;
                p = __builtin_amdgcn_exp2f(s[kt][r] + biasrow[bk]);
                if (SEL) p = tq >= 0 ? p : 0.f;
            } else {
            const int rel = rel0 - r * pstride;
            const bool valid = (unsigned)rel < (unsigned)relmax;
            const int n = valid ? rel : 0;
            const int nn = (int)__umul24((unsigned)n, (unsigned)n);
            int bk = 39 - __clz(nn); bk = bk > 31 ? 31 : bk; bk = n < 16 ? n : bk;
            const float x = s[kt][r] + biasrow[bk];
            p = valid ? __builtin_amdgcn_exp2f(x) : 0.f;
            }
            if (MODE == 2) p *= pscale;
            s[kt][r] = p; lsum += p;
        }
        __builtin_amdgcn_sched_barrier(0);
        if (MODE == 2) {
            float av = 2.f * (s[kt][0] + s[kt][1] + s[kt][2]) + s[kt][3], bv = s[kt][3];
            av += __shfl_xor(av, 1); av += __shfl_xor(av, 2); bv += __shfl_xor(bv, 1); bv += __shfl_xor(bv, 2);
            if (h == 0) { const int j = jbase + (kap0 >> 2);
                improw[j] = improw[j] + av;
                if (j + 1 < 128) improw[j + 1] = improw[j + 1] + bv; }
        }
    }
    if (MODE >= 1) {
#pragma unroll
        for (int hh = 0; hh < 2; ++hh) {
            u32x4 pw; pw.x = cvt_pk(s[2 * hh][0], s[2 * hh][1]); pw.y = cvt_pk(s[2 * hh][2], s[2 * hh][3]); pw.z = cvt_pk(s[2 * hh + 1][0], s[2 * hh + 1][1]); pw.w = cvt_pk(s[2 * hh + 1][2], s[2 * hh + 1][3]);
            const bf16x8 pf = __builtin_bit_cast(bf16x8, pw);
#pragma unroll
            for (int dt = 0; dt < 4; ++dt) oacc[dt] = __builtin_amdgcn_mfma_f32_16x16x32_bf16(vf[dt][hh], pf, oacc[dt], 0, 0, 0);
        }
    }
}
__device__ __forceinline__ int rel_bucket_i(int n) { int bk = 39 - __clz((int)((unsigned)n * (unsigned)n)); bk = bk > 31 ? 31 : bk; return n < 16 ? n : bk; }
template <int MODE, bool SEL>
__device__ __forceinline__ void tile_stream(LAS unsigned char* ring, const bf16* Kbase, const bf16* Vbase, int ldv, int nt, int pb0, int pbstep, int pstride, int relmax,
                                            const bf16x8 (&qf)[2][2], const int (&tq)[2], const LAS float* biasrow, const float (&psc)[2], f32x4 (&oacc)[2][4], float (&ls)[2],
                                            LAS float* imp0, LAS float* imp1, const LAS u64* selA, const LAS u64* selB, int tid, int lc, int lg, int h) {
    const int row = tid >> 3, ch = tid & 7;
    const bf16* kp = Kbase + row * 64 + ch * 8;
    const bf16* vp = Vbase + (size_t)row * ldv + ch * 8;
    const int woff = row * TILE_PITCH + ch * 16;
    const float bfar = biasrow[31]; const int tqlo = __builtin_amdgcn_readfirstlane(tq[0]) ;
    u32x4 rk = {0u, 0u, 0u, 0u}, rv = {0u, 0u, 0u, 0u};
    if (nt > 0) { rk = *(const u32x4*)kp; if (MODE > 0) rv = *(const u32x4*)vp; }
#define TILE_STEP(t, rk, rv) do { \
        LAS unsigned char* st = ring + (t & 1) * STAGE_B; \
        *(LAS u32x4*)(st + woff) = rk; if (MODE > 0) *(LAS u32x4*)(st + TILE_B + woff) = rv; \
        asm volatile("s_waitcnt lgkmcnt(0)" ::: "memory"); __builtin_amdgcn_s_barrier(); asm volatile("" ::: "memory"); \
        if (t + 2 < nt) { rk = *(const u32x4*)(kp + (size_t)(t + 2) * 4096); if (MODE > 0) rv = *(const u32x4*)(vp + (t + 2) * 64); } \
        int tq0 = tq[0], tq1 = tq[1]; bool do0 = true, do1 = true; \
        if (SEL) { \
            const bool b0 = ((selA[t >> 6] >> (t & 63)) & 1ull) != 0ull, b1 = ((selB[t >> 6] >> (t & 63)) & 1ull) != 0ull; \
            tq0 = b0 ? tq0 : -1; tq1 = b1 ? tq1 : -1; do0 = __ballot(b0) != 0ull; do1 = __ballot(b1) != 0ull; \
        } \
        if (do0 || do1) { \
            bf16x8 kf[4][2], vf[4][2]; \
_Pragma("unroll") \
            for (int kt = 0; kt < 4; ++kt) { const LAS unsigned char* p = st + (32 * (kt >> 1) + 8 * (lc >> 2) + 4 * (kt & 1) + (lc & 3)) * TILE_PITCH + 16 * lg; \
                kf[kt][0] = *(const LAS bf16x8*)p; kf[kt][1] = *(const LAS bf16x8*)(p + 64); } \
            if (MODE > 0) { \
_Pragma("unroll") \
                for (int dt = 0; dt < 4; ++dt) { const LAS unsigned char* p = st + TILE_B + (16 * dt + lc) * TILE_PITCH + 16 * lg; \
                    vf[dt][0] = *(const LAS bf16x8*)p; vf[dt][1] = *(const LAS bf16x8*)(p + 64); } \
            } \
            const int pbase = pb0 + t * pbstep; \
            { \
 \
                const int rlo = tqlo - (pbase + 63 * pstride), rhi = tqlo + 7 - pbase; \
                const int blo = rel_bucket_i(rlo < 0 ? 0 : rlo), bhi = rel_bucket_i(rhi < 0 ? 0 : rhi); \
                if (rlo >= 0 && rhi < relmax && bhi - blo <= 1) { \
                    int thr = 0x7fffffff; \
                    if (bhi != blo) { int a = rlo, b = rhi; \
                        while (b - a > 1) { const int mid = (a + b) >> 1; if (rel_bucket_i(mid) == blo) a = mid; else b = mid; } \
                        thr = b; } \
                    const float pb1 = biasrow[blo], pb2 = biasrow[bhi]; \
                    const float pa0 = (!SEL || tq0 >= 0) ? pb1 : -1e30f, pa1 = (!SEL || tq0 >= 0) ? pb2 : -1e30f, pc0 = (!SEL || tq1 >= 0) ? pb1 : -1e30f, pc1 = (!SEL || tq1 >= 0) ? pb2 : -1e30f; \
                    if (bhi == blo) { \
                        if (do0) attn_core<MODE, 1, SEL>(kf, vf, qf[0], tq0, pbase, pstride, relmax, biasrow, psc[0], oacc[0], ls[0], imp0, 16 * t, lg, h, pa0); \
                        if (do1) attn_core<MODE, 1, SEL>(kf, vf, qf[1], tq1, pbase, pstride, relmax, biasrow, psc[1], oacc[1], ls[1], imp1, 16 * t, lg, h, pc0); \
                    } else { \
                        if (do0) attn_core<MODE, 2, SEL>(kf, vf, qf[0], tq[0], pbase, pstride, relmax, biasrow, psc[0], oacc[0], ls[0], imp0, 16 * t, lg, h, pa0, pa1, thr); \
                        if (do1) attn_core<MODE, 2, SEL>(kf, vf, qf[1], tq[1], pbase, pstride, relmax, biasrow, psc[1], oacc[1], ls[1], imp1, 16 * t, lg, h, pc0, pc1, thr); \
                    } \
                } else if (rlo >= 16 && rhi < relmax) { \
                    if (do0) attn_core<MODE, 3, SEL>(kf, vf, qf[0], tq0, pbase, pstride, relmax, biasrow, psc[0], oacc[0], ls[0], imp0, 16 * t, lg, h); \
                    if (do1) attn_core<MODE, 3, SEL>(kf, vf, qf[1], tq1, pbase, pstride, relmax, biasrow, psc[1], oacc[1], ls[1], imp1, 16 * t, lg, h); \
                } else { \
                    if (do0) attn_core<MODE>(kf, vf, qf[0], tq0, pbase, pstride, relmax, biasrow, psc[0], oacc[0], ls[0], imp0, 16 * t, lg, h); \
                    if (do1) attn_core<MODE>(kf, vf, qf[1], tq1, pbase, pstride, relmax, biasrow, psc[1], oacc[1], ls[1], imp1, 16 * t, lg, h); \
                } \
            } \
        } \
    } while (0)
    u32x4 rk1 = {0u, 0u, 0u, 0u}, rv1 = {0u, 0u, 0u, 0u};
    if (nt > 1) { rk1 = *(const u32x4*)(kp + 4096); if (MODE > 0) rv1 = *(const u32x4*)(vp + 64); }
    for (int t2 = 0; t2 < nt; t2 += 2) {
        { const int t = t2; TILE_STEP(t, rk, rv); }
        if (t2 + 1 < nt) { const int t = t2 + 1; TILE_STEP(t, rk1, rv1); }
    }
#undef TILE_STEP
    __syncthreads();
}

__device__ __forceinline__ void phase_attn(const Args& a, LAS unsigned char* lds) {
    unsigned char* ws = WSP;
    int tid_ = threadIdx.x; asm volatile("" : "+v"(tid_));
    const int w = __builtin_amdgcn_readfirstlane(tid_ >> 6);
    LAS float* imp = (LAS float*)(lds + A_IMP);
    LAS unsigned char* ring = lds + A_RING;
    LAS u64* selq = (LAS u64*)(lds + A_SELQ);
    LAS float* biasL = (LAS float*)(lds + A_BIAS);
    LAS float* mbound = (LAS float*)(lds + A_MB);
    const bf16* Q = (const bf16*)(ws + WS_Q);
    const float* gates = (const float*)(ws + WS_GATES);
    const float* relb = IN(23);
    if (w == 0) {
        const int lane = tid_ & 63;
        float mq = fabsf(IN(12)[lane]);
        float mk = fmaxf(fabsf(IN(16)[lane]), fmaxf(fabsf(IN(16)[64 + lane]), fabsf(IN(16)[128 + lane])));
        mq = wave_max(mq); mk = wave_max(mk);
        float mb = -1e30f;
        if (lane < 16) { for (int bk = 0; bk < 32; ++bk) mb = fmaxf(mb, relb[bk * 16 + lane]); mbound[lane] = mb + 8.f * mq * mk; }
    }
    __syncthreads();
    const int nunits = 2048, G = gridDim.x, bx = blockIdx.x;
    for (int it = 0; ; ++it) {
        int bg, qb;
        if (G == 256) {
            if (it >= 8) break;
            const int slot = bx >> 3, oo = slot >> 1; bg = 2 * (bx & 7) + (slot & 1);
            qb = (it & 1) ? 127 - 16 * (it >> 1) - oo : 16 * (it >> 1) + oo;
        } else {
            const int u = bx + it * G; if (u >= nunits) break;
            const int rr = u >> 4, ui = rr >> 4, oo = rr & 15; bg = u & 15;
            qb = (ui & 1) ? 127 - 16 * (ui >> 1) - oo : 16 * (ui >> 1) + oo;
        }
        const int b = bg >> 2, grp = bg & 3, t0 = 64 * qb, tokbase = b * SEQ + t0;
        int tidu = tid_; asm volatile("" : "+v"(tidu));
        const int tid = tidu, lane = tid & 63, lc = lane & 15, lg = lane >> 4, hq = lc >> 2, h = lc & 3;
        const u64 ltmask = (1ull << lane) - 1ull;
        for (int i = tid; i < 8192; i += 512) imp[i] = 0.f;
        if (tid < 128) { const int hh = tid >> 5, bk = tid & 31; biasL[tid] = (relb[bk * 16 + grp * 4 + hh] - mbound[grp * 4 + hh]) * LOG2E; }
        __syncthreads();
        const LAS float* biasrow = biasL + h * 32;
        bf16x8 qf[2][2]; int tqd[2]; float g0[2], g1[2], g2[2];
#pragma unroll
        for (int ct = 0; ct < 2; ++ct) { const int q = 8 * w + 4 * ct + hq; tqd[ct] = t0 + q;
            const bf16* qp = Q + (size_t)(tokbase + q) * DM + (grp * 4 + h) * 64 + 8 * lg; qf[ct][0] = *(const bf16x8*)qp; qf[ct][1] = *(const bf16x8*)(qp + 32);
            const float* gp = gates + (size_t)(tokbase + q) * 48 + (grp * 4 + h) * 3; g0[ct] = gp[0]; g1[ct] = gp[1]; g2[ct] = gp[2]; }
        LAS float* imp0 = imp + (8 * w + hq) * 128; LAS float* imp1 = imp + (8 * w + 4 + hq) * 128;
        LAS float* outp[2] = {(LAS float*)(lds + A_OUT) + ((8 * w + hq) * 4 + h) * 64 + 4 * lg, (LAS float*)(lds + A_OUT) + ((8 * w + 4 + hq) * 4 + h) * 64 + 4 * lg};
        const float one2[2] = {1.f, 1.f};
        {
            const int ncb = 4 * qb + 3, ntc = (ncb + 63) >> 6;
            const bf16* Kc = (const bf16*)(ws + WS_KC) + (size_t)bg * NCB * 64;
            const bf16* VcT = (const bf16*)(ws + WS_VCT) + (size_t)bg * 64 * NCB;
            float ls[2] = {0.f, 0.f}; f32x4 oc[2][4];
#pragma unroll
            for (int ct = 0; ct < 2; ++ct)
#pragma unroll
                for (int dt = 0; dt < 4; ++dt) oc[ct][dt] = (f32x4){0.f, 0.f, 0.f, 0.f};
            tile_stream<0, false>(ring, Kc, VcT, NCB, ntc, 31, 1024, 16, RELMAX_BIG, qf, tqd, biasrow, one2, oc, ls, imp0, imp1, selq, selq, tid, lc, lg, h);
            float inv[2];
#pragma unroll
            for (int ct = 0; ct < 2; ++ct) { float l = ls[ct]; l += __shfl_xor(l, 16); l += __shfl_xor(l, 32); inv[ct] = l > 0.f ? 1.f / l : 0.f; }
            float dummy[2] = {0.f, 0.f};
            tile_stream<2, false>(ring, Kc, VcT, NCB, ntc, 31, 1024, 16, RELMAX_BIG, qf, tqd, biasrow, inv, oc, dummy, imp0, imp1, selq, selq, tid, lc, lg, h);
#pragma unroll
            for (int ct = 0; ct < 2; ++ct)
#pragma unroll
                for (int dt = 0; dt < 4; ++dt) *(LAS f32x4*)(outp[ct] + 16 * dt) = oc[ct][dt] * g0[ct];
        }
        for (int qi = 0; qi < 8; ++qi) {
            const int q = 8 * w + qi; u64 lo, hi;
            if (qb < 16) { lo = (2ull << qb) - 1ull; hi = 0ull; }
            else {
                const int j0 = lane, j1 = lane + 64;
                const bool c0 = (j0 >= 1 && j0 <= qb - 2), c1 = (j1 <= qb - 2);
                const unsigned key0 = c0 ? __builtin_bit_cast(unsigned, imp[q * 128 + j0]) : 0u, key1 = c1 ? __builtin_bit_cast(unsigned, imp[q * 128 + j1]) : 0u;
                unsigned Tk = 0u;
                for (int bit = 30; bit >= 0; --bit) { const unsigned trial = Tk | (1u << bit);
                    const int cnt = __popcll(__ballot(key0 >= trial)) + __popcll(__ballot(key1 >= trial)); if (cnt >= 13) Tk = trial; }
                const bool gt0 = key0 > Tk, gt1 = key1 > Tk, e0 = (key0 == Tk) && c0, e1 = (key1 == Tk) && c1;
                const int need = 13 - (__popcll(__ballot(gt0)) + __popcll(__ballot(gt1)));
                const u64 m0 = __ballot(e0), m1 = __ballot(e1);
                const int r0 = __popcll(m0 & ltmask), r1 = __popcll(m0) + __popcll(m1 & ltmask);
                const bool s0 = gt0 || (e0 && r0 < need) || j0 == 0 || j0 == qb || j0 == qb - 1;
                const bool s1 = gt1 || (e1 && r1 < need) || j1 == qb || j1 == qb - 1;
                lo = __ballot(s0); hi = __ballot(s1);
            }
            if (lane == 0) { selq[q * 2] = lo; selq[q * 2 + 1] = hi; }
        }
        __builtin_amdgcn_wave_barrier();
        {
            const int tf = qb >= 8 ? 0 : 8 - qb, p0 = t0 - 512 + 64 * tf;
            const bf16* Kw = (const bf16*)(ws + WS_KW) + ((size_t)bg * SEQ + p0) * 64;
            const bf16* VwT = (const bf16*)(ws + WS_VWT) + (size_t)bg * 64 * SEQ + p0;
            float ls[2] = {0.f, 0.f}; f32x4 ow[2][4];
#pragma unroll
            for (int ct = 0; ct < 2; ++ct)
#pragma unroll
                for (int dt = 0; dt < 4; ++dt) ow[ct][dt] = (f32x4){0.f, 0.f, 0.f, 0.f};
            tile_stream<1, false>(ring, Kw, VwT, SEQ, 9 - tf, p0, 64, 1, 512, qf, tqd, biasrow, one2, ow, ls, imp0, imp1, selq, selq, tid, lc, lg, h);
#pragma unroll
            for (int ct = 0; ct < 2; ++ct) { float l = ls[ct]; l += __shfl_xor(l, 16); l += __shfl_xor(l, 32); const float sc = g2[ct] / l;
#pragma unroll
                for (int dt = 0; dt < 4; ++dt) *(LAS f32x4*)(outp[ct] + 16 * dt) = *(LAS f32x4*)(outp[ct] + 16 * dt) + ow[ct][dt] * sc; }
        }
        {
            const bf16* Ks = (const bf16*)(ws + WS_KS) + (size_t)bg * SEQ * 64;
            const bf16* VsT = (const bf16*)(ws + WS_VST) + (size_t)bg * 64 * SEQ;
            float ls[2] = {0.f, 0.f}; f32x4 os[2][4];
#pragma unroll
            for (int ct = 0; ct < 2; ++ct)
#pragma unroll
                for (int dt = 0; dt < 4; ++dt) os[ct][dt] = (f32x4){0.f, 0.f, 0.f, 0.f};
            tile_stream<1, true>(ring, Ks, VsT, SEQ, qb + 1, 0, 64, 1, RELMAX_BIG, qf, tqd, biasrow, one2, os, ls, imp0, imp1, selq + (8 * w + hq) * 2, selq + (8 * w + 4 + hq) * 2, tid, lc, lg, h);
            bf16* AO = (bf16*)(ws + WS_AO);
#pragma unroll
            for (int ct = 0; ct < 2; ++ct) { float l = ls[ct]; l += __shfl_xor(l, 16); l += __shfl_xor(l, 32); const float sc = g1[ct] / l;
                bf16* op = AO + (size_t)(tokbase + 8 * w + 4 * ct + hq) * DM + (grp * 4 + h) * 64 + 4 * lg;
#pragma unroll
                for (int dt = 0; dt < 4; ++dt) { const f32x4 v = *(LAS f32x4*)(outp[ct] + 16 * dt) + os[ct][dt] * sc; *(u64*)(op + 16 * dt) = (u64)cvt_pk(v[0], v[1]) | ((u64)cvt_pk(v[2], v[3]) << 32); } }
        }
    }
}

#define XB_TMO      128
#define XB_XCNT(j)  (256  + 64 * (j))
#define XB_XSUB(j)  (1280 + 64 * (j))
#define XB_XGEN(j)  (2304 + 64 * (j))
#define XB_TOP      3328
#define XB_TOPGEN   3392
#define XCD_BAR_WORDS 3456
#define XB_SPIN_CAP (1u << 23)

__device__ __forceinline__ unsigned xb_ld(unsigned* p)              { return __hip_atomic_load(p, __ATOMIC_RELAXED, __HIP_MEMORY_SCOPE_AGENT); }
__device__ __forceinline__ unsigned xb_add(unsigned* p, unsigned v) { return __hip_atomic_fetch_add(p, v, __ATOMIC_RELAXED, __HIP_MEMORY_SCOPE_AGENT); }
__device__ __forceinline__ unsigned xb_xcc_id() { return (unsigned)__builtin_amdgcn_s_getreg((3 << 11) | 20) & 0xFu; }
#define XB_SPIN(cond, bar) do { unsigned _sp = 0; while (cond) { __builtin_amdgcn_s_sleep(1); \
    if ((++_sp & 255u) == 0u) { if (xb_ld(&(bar)[XB_TMO])) break; if (_sp > XB_SPIN_CAP) { atomicAdd(&(bar)[XB_TMO], 1u); break; } } } } while (0)

struct XcdBarrier {
    unsigned* bar; unsigned x;
    volatile LAS unsigned* st;
};

__device__ __forceinline__ XcdBarrier xcd_barrier_post(unsigned* bar, volatile LAS unsigned* st) {
    XcdBarrier b; b.bar = bar; b.x = xb_xcc_id(); b.st = st;
    if (threadIdx.x == 0) (void)xb_add(&bar[XB_XCNT(b.x)], 1u);
    return b;
}
__device__ __forceinline__ void xcd_barrier_complete(unsigned* bar, unsigned x, unsigned& nloc, unsigned& nx) {
    const unsigned G = gridDim.x * gridDim.y * gridDim.z;
    unsigned sum, cnt, mine, sp = 0u;
    for (;;) {
        sum = 0u; cnt = 0u; mine = 0u;
#pragma unroll
        for (unsigned j = 0; j < 16; ++j) { const unsigned c = xb_ld(&bar[XB_XCNT(j)]); sum += c; cnt += (c > 0u) ? 1u : 0u; mine = (j == x) ? c : mine; }
        if (sum == G) break;
        __builtin_amdgcn_s_sleep(1);
        if ((++sp & 255u) == 0u) { if (xb_ld(&bar[XB_TMO])) break; if (sp > XB_SPIN_CAP) { atomicAdd(&bar[XB_TMO], 1u); break; } }
    }
    nloc = mine > 0u ? mine : 1u; nx = cnt > 0u ? cnt : 1u;
}

__device__ __forceinline__ void xcd_barrier(const XcdBarrier& b) {
    asm volatile("s_waitcnt vmcnt(0)" ::: "memory");
    __syncthreads();
    if (threadIdx.x == 0) {
        unsigned* bar = b.bar;
        __builtin_amdgcn_s_waitcnt(0);
        unsigned nloc = b.st[0], nx = b.st[1];
        if (nloc == 0u) { xcd_barrier_complete(bar, b.x, nloc, nx); b.st[0] = nloc; b.st[1] = nx; }
        const unsigned old = xb_add(&bar[XB_XSUB(b.x)], 1u);
        const unsigned gen = old / nloc;
        if (old + 1u == (gen + 1u) * nloc) {
            __builtin_amdgcn_fence(__ATOMIC_RELEASE, "agent");
            asm volatile("s_waitcnt vmcnt(0)" ::: "memory");
            const unsigned og = xb_add(&bar[XB_TOP], 1u);
            const unsigned tg = og / nx;
            if (og + 1u == (tg + 1u) * nx) xb_add(&bar[XB_TOPGEN], 1u);
            else XB_SPIN(xb_ld(&bar[XB_TOPGEN]) == tg, bar);
            __builtin_amdgcn_fence(__ATOMIC_ACQUIRE, "agent");
            xb_add(&bar[XB_XGEN(b.x)], 1u);
            asm volatile("s_waitcnt vmcnt(0)" ::: "memory");
        } else {
            XB_SPIN(xb_ld(&bar[XB_XGEN(b.x)]) == gen, bar);
            __builtin_amdgcn_fence(__ATOMIC_ACQUIRE, "agent");
            asm volatile("s_waitcnt vmcnt(0)" ::: "memory");
        }
    }
    __syncthreads();
}


__global__ void __launch_bounds__(512, 2) mk_fwd(Args a) {
    extern __shared__ __attribute__((aligned(16))) unsigned char lds_raw[];
    LAS unsigned char* lds = (LAS unsigned char*)lds_raw;
    cg::grid_group grid = cg::this_grid();
    unsigned char* ws = WSP;
    const float* x = IN(0); float* hout = KA()->out;
    bf16* HN = (bf16*)(ws + WS_HN); bf16* HN2 = (bf16*)(ws + WS_HN2); bf16* ACT = (bf16*)(ws + WS_ACT);
    const int G = gridDim.x, bx = blockIdx.x;
#define GRID_SYNC() do { \
        if (sync_no == 0u) { asm volatile("s_waitcnt vmcnt(0) lgkmcnt(0)" ::: "memory"); grid.sync(); \
            if (threadIdx.x == 0) { __builtin_amdgcn_fence(__ATOMIC_ACQUIRE, "agent"); asm volatile("s_waitcnt vmcnt(0)" ::: "memory"); } __syncthreads(); \
            xb = xcd_barrier_post(bar_words, xb_st); } \
        else xcd_barrier(xb); \
        ++sync_no; } while (0)
#define GEMM(EPI, Aptr, Bptr, N_, K_, E) do { pg8::Gemm g_{(const pg8::bf16_t*)(Aptr), (const pg8::bf16_t*)(Bptr), T, (N_), (K_)}; pg8::StaticOrder S_; S_.init(T, (N_), G, bx); \
        pg8::gemm_phase<std::remove_cv_t<std::remove_reference_t<decltype(E)>>, pg8::StaticOrder, true, true>((PG8_LAS unsigned char*)lds, g_, S_, (E)); } while (0)

    unsigned* bar_words = (unsigned*)(ws + 4096); unsigned sync_no = 0u;
    for (int i = bx * 512 + threadIdx.x; i < XCD_BAR_WORDS; i += G * 512) __hip_atomic_store(bar_words + i, 0u, __ATOMIC_RELAXED, __HIP_MEMORY_SCOPE_AGENT);
    volatile LAS unsigned* xb_st = (volatile LAS unsigned*)(lds + LDS_BYTES - 16);
    if (threadIdx.x < 2) xb_st[threadIdx.x] = 0u;
    XcdBarrier xb; xb.bar = bar_words; xb.x = 0u; xb.st = xb_st;
    float* SS = (float*)(ws + WS_SS);
#define SSK(k) (SS + (size_t)(k) * T)
    phase_prep(a, lds);
    phase_x(x, HN, SS);
    GRID_SYNC();
    { pg8::EpiSwiglu E{ACT, DFF, SSK(0)}; GEMM(pg8::EpiSwiglu, HN, ws + WS_WIN, 2 * DFF, DM, E); }
    GRID_SYNC();
    { pg8::EpiResid<true, 1, 0, false> E{x, hout, HN, SSK(1)}; GEMM((pg8::EpiResid<true, 1, 0, false>), ACT, ws + WS_WOUT, DM, DFF, E); }
    GRID_SYNC();
    { pg8::EpiConvIn E{(bf16*)(ws + WS_BG), (bf16*)(ws + WS_U), SSK(1)}; GEMM(pg8::EpiConvIn, HN, ws + WS_CWIN, 3072, DM, E); }
    GRID_SYNC();
    phase_conv((const bf16*)(ws + WS_BG), (const bf16*)(ws + WS_U), IN(9), HN2);
    GRID_SYNC();
    { pg8::EpiResid<true, 2, 1, false> E{hout, hout, HN, SSK(2)}; GEMM((pg8::EpiResid<true, 2, 1, false>), HN2, ws + WS_CWOUT, DM, DM, E); }
    GRID_SYNC();
    { pg8::EpiSwiglu E{ACT, DFF, SSK(2)}; GEMM(pg8::EpiSwiglu, HN, ws + WS_WIN + SZ_WIN, 2 * DFF, DM, E); }
    GRID_SYNC();
    { pg8::EpiResid<true, 1, 1, false> E{hout, hout, HN, SSK(3)}; GEMM((pg8::EpiResid<true, 1, 1, false>), ACT, ws + WS_WOUT + SZ_WOUT, DM, DFF, E); }
    GRID_SYNC();
    { pg8::EpiKV E; E.Kb = (bf16*)(ws + WS_KCR); E.Vb = (bf16*)(ws + WS_VCR); E.brstride = KV_BYTES / 2; E.knorm = IN(16); E.ss = SSK(3);
      GEMM(pg8::EpiKV, HN, ws + WS_WKV, NKV, DM, E); }
    GRID_SYNC();
    phase_compress(a, lds);
    { pg8::EpiSwiglu E{ACT, DFF, SSK(3)}; GEMM(pg8::EpiSwiglu, HN, ws + WS_WIN + 2 * SZ_WIN, 2 * DFF, DM, E); }
    GRID_SYNC();
    { pg8::EpiResid<true, 1, 1, false> E{hout, hout, HN, SSK(4)}; GEMM((pg8::EpiResid<true, 1, 1, false>), ACT, ws + WS_WOUT + 2 * SZ_WOUT, DM, DFF, E); }
    GRID_SYNC();
    { pg8::EpiQ E{(bf16*)(ws + WS_Q), (float*)(ws + WS_GATES), IN(12), 0.125f * LOG2E, SSK(4)}; GEMM(pg8::EpiQ, HN, ws + WS_WQ, NQP, DM, E); }
    GRID_SYNC();
    phase_attn(a, lds);
    GRID_SYNC();
    { pg8::EpiResid<true, 2, 1, false> E{hout, hout, HN, SSK(5)}; GEMM((pg8::EpiResid<true, 2, 1, false>), ws + WS_AO, ws + WS_WO, DM, DM, E); }
    GRID_SYNC();
    { pg8::EpiSwiglu E{ACT, DFF, SSK(5)}; GEMM(pg8::EpiSwiglu, HN, ws + WS_WIN + 3 * SZ_WIN, 2 * DFF, DM, E); }
    GRID_SYNC();
    { pg8::EpiResid<false, 1, 1, true> E{hout, hout, HN, nullptr}; GEMM((pg8::EpiResid<false, 1, 1, true>), ACT, ws + WS_WOUT + 3 * SZ_WOUT, DM, DFF, E); }
#undef SSK
#undef GEMM
}

extern "C" void kernel_launch(void* const* d_in, const int* in_sizes, int n_in, void* d_out, int out_size, void* d_ws, size_t ws_size, hipStream_t stream) {
    static int grid = 0;
    if (grid == 0) {
        if (n_in != 24 || out_size != T * DM || ws_size < WS_END) { fprintf(stderr, "kernel_launch: unexpected problem (n_in %d out %d ws %zu)\n", n_in, out_size, ws_size); grid = -1; return; }
        int dev = 0, cus = 0, per_cu = 0;
        (void)hipGetDevice(&dev);
        (void)hipDeviceGetAttribute(&cus, hipDeviceAttributeMultiprocessorCount, dev);
        (void)hipFuncSetAttribute((const void*)mk_fwd, hipFuncAttributeMaxDynamicSharedMemorySize, LDS_BYTES);
        (void)hipOccupancyMaxActiveBlocksPerMultiprocessor(&per_cu, (const void*)mk_fwd, 512, LDS_BYTES);
        if (per_cu < 1) per_cu = 1;
        grid = cus * per_cu;
    }
    if (grid < 0) return;
    Args a{};
    for (int i = 0; i < 24; ++i) a.in[i] = (const float*)d_in[i];
    a.out = (float*)d_out; a.ws = (unsigned char*)d_ws;
    void* args[] = {&a};
    hipError_t e = hipLaunchCooperativeKernel((const void*)mk_fwd, dim3(grid), dim3(512), args, LDS_BYTES, stream);
    if (e != hipSuccess) fprintf(stderr, "cooperative launch failed: %s (grid %d)\n", hipGetErrorString(e), grid);
}
```
